# Optimizing an MI355X kernel written in HIP

```python
import math
import jax, jax.numpy as jnp
from jax import lax
import numpy as np

D_MODEL = 1024
BATCH = 2
SEQ = 8192
DEPTH = 2

CONV_WIDTH = D_MODEL // 2
CONV_K = 3
N_HEADS = 8
QK_NOPE_DIM = 64
QK_ROPE_DIM = 32
V_HEAD_DIM = 64
QK_HEAD_DIM = QK_NOPE_DIM + QK_ROPE_DIM
Q_LORA_RANK = 256
KV_LORA_RANK = 128
ROPE_THETA = 10000.0
Q_BLOCK = 128
N_BRANCHES = 2
IN_COLS = 3 * CONV_WIDTH + Q_LORA_RANK + KV_LORA_RANK + QK_ROPE_DIM + N_BRANCHES * D_MODEL
N_EXPERTS = 16
N_GROUPS = 4
EXPERTS_PER_GROUP = N_EXPERTS // N_GROUPS
TOP_K = 2
D_EXPERT = 256
D_SHARED = 256
EPS = 1e-6

kernel_name = "hybrid_conv_mla_grouped_moe_adaln_encoder"


def rmsnorm(x, g):
    xf = x.astype(jnp.float32)
    y = xf * lax.rsqrt(jnp.mean(xf * xf, axis=-1, keepdims=True) + EPS)
    return (y * g.astype(jnp.float32)).astype(x.dtype)


def rope(x, positions):
    half = QK_ROPE_DIM // 2
    inv_freq = ROPE_THETA ** (-jnp.arange(half, dtype=jnp.float32) / half)
    ang = positions.astype(jnp.float32)[..., None] * inv_freq
    cos = jnp.cos(ang)[:, :, None, :]
    sin = jnp.sin(ang)[:, :, None, :]
    xf = x.astype(jnp.float32)
    x1, x2 = xf[..., :half], xf[..., half:]
    out = jnp.concatenate([x1 * cos - x2 * sin, x2 * cos + x1 * sin], axis=-1)
    return out.astype(x.dtype)


def short_conv(u, w):
    pad = CONV_K // 2
    return lax.conv_general_dilated(
        u, w[:, None, :], window_strides=(1,), padding=[(pad, pad)],
        dimension_numbers=('NWC', 'WIO', 'NWC'), feature_group_count=u.shape[-1])


def block_attention(q, k, v):
    b, s, h, dq = q.shape
    nblk = s // Q_BLOCK
    scale = QK_HEAD_DIM ** -0.5
    qb = q.reshape(b, nblk, Q_BLOCK, h, dq).transpose(1, 0, 2, 3, 4)

    def one_block(qblk):
        sc = jnp.einsum('bqhd,bkhd->bhqk', qblk, k).astype(jnp.float32) * scale
        p = jax.nn.softmax(sc, axis=-1)
        return jnp.einsum('bhqk,bkhd->bqhd', p.astype(v.dtype), v)

    o = lax.map(one_block, qb)
    return o.transpose(1, 0, 2, 3, 4).reshape(b, s, h, v.shape[-1])


def mixer(h, positions, w_in, conv_w, g_q_a, w_uq, g_kv_a, w_ukv, g_qn, g_kn,
          w_conv_out, w_attn_out, w_o):
    b, s, _ = h.shape
    sizes = [CONV_WIDTH, CONV_WIDTH, CONV_WIDTH, Q_LORA_RANK, KV_LORA_RANK, QK_ROPE_DIM, D_MODEL]
    splits = [int(i) for i in np.cumsum(sizes)]
    proj = h @ w_in
    cb, cc, cx, cq, ckv, k_pe, ga, gb = jnp.split(proj, splits, axis=-1)

    ya = (cb * short_conv(cc * cx, conv_w)) @ w_conv_out

    q = (rmsnorm(cq, g_q_a) @ w_uq).reshape(b, s, N_HEADS, QK_HEAD_DIM)
    kv = (rmsnorm(ckv, g_kv_a) @ w_ukv).reshape(b, s, N_HEADS, QK_NOPE_DIM + V_HEAD_DIM)
    k_nope, v = kv[..., :QK_NOPE_DIM], kv[..., QK_NOPE_DIM:]
    k = jnp.concatenate(
        [k_nope, jnp.broadcast_to(k_pe[:, :, None, :], (b, s, N_HEADS, QK_ROPE_DIM))], axis=-1)
    q = rmsnorm(q, g_qn)
    k = rmsnorm(k, g_kn)
    q = jnp.concatenate([q[..., :QK_NOPE_DIM], rope(q[..., QK_NOPE_DIM:], positions)], axis=-1)
    k = jnp.concatenate([k[..., :QK_NOPE_DIM], rope(k[..., QK_NOPE_DIM:], positions)], axis=-1)
    o = block_attention(q, k, v).reshape(b, s, N_HEADS * V_HEAD_DIM)
    yb = o @ w_attn_out

    merged = jax.nn.sigmoid(ga) * ya + jax.nn.sigmoid(gb) * yb
    return merged @ w_o


def moe(h, w_router, b_router, w_e_gate, w_e_up, w_e_down, w_s_gate, w_s_up, w_s_down):
    scores = jax.nn.sigmoid(jnp.einsum('bsd,de->bse', h, w_router).astype(jnp.float32))
    biased = scores + b_router.astype(jnp.float32)
    grouped = biased.reshape(biased.shape[:-1] + (N_GROUPS, EXPERTS_PER_GROUP))
    group_score = lax.top_k(grouped, TOP_K)[0].sum(axis=-1)
    sel_group = jnp.argmax(group_score, axis=-1)
    expert_group = jnp.arange(N_EXPERTS) // EXPERTS_PER_GROUP
    masked = jnp.where(expert_group == sel_group[..., None], biased, -jnp.inf)
    _, idx = lax.top_k(masked, TOP_K)
    sel = jnp.take_along_axis(scores, idx, axis=-1)
    wts = sel / jnp.sum(sel, axis=-1, keepdims=True)
    combine = jnp.sum(jax.nn.one_hot(idx, N_EXPERTS, dtype=jnp.float32) * wts[..., None], axis=-2)

    a = jax.nn.silu(jnp.einsum('bsd,edf->bsef', h, w_e_gate)) * jnp.einsum('bsd,edf->bsef', h, w_e_up)
    a = a * combine.astype(h.dtype)[..., None]
    routed = jnp.einsum('bsef,efd->bsd', a, w_e_down)
    shared = (jax.nn.silu(h @ w_s_gate) * (h @ w_s_up)) @ w_s_down
    return routed + shared


def setup_inputs(seed: int = 0) -> dict:
    key = jax.random.key(seed)
    ks = jax.random.split(key, 32)
    f32 = jnp.float32

    def nrm(k, shape, fan_in, mult=1.0):
        return jax.random.normal(k, shape, f32) * (mult * fan_in ** -0.5)

    def gain(k, shape):
        return 1.0 + 0.02 * jax.random.normal(k, shape, f32)

    x = jax.random.normal(ks[0], (BATCH, SEQ, D_MODEL), f32)
    c = jax.random.normal(ks[1], (BATCH, D_MODEL), f32)
    offset = jax.random.randint(ks[2], (BATCH, 1), 0, SEQ, dtype=jnp.int32)
    positions = jnp.broadcast_to(jnp.arange(SEQ, dtype=jnp.int32)[None, :], (BATCH, SEQ)) + offset
    L = DEPTH
    return {
        'x': x,
        'c': c,
        'positions': positions,
        'w_ada': nrm(ks[3], (L, D_MODEL, 6 * D_MODEL), D_MODEL, 0.5),
        'b_ada': 0.01 * jax.random.normal(ks[4], (L, 6 * D_MODEL), f32),
        'g_mix': gain(ks[5], (L, D_MODEL)),
        'g_ffn': gain(ks[6], (L, D_MODEL)),
        'w_in': nrm(ks[7], (L, D_MODEL, IN_COLS), D_MODEL),
        'conv_w': nrm(ks[8], (L, CONV_K, CONV_WIDTH), CONV_K),
        'g_q_a': gain(ks[9], (L, Q_LORA_RANK)),
        'w_uq': nrm(ks[10], (L, Q_LORA_RANK, N_HEADS * QK_HEAD_DIM), Q_LORA_RANK),
        'g_kv_a': gain(ks[11], (L, KV_LORA_RANK)),
        'w_ukv': nrm(ks[12], (L, KV_LORA_RANK, N_HEADS * (QK_NOPE_DIM + V_HEAD_DIM)), KV_LORA_RANK),
        'g_qn': gain(ks[13], (L, QK_HEAD_DIM)),
        'g_kn': gain(ks[14], (L, QK_HEAD_DIM)),
        'w_conv_out': nrm(ks[15], (L, CONV_WIDTH, D_MODEL), CONV_WIDTH),
        'w_attn_out': nrm(ks[16], (L, N_HEADS * V_HEAD_DIM, D_MODEL), N_HEADS * V_HEAD_DIM),
        'w_o': nrm(ks[17], (L, D_MODEL, D_MODEL), D_MODEL),
        'w_router': nrm(ks[18], (D_MODEL, N_EXPERTS), D_MODEL),
        'b_router': 0.01 * jax.random.normal(ks[19], (N_EXPERTS,), f32),
        'w_e_gate': nrm(ks[20], (L, N_EXPERTS, D_MODEL, D_EXPERT), D_MODEL),
        'w_e_up': nrm(ks[21], (L, N_EXPERTS, D_MODEL, D_EXPERT), D_MODEL),
        'w_e_down': nrm(ks[22], (L, N_EXPERTS, D_EXPERT, D_MODEL), D_EXPERT),
        'w_s_gate': nrm(ks[23], (L, D_MODEL, D_SHARED), D_MODEL),
        'w_s_up': nrm(ks[24], (L, D_MODEL, D_SHARED), D_MODEL),
        'w_s_down': nrm(ks[25], (L, D_SHARED, D_MODEL), D_SHARED),
    }


def reference(x, c, positions, w_ada, b_ada, g_mix, g_ffn, w_in, conv_w, g_q_a, w_uq,
              g_kv_a, w_ukv, g_qn, g_kn, w_conv_out, w_attn_out, w_o, w_router, b_router,
              w_e_gate, w_e_up, w_e_down, w_s_gate, w_s_up, w_s_down):
    for l in range(DEPTH):
        mod = jax.nn.silu(c) @ w_ada[l] + b_ada[l]
        sh1, sc1, gt1, sh2, sc2, gt2 = jnp.split(mod[:, None, :], 6, axis=-1)
        h = rmsnorm(x, g_mix[l]) * (1 + sc1) + sh1
        x = x + gt1 * mixer(h, positions, w_in[l], conv_w[l], g_q_a[l], w_uq[l], g_kv_a[l],
                            w_ukv[l], g_qn[l], g_kn[l], w_conv_out[l], w_attn_out[l], w_o[l])
        h = rmsnorm(x, g_ffn[l]) * (1 + sc2) + sh2
        x = x + gt2 * moe(h, w_router, b_router, w_e_gate[l], w_e_up[l], w_e_down[l],
                          w_s_gate[l], w_s_up[l], w_s_down[l])
    return x
```

```cpp
#include <hip/hip_runtime.h>
#include <cstdio>
#include <cstdint>

#ifndef FAST_GEMM
#define FAST_GEMM 1
#endif
#ifndef FAST_B
#define FAST_B FAST_GEMM
#endif
#ifndef FAST_D
#define FAST_D FAST_GEMM
#endif
#ifndef FAST_G
#define FAST_G FAST_GEMM
#endif
#ifndef FAST_H
#define FAST_H FAST_GEMM
#endif
#ifndef FAST_I
#define FAST_I FAST_GEMM
#endif
#ifndef FAST_K
#define FAST_K FAST_GEMM
#endif
#ifndef FAST_L
#define FAST_L FAST_GEMM
#endif
#define FAST_ANY (FAST_B || FAST_D || FAST_G || FAST_H || FAST_I || FAST_K || FAST_L)
#ifndef USE_OLD_J
#define USE_OLD_J 0
#endif
#ifndef DBG_SHFL
#define DBG_SHFL 1
#endif
#ifndef FAST_ATTN
#define FAST_ATTN 1
#endif
#ifndef REP_F
#define REP_F 1
#endif
#ifndef REP_CVT
#define REP_CVT 1
#endif
#ifndef REP_B
#define REP_B 1
#endif
#ifndef REP_C
#define REP_C 1
#endif
#ifndef REP_D
#define REP_D 1
#endif
#ifndef REP_E
#define REP_E 1
#endif
#ifndef REP_K
#define REP_K 1
#endif
#ifndef REP_L
#define REP_L 1
#endif
#ifndef REP_J
#define REP_J 1
#endif
#ifndef REP_A0
#define REP_A0 1
#endif
#ifndef REP_P0
#define REP_P0 1
#endif
#ifndef REP_BAR
#define REP_BAR 1
#endif
#ifndef ATTN_W64
#define ATTN_W64 1
#endif
#ifndef MK_SPLIT
#define MK_SPLIT 0
#endif

#define GAS __attribute__((address_space(1)))
#define LAS __attribute__((address_space(3)))
typedef unsigned short bf16;
typedef unsigned v4u __attribute__((ext_vector_type(4)));
typedef unsigned v2u __attribute__((ext_vector_type(2)));
typedef float f32x4 __attribute__((ext_vector_type(4)));
typedef float f32x2 __attribute__((ext_vector_type(2)));
typedef unsigned short bf16x8 __attribute__((ext_vector_type(8)));
typedef unsigned short bf16x4 __attribute__((ext_vector_type(4)));
typedef GAS unsigned gu32;

constexpr int NB = 2, S = 8192, T = NB * S, D = 1024, H = 8, DQK = 96, DV = 64;
constexpr int NIN = 4000, CW = 512, QL = 256, KVL = 128, NE = 16, DE = 256, NEX = NE + 1;
constexpr float EPS = 1e-6f;
constexpr float QSCALE = 0.10206207261596577f * 1.4426950408889634f;
constexpr int NWAVES = 8, NTHREADS = 512;

constexpr size_t MiB = 1u << 20, KiB = 1u << 10;
constexpr size_t WS_CTL = 0, CTL_ZERO_BYTES = 64 * KiB;
constexpr size_t WS_MOD = 1 * MiB;
constexpr size_t WS_TOKS = WS_MOD + 128 * KiB;
constexpr size_t WS_TOKW = WS_TOKS + 128 * KiB;
constexpr size_t WS_RS = WS_TOKW + 128 * KiB;
constexpr size_t WS_ROPE = 2 * MiB;
constexpr size_t WS_LIST = 4 * MiB;
constexpr size_t WS_WT = 5 * MiB;
constexpr size_t WS_XN = 45 * MiB;
constexpr size_t WS_R1 = 109 * MiB;
constexpr size_t WS_R2 = 157 * MiB;
constexpr size_t WS_GA = 173 * MiB;
constexpr size_t WS_X16 = 77 * MiB;
#define GBP(F_) ((bf16*)((unsigned char*)(F_).out + 32 * MiB))
constexpr size_t WS_U = 205 * MiB;
constexpr size_t WS_K = WS_XN;
constexpr size_t WS_V = 245 * MiB;
constexpr size_t WS_END = 261 * MiB;
constexpr size_t WS_KVRAW = WS_XN, WS_CONV = WS_R1, WS_QRAW = 221 * MiB  , WS_Q = WS_R1 + 24 * MiB, WS_SMALL = WS_R2, WS_O = WS_R2;
constexpr size_t WS_A2 = WS_R1;
constexpr size_t WS_Y = WS_R1 + 26 * MiB;
constexpr int SLOTS_MAX = 3 * T + NE * 256;
static_assert(WS_Y + (size_t)SLOTS_MAX * 2048 <= WS_END, "MoE overlay");
constexpr int CW_CNT = 8192, CNT_LS = 2048, CNT_ES = 64;
static_assert((CW_CNT + 2 * CNT_LS) * 4 <= (int)CTL_ZERO_BYTES && (4096 + 3456) * 4 <= (int)CTL_ZERO_BYTES, "control words (barrier region at word 4096, 3456 words; counters) inside the per-call memset");
constexpr int CW_BASE = 192;
constexpr int CW_BAR = 4096;
constexpr int CW_KF = 12288;
static_assert((CW_KF + 2 * 256) * 4 <= (int)CTL_ZERO_BYTES && CW_KF >= CW_CNT + 2 * CNT_LS, "slot-tile flags inside the per-call memset");

#define RLX_AGENT __ATOMIC_RELAXED, __HIP_MEMORY_SCOPE_AGENT
__device__ __forceinline__ unsigned f2bf(float f) { unsigned u = __builtin_bit_cast(unsigned, f); return (u + 0x7fffu + ((u >> 16) & 1u)) >> 16; }
typedef __bf16 hwbf16x2 __attribute__((ext_vector_type(2)));
__device__ __forceinline__ unsigned pk2(float lo, float hi) { f32x2 v = {lo, hi}; hwbf16x2 b = __builtin_convertvector(v, hwbf16x2); return __builtin_bit_cast(unsigned, b); }
__device__ __forceinline__ float bf2f(unsigned short b) { return __builtin_bit_cast(float, (unsigned)b << 16); }
template <int CTRL> __device__ __forceinline__ float dpp_mov(float v) { return __builtin_bit_cast(float, __builtin_amdgcn_update_dpp(0, __builtin_bit_cast(int, v), CTRL, 0xF, 0xF, false)); }
template <int K> __device__ __forceinline__ float xor_lane(float v) {
    if constexpr (K == 1) return dpp_mov<0xB1>(v);
    else if constexpr (K == 2) return dpp_mov<0x4E>(v);
    else return __builtin_bit_cast(float, __builtin_amdgcn_ds_swizzle(__builtin_bit_cast(int, v), (K << 10) | 0x1f)); }
__device__ __forceinline__ float row16_sum_dpp(float v) { v += dpp_mov<0x121>(v); v += dpp_mov<0x122>(v); v += dpp_mov<0x124>(v); v += dpp_mov<0x128>(v); return v; }
__device__ __forceinline__ float add_xor32(float v) {
    auto r = __builtin_amdgcn_permlane32_swap(__builtin_bit_cast(unsigned, v), __builtin_bit_cast(unsigned, v), false, false);
    return __builtin_bit_cast(float, r[0]) + __builtin_bit_cast(float, r[1]); }
__device__ __forceinline__ float bperm_xor(float v, int lane, int k) { return __builtin_bit_cast(float, __builtin_amdgcn_ds_bpermute((lane ^ k) << 2, __builtin_bit_cast(int, v))); }
__device__ __forceinline__ float wave_sum(float v, int lane) {
    v = row16_sum_dpp(v);
    const float r0 = __builtin_bit_cast(float, __builtin_amdgcn_readlane(__builtin_bit_cast(int, v), 0)), r1 = __builtin_bit_cast(float, __builtin_amdgcn_readlane(__builtin_bit_cast(int, v), 16));
    const float r2 = __builtin_bit_cast(float, __builtin_amdgcn_readlane(__builtin_bit_cast(int, v), 32)), r3 = __builtin_bit_cast(float, __builtin_amdgcn_readlane(__builtin_bit_cast(int, v), 48));
    return (r0 + r1) + (r2 + r3);
}
__device__ __forceinline__ float sigmoidf_(float x) { return 1.f / (1.f + __expf(-x)); }

#define XB_TMO      128
#define XB_XCNT(j)  (256  + 64 * (j))
#define XB_XSUB(j)  (1280 + 64 * (j))
#define XB_XGEN(j)  (2304 + 64 * (j))
#define XB_TOP      3328
#define XB_TOPGEN   3392
#define XCD_BAR_WORDS 3456
#define XB_SPIN_CAP (1u << 22)
__device__ __forceinline__ unsigned xb_ld(unsigned* p)              { return __hip_atomic_load(p, __ATOMIC_RELAXED, __HIP_MEMORY_SCOPE_AGENT); }
__device__ __forceinline__ unsigned xb_add(unsigned* p, unsigned v) { return __hip_atomic_fetch_add(p, v, __ATOMIC_RELAXED, __HIP_MEMORY_SCOPE_AGENT); }
__device__ __forceinline__ unsigned xb_xcc_id() { return (unsigned)__builtin_amdgcn_s_getreg((3 << 11) | 20) & 0xFu; }
#define XB_SPIN(cond, bar) do { unsigned _sp = 0; while (cond) { __builtin_amdgcn_s_sleep(1); \
    if ((++_sp & 255u) == 0u) { if (xb_ld(&(bar)[XB_TMO])) break; if (_sp > XB_SPIN_CAP) { atomicAdd(&(bar)[XB_TMO], 1u); break; } } } } while (0)
struct XcdBarrier { unsigned* bar; unsigned x; volatile LAS unsigned* st; };
__device__ __forceinline__ XcdBarrier xcd_barrier_post(unsigned* bar, volatile LAS unsigned* st) {
    XcdBarrier b; b.bar = bar; b.x = xb_xcc_id(); b.st = st;
    if (threadIdx.x == 0) (void)xb_add(&bar[XB_XCNT(b.x)], 1u);
    return b;
}
__device__ __forceinline__ void xcd_barrier_complete(unsigned* bar, unsigned x, unsigned& nloc, unsigned& nx) {
    const unsigned G = gridDim.x * gridDim.y * gridDim.z;
    unsigned sum, cnt, mine, sp = 0u;
    for (;;) {
        sum = 0u; cnt = 0u; mine = 0u;
#pragma unroll
        for (unsigned j = 0; j < 16; ++j) { const unsigned c = xb_ld(&bar[XB_XCNT(j)]); sum += c; cnt += (c > 0u) ? 1u : 0u; mine = (j == x) ? c : mine; }
        if (sum == G) break;
        __builtin_amdgcn_s_sleep(1);
        if ((++sp & 255u) == 0u) { if (xb_ld(&bar[XB_TMO])) break; if (sp > XB_SPIN_CAP) { atomicAdd(&bar[XB_TMO], 1u); break; } }
    }
    nloc = mine > 0u ? mine : 1u; nx = cnt > 0u ? cnt : 1u;
}
__device__ __forceinline__ void xcd_barrier(const XcdBarrier& b) {
    asm volatile("s_waitcnt vmcnt(0)" ::: "memory");
    __syncthreads();
    if (threadIdx.x == 0) {
        unsigned* bar = b.bar;
        __builtin_amdgcn_s_waitcnt(0);
        unsigned nloc = b.st[0], nx = b.st[1];
        if (nloc == 0u) { xcd_barrier_complete(bar, b.x, nloc, nx); b.st[0] = nloc; b.st[1] = nx; }
        const unsigned old = xb_add(&bar[XB_XSUB(b.x)], 1u);
        const unsigned gen = old / nloc;
        if (old + 1u == (gen + 1u) * nloc) {
            __builtin_amdgcn_fence(__ATOMIC_RELEASE, "agent");
            asm volatile("s_waitcnt vmcnt(0)" ::: "memory");
            const unsigned og = xb_add(&bar[XB_TOP], 1u);
            const unsigned tg = og / nx;
            if (og + 1u == (tg + 1u) * nx) xb_add(&bar[XB_TOPGEN], 1u);
            else XB_SPIN(xb_ld(&bar[XB_TOPGEN]) == tg, bar);
            __builtin_amdgcn_fence(__ATOMIC_ACQUIRE, "agent");
            xb_add(&bar[XB_XGEN(b.x)], 1u);
            asm volatile("s_waitcnt vmcnt(0)" ::: "memory");
        } else {
            XB_SPIN(xb_ld(&bar[XB_XGEN(b.x)]) == gen, bar);
            __builtin_amdgcn_fence(__ATOMIC_ACQUIRE, "agent");
            asm volatile("s_waitcnt vmcnt(0)" ::: "memory");
        }
    }
    __syncthreads();
}

constexpr int LDS_BYTES = 147456;
constexpr int MISC_OFF = 131072 + 320;
struct Frame {
    LAS unsigned char* lds; volatile LAS unsigned* MISC; unsigned* ctl;
    int tid, lane, wave, bid, G;
    const GAS void* const* in;
    float* out; GAS unsigned char* ws;
};
#define WSP(T_, off) ((T_*)(GAS T_*)(F.ws + (off)))
__device__ __forceinline__ void fresh_tid(Frame& F) { unsigned z_ = 0u; asm volatile("" : "+v"(z_)); const int l_ = (int)__builtin_amdgcn_mbcnt_hi(~0u, __builtin_amdgcn_mbcnt_lo(~0u, z_)); F.lane = l_; F.tid = F.wave * 64 + l_; }

__constant__ double INVF[16] = {1.0, 0.5623413251903491, 0.31622776601683794, 0.1778279410038923, 0.1, 0.05623413251903491, 0.03162277660168379, 0.01778279410038923,
                                0.01, 0.005623413251903491, 0.0031622776601683794, 0.001778279410038923, 0.001, 0.0005623413251903491, 0.00031622776601683794, 0.0001778279410038923};

constexpr size_t WS_MODP = WS_XN;
__device__ __forceinline__ void step_p0(Frame& F) {
    fresh_tid(F);
    const int gw = F.bid * NWAVES + F.wave, NGW = F.G * NWAVES;
    float* MODP = WSP(float, WS_MODP);
    const float* cin = (const float*)F.in[1];
    for (int it = gw; it < 2 * 96 * 16; it += NGW) {
        const int kc = it & 15, nc = (it >> 4) % 96, l = (it >> 4) / 96, n = nc * 64 + F.lane;
        const float* w = ((const float*)(const GAS float*)F.in[3]) + ((size_t)l * D + kc * 64) * (6 * D) + n;
        float a0 = 0.f, a1 = 0.f;
#pragma unroll
        for (int kh = 0; kh < 2; ++kh) {
            float wv[32];
#pragma unroll
            for (int k = 0; k < 32; ++k) wv[k] = w[(size_t)(kh * 32 + k) * (6 * D)];
#pragma unroll
            for (int k = 0; k < 32; ++k) {
                const float c0 = cin[kc * 64 + kh * 32 + k], c1 = cin[D + kc * 64 + kh * 32 + k];
                const float s0 = c0 / (1.f + __expf(-c0)), s1 = c1 / (1.f + __expf(-c1));
                a0 += s0 * wv[k]; a1 += s1 * wv[k];
            }
        }
        MODP[((size_t)(kc * 2 + l) * 2 + 0) * 6 * D + n] = a0; MODP[((size_t)(kc * 2 + l) * 2 + 1) * 6 * D + n] = a1;
    }
    f32x2* ROPE = WSP(f32x2, WS_ROPE);
    for (int idx = F.bid * NTHREADS + F.tid; idx < T * 16; idx += F.G * NTHREADS) {
        const int t = idx >> 4, i = idx & 15;
        const double a = (double)((const int*)(const GAS int*)F.in[2])[t] * INVF[i];
        const double n = __builtin_rint(a * 0.15915494309189535);
        double r = __builtin_fma(-n, 6.283185307179586, a); r = __builtin_fma(-n, 2.4492935982947064e-16, r);
        const float rf = (float)r;
        f32x2 cs; cs.x = __cosf(rf); cs.y = __sinf(rf);
        ROPE[idx] = cs;
    }
}
__device__ __forceinline__ void step_p0_reduce(Frame& F) {
    fresh_tid(F);
    const float* MODP = WSP(float, WS_MODP); float* MOD = WSP(float, WS_MOD);
    for (int idx = F.bid * NTHREADS + F.tid; idx < 2 * 2 * 6 * D; idx += F.G * NTHREADS) {
        const int n = idx % (6 * D), l = idx / (2 * 6 * D);
        float a = ((const float*)(const GAS float*)F.in[4])[l * 6 * D + n];
#pragma unroll
        for (int kc = 0; kc < 16; ++kc) a += MODP[(size_t)kc * (2 * 2 * 6 * D) + idx];
        MOD[idx] = a;
    }
}

__device__ __forceinline__ void step_a(Frame& F, int l) {
    fresh_tid(F);
    const int gw = F.bid * NWAVES + F.wave, NGW = F.G * NWAVES;
    const float* MOD = WSP(float, WS_MOD);
    const unsigned char* Y = WSP(unsigned char, WS_Y);
    const int* TOKS = WSP(int, WS_TOKS);
    bf16* XN = WSP(bf16, WS_XN); bf16* X16 = WSP(bf16, WS_X16);
    for (int row0 = gw; row0 < T; row0 += 2 * NGW) {
        const bool has1 = row0 + NGW < T;
        int rr[2]; rr[0] = row0; rr[1] = has1 ? row0 + NGW : row0;
        f32x4 v[2][4];
        if (l == 0) {
#pragma unroll
            for (int k = 0; k < 2; ++k)
#pragma unroll
                for (int j = 0; j < 4; ++j) v[k][j] = *(const f32x4*)(((const float*)(const GAS float*)F.in[0]) + (size_t)rr[k] * D + 4 * F.lane + 256 * j);
        } else {
            const unsigned* base = F.ctl + CW_BASE + 32 * (l - 1);
            int tk[2][2];
#pragma unroll
            for (int k = 0; k < 2; ++k) { tk[k][0] = TOKS[2 * rr[k]]; tk[k][1] = TOKS[2 * rr[k] + 1]; }
            size_t sl[2][3];
#pragma unroll
            for (int k = 0; k < 2; ++k) { sl[k][0] = base[tk[k][0] >> 16] + (tk[k][0] & 0xffff); sl[k][1] = base[tk[k][1] >> 16] + (tk[k][1] & 0xffff); sl[k][2] = base[16] + rr[k]; }
            f32x4 xo[2][4], gg[2][4]; unsigned ya[2][4], yb[2][4], yc[2][4];
#pragma unroll
            for (int k = 0; k < 2; ++k) { const float* gt2 = MOD + ((l - 1) * 2 + rr[k] / S) * 6 * D + 5 * D;
#pragma unroll
                for (int j = 0; j < 4; ++j) { const int col = 4 * F.lane + 256 * j;
                    { const bf16x4 t = *(const bf16x4*)(X16 + (size_t)rr[k] * D + col); xo[k][j] = (f32x4){bf2f(t[0]), bf2f(t[1]), bf2f(t[2]), bf2f(t[3])}; } gg[k][j] = *(const f32x4*)(gt2 + col);
                    ya[k][j] = *(const unsigned*)(Y + sl[k][0] * D + col); yb[k][j] = *(const unsigned*)(Y + sl[k][1] * D + col); yc[k][j] = *(const unsigned*)(Y + sl[k][2] * D + col); } }
#pragma unroll
            for (int k = 0; k < 2; ++k)
#pragma unroll
                for (int j = 0; j < 4; ++j) { f32x4 r;
                    const f32x2 a0 = __builtin_amdgcn_cvt_pk_f32_fp8((int)ya[k][j], false), a1 = __builtin_amdgcn_cvt_pk_f32_fp8((int)ya[k][j], true);
                    const f32x2 b0 = __builtin_amdgcn_cvt_pk_f32_fp8((int)yb[k][j], false), b1 = __builtin_amdgcn_cvt_pk_f32_fp8((int)yb[k][j], true);
                    const f32x2 c0 = __builtin_amdgcn_cvt_pk_f32_fp8((int)yc[k][j], false), c1 = __builtin_amdgcn_cvt_pk_f32_fp8((int)yc[k][j], true);
                    const f32x4 ys = (f32x4){a0.x + b0.x + c0.x, a0.y + b0.y + c0.y, a1.x + b1.x + c1.x, a1.y + b1.y + c1.y};
#pragma unroll
                    for (int e = 0; e < 4; ++e) r[e] = xo[k][j][e] + gg[k][j][e] * ys[e];
                    v[k][j] = r;
                    if (k == 0 || has1) { if (l == 2) *(f32x4*)(F.out + (size_t)rr[k] * D + 4 * F.lane + 256 * j) = r;
                        else { v2u o_; o_.x = pk2(r[0], r[1]); o_.y = pk2(r[2], r[3]); *(v2u*)(X16 + (size_t)rr[k] * D + 4 * F.lane + 256 * j) = o_; } } }
        }
        if (l < 2) {
            f32x4 g[4], sc[2][4], sh[2][4];
#pragma unroll
            for (int j = 0; j < 4; ++j) g[j] = *(const f32x4*)(((const float*)(const GAS float*)F.in[5]) + l * D + 4 * F.lane + 256 * j);
#pragma unroll
            for (int k = 0; k < 2; ++k) { const float* m = MOD + (l * 2 + rr[k] / S) * 6 * D;
#pragma unroll
                for (int j = 0; j < 4; ++j) { sc[k][j] = *(const f32x4*)(m + D + 4 * F.lane + 256 * j); sh[k][j] = *(const f32x4*)(m + 4 * F.lane + 256 * j); } }
            float ss[2];
#pragma unroll
            for (int k = 0; k < 2; ++k) { float a = 0.f;
#pragma unroll
                for (int j = 0; j < 4; ++j) a += (v[k][j].x * v[k][j].x + v[k][j].y * v[k][j].y) + (v[k][j].z * v[k][j].z + v[k][j].w * v[k][j].w);
                ss[k] = a; }
            const float rs0 = 1.0f / sqrtf(wave_sum(ss[0], F.lane) * (1.f / D) + EPS), rs1 = 1.0f / sqrtf(wave_sum(ss[1], F.lane) * (1.f / D) + EPS);
#pragma unroll
            for (int k = 0; k < 2; ++k) { const float rs = k ? rs1 : rs0;
#pragma unroll
                for (int j = 0; j < 4; ++j) { f32x4 h;
#pragma unroll
                    for (int e = 0; e < 4; ++e) h[e] = v[k][j][e] * rs * g[j][e] * (1.f + sc[k][j][e]) + sh[k][j][e];
                    v2u o; o.x = pk2(h[0], h[1]); o.y = pk2(h[2], h[3]);
                    if (k == 0 || has1) *(v2u*)(XN + (size_t)rr[k] * D + 4 * F.lane + 256 * j) = o; } }
        }
    }
}

template <int RPT, bool DUAL, class RowF, class Epi>
__device__ __forceinline__ void ngemm(Frame& F, int M, int N, int K, RowF rowf, const float* W, const float* W2, int ldw, const float* ksc, Epi epi) {
    fresh_tid(F);
    const int gw = F.bid * NWAVES + F.wave, NGW = F.G * NWAVES;
    const int nrb = (M + RPT - 1) / RPT, ncc = (N + 255) / 256;
    for (int it = gw; it < nrb * ncc; it += NGW) {
        const int cc = it / nrb, rb = it % nrb;
        const int n4 = cc * 256 + F.lane * 4;
        const bool nv = n4 < N;
        const int n4c = nv ? n4 : 0;
        const bf16* rp[RPT];
#pragma unroll
        for (int r = 0; r < RPT; ++r) { int m = rb * RPT + r; if (m >= M) m = M - 1; rp[r] = rowf(m); }
        f32x4 acc[RPT], acc2[RPT];
#pragma unroll
        for (int r = 0; r < RPT; ++r) { acc[r] = (f32x4){0.f, 0.f, 0.f, 0.f}; acc2[r] = (f32x4){0.f, 0.f, 0.f, 0.f}; }
        for (int k0 = 0; k0 < K; k0 += 8) {
            bf16x8 a[RPT];
#pragma unroll
            for (int r = 0; r < RPT; ++r) a[r] = *(const bf16x8*)(rp[r] + k0);
#pragma unroll
            for (int j = 0; j < 8; ++j) {
                f32x4 w = *(const f32x4*)(W + (size_t)(k0 + j) * ldw + n4c);
                f32x4 w2 = (f32x4){0.f, 0.f, 0.f, 0.f};
                if (DUAL) w2 = *(const f32x4*)(W2 + (size_t)(k0 + j) * ldw + n4c);
                if (ksc) { const float s = ksc[k0 + j]; w = w * s; }
#pragma unroll
                for (int r = 0; r < RPT; ++r) { const float av = bf2f(a[r][j]); acc[r] += av * w; if (DUAL) acc2[r] += av * w2; }
            }
        }
        if (nv) {
#pragma unroll
            for (int r = 0; r < RPT; ++r) { const int m = rb * RPT + r; if (m < M) epi(m, n4, acc[r], acc2[r]); }
        }
    }
}
struct RowLin { const bf16* p; int ld; __device__ __forceinline__ const bf16* operator()(int m) const { return p + (size_t)m * ld; } };
struct RowGather { const bf16* p; int ld; const int* list; __device__ __forceinline__ const bf16* operator()(int m) const { return p + (size_t)(list[m] >> 1) * ld; } };
__device__ __forceinline__ void st_bf4(bf16* p, f32x4 v) { v2u o; o.x = pk2(v[0], v[1]); o.y = pk2(v[2], v[3]); *(v2u*)p = o; }

struct EpiProj { bf16 *conv, *small, *ga, *gb;
    __device__ __forceinline__ void operator()(int m, int n, f32x4 a, f32x4) const {
        bf16* p;
        if (n < 1536) p = conv + (size_t)m * 1536 + n;
        else if (n < 1952) p = small + (size_t)m * 512 + (n - 1536);
        else if (n < 2976) p = ga + (size_t)m * 1024 + (n - 1952);
        else p = gb + (size_t)m * 1024 + (n - 2976);
        st_bf4(p, a);
    } };
struct EpiStore { bf16* o; int ld; __device__ __forceinline__ void operator()(int m, int n, f32x4 a, f32x4) const { st_bf4(o + (size_t)m * ld + n, a); } };
struct EpiGate1 { bf16* ga; __device__ __forceinline__ void operator()(int m, int n, f32x4 a, f32x4) const {
        bf16* p = ga + (size_t)m * D + n; const bf16x4 g = *(const bf16x4*)p; f32x4 r;
#pragma unroll
        for (int e = 0; e < 4; ++e) r[e] = sigmoidf_(bf2f(g[e])) * a[e];
        st_bf4(p, r); } };
struct EpiGate2 { bf16* t1; const bf16* gb; __device__ __forceinline__ void operator()(int m, int n, f32x4 a, f32x4) const {
        bf16* p = t1 + (size_t)m * D + n; const bf16x4 t = *(const bf16x4*)p; const bf16x4 g = *(const bf16x4*)(gb + (size_t)m * D + n); f32x4 r;
#pragma unroll
        for (int e = 0; e < 4; ++e) r[e] = bf2f(t[e]) + sigmoidf_(bf2f(g[e])) * a[e];
        st_bf4(p, r); } };
struct EpiRes { const float* xin; float* out; const float* gt; __device__ __forceinline__ void operator()(int m, int n, f32x4 a, f32x4) const {
        const f32x4 xv = *(const f32x4*)(xin + (size_t)m * D + n); const f32x4 g = *(const f32x4*)(gt + (m / S) * 6 * D + n);
        *(f32x4*)(out + (size_t)m * D + n) = xv + g * a; } };
struct EpiAct { bf16* a2; size_t slot0; const int* list; const float* tokw; __device__ __forceinline__ void operator()(int m, int n, f32x4 g, f32x4 u) const {
        const float w = list ? tokw[list[m]] : 1.f; f32x4 r;
#pragma unroll
        for (int e = 0; e < 4; ++e) r[e] = g[e] / (1.f + __expf(-g[e])) * u[e] * w;
        st_bf4(a2 + (slot0 + m) * DE + n, r); } };

__device__ __forceinline__ void step_c(Frame& F, int l) {
    fresh_tid(F);
    const bf16* CONV = WSP(bf16, WS_CONV); bf16* U = WSP(bf16, WS_U);
    const int gt = F.bid * NTHREADS + F.tid, NT = F.G * NTHREADS;
    for (int idx = gt; idx < T * 64; idx += NT) {
        const int t = idx >> 6, c8 = (idx & 63) * 8, s = t % S;
        const bf16* r0 = CONV + (size_t)t * 1024;
        const bf16x8 cb = *(const bf16x8*)(r0 + c8), p0v = *(const bf16x8*)(r0 + 512 + c8);
        bf16x8 pmv = (bf16x8){0, 0, 0, 0, 0, 0, 0, 0}, ppv = pmv;
        if (s > 0) pmv = *(const bf16x8*)(r0 - 1024 + 512 + c8);
        if (s < S - 1) ppv = *(const bf16x8*)(r0 + 1024 + 512 + c8);
        const float* cw = ((const float*)(const GAS float*)F.in[8]) + l * 3 * CW + c8;
        float o[8];
#pragma unroll
        for (int e = 0; e < 8; ++e) o[e] = bf2f(cb[e]) * (cw[e] * bf2f(pmv[e]) + cw[CW + e] * bf2f(p0v[e]) + cw[2 * CW + e] * bf2f(ppv[e]));
        v4u w; w.x = pk2(o[0], o[1]); w.y = pk2(o[2], o[3]); w.z = pk2(o[4], o[5]); w.w = pk2(o[6], o[7]);
        *(v4u*)(U + (size_t)t * CW + c8) = w;
    }
}

__device__ __forceinline__ float row16_sum(float v) { return row16_sum_dpp(v); }
__device__ __forceinline__ void step_e(Frame& F, int l) {
    fresh_tid(F);
    const bf16* QRAW = WSP(bf16, WS_QRAW); const bf16* SMALL = WSP(bf16, WS_SMALL);
    const f32x2* ROPE = WSP(f32x2, WS_ROPE);
    bf16* Q = WSP(bf16, WS_Q);
    const int gw = F.bid * NWAVES + F.wave, NGW = F.G * NWAVES;
    const int j = F.lane & 15, hh = F.lane >> 4; const bool act = j < 12, isrope = j >= 8 && act;
    const int jc = act ? j : 0;
    const float* gqp = ((const float*)(const GAS float*)F.in[13]) + l * DQK + 8 * jc;
    const f32x4 gq0 = *(const f32x4*)gqp, gq1 = *(const f32x4*)(gqp + 4);
    const float sgn = (j >= 10) ? 1.f : -1.f;
    for (int t = gw; t < T; t += NGW) {
        const int b = t / S, s = t % S;
        const bf16x8 xs = *(const bf16x8*)(SMALL + (size_t)t * 512 + 8 * (F.lane & 31));
        const f32x4* rp = (const f32x4*)(ROPE + (size_t)t * 16 + 8 * (j & 1));
        const f32x4 r0 = rp[0], r1 = rp[1], r2 = rp[2], r3 = rp[3];
        bf16x8 xq[2];
#pragma unroll
        for (int pass = 0; pass < 2; ++pass) xq[pass] = *(const bf16x8*)(QRAW + (size_t)t * 768 + (pass * 4 + hh) * 96 + 8 * jc);
        float sq = 0.f;
#pragma unroll
        for (int e = 0; e < 8; ++e) { const float f = bf2f(xs[e]); sq += f * f; }
        const float rsq = 1.0f / sqrtf(wave_sum(F.lane < 32 ? sq : 0.f, F.lane) * (1.f / 256.f) + EPS);
        float cs[8], sn[8];
        cs[0] = r0.x; sn[0] = r0.y; cs[1] = r0.z; sn[1] = r0.w; cs[2] = r1.x; sn[2] = r1.y; cs[3] = r1.z; sn[3] = r1.w;
        cs[4] = r2.x; sn[4] = r2.y; cs[5] = r2.z; sn[5] = r2.w; cs[6] = r3.x; sn[6] = r3.y; cs[7] = r3.z; sn[7] = r3.w;
#pragma unroll
        for (int pass = 0; pass < 2; ++pass) {
            const int h = pass * 4 + hh;
            const size_t orow = ((size_t)(b * H + h) * S + s);
            const bf16x8 x = xq[pass];
            float v[8]; float ss = 0.f;
#pragma unroll
            for (int e = 0; e < 8; ++e) { v[e] = act ? bf2f(x[e]) * rsq : 0.f; ss += v[e] * v[e]; }
            const float r = 1.0f / sqrtf(row16_sum(ss) * (1.f / 96.f) + EPS);
#pragma unroll
            for (int e = 0; e < 8; ++e) v[e] = v[e] * r * (e < 4 ? gq0[e & 3] : gq1[e & 3]);
#pragma unroll
            for (int e = 0; e < 8; ++e) { const float p = xor_lane<2>(v[e]); if (isrope) v[e] = v[e] * cs[e] + sgn * p * sn[e]; }
            if (act) { v4u w; w.x = pk2(v[0] * QSCALE, v[1] * QSCALE); w.y = pk2(v[2] * QSCALE, v[3] * QSCALE); w.z = pk2(v[4] * QSCALE, v[5] * QSCALE); w.w = pk2(v[6] * QSCALE, v[7] * QSCALE);
                *(v4u*)(Q + orow * 96 + 8 * j) = w; }
        }
    }
}

__device__ __forceinline__ void step_f(Frame& F) {
    fresh_tid(F);
    const bf16* Q = WSP(bf16, WS_Q); const bf16* K = WSP(bf16, WS_K); const bf16* V = WSP(bf16, WS_V); bf16* O = WSP(bf16, WS_O);
    const int gw = F.bid * NWAVES + F.wave, NGW = F.G * NWAVES;
    for (int it = gw; it < NB * H * (S / 64) * 2; it += NGW) {
        const int half = it & 1, it2 = it >> 1;
        const int bh = it2 / (S / 64), qi = (it2 % (S / 64)) * 64 + F.lane;
        bf16x8 q[12]; float o[32];
#pragma unroll
        for (int c = 0; c < 12; ++c) q[c] = *(const bf16x8*)(Q + ((size_t)bh * S + qi) * 96 + c * 8);
#pragma unroll
        for (int d = 0; d < 32; ++d) o[d] = 0.f;
        float m = -1e30f, lsum = 0.f;
        const bf16* kb = K + (size_t)bh * S * 96; const bf16* vb = V + (size_t)bh * S * 64 + half * 32;
#pragma unroll 1
        for (int j = 0; j < S; j += 2) {
            float sc[2];
#pragma unroll
            for (int i = 0; i < 2; ++i) { float a = 0.f;
#pragma unroll
                for (int c = 0; c < 12; ++c) { const bf16x8 kk = *(const bf16x8*)(kb + (size_t)(j + i) * 96 + c * 8);
#pragma unroll
                    for (int e = 0; e < 8; ++e) a += bf2f(q[c][e]) * bf2f(kk[e]); }
                sc[i] = a; asm volatile("" ::: "memory"); }
            const float mn = fmaxf(m, fmaxf(sc[0], sc[1]));
            const float alpha = exp2f(m - mn), p0 = exp2f(sc[0] - mn), p1 = exp2f(sc[1] - mn);
            lsum = lsum * alpha + (p0 + p1); m = mn;
#pragma unroll
            for (int c = 0; c < 4; ++c) {
                const bf16x8 v0 = *(const bf16x8*)(vb + (size_t)(j + 0) * 64 + c * 8), v1 = *(const bf16x8*)(vb + (size_t)(j + 1) * 64 + c * 8);
#pragma unroll
                for (int e = 0; e < 8; ++e) o[c * 8 + e] = o[c * 8 + e] * alpha + (p0 * bf2f(v0[e]) + p1 * bf2f(v1[e]));
                asm volatile("" ::: "memory");
            }
        }
        const float inv = 1.f / lsum; const int b = bh / H, h = bh % H;
        bf16* op = O + ((size_t)(b * S + qi)) * 512 + h * 64 + half * 32;
#pragma unroll
        for (int c = 0; c < 4; ++c) { v4u w; w.x = pk2(o[c * 8] * inv, o[c * 8 + 1] * inv); w.y = pk2(o[c * 8 + 2] * inv, o[c * 8 + 3] * inv); w.z = pk2(o[c * 8 + 4] * inv, o[c * 8 + 5] * inv);
            w.w = pk2(o[c * 8 + 6] * inv, o[c * 8 + 7] * inv); *(v4u*)(op + c * 8) = w; }
    }
}

__device__ __forceinline__ void route16(float myscore, float mybiased, int& e1, int& e2, float& w1, float& w2) {
    float scv[16], bi[16];
#pragma unroll
    for (int e = 0; e < 16; ++e) { scv[e] = __builtin_bit_cast(float, __builtin_amdgcn_readlane(__builtin_bit_cast(int, myscore), e)); bi[e] = __builtin_bit_cast(float, __builtin_amdgcn_readlane(__builtin_bit_cast(int, mybiased), e)); }
    float gs[4];
#pragma unroll
    for (int g = 0; g < 4; ++g) { const float a0 = bi[4 * g], a1 = bi[4 * g + 1], a2 = bi[4 * g + 2], a3 = bi[4 * g + 3];
        const float h1 = fmaxf(a0, a1), l1 = fminf(a0, a1), h2 = fmaxf(a2, a3), l2 = fminf(a2, a3);
        gs[g] = fmaxf(h1, h2) + fmaxf(fminf(h1, h2), fmaxf(l1, l2)); }
    int sg = 0; float bg = gs[0];
#pragma unroll
    for (int g = 1; g < 4; ++g) if (gs[g] > bg) { bg = gs[g]; sg = g; }
    float b0 = bi[0], b1 = bi[1], b2 = bi[2], b3 = bi[3], s0 = scv[0], s1 = scv[1], s2 = scv[2], s3 = scv[3];
#pragma unroll
    for (int g = 1; g < 4; ++g) if (sg == g) { b0 = bi[4 * g]; b1 = bi[4 * g + 1]; b2 = bi[4 * g + 2]; b3 = bi[4 * g + 3]; s0 = scv[4 * g]; s1 = scv[4 * g + 1]; s2 = scv[4 * g + 2]; s3 = scv[4 * g + 3]; }
    int i1 = 0; float m1 = b0, q1 = s0;
    if (b1 > m1) { m1 = b1; i1 = 1; q1 = s1; } if (b2 > m1) { m1 = b2; i1 = 2; q1 = s2; } if (b3 > m1) { m1 = b3; i1 = 3; q1 = s3; }
    int i2 = -1; float m2 = -1e30f, q2 = 0.f;
    if (i1 != 0 && (i2 < 0 || b0 > m2)) { m2 = b0; i2 = 0; q2 = s0; }
    if (i1 != 1 && (i2 < 0 || b1 > m2)) { m2 = b1; i2 = 1; q2 = s1; }
    if (i1 != 2 && (i2 < 0 || b2 > m2)) { m2 = b2; i2 = 2; q2 = s2; }
    if (i1 != 3 && (i2 < 0 || b3 > m2)) { m2 = b3; i2 = 3; q2 = s3; }
    const float inv = 1.f / (q1 + q2);
    e1 = 4 * sg + i1; e2 = 4 * sg + i2; w1 = q1 * inv; w2 = q2 * inv;
}
__device__ __forceinline__ void step_j(Frame& F, int l, bool dry = false) {
    fresh_tid(F);
    const bf16* X16 = WSP(bf16, WS_X16);
    const int gw = F.bid * NWAVES + F.wave, NGW = F.G * NWAVES;
    const float* MOD = WSP(float, WS_MOD); bf16* XN = WSP(bf16, WS_XN);
    int* TOKS = WSP(int, WS_TOKS); float* TOKW = WSP(float, WS_TOKW); int* LIST = WSP(int, WS_LIST);
    unsigned* cnt = F.ctl + CW_CNT + CNT_LS * l;
    LAS unsigned* lcnt = (LAS unsigned*)(F.lds + 65536); LAS unsigned* gbase = lcnt + 16; LAS unsigned* rinfo = (LAS unsigned*)(F.lds + 65536 + 256) + F.wave * 512;
    if (F.tid < 16) lcnt[F.tid] = 0u;
    __syncthreads();
    int ri = 0;
    LAS float* hrow = (LAS float*)(F.lds + F.wave * 8192);
    const int re = F.lane & 15, rq = F.lane >> 4;
    const float* wr = ((const float*)(const GAS float*)F.in[18]) + (size_t)(rq * 256) * NE + re;
    const float brt = ((const float*)(const GAS float*)F.in[19])[re];
    for (int row0 = gw; row0 < T; row0 += 2 * NGW) {
        const bool has1 = row0 + NGW < T;
        int rr[2]; rr[0] = row0; rr[1] = has1 ? row0 + NGW : row0;
        f32x4 v[2][4], g[4], sc[2][4], sh[2][4];
#pragma unroll
        for (int k = 0; k < 2; ++k)
#pragma unroll
            for (int j = 0; j < 4; ++j) { const bf16x4 t = *(const bf16x4*)(X16 + (size_t)rr[k] * D + 4 * F.lane + 256 * j); v[k][j] = (f32x4){bf2f(t[0]), bf2f(t[1]), bf2f(t[2]), bf2f(t[3])}; }
#pragma unroll
        for (int j = 0; j < 4; ++j) g[j] = *(const f32x4*)(((const float*)(const GAS float*)F.in[6]) + l * D + 4 * F.lane + 256 * j);
#pragma unroll
        for (int k = 0; k < 2; ++k) { const float* m = MOD + (l * 2 + rr[k] / S) * 6 * D;
#pragma unroll
            for (int j = 0; j < 4; ++j) { sc[k][j] = *(const f32x4*)(m + 4 * D + 4 * F.lane + 256 * j); sh[k][j] = *(const f32x4*)(m + 3 * D + 4 * F.lane + 256 * j); } }
        float ss[2];
#pragma unroll
        for (int k = 0; k < 2; ++k) { float a = 0.f;
#pragma unroll
            for (int j = 0; j < 4; ++j) a += (v[k][j].x * v[k][j].x + v[k][j].y * v[k][j].y) + (v[k][j].z * v[k][j].z + v[k][j].w * v[k][j].w);
            ss[k] = a; }
        const float rs0 = 1.0f / sqrtf(wave_sum(ss[0], F.lane) * (1.f / D) + EPS), rs1 = 1.0f / sqrtf(wave_sum(ss[1], F.lane) * (1.f / D) + EPS);
#pragma unroll
        for (int k = 0; k < 2; ++k) { const float rs = k ? rs1 : rs0;
#pragma unroll
            for (int j = 0; j < 4; ++j) { const int col = 4 * F.lane + 256 * j; f32x4 hh;
#pragma unroll
                for (int e = 0; e < 4; ++e) hh[e] = v[k][j][e] * rs * g[j][e] * (1.f + sc[k][j][e]) + sh[k][j][e];
                v2u o; o.x = pk2(hh[0], hh[1]); o.y = pk2(hh[2], hh[3]);
                if (k == 0 || has1) *(v2u*)(XN + (size_t)rr[k] * D + col) = o;
                *(LAS f32x4*)(hrow + k * 1024 + col) = hh; } }
        asm volatile("s_waitcnt lgkmcnt(0)" ::: "memory");
        float a0 = 0.f, a1 = 0.f, a2 = 0.f, a3 = 0.f, c0 = 0.f, c1 = 0.f, c2 = 0.f, c3 = 0.f;
#pragma unroll 4
        for (int c = 0; c < 256; c += 4) {
            const f32x4 h0 = *(const LAS f32x4*)(hrow + rq * 256 + c), h1 = *(const LAS f32x4*)(hrow + 1024 + rq * 256 + c);
            const float w0 = wr[(size_t)(c + 0) * NE], w1 = wr[(size_t)(c + 1) * NE], w2 = wr[(size_t)(c + 2) * NE], w3 = wr[(size_t)(c + 3) * NE];
            a0 += h0.x * w0; a1 += h0.y * w1; a2 += h0.z * w2; a3 += h0.w * w3;
            c0 += h1.x * w0; c1 += h1.y * w1; c2 += h1.z * w2; c3 += h1.w * w3;
        }
        float z0 = (a0 + a1) + (a2 + a3), z1 = (c0 + c1) + (c2 + c3);
        z0 += bperm_xor(z0, F.lane, 16); z0 += bperm_xor(z0, F.lane, 32);
        z1 += bperm_xor(z1, F.lane, 16); z1 += bperm_xor(z1, F.lane, 32);
        asm volatile("s_waitcnt lgkmcnt(0)" ::: "memory");
#pragma unroll
        for (int k = 0; k < 2; ++k) {
            const float z = k ? z1 : z0;
            const float myscore = 1.f / (1.f + expf(-z)), mybiased = myscore + brt;
            int e1, e2; float w1, w2;
            route16(myscore, mybiased, e1, e2, w1, w2);
            if (F.lane == 0 && !dry && (k == 0 || has1)) {
                const unsigned p1 = __hip_atomic_fetch_add(lcnt + e1, 1u, __ATOMIC_RELAXED, __HIP_MEMORY_SCOPE_WORKGROUP), p2 = __hip_atomic_fetch_add(lcnt + e2, 1u, __ATOMIC_RELAXED, __HIP_MEMORY_SCOPE_WORKGROUP);
                LAS unsigned* r = rinfo + ri * 8;
                r[0] = (unsigned)rr[k]; r[1] = (unsigned)e1; r[2] = p1; r[3] = (unsigned)e2; r[4] = p2; r[5] = __builtin_bit_cast(unsigned, w1); r[6] = __builtin_bit_cast(unsigned, w2);
            }
            if (k == 0 || has1) ++ri;
        }
    }
    if (dry) return;
    __syncthreads();
    if (F.tid < 16) { const unsigned c = lcnt[F.tid]; gbase[F.tid] = c ? __hip_atomic_fetch_add(cnt + CNT_ES * F.tid, c, RLX_AGENT) : 0u; }
    __syncthreads();
    if (F.lane < ri) {
        const LAS unsigned* r = rinfo + F.lane * 8;
        const int row = (int)r[0], e1 = (int)r[1], e2 = (int)r[3]; const unsigned p1 = gbase[e1] + r[2], p2 = gbase[e2] + r[4];
        LIST[(size_t)e1 * T + p1] = 2 * row; LIST[(size_t)e2 * T + p2] = 2 * row + 1;
        TOKS[2 * row] = (e1 << 16) | (int)p1; TOKS[2 * row + 1] = (e2 << 16) | (int)p2;
        TOKW[2 * row] = __builtin_bit_cast(float, r[5]); TOKW[2 * row + 1] = __builtin_bit_cast(float, r[6]);
    }
}

__device__ __forceinline__ void step_j_old(Frame& F, int l, bool dry = false) {
    fresh_tid(F);
    const int gw = F.bid * NWAVES + F.wave, NGW = F.G * NWAVES;
    const float* MOD = WSP(float, WS_MOD); bf16* XN = WSP(bf16, WS_XN);
    int* TOKS = WSP(int, WS_TOKS); float* TOKW = WSP(float, WS_TOKW); int* LIST = WSP(int, WS_LIST);
    unsigned* cnt = F.ctl + CW_CNT + CNT_LS * l;
    for (int row = gw; row < T; row += NGW) {
        const int b = row / S;
        float ss = 0.f;
#pragma unroll
        for (int j = 0; j < 4; ++j) { const f32x4 vv = *(const f32x4*)(F.out + (size_t)row * D + 4 * F.lane + 256 * j); ss += (vv.x * vv.x + vv.y * vv.y) + (vv.z * vv.z + vv.w * vv.w); }
        const float rs = 1.0f / sqrtf(wave_sum(ss, F.lane) * (1.f / D) + EPS);
        const float* m = MOD + (l * 2 + b) * 6 * D;
        float lg[16];
#pragma unroll
        for (int e = 0; e < 16; ++e) lg[e] = 0.f;
#pragma unroll 1
        for (int j = 0; j < 4; ++j) {
            const int col = 4 * F.lane + 256 * j;
            const f32x4 vj = *(const f32x4*)(F.out + (size_t)row * D + col);
            const f32x4 g = *(const f32x4*)(((const float*)(const GAS float*)F.in[6]) + l * D + col), sc = *(const f32x4*)(m + 4 * D + col), sh = *(const f32x4*)(m + 3 * D + col);
            f32x4 hh;
#pragma unroll
            for (int e = 0; e < 4; ++e) hh[e] = vj[e] * rs * g[e] * (1.f + sc[e]) + sh[e];
            v2u o; o.x = pk2(hh[0], hh[1]); o.y = pk2(hh[2], hh[3]);
            *(v2u*)(XN + (size_t)row * D + col) = o;
#pragma unroll
            for (int i = 0; i < 4; ++i) {
                const float* wr = ((const float*)(const GAS float*)F.in[18]) + (size_t)(col + i) * NE;
                const f32x4 w0 = *(const f32x4*)(wr), w1 = *(const f32x4*)(wr + 4), w2 = *(const f32x4*)(wr + 8), w3 = *(const f32x4*)(wr + 12);
#pragma unroll
                for (int e = 0; e < 4; ++e) { lg[e] += hh[i] * w0[e]; lg[4 + e] += hh[i] * w1[e]; lg[8 + e] += hh[i] * w2[e]; lg[12 + e] += hh[i] * w3[e]; }
            }
        }
        float scv[16], bi[16];
#pragma unroll
        for (int e = 0; e < 16; ++e) { const float z = wave_sum(lg[e], F.lane); scv[e] = 1.f / (1.f + expf(-z)); bi[e] = scv[e] + ((const float*)(const GAS float*)F.in[19])[e]; }
        float gs[4];
#pragma unroll
        for (int g = 0; g < 4; ++g) { const float a0 = bi[4 * g], a1 = bi[4 * g + 1], a2 = bi[4 * g + 2], a3 = bi[4 * g + 3];
            const float h1 = fmaxf(a0, a1), l1 = fminf(a0, a1), h2 = fmaxf(a2, a3), l2 = fminf(a2, a3);
            gs[g] = fmaxf(h1, h2) + fmaxf(fminf(h1, h2), fmaxf(l1, l2)); }
        int sg = 0; float bg = gs[0];
#pragma unroll
        for (int g = 1; g < 4; ++g) if (gs[g] > bg) { bg = gs[g]; sg = g; }
        float b0 = bi[0], b1 = bi[1], b2 = bi[2], b3 = bi[3], s0 = scv[0], s1 = scv[1], s2 = scv[2], s3 = scv[3];
#pragma unroll
        for (int g = 1; g < 4; ++g) if (sg == g) { b0 = bi[4 * g]; b1 = bi[4 * g + 1]; b2 = bi[4 * g + 2]; b3 = bi[4 * g + 3]; s0 = scv[4 * g]; s1 = scv[4 * g + 1]; s2 = scv[4 * g + 2]; s3 = scv[4 * g + 3]; }
        int i1 = 0; float m1 = b0, q1 = s0;
        if (b1 > m1) { m1 = b1; i1 = 1; q1 = s1; } if (b2 > m1) { m1 = b2; i1 = 2; q1 = s2; } if (b3 > m1) { m1 = b3; i1 = 3; q1 = s3; }
        int i2 = -1; float m2 = -1e30f, q2 = 0.f;
        if (i1 != 0 && (i2 < 0 || b0 > m2)) { m2 = b0; i2 = 0; q2 = s0; }
        if (i1 != 1 && (i2 < 0 || b1 > m2)) { m2 = b1; i2 = 1; q2 = s1; }
        if (i1 != 2 && (i2 < 0 || b2 > m2)) { m2 = b2; i2 = 2; q2 = s2; }
        if (i1 != 3 && (i2 < 0 || b3 > m2)) { m2 = b3; i2 = 3; q2 = s3; }
        if (F.lane == 0 && !dry) {
            const int e1 = 4 * sg + i1, e2 = 4 * sg + i2; const float inv = 1.f / (q1 + q2);
            const unsigned p1 = __hip_atomic_fetch_add(cnt + CNT_ES * e1, 1u, RLX_AGENT), p2 = __hip_atomic_fetch_add(cnt + CNT_ES * e2, 1u, RLX_AGENT);
            LIST[(size_t)e1 * T + p1] = 2 * row; LIST[(size_t)e2 * T + p2] = 2 * row + 1;
            TOKS[2 * row] = (e1 << 16) | (int)p1; TOKS[2 * row + 1] = (e2 << 16) | (int)p2;
            TOKW[2 * row] = q1 * inv; TOKW[2 * row + 1] = q2 * inv;
        }
    }
}


namespace att {
typedef short sbf16x8 __attribute__((ext_vector_type(8)));
typedef short s16x4 __attribute__((ext_vector_type(4)));
typedef float f32x16 __attribute__((ext_vector_type(16)));
constexpr int NW = 8, QBLK = 32, KVBLK = 64;
constexpr int SHM_K = KVBLK * 256, SHM_V = KVBLK * 256;
constexpr int OFF_V = 0, OFF_K = 2 * SHM_V, OFF_WS = 2 * SHM_V + 2 * SHM_K, OFF_OST = OFF_WS + NW * 64 * 4, LDS_NEED = OFF_OST + NW * 4096;
static_assert(LDS_NEED <= 131072, "attention LDS");
constexpr float THR2 = 11.f;
#define ATT_KSWZ(row, colB) ((row) * 256 + ((colB) ^ (((row) & 15) << 4)))
#define ATT_SBAR() __builtin_amdgcn_sched_barrier(0)
__device__ __forceinline__ int crow(int r, int hi) { return (r & 3) + 8 * (r >> 2) + 4 * hi; }
__device__ __forceinline__ void partialSM(f32x16& p0, f32x16& p1) {
#pragma unroll
    for (int r = 0; r < 16; ++r) p0[r] = __builtin_amdgcn_exp2f(p0[r]);
}
__device__ __forceinline__ void finishSM(f32x16& p0, f32x16& p1, float& l_reg, sbf16x8& pa0, sbf16x8& pa1, sbf16x8& pa2, sbf16x8& pa3) {
#pragma unroll
    for (int r = 0; r < 16; ++r) p1[r] = __builtin_amdgcn_exp2f(p1[r]);
    float ps0 = 0.f, ps1 = 0.f;
#pragma unroll
    for (int r = 0; r < 16; ++r) { ps0 += p0[r]; ps1 += p1[r]; }
    l_reg += ps0 + ps1;
#define ATT_PK4(P, BASE, OUT) do { unsigned a0 = pk2(P[BASE + 0], P[BASE + 1]), a1 = pk2(P[BASE + 2], P[BASE + 3]);   \
    unsigned b0 = pk2(P[BASE + 4], P[BASE + 5]), b1 = pk2(P[BASE + 6], P[BASE + 7]);                              \
    auto r0 = __builtin_amdgcn_permlane32_swap(a0, b0, false, false); auto r1 = __builtin_amdgcn_permlane32_swap(a1, b1, false, false); \
    v4u w = {r0[0], r1[0], r0[1], r1[1]}; OUT = __builtin_bit_cast(sbf16x8, w); } while (0)
    ATT_PK4(p0, 0, pa0); ATT_PK4(p0, 8, pa1); ATT_PK4(p1, 0, pa2); ATT_PK4(p1, 8, pa3);
#undef ATT_PK4
}
__device__ __forceinline__ void qkt(f32x16& p0, f32x16& p1, const LAS char* Ks, const sbf16x8* qr, int r32, int hi) {
    asm volatile("" : "+v"(r32));
    p0 = f32x16{}; p1 = f32x16{};
    sbf16x8 c0 = *(const LAS sbf16x8*)(Ks + ATT_KSWZ(r32, (hi * 8) * 2)), c1 = *(const LAS sbf16x8*)(Ks + ATT_KSWZ(32 + r32, (hi * 8) * 2));
#pragma unroll
    for (int d0 = 0; d0 < 6; ++d0) {
        sbf16x8 n0 = c0, n1 = c1;
        if (d0 < 5) { const int cb = ((d0 + 1) * 16 + hi * 8) * 2; n0 = *(const LAS sbf16x8*)(Ks + ATT_KSWZ(r32, cb)); n1 = *(const LAS sbf16x8*)(Ks + ATT_KSWZ(32 + r32, cb)); }
        p0 = __builtin_amdgcn_mfma_f32_32x32x16_bf16(c0, qr[d0], p0, 0, 0, 0);
        p1 = __builtin_amdgcn_mfma_f32_32x32x16_bf16(c1, qr[d0], p1, 0, 0, 0);
        c0 = n0; c1 = n1;
    }
}
__device__ __forceinline__ int v_st(int k, int c) { const int kk = (k & ~0xC) | ((k & 4) << 1) | ((k & 8) >> 1); return ((kk >> 3) * 4 + (c >> 5)) * 512 + ((kk & 7) * 32 + (c & 31)) * 2; }
__device__ __forceinline__ int v_rd_base(int lane) { return ((lane & 3) << 3) | (((lane >> 2) & 3) << 6) | (((lane >> 4) & 1) << 5) | (((lane >> 5) & 1) << 8); }
constexpr int v_rd_off(int d0, int ks, int half) { return d0 * 512 + ks * 4096 + half * 2048; }
template <int OFF> __device__ __forceinline__ s16x4 tr_read(int vb) { s16x4 r; asm volatile("ds_read_b64_tr_b16 %0, %1 offset:%2" : "=&v"(r) : "v"(vb), "i"(OFF) : "memory"); return r; }
template <int D0> __device__ __forceinline__ void pv_one(f32x16& od, int vb, sbf16x8 pa0, sbf16x8 pa1, sbf16x8 pa2, sbf16x8 pa3) {
    const s16x4 l0 = tr_read<v_rd_off(D0, 0, 0)>(vb), h0 = tr_read<v_rd_off(D0, 0, 1)>(vb), l1 = tr_read<v_rd_off(D0, 1, 0)>(vb), h1 = tr_read<v_rd_off(D0, 1, 1)>(vb);
    const s16x4 l2 = tr_read<v_rd_off(D0, 2, 0)>(vb), h2 = tr_read<v_rd_off(D0, 2, 1)>(vb), l3 = tr_read<v_rd_off(D0, 3, 0)>(vb), h3 = tr_read<v_rd_off(D0, 3, 1)>(vb);
    asm volatile("s_waitcnt lgkmcnt(0)" ::: "memory"); ATT_SBAR();
#define ATT_PK(L, H) (sbf16x8){L[0], L[1], L[2], L[3], H[0], H[1], H[2], H[3]}
    od = __builtin_amdgcn_mfma_f32_32x32x16_bf16(pa0, ATT_PK(l0, h0), od, 0, 0, 0);
    od = __builtin_amdgcn_mfma_f32_32x32x16_bf16(pa1, ATT_PK(l1, h1), od, 0, 0, 0);
    od = __builtin_amdgcn_mfma_f32_32x32x16_bf16(pa2, ATT_PK(l2, h2), od, 0, 0, 0);
    od = __builtin_amdgcn_mfma_f32_32x32x16_bf16(pa3, ATT_PK(l3, h3), od, 0, 0, 0);
#undef ATT_PK
}
__device__ __forceinline__ void pv2(f32x16* o, int vb, sbf16x8 pa0, sbf16x8 pa1, sbf16x8 pa2, sbf16x8 pa3) { pv_one<0>(o[0], vb, pa0, pa1, pa2, pa3); pv_one<1>(o[1], vb, pa0, pa1, pa2, pa3); }

__device__ __forceinline__ void attn_unit(const bf16* Qb, const bf16* Kh, const bf16* Vh, bf16* Ob, int seq, LAS char* lds, int tid) {
    const int wid = __builtin_amdgcn_readfirstlane(tid >> 6), lane = tid & 63, r32 = lane & 31, hi = lane >> 5; int lane2;
    LAS char* V_lds = lds + OFF_V; LAS char* K_lds = lds + OFF_K;
    LAS float* ws = (LAS float*)(lds + OFF_WS) + wid * 64; LAS float* li_l = ws;
    float l_reg = 0.f; f32x16 o[2]; o[0] = f32x16{}; o[1] = f32x16{}; sbf16x8 qr[6];
    const bf16* Qw = Qb + (size_t)(wid * QBLK + r32) * 96 + hi * 8;
#pragma unroll
    for (int d0 = 0; d0 < 6; ++d0) qr[d0] = *(const GAS sbf16x8*)((const GAS bf16*)Qw + d0 * 16);
    const int kc1 = 512 + (tid & 255), kr0 = tid / 12, kq0 = (tid % 12) * 8, kr1 = kc1 / 12, kq1 = (kc1 % 12) * 8;
    const int ksto0 = ATT_KSWZ(kr0, kq0 * 2), ksto1 = ATT_KSWZ(kr1, kq1 * 2);
    const int vr = tid >> 3, vq = (tid & 7) * 8, vsto = v_st(vr, vq);
    const int vb0 = (int)(unsigned)(size_t)V_lds + v_rd_base(lane);
    const unsigned ko0 = (unsigned)(kr0 * 96 + kq0) * 2u, ko1 = (unsigned)(kr1 * 96 + kq1) * 2u, vo = (unsigned)(vr * 64 + vq) * 2u;
    sbf16x8 sk0[2], sk1[2], sv[2];
    const GAS char* Kg = (const GAS char*)Kh; const GAS char* Vg = (const GAS char*)Vh;
#define ATT_SLOAD(i, k0) do { sk0[i] = *(const GAS sbf16x8*)(Kg + (ko0 + (unsigned)(k0) * 192u)); sk1[i] = *(const GAS sbf16x8*)(Kg + (ko1 + (unsigned)(k0) * 192u)); sv[i] = *(const GAS sbf16x8*)(Vg + (vo + (unsigned)(k0) * 128u)); } while (0)
#define ATT_SWRITE(b, i) do { *(LAS sbf16x8*)(K_lds + (b) * SHM_K + ksto0) = sk0[i]; *(LAS sbf16x8*)(K_lds + (b) * SHM_K + ksto1) = sk1[i]; *(LAS sbf16x8*)(V_lds + (b) * SHM_V + vsto) = sv[i]; } while (0)
#define ATT_SWAIT() asm volatile("s_waitcnt vmcnt(3)" ::: "memory")
    f32x16 pA0, pA1, pB0, pB1; sbf16x8 pa0, pa1, pa2, pa3; const int NT = seq / KVBLK;
    ATT_SLOAD(0, 0); asm volatile("s_waitcnt vmcnt(0)" ::: "memory"); ATT_SWRITE(0, 0); __syncthreads();
    qkt(pA0, pA1, K_lds, qr, r32, hi); partialSM(pA0, pA1);
    ATT_SLOAD(1, KVBLK); if (2 < NT) ATT_SLOAD(0, 2 * KVBLK);
    ATT_SWAIT(); ATT_SWRITE(1, 1); __syncthreads();
#pragma unroll 1
    for (int j = 1; j + 1 < NT; j += 2) {
        ATT_SBAR(); qkt(pB0, pB1, K_lds + SHM_K, qr, r32, hi);
        finishSM(pA0, pA1, l_reg, pa0, pa1, pa2, pa3); ATT_SBAR();
        ATT_SLOAD(1, (j + 2) * KVBLK); ATT_SBAR();
        pv2(o, vb0, pa0, pa1, pa2, pa3); partialSM(pB0, pB1);
        __syncthreads(); ATT_SWAIT(); ATT_SWRITE(0, 0);
        __syncthreads();
        ATT_SBAR(); qkt(pA0, pA1, K_lds, qr, r32, hi);
        finishSM(pB0, pB1, l_reg, pa0, pa1, pa2, pa3); ATT_SBAR();
        if (j + 3 < NT) ATT_SLOAD(0, (j + 3) * KVBLK); ATT_SBAR();
        pv2(o, vb0 + SHM_V, pa0, pa1, pa2, pa3); partialSM(pA0, pA1);
        __syncthreads(); ATT_SWAIT(); ATT_SWRITE(1, 1);
        __syncthreads();
    }
    ATT_SBAR(); qkt(pB0, pB1, K_lds + SHM_K, qr, r32, hi);
    finishSM(pA0, pA1, l_reg, pa0, pa1, pa2, pa3); ATT_SBAR();
    pv2(o, vb0, pa0, pa1, pa2, pa3); partialSM(pB0, pB1);
    __syncthreads();
    finishSM(pB0, pB1, l_reg, pa0, pa1, pa2, pa3); ATT_SBAR();
    pv2(o, vb0 + SHM_V, pa0, pa1, pa2, pa3);
    { auto rr = __builtin_amdgcn_permlane32_swap(__float_as_uint(l_reg), __float_as_uint(l_reg), false, false); l_reg = __uint_as_float(rr[0]) + __uint_as_float(rr[1]); }
    { unsigned z_ = 0u; asm volatile("" : "+v"(z_)); lane2 = (int)__builtin_amdgcn_mbcnt_hi(~0u, __builtin_amdgcn_mbcnt_lo(~0u, z_)); }
    const int r32e = lane2 & 31, hie = lane2 >> 5;
    if (hie == 0) li_l[r32e] = l_reg; asm volatile("s_waitcnt lgkmcnt(0)" ::: "memory");
    float rli[16];
#pragma unroll
    for (int r = 0; r < 16; ++r) rli[r] = __builtin_amdgcn_rcpf(li_l[crow(r, hie)]);
    LAS bf16* stg = (LAS bf16*)(lds + OFF_OST) + wid * 2048;
#pragma unroll
    for (int r = 0; r < 16; ++r) { const int orow = crow(r, hie);
#pragma unroll
        for (int d0 = 0; d0 < 2; ++d0) stg[orow * 64 + d0 * 32 + r32e] = (bf16)(pk2(o[d0][r] * rli[r], 0.f) & 0xffffu); }
    asm volatile("s_waitcnt lgkmcnt(0)" ::: "memory");
    bf16* Ow = Ob + (size_t)(wid * QBLK) * 512;
#pragma unroll
    for (int i = 0; i < 4; ++i) { const int row = i * 8 + (lane2 >> 3), ch = lane2 & 7; const v4u v = *(const LAS v4u*)(stg + row * 64 + ch * 8); *(GAS v4u*)((GAS bf16*)Ow + (size_t)row * 512 + ch * 8) = v; }
    asm volatile("s_waitcnt lgkmcnt(0)" ::: "memory");
#undef ATT_SLOAD
#undef ATT_SWRITE
#undef ATT_SWAIT
}
__device__ __forceinline__ void softmax_pack(f32x16& p0, f32x16& p1, float& l_reg, sbf16x8& pa0, sbf16x8& pa1, sbf16x8& pa2, sbf16x8& pa3) {
#pragma unroll
    for (int r = 0; r < 16; ++r) p0[r] = __builtin_amdgcn_exp2f(p0[r]);
#pragma unroll
    for (int r = 0; r < 16; ++r) p1[r] = __builtin_amdgcn_exp2f(p1[r]);
    float ps0 = 0.f, ps1 = 0.f;
#pragma unroll
    for (int r = 0; r < 16; ++r) { ps0 += p0[r]; ps1 += p1[r]; }
    l_reg += ps0 + ps1;
#define ATT_PK4(P, BASE, OUT) do { unsigned a0 = pk2(P[BASE + 0], P[BASE + 1]), a1 = pk2(P[BASE + 2], P[BASE + 3]);   \
    unsigned b0 = pk2(P[BASE + 4], P[BASE + 5]), b1 = pk2(P[BASE + 6], P[BASE + 7]);                              \
    auto r0 = __builtin_amdgcn_permlane32_swap(a0, b0, false, false); auto r1 = __builtin_amdgcn_permlane32_swap(a1, b1, false, false); \
    v4u w = {r0[0], r1[0], r0[1], r1[1]}; OUT = __builtin_bit_cast(sbf16x8, w); } while (0)
    ATT_PK4(p0, 0, pa0); ATT_PK4(p0, 8, pa1); ATT_PK4(p1, 0, pa2); ATT_PK4(p1, 8, pa3);
#undef ATT_PK4
}
__device__ __forceinline__ void qkt2(f32x16& x0, f32x16& x1, f32x16& y0, f32x16& y1, const LAS char* Ks, const sbf16x8* qx, const sbf16x8* qy, int r32, int hi) {
    asm volatile("" : "+v"(r32));
    x0 = f32x16{}; x1 = f32x16{}; y0 = f32x16{}; y1 = f32x16{};
    sbf16x8 c0 = *(const LAS sbf16x8*)(Ks + ATT_KSWZ(r32, (hi * 8) * 2)), c1 = *(const LAS sbf16x8*)(Ks + ATT_KSWZ(32 + r32, (hi * 8) * 2));
#pragma unroll
    for (int d0 = 0; d0 < 6; ++d0) {
        sbf16x8 n0 = c0, n1 = c1;
        if (d0 < 5) { const int cb = ((d0 + 1) * 16 + hi * 8) * 2; n0 = *(const LAS sbf16x8*)(Ks + ATT_KSWZ(r32, cb)); n1 = *(const LAS sbf16x8*)(Ks + ATT_KSWZ(32 + r32, cb)); }
        x0 = __builtin_amdgcn_mfma_f32_32x32x16_bf16(c0, qx[d0], x0, 0, 0, 0);
        x1 = __builtin_amdgcn_mfma_f32_32x32x16_bf16(c1, qx[d0], x1, 0, 0, 0);
        y0 = __builtin_amdgcn_mfma_f32_32x32x16_bf16(c0, qy[d0], y0, 0, 0, 0);
        y1 = __builtin_amdgcn_mfma_f32_32x32x16_bf16(c1, qy[d0], y1, 0, 0, 0);
        c0 = n0; c1 = n1;
    }
}
template <int D0> __device__ __forceinline__ void pv_one2(f32x16& ox, f32x16& oy, int vb, const sbf16x8 (&px)[4], const sbf16x8 (&py)[4]) {
    const s16x4 l0 = tr_read<v_rd_off(D0, 0, 0)>(vb), h0 = tr_read<v_rd_off(D0, 0, 1)>(vb), l1 = tr_read<v_rd_off(D0, 1, 0)>(vb), h1 = tr_read<v_rd_off(D0, 1, 1)>(vb);
    const s16x4 l2 = tr_read<v_rd_off(D0, 2, 0)>(vb), h2 = tr_read<v_rd_off(D0, 2, 1)>(vb), l3 = tr_read<v_rd_off(D0, 3, 0)>(vb), h3 = tr_read<v_rd_off(D0, 3, 1)>(vb);
    asm volatile("s_waitcnt lgkmcnt(0)" ::: "memory"); ATT_SBAR();
#define ATT_PK(L, H) (sbf16x8){L[0], L[1], L[2], L[3], H[0], H[1], H[2], H[3]}
    ox = __builtin_amdgcn_mfma_f32_32x32x16_bf16(px[0], ATT_PK(l0, h0), ox, 0, 0, 0);
    oy = __builtin_amdgcn_mfma_f32_32x32x16_bf16(py[0], ATT_PK(l0, h0), oy, 0, 0, 0);
    ox = __builtin_amdgcn_mfma_f32_32x32x16_bf16(px[1], ATT_PK(l1, h1), ox, 0, 0, 0);
    oy = __builtin_amdgcn_mfma_f32_32x32x16_bf16(py[1], ATT_PK(l1, h1), oy, 0, 0, 0);
    ox = __builtin_amdgcn_mfma_f32_32x32x16_bf16(px[2], ATT_PK(l2, h2), ox, 0, 0, 0);
    oy = __builtin_amdgcn_mfma_f32_32x32x16_bf16(py[2], ATT_PK(l2, h2), oy, 0, 0, 0);
    ox = __builtin_amdgcn_mfma_f32_32x32x16_bf16(px[3], ATT_PK(l3, h3), ox, 0, 0, 0);
    oy = __builtin_amdgcn_mfma_f32_32x32x16_bf16(py[3], ATT_PK(l3, h3), oy, 0, 0, 0);
#undef ATT_PK
}
__device__ __forceinline__ void softmax_half(f32x16& p, float& l_reg, sbf16x8& pa, sbf16x8& pb) {
#pragma unroll
    for (int r = 0; r < 16; ++r) p[r] = __builtin_amdgcn_exp2f(p[r]);
    float ps0 = 0.f, ps1 = 0.f;
#pragma unroll
    for (int r = 0; r < 8; ++r) { ps0 += p[r]; ps1 += p[8 + r]; }
    l_reg += ps0 + ps1;
    { v4u w; w.x = pk2(p[0], p[1]); w.y = pk2(p[2], p[3]); w.z = pk2(p[4], p[5]); w.w = pk2(p[6], p[7]); pa = __builtin_bit_cast(sbf16x8, w); }
    { v4u w; w.x = pk2(p[8], p[9]); w.y = pk2(p[10], p[11]); w.z = pk2(p[12], p[13]); w.w = pk2(p[14], p[15]); pb = __builtin_bit_cast(sbf16x8, w); }
}
template <int ROW0> __device__ __forceinline__ void qk_half(f32x16& x, f32x16& y, const LAS char* Ks, const sbf16x8* qx, const sbf16x8* qy, int r32, int hi) {
    asm volatile("" : "+v"(r32));
    x = f32x16{}; y = f32x16{};
    sbf16x8 c[6];
#pragma unroll
    for (int d0 = 0; d0 < 6; ++d0) c[d0] = *(const LAS sbf16x8*)(Ks + ATT_KSWZ(ROW0 + r32, (d0 * 16 + hi * 8) * 2));
#pragma unroll
    for (int d0 = 0; d0 < 6; ++d0) {
        x = __builtin_amdgcn_mfma_f32_32x32x16_bf16(c[d0], qx[d0], x, 0, 0, 0);
        y = __builtin_amdgcn_mfma_f32_32x32x16_bf16(c[d0], qy[d0], y, 0, 0, 0);
    }
}
template <int KS0> __device__ __forceinline__ void pv_half(f32x16* ox, f32x16* oy, int vb, sbf16x8 pxa, sbf16x8 pxb, sbf16x8 pya, sbf16x8 pyb) {
    const s16x4 l00 = tr_read<v_rd_off(0, KS0, 0)>(vb), h00 = tr_read<v_rd_off(0, KS0, 1)>(vb), l01 = tr_read<v_rd_off(0, KS0 + 1, 0)>(vb), h01 = tr_read<v_rd_off(0, KS0 + 1, 1)>(vb);
    const s16x4 l10 = tr_read<v_rd_off(1, KS0, 0)>(vb), h10 = tr_read<v_rd_off(1, KS0, 1)>(vb), l11 = tr_read<v_rd_off(1, KS0 + 1, 0)>(vb), h11 = tr_read<v_rd_off(1, KS0 + 1, 1)>(vb);
    asm volatile("s_waitcnt lgkmcnt(0)" ::: "memory"); ATT_SBAR();
#define ATT_PK(L, H) (sbf16x8){L[0], L[1], L[2], L[3], H[0], H[1], H[2], H[3]}
    ox[0] = __builtin_amdgcn_mfma_f32_32x32x16_bf16(ATT_PK(l00, h00), pxa, ox[0], 0, 0, 0);
    oy[0] = __builtin_amdgcn_mfma_f32_32x32x16_bf16(ATT_PK(l00, h00), pya, oy[0], 0, 0, 0);
    ox[1] = __builtin_amdgcn_mfma_f32_32x32x16_bf16(ATT_PK(l10, h10), pxa, ox[1], 0, 0, 0);
    oy[1] = __builtin_amdgcn_mfma_f32_32x32x16_bf16(ATT_PK(l10, h10), pya, oy[1], 0, 0, 0);
    ox[0] = __builtin_amdgcn_mfma_f32_32x32x16_bf16(ATT_PK(l01, h01), pxb, ox[0], 0, 0, 0);
    oy[0] = __builtin_amdgcn_mfma_f32_32x32x16_bf16(ATT_PK(l01, h01), pyb, oy[0], 0, 0, 0);
    ox[1] = __builtin_amdgcn_mfma_f32_32x32x16_bf16(ATT_PK(l11, h11), pxb, ox[1], 0, 0, 0);
    oy[1] = __builtin_amdgcn_mfma_f32_32x32x16_bf16(ATT_PK(l11, h11), pyb, oy[1], 0, 0, 0);
#undef ATT_PK
}
constexpr int OFF2_V = 0, OFF2_K = 2 * SHM_V, OFF2_WS = 2 * SHM_V + 2 * SHM_K;
__device__ __forceinline__ void attn_unit2(const bf16* Qb, const bf16* Kh, const bf16* Vh, bf16* Ob, int seq, LAS char* lds, int tid) {
    const int wid = __builtin_amdgcn_readfirstlane(tid >> 6), lane = tid & 63, r32 = lane & 31, hi = lane >> 5; int lane2;
    LAS char* V_lds = lds + OFF2_V; LAS char* K_lds = lds + OFF2_K;
    LAS float* ws = (LAS float*)(lds + OFF2_WS) + wid * 64;
    float lx = 0.f, ly = 0.f; f32x16 ox[2], oy[2]; ox[0] = f32x16{}; ox[1] = f32x16{}; oy[0] = f32x16{}; oy[1] = f32x16{}; sbf16x8 qx[6], qy[6];
    { const GAS bf16* Qw = (const GAS bf16*)Qb + (size_t)(wid * 64 + r32) * 96 + hi * 8;
#pragma unroll
      for (int d0 = 0; d0 < 6; ++d0) { qx[d0] = *(const GAS sbf16x8*)(Qw + d0 * 16); qy[d0] = *(const GAS sbf16x8*)(Qw + 32 * 96 + d0 * 16); } }
    const int kc1 = 512 + (tid & 255), kr0 = tid / 12, kq0 = (tid % 12) * 8, kr1 = kc1 / 12, kq1 = (kc1 % 12) * 8;
    const int ksto0 = ATT_KSWZ(kr0, kq0 * 2), ksto1 = ATT_KSWZ(kr1, kq1 * 2);
    const int vr = tid >> 3, vq = (tid & 7) * 8, vsto = v_st(vr, vq);
    const int vb0 = (int)(unsigned)(size_t)V_lds + v_rd_base(lane);
    const unsigned ko0 = (unsigned)(kr0 * 96 + kq0) * 2u, ko1 = (unsigned)(kr1 * 96 + kq1) * 2u, vo = (unsigned)(vr * 64 + vq) * 2u;
    const GAS char* Kg = (const GAS char*)Kh; const GAS char* Vg = (const GAS char*)Vh;
    sbf16x8 sk0, sk1, sv;
#define ATT2_SLOAD(k0) do { sk0 = *(const GAS sbf16x8*)(Kg + (ko0 + (unsigned)(k0) * 192u)); sk1 = *(const GAS sbf16x8*)(Kg + (ko1 + (unsigned)(k0) * 192u)); sv = *(const GAS sbf16x8*)(Vg + (vo + (unsigned)(k0) * 128u)); } while (0)
#define ATT2_SWRITE(b) do { *(LAS sbf16x8*)(K_lds + (b) * SHM_K + ksto0) = sk0; *(LAS sbf16x8*)(K_lds + (b) * SHM_K + ksto1) = sk1; *(LAS sbf16x8*)(V_lds + (b) * SHM_V + vsto) = sv; } while (0)
    const int NT = seq / KVBLK;
    ATT2_SLOAD(0); ATT2_SWRITE(0); __syncthreads();
    f32x16 x0, x1, y0, y1; sbf16x8 px[4], py[4];
#pragma unroll 1
    for (int j = 0; j < NT; ++j) {
        const int b = j & 1;
        if (j + 1 < NT) ATT2_SLOAD((j + 1) * KVBLK);
        ATT_SBAR();
        qk_half<0>(x0, y0, K_lds + b * SHM_K, qx, qy, r32, hi);
        ATT_SBAR();
        qk_half<32>(x1, y1, K_lds + b * SHM_K, qx, qy, r32, hi);
        softmax_half(x0, lx, px[0], px[1]); softmax_half(y0, ly, py[0], py[1]);
        ATT_SBAR();
        pv_half<0>(ox, oy, vb0 + b * SHM_V, px[0], px[1], py[0], py[1]);
        softmax_half(x1, lx, px[2], px[3]); softmax_half(y1, ly, py[2], py[3]);
        ATT_SBAR();
        pv_half<2>(ox, oy, vb0 + b * SHM_V, px[2], px[3], py[2], py[3]);
        ATT_SBAR();
        if (j + 1 < NT) ATT2_SWRITE(b ^ 1);
        __syncthreads();
    }
#undef ATT2_SLOAD
#undef ATT2_SWRITE
    { auto rr = __builtin_amdgcn_permlane32_swap(__float_as_uint(lx), __float_as_uint(lx), false, false); lx = __uint_as_float(rr[0]) + __uint_as_float(rr[1]); }
    { auto rr = __builtin_amdgcn_permlane32_swap(__float_as_uint(ly), __float_as_uint(ly), false, false); ly = __uint_as_float(rr[0]) + __uint_as_float(rr[1]); }
    { unsigned z_ = 0u; asm volatile("" : "+v"(z_)); lane2 = (int)__builtin_amdgcn_mbcnt_hi(~0u, __builtin_amdgcn_mbcnt_lo(~0u, z_)); }
    const int r32e = lane2 & 31, hie = lane2 >> 5;
    if (hie == 0) { ws[r32e] = lx; ws[32 + r32e] = ly; }
    asm volatile("s_waitcnt lgkmcnt(0)" ::: "memory");
    LAS bf16* stg = (LAS bf16*)(lds + wid * 8192);
#pragma unroll
    for (int r = 0; r < 16; ++r) { const int orow = crow(r, hie); const float rlx = __builtin_amdgcn_rcpf(ws[orow]), rly = __builtin_amdgcn_rcpf(ws[32 + orow]);
#pragma unroll
        for (int d0 = 0; d0 < 2; ++d0) { stg[orow * 64 + d0 * 32 + r32e] = (bf16)(pk2(ox[d0][r] * rlx, 0.f) & 0xffffu); stg[(32 + orow) * 64 + d0 * 32 + r32e] = (bf16)(pk2(oy[d0][r] * rly, 0.f) & 0xffffu); } }
    asm volatile("s_waitcnt lgkmcnt(0)" ::: "memory");
    GAS bf16* Ow = (GAS bf16*)Ob + (size_t)(wid * 64) * 512;
#pragma unroll
    for (int i = 0; i < 8; ++i) { const int row = i * 8 + (lane2 >> 3), ch = lane2 & 7; const v4u v = *(const LAS v4u*)(stg + row * 64 + ch * 8); *(GAS v4u*)(Ow + (size_t)row * 512 + ch * 8) = v; }
    asm volatile("s_waitcnt lgkmcnt(0)" ::: "memory");
}
constexpr int OFF4_K = 0, OFF4_V = 3 * SHM_K, OFF4_WS = 3 * SHM_K + 3 * SHM_V;
static_assert(OFF4_WS + NW * 64 * 4 <= 131072, "attention LDS");
__device__ __forceinline__ void attn_unit4(const bf16* Qb, const bf16* Kh, const bf16* Vh, bf16* Ob, int seq, LAS char* lds, int tid) {
    const int wid = __builtin_amdgcn_readfirstlane(tid >> 6), lane = tid & 63, r32 = lane & 31, hi = lane >> 5; int lane2;
    LAS char* K_lds = lds + OFF4_K; LAS char* V_lds = lds + OFF4_V;
    LAS float* ws = (LAS float*)(lds + OFF4_WS) + wid * 64;
    float lx = 0.f, ly = 0.f; f32x16 ox[2], oy[2]; ox[0] = f32x16{}; ox[1] = f32x16{}; oy[0] = f32x16{}; oy[1] = f32x16{}; sbf16x8 qx[6], qy[6];
    { const GAS bf16* Qw = (const GAS bf16*)Qb + (size_t)(wid * 64 + r32) * 96 + hi * 8;
#pragma unroll
      for (int d0 = 0; d0 < 6; ++d0) { qx[d0] = *(const GAS sbf16x8*)(Qw + d0 * 16); qy[d0] = *(const GAS sbf16x8*)(Qw + 32 * 96 + d0 * 16); } }
    const int rowA = 4 * wid + (lane >> 4), chA = (lane & 15) ^ (rowA & 15);
    const unsigned kofA = (unsigned)(rowA * 96 + (chA < 12 ? chA * 8 : 0)) * 2u, kofB = kofA + 32u * 192u;
    const int kkv = wid * 8 + ((lane & 31) >> 2), kv = kkv;
    const unsigned vof = (unsigned)(kv * 64 + (lane >> 5) * 32 + (lane & 3) * 8) * 2u;
    const GAS char* Kg = (const GAS char*)Kh; const GAS char* Vg = (const GAS char*)Vh;
    const int vb0 = (int)(unsigned)(size_t)V_lds + v_rd_base(lane);
#define ATT4_DMA(t, slot) do { \
    __builtin_amdgcn_global_load_lds((const GAS unsigned*)(Kg + (kofA + (unsigned)(t) * (64u * 192u))), (LAS unsigned*)(K_lds + (slot) * SHM_K + wid * 1024), 16, 0, 0); \
    __builtin_amdgcn_global_load_lds((const GAS unsigned*)(Kg + (kofB + (unsigned)(t) * (64u * 192u))), (LAS unsigned*)(K_lds + (slot) * SHM_K + (wid + 8) * 1024), 16, 0, 0); \
    __builtin_amdgcn_global_load_lds((const GAS unsigned*)(Vg + (vof + (unsigned)(t) * (64u * 128u))), (LAS unsigned*)(V_lds + (slot) * SHM_V + wid * 2048), 16, 0, 0); } while (0)
    const int NT = seq / KVBLK;
    ATT4_DMA(0, 0);
    asm volatile("s_waitcnt vmcnt(0)" ::: "memory"); __syncthreads();
    f32x16 x0, x1, y0, y1; sbf16x8 px[4], py[4];
    x1 = f32x16{}; y1 = f32x16{};
#pragma unroll
    for (int i = 0; i < 4; ++i) { px[i] = sbf16x8{}; py[i] = sbf16x8{}; }
    int s_prev = 2, s_cur = 0, s_next = 1;
#pragma unroll 1
    for (int j = 0; j < NT; ++j) {
        if (j + 1 < NT) ATT4_DMA(j + 1, s_next);
        ATT_SBAR();
        qk_half<0>(x0, y0, K_lds + s_cur * SHM_K, qx, qy, r32, hi);
        qk_half<32>(x1, y1, K_lds + s_cur * SHM_K, qx, qy, r32, hi);
        softmax_half(x0, lx, px[0], px[1]); softmax_half(y0, ly, py[0], py[1]);
        pv_half<0>(ox, oy, vb0 + s_cur * SHM_V, px[0], px[1], py[0], py[1]);
        softmax_half(x1, lx, px[2], px[3]); softmax_half(y1, ly, py[2], py[3]);
        pv_half<2>(ox, oy, vb0 + s_cur * SHM_V, px[2], px[3], py[2], py[3]);
        asm volatile("s_waitcnt vmcnt(0)" ::: "memory");
        __syncthreads();
        { const int t_ = s_prev; s_prev = s_cur; s_cur = s_next; s_next = t_; }
    }
#undef ATT4_DMA
    { auto rr = __builtin_amdgcn_permlane32_swap(__float_as_uint(lx), __float_as_uint(lx), false, false); lx = __uint_as_float(rr[0]) + __uint_as_float(rr[1]); }
    { auto rr = __builtin_amdgcn_permlane32_swap(__float_as_uint(ly), __float_as_uint(ly), false, false); ly = __uint_as_float(rr[0]) + __uint_as_float(rr[1]); }
    { unsigned z_ = 0u; asm volatile("" : "+v"(z_)); lane2 = (int)__builtin_amdgcn_mbcnt_hi(~0u, __builtin_amdgcn_mbcnt_lo(~0u, z_)); }
    const int r32e = lane2 & 31, hie = lane2 >> 5;
    const float rlx = __builtin_amdgcn_rcpf(lx), rly = __builtin_amdgcn_rcpf(ly);
    LAS bf16* stg = (LAS bf16*)(lds + wid * 8192);
#pragma unroll
    for (int d0 = 0; d0 < 2; ++d0)
#pragma unroll
        for (int g = 0; g < 4; ++g) {
            v2u wx, wy; wx.x = pk2(ox[d0][4 * g] * rlx, ox[d0][4 * g + 1] * rlx); wx.y = pk2(ox[d0][4 * g + 2] * rlx, ox[d0][4 * g + 3] * rlx);
            wy.x = pk2(oy[d0][4 * g] * rly, oy[d0][4 * g + 1] * rly); wy.y = pk2(oy[d0][4 * g + 2] * rly, oy[d0][4 * g + 3] * rly);
            *(LAS v2u*)(stg + r32e * 64 + d0 * 32 + 8 * g + 4 * hie) = wx; *(LAS v2u*)(stg + (32 + r32e) * 64 + d0 * 32 + 8 * g + 4 * hie) = wy; }
    asm volatile("s_waitcnt lgkmcnt(0)" ::: "memory");
    GAS bf16* Ow = (GAS bf16*)Ob + (size_t)(wid * 64) * 512;
#pragma unroll
    for (int i = 0; i < 8; ++i) { const int row = i * 8 + (lane2 >> 3), ch = lane2 & 7; const v4u v = *(const LAS v4u*)(stg + row * 64 + ch * 8); *(GAS v4u*)(Ow + (size_t)row * 512 + ch * 8) = v; }
    asm volatile("s_waitcnt lgkmcnt(0)" ::: "memory");
}
}

__device__ __forceinline__ bool attn_static_ok(Frame& F, int l) {
    const float* gq = ((const float*)(const GAS float*)F.in[13]) + l * DQK; const float* gk = ((const float*)(const GAS float*)F.in[14]) + l * DQK; float mq = 0.f, mk = 0.f;
    for (int d = 0; d < DQK; ++d) { mq = fmaxf(mq, fabsf(gq[d])); mk = fmaxf(mk, fabsf(gk[d])); }
    return 96.f * mq * mk * QSCALE <= 60.f;
}
__device__ __forceinline__ void step_f_fast(Frame& F) {
    fresh_tid(F);
    const bf16* Q = WSP(bf16, WS_Q); const bf16* K = WSP(bf16, WS_K); const bf16* V = WSP(bf16, WS_V); bf16* O = WSP(bf16, WS_O);
    const int vcu = (F.G % 8 == 0) ? (F.bid % 8) * (F.G / 8) + F.bid / 8 : F.bid;
#if ATTN_W64
    for (int u = vcu; u < NB * H * (S / 512); u += F.G) {
        const int qb = u % 16, bh = (u / 16), b = bh / H, h = bh % H;
        fresh_tid(F);
        att::attn_unit4(Q + ((size_t)bh * S + qb * 512) * 96, K + (size_t)bh * S * 96, V + (size_t)bh * S * 64, O + ((size_t)(b * S + qb * 512)) * 512 + h * 64, S, (LAS char*)F.lds, F.tid);
        __syncthreads();
    }
#else
    for (int u = vcu; u < NB * H * (S / 256); u += F.G) {
        const int qb = u % 32, bh = (u / 32), b = bh / H, h = bh % H;
        fresh_tid(F);
        att::attn_unit(Q + ((size_t)bh * S + qb * 256) * 96, K + (size_t)bh * S * 96, V + (size_t)bh * S * 64, O + ((size_t)(b * S + qb * 256)) * 512 + h * 64, S, (LAS char*)F.lds, F.tid);
        __syncthreads();
    }
#endif
}
constexpr size_t WT_IN = WS_WT, WT_UQ = WS_WT + 8 * MiB, WT_UKV = WT_UQ + 384 * KiB, WT_CO = WS_WT + 9 * MiB, WT_AO = WS_WT + 10 * MiB, WT_O = WS_WT + 11 * MiB,
                 WT_GU = WS_WT + 13 * MiB, WT_DN = WS_WT + 30 * MiB;
constexpr int NPROJ = 4096;
static_assert(WT_DN + (size_t)NEX * 1024 * 256 * 2 <= WS_WT + 40 * MiB, "weight region");
__device__ __forceinline__ void cvt_item(const float* W, int K, int N, bf16* WT, int drow0, const float* ksc, LAS float* scr, int k0, int n0, int lane) {
    float wv[32];
#pragma unroll
    for (int i = 0; i < 32; ++i) wv[i] = W[(size_t)(k0 + 2 * i + (lane >> 5)) * N + n0 + (lane & 31)];
#pragma unroll
    for (int i = 0; i < 32; ++i) { const int kk = 2 * i + (lane >> 5); float v = wv[i]; if (ksc) v *= ksc[k0 + kk]; scr[kk * 33 + (lane & 31)] = v; }
    asm volatile("s_waitcnt lgkmcnt(0)" ::: "memory");
    const int c = lane & 7;
#pragma unroll
    for (int j = 0; j < 4; ++j) { const int n = (lane >> 3) + 8 * j; const LAS float* s = scr + (8 * c) * 33 + n;
        v4u o; o.x = pk2(s[0 * 33], s[1 * 33]); o.y = pk2(s[2 * 33], s[3 * 33]); o.z = pk2(s[4 * 33], s[5 * 33]); o.w = pk2(s[6 * 33], s[7 * 33]);
        *(v4u*)(WT + (size_t)(drow0 + n) * K + k0 + 8 * c) = o; }
    asm volatile("s_waitcnt lgkmcnt(0)" ::: "memory");
}
__device__ __forceinline__ int proj_dest(int n0) {
    if (n0 < 512) return n0;
    if (n0 < 1024) return 512 + ((n0 - 512) >> 7) * 256 + ((n0 - 512) & 127);
    if (n0 < 1536) return 512 + ((n0 - 1024) >> 7) * 256 + 128 + ((n0 - 1024) & 127);
    if (n0 < 1952) return n0;
    return n0 + 96;
}
__device__ __forceinline__ int ukv_dest(int n0) { const int h = n0 >> 7, j0 = n0 & 127, kind = j0 >> 6, d0 = j0 & 63; return (kind * 2 + (h >> 2)) * 256 + (d0 >> 5) * 128 + (h & 3) * 32; }
__device__ __forceinline__ void convert_weights(Frame& F, int l) {
    fresh_tid(F);
    LAS float* scr = (LAS float*)(F.lds + F.wave * 16384);
    const int gw = F.bid * NWAVES + F.wave, NGW = F.G * NWAVES;
    constexpr int I_IN = 16 * 125, I_UQ = 4 * 24, I_UKV = 2 * 32, I_CO = 8 * 32, I_O = 16 * 32, I_GU = NEX * 16 * 8, I_DN = NEX * 4 * 32;
    constexpr int NITEMS = I_IN + I_UQ + I_UKV + 2 * I_CO + I_O + 2 * I_GU + I_DN;
    for (int it = gw; it < NITEMS; it += NGW) {
        int r = it;
        if (r < I_IN) { const int kb = r / 125, nb = r % 125, n0 = 32 * nb; cvt_item(((const float*)(const GAS float*)F.in[7]) + (size_t)l * D * NIN, D, NIN, WSP(bf16, WT_IN), proj_dest(n0), nullptr, scr, 64 * kb, n0, F.lane); continue; } r -= I_IN;
        if (r < I_UQ) { const int kb = r / 24, nb = r % 24; cvt_item(((const float*)(const GAS float*)F.in[10]) + (size_t)l * QL * 768, QL, 768, WSP(bf16, WT_UQ), 32 * nb, ((const float*)(const GAS float*)F.in[9]) + l * QL, scr, 64 * kb, 32 * nb, F.lane); continue; } r -= I_UQ;
        if (r < I_UKV) { const int kb = r / 32, nb = r % 32; cvt_item(((const float*)(const GAS float*)F.in[12]) + (size_t)l * KVL * 1024, KVL, 1024, WSP(bf16, WT_UKV), ukv_dest(32 * nb), ((const float*)(const GAS float*)F.in[11]) + l * KVL, scr, 64 * kb, 32 * nb, F.lane); continue; } r -= I_UKV;
        if (r < I_CO) { const int kb = r / 32, nb = r % 32; cvt_item(((const float*)(const GAS float*)F.in[15]) + (size_t)l * CW * D, CW, D, WSP(bf16, WT_CO), 32 * nb, nullptr, scr, 64 * kb, 32 * nb, F.lane); continue; } r -= I_CO;
        if (r < I_CO) { const int kb = r / 32, nb = r % 32; cvt_item(((const float*)(const GAS float*)F.in[16]) + (size_t)l * 512 * D, 512, D, WSP(bf16, WT_AO), 32 * nb, nullptr, scr, 64 * kb, 32 * nb, F.lane); continue; } r -= I_CO;
        if (r < I_O) { const int kb = r / 32, nb = r % 32; cvt_item(((const float*)(const GAS float*)F.in[17]) + (size_t)l * D * D, D, D, WSP(bf16, WT_O), 32 * nb, nullptr, scr, 64 * kb, 32 * nb, F.lane); continue; } r -= I_O;
        if (r < 2 * I_GU) { const int up = r >= I_GU ? 1 : 0; r -= up * I_GU; const int e = r / 128, q = r % 128, kb = q / 8, nb = q % 8, n0 = 32 * nb;
            const float* W = e < NE ? ((const float*)(const GAS float*)F.in[20 + up]) + ((size_t)l * NE + e) * D * DE : ((const float*)(const GAS float*)F.in[23 + up]) + (size_t)l * D * DE;
            cvt_item(W, D, DE, WSP(bf16, WT_GU) + (size_t)e * 512 * D, (n0 >> 7) * 256 + up * 128 + (n0 & 127), nullptr, scr, 64 * kb, n0, F.lane); continue; } r -= 2 * I_GU;
        { const int e = r / 128, q = r % 128, kb = q / 32, nb = q % 32;
            const float* W = e < NE ? ((const float*)(const GAS float*)F.in[22]) + ((size_t)l * NE + e) * DE * D : ((const float*)(const GAS float*)F.in[25]) + (size_t)l * DE * D;
            cvt_item(W, DE, D, WSP(bf16, WT_DN) + (size_t)e * D * DE, 32 * nb, nullptr, scr, 64 * kb, 32 * nb, F.lane); }
    }
    v4u* z = (v4u*)(WSP(bf16, WT_IN) + (size_t)1952 * D);
    unsigned z0 = 0u; asm volatile("" : "+v"(z0));
    for (int i = F.bid * NTHREADS + F.tid; i < 96 * D * 2 / 16; i += F.G * NTHREADS) z[i] = (v4u){z0, z0, z0, z0};
}

namespace pg8 {
typedef short sbf16x8 __attribute__((ext_vector_type(8)));
constexpr int BM = 256, BK = 64, HALF = 128, HTB = HALF * BK * 2, STAGE_BYTES = 8 * HTB, NXCD = 8, WGM = 8;
__device__ __forceinline__ int lds_byte(int r, int c) { const int st = (r >> 4) * 2 + (c >> 5), rr = r & 15, cc = c & 31, ob = rr * 64 + cc * 2; return st * 1024 + (ob ^ (((ob >> 9) & 1) << 5)); }
__device__ __forceinline__ void stage_rc(int b, int& R, int& C) { const int st = b / 1024, sb = b % 1024, swz = sb ^ (((sb >> 9) & 1) << 5); R = (st >> 1) * 16 + swz / 64; C = (st & 1) * 32 + (swz % 64) / 2; }
__device__ __forceinline__ int perm32(int rho) { const int n = rho >> 4, i = rho & 15; return 8 * (i >> 2) + 4 * n + (i & 3); }
__device__ __forceinline__ int xcd_remap(int L, int nwg) { const int q = nwg / NXCD, r = nwg % NXCD, xcd = L % NXCD, off = L / NXCD; return (xcd < r ? xcd * (q + 1) : r * (q + 1) + (xcd - r) * q) + off; }

struct Unit { int pm, pn; const char* a; const char* b; const int* list; int rows, tok0, e; };
struct Gemm { unsigned lda; int K; };

struct StaticOrder {
    const char* A; const char* Bt; unsigned lda; int K, nM, nN, nwg, G, c;
    static constexpr bool WAITS = false;
    __device__ __forceinline__ bool next(int i, Unit& u, int) const {
        const long L = (long)i * G + c; if (L >= nwg) return false;
        const int wgid = xcd_remap((int)L, nwg);
        const int nig = WGM * nN, gid = wgid / nig, fm = gid * WGM, gsz = (nM - fm) < WGM ? (nM - fm) : WGM;
        u.pm = fm + ((wgid % nig) % gsz); u.pn = (wgid % nig) / gsz;
        u.a = A + (size_t)u.pm * BM * lda; u.b = Bt + (size_t)u.pn * BM * K * 2; u.list = nullptr; u.rows = BM; u.tok0 = u.pm * BM; u.e = 0; return true;
    }
};
struct MoeOrder {
    const char* A; const char* Bt; size_t estride; unsigned lda; int K, nN, MT, G, c; const LAS unsigned* tb; const LAS unsigned* cnt; const int* LIST; bool gather;
    static constexpr bool WAITS = false;
    __device__ __forceinline__ bool next(int i, Unit& u, int) const {
        const int nwg = MT * nN; const long L = (long)i * G + c; if (L >= nwg) return false;
        const int wgid = xcd_remap((int)L, nwg);
        const int mt = wgid / nN, pn = wgid % nN; int e = 0;
#pragma unroll 1
        for (int j = 1; j <= NE; ++j) if ((unsigned)mt >= (unsigned)__builtin_amdgcn_readfirstlane(tb[j])) e = j;
        const int lt = mt - (int)__builtin_amdgcn_readfirstlane(tb[e]);
        u.pm = mt; u.pn = pn; u.e = e; u.tok0 = lt * BM;
        if (e < NE) { const int left = (int)__builtin_amdgcn_readfirstlane(cnt[e]) - lt * BM; u.rows = left < BM ? left : BM; u.list = LIST + (size_t)e * T + lt * BM; } else { u.rows = BM; u.list = nullptr; }
        u.a = gather ? A : A + (size_t)mt * BM * lda; u.b = Bt + (size_t)e * estride + (size_t)pn * BM * K * 2; return true;
    }
};

#ifndef KL_R
#define KL_R 3
#endif
struct MoeOrderX {
    static constexpr bool WAITS = true;
    const char* A; const char* Bt; size_t estride; unsigned lda; int K, nN, MT, G, c; const LAS unsigned* tb; const LAS unsigned* cnt; const int* LIST; bool gather;
    int mode, kN; unsigned* flags; unsigned* bar;
    __device__ __forceinline__ bool next(int i, Unit& u, int wid) const {
        const int NX = (G % NXCD == 0) ? NXCD : 1, x = c % NX, cl = c / NX, GX = G / NX;
        const int qm = MT / NX, rm = MT % NX, sz = qm + (x < rm ? 1 : 0), m0 = x * qm + (x < rm ? x : rm);
        if (sz == 0) return false;
        int off;
        if (mode == 0) off = cl + i * GX;
        else {
            const int ku = kN * sz, kmax = (ku + GX - 1) / GX, hx = ku - (kmax - 1) * GX, nl = GX - hx;
            if (cl >= hx && i < KL_R) off = (cl - hx) + i * nl;
            else { const int p = cl + (cl >= hx ? i - KL_R : i) * GX; off = KL_R * nl + (p < GX ? (p >= hx ? p - hx : nl + p) : p); }
        }
        const int sl = off / nN, pn = off % nN; if (sl >= sz) return false;
        const int mt = m0 + sl; int e = 0;
#pragma unroll 1
        for (int j = 1; j <= NE; ++j) if ((unsigned)mt >= (unsigned)__builtin_amdgcn_readfirstlane(tb[j])) e = j;
        const int lt = mt - (int)__builtin_amdgcn_readfirstlane(tb[e]);
        u.pm = mt; u.pn = pn; u.e = e; u.tok0 = lt * BM;
        if (e < NE) { const int left = (int)__builtin_amdgcn_readfirstlane(cnt[e]) - lt * BM; u.rows = left < BM ? left : BM; u.list = LIST + (size_t)e * T + lt * BM; } else { u.rows = BM; u.list = nullptr; }
        u.a = gather ? A : A + (size_t)mt * BM * lda; u.b = Bt + (size_t)e * estride + (size_t)pn * BM * K * 2;
        if (mode == 1 && wid == 0) {
            XB_SPIN(xb_ld(flags + mt) < (unsigned)kN, bar);
            __builtin_amdgcn_fence(__ATOMIC_ACQUIRE, "agent");
        }
        return true;
    }
};

__device__ __forceinline__ v4u pack8(f32x4 v0, f32x4 v1) { v4u w; w.x = pk2(v0[0], v0[1]); w.y = pk2(v0[2], v0[3]); w.z = pk2(v1[0], v1[1]); w.w = pk2(v1[2], v1[3]); return w; }
struct EpiBf16 {
    static constexpr bool PERM = true; static constexpr bool SIGNAL = false;
    bf16* O; int ldc; int split; bf16* gbp;
    __device__ __forceinline__ void operator()(const f32x4 (&acc)[2][2][4][2], const Unit& u, int wr, int wc, int fr, int fq) const {
        bf16* base = O; int ld = ldc, c0 = u.pn * BM;
        if (split) { const int pn = u.pn; unsigned char* w = (unsigned char*)O;
            if (pn >= 2 && pn < 6) {
                bf16* pb = (bf16*)(w + WS_CONV) + 512 + (pn - 2) * 128 + wc * 32 + 8 * fq; const int row0 = u.pm * BM + wr * 64 + fr;
#pragma unroll
                for (int ai = 0; ai < 2; ++ai)
#pragma unroll
                    for (int m = 0; m < 4; ++m) { *(v4u*)(pb + (size_t)(row0 + ai * HALF + m * 16) * 1024) = pack8(acc[ai][0][m][0] * acc[ai][1][m][0], acc[ai][0][m][1] * acc[ai][1][m][1]);
                        asm volatile("" ::: "memory"); }
                return; }
            if (pn < 2) { base = (bf16*)(w + WS_CONV); ld = 1024; c0 = pn * 256; }
            else if (pn < 8) { base = (bf16*)(w + WS_SMALL); ld = 512; c0 = (pn - 6) * 256; }
            else if (pn < 12) { base = (bf16*)(w + WS_GA); ld = 1024; c0 = (pn - 8) * 256; }
            else { base = gbp; ld = 1024; c0 = (pn - 12) * 256; } }
        const int row0 = u.pm * BM + wr * 64 + fr, col0 = c0 + wc * 32 + 8 * fq;
#pragma unroll
        for (int ai = 0; ai < 2; ++ai)
#pragma unroll
            for (int m = 0; m < 4; ++m) { bf16* rowp = base + (size_t)(row0 + ai * HALF + m * 16) * ld + col0;
#pragma unroll
                for (int bj = 0; bj < 2; ++bj) *(v4u*)(rowp + bj * HALF) = pack8(acc[ai][bj][m][0], acc[ai][bj][m][1]);
                asm volatile("" ::: "memory"); }
    }
};
__device__ __forceinline__ unsigned pk4_fp8(f32x4 v) {
#pragma unroll
    for (int e = 0; e < 4; ++e) v[e] = __builtin_fminf(__builtin_fmaxf(v[e], -448.f), 448.f);
    int w = __builtin_amdgcn_cvt_pk_fp8_f32(v[0], v[1], 0, false); w = __builtin_amdgcn_cvt_pk_fp8_f32(v[2], v[3], w, true); return (unsigned)w;
}
struct EpiY8 {
    static constexpr bool PERM = true; static constexpr bool SIGNAL = false;
    unsigned char* Y8;
    __device__ __forceinline__ void operator()(const f32x4 (&acc)[2][2][4][2], const Unit& u, int wr, int wc, int fr, int fq) const {
        const int row0 = u.pm * BM + wr * 64 + fr, col0 = u.pn * BM + wc * 32 + 8 * fq;
#pragma unroll
        for (int ai = 0; ai < 2; ++ai)
#pragma unroll
            for (int m = 0; m < 4; ++m) { unsigned char* rowp = Y8 + (size_t)(row0 + ai * HALF + m * 16) * D + col0;
#pragma unroll
                for (int bj = 0; bj < 2; ++bj) { v2u w; w.x = pk4_fp8(acc[ai][bj][m][0]); w.y = pk4_fp8(acc[ai][bj][m][1]); *(v2u*)(rowp + bj * HALF) = w; }
                asm volatile("" ::: "memory"); }
    }
};
struct EpiKV {
    static constexpr bool PERM = true; static constexpr bool SIGNAL = false;
    bf16* Kb; bf16* Vb; const bf16* small; const f32x2* rope; const float* gk;
    __device__ __forceinline__ void operator()(const f32x4 (&acc)[2][2][4][2], const Unit& u, int wr, int wc, int fr, int fq) const {
        const int lane = fq * 16 + fr; const bool isK = u.pn < 2; const int h = (u.pn & 1) * 4 + wc, i0 = 8 * (fq & 1);
#pragma unroll
        for (int ai = 0; ai < 2; ++ai)
#pragma unroll
            for (int m = 0; m < 4; ++m) {
                const int t = u.pm * BM + ai * HALF + wr * 64 + m * 16 + fr, b = t / S, sq = t % S;
                const bf16* sm = small + (size_t)t * 512;
                const size_t orow = (size_t)(b * H + h) * S + sq;
                float ss = 0.f;
#pragma unroll
                for (int c = 0; c < 4; ++c) { const bf16x8 x = *(const bf16x8*)(sm + 256 + 32 * fq + 8 * c);
#pragma unroll
                    for (int e = 0; e < 8; ++e) { const float f = bf2f(x[e]); ss += f * f; } }
                ss += bperm_xor(ss, lane, 16); ss += bperm_xor(ss, lane, 32);
                const float rs = 1.0f / sqrtf(ss * (1.f / 128.f) + EPS);
                if (isK) {
                    f32x4 gn[2][2], gr1[2], gr2[2];
#pragma unroll
                    for (int bj = 0; bj < 2; ++bj)
#pragma unroll
                        for (int n = 0; n < 2; ++n) gn[bj][n] = *(const f32x4*)(gk + 32 * bj + 8 * fq + 4 * n);
#pragma unroll
                    for (int n = 0; n < 2; ++n) { gr1[n] = *(const f32x4*)(gk + 64 + i0 + 4 * n); gr2[n] = *(const f32x4*)(gk + 80 + i0 + 4 * n); }
                    const bf16x8 x1v = *(const bf16x8*)(sm + 384 + i0), x2v = *(const bf16x8*)(sm + 384 + 16 + i0);
                    const f32x4* rp = (const f32x4*)(rope + (size_t)t * 16 + i0);
                    const f32x4 rp0 = rp[0], rp1 = rp[1], rp2 = rp[2], rp3 = rp[3];
                    float sk = 0.f, sn = 0.f;
#pragma unroll
                    for (int e = 0; e < 8; ++e) { const float f = bf2f(fq < 2 ? x1v[e] : x2v[e]); sk += f * f; }
                    f32x4 v[2][2];
#pragma unroll
                    for (int bj = 0; bj < 2; ++bj)
#pragma unroll
                        for (int n = 0; n < 2; ++n) { v[bj][n] = acc[ai][bj][m][n] * rs;
#pragma unroll
                            for (int e = 0; e < 4; ++e) sn += v[bj][n][e] * v[bj][n][e]; }
                    sk += bperm_xor(sk, lane, 16); sk += bperm_xor(sk, lane, 32);
                    sn += bperm_xor(sn, lane, 16); sn += bperm_xor(sn, lane, 32);
                    const float r = 1.0f / sqrtf((sn + sk) * (1.f / 96.f) + EPS);
#pragma unroll
                    for (int bj = 0; bj < 2; ++bj) *(v4u*)(Kb + orow * 96 + 32 * bj + 8 * fq) = pack8(v[bj][0] * r * gn[bj][0], v[bj][1] * r * gn[bj][1]);
                    f32x4 o0, o1;
#pragma unroll
                    for (int e = 0; e < 8; ++e) {
                        const float a = bf2f(x1v[e]) * r * (e < 4 ? gr1[0][e & 3] : gr1[1][e & 3]), bb = bf2f(x2v[e]) * r * (e < 4 ? gr2[0][e & 3] : gr2[1][e & 3]);
                        const f32x4 cq = e < 2 ? rp0 : e < 4 ? rp1 : e < 6 ? rp2 : rp3; const float cs = (e & 1) ? cq.z : cq.x, sn_ = (e & 1) ? cq.w : cq.y;
                        const float o = fq < 2 ? a * cs - bb * sn_ : bb * cs + a * sn_;
                        if (e < 4) o0[e & 3] = o; else o1[e & 3] = o; }
                    *(v4u*)(Kb + orow * 96 + 64 + 8 * fq) = pack8(o0, o1);
                } else {
#pragma unroll
                    for (int bj = 0; bj < 2; ++bj) *(v4u*)(Vb + orow * 64 + 32 * bj + 8 * fq) = pack8(acc[ai][bj][m][0] * rs, acc[ai][bj][m][1] * rs);
                }
                asm volatile("" ::: "memory");
            }
    }
};
template <int MODE> struct EpiGate {
    static constexpr bool PERM = true; static constexpr bool SIGNAL = false;
    bf16* ga; const bf16* gb;
    __device__ __forceinline__ void operator()(const f32x4 (&acc)[2][2][4][2], const Unit& u, int wr, int wc, int fr, int fq) const {
        const int row0 = u.pm * BM + wr * 64 + fr, col0 = u.pn * BM + wc * 32 + 8 * fq;
#pragma unroll
        for (int ai = 0; ai < 2; ++ai) {
            bf16x8 g[4][2], t[4][2];
#pragma unroll
            for (int m = 0; m < 4; ++m) { const size_t off = (size_t)(row0 + ai * HALF + m * 16) * D + col0;
#pragma unroll
                for (int bj = 0; bj < 2; ++bj) { g[m][bj] = *(const bf16x8*)((MODE == 1 ? ga : gb) + off + bj * HALF);
                    t[m][bj] = (bf16x8){0, 0, 0, 0, 0, 0, 0, 0}; if (MODE == 2) t[m][bj] = *(const bf16x8*)(ga + off + bj * HALF); } }
#pragma unroll
            for (int m = 0; m < 4; ++m) { const size_t off = (size_t)(row0 + ai * HALF + m * 16) * D + col0;
#pragma unroll
                for (int bj = 0; bj < 2; ++bj) {
                    f32x4 v0 = acc[ai][bj][m][0], v1 = acc[ai][bj][m][1];
#pragma unroll
                    for (int e = 0; e < 4; ++e) { v0[e] = sigmoidf_(bf2f(g[m][bj][e])) * v0[e]; v1[e] = sigmoidf_(bf2f(g[m][bj][4 + e])) * v1[e];
                        if (MODE == 2) { v0[e] += bf2f(t[m][bj][e]); v1[e] += bf2f(t[m][bj][4 + e]); } }
                    *(v4u*)(ga + off + bj * HALF) = pack8(v0, v1); } }
            asm volatile("" ::: "memory");
        }
    }
};
struct EpiRes {
    static constexpr bool PERM = false; static constexpr bool SIGNAL = false;
    const float* xin; float* out; const float* gt;
    __device__ __forceinline__ void operator()(const f32x4 (&acc)[2][2][4][2], const Unit& u, int wr, int wc, int fr, int fq) const {
        const int col0 = u.pn * BM + wc * 32 + 4 * fq;
        const float* g = gt + ((u.pm * BM) / S) * 6 * D;
        f32x4 gv[2][2];
#pragma unroll
        for (int bj = 0; bj < 2; ++bj)
#pragma unroll
            for (int n = 0; n < 2; ++n) gv[bj][n] = *(const f32x4*)(g + col0 + bj * HALF + n * 16);
#pragma unroll
        for (int ai = 0; ai < 2; ++ai)
#pragma unroll
            for (int mp = 0; mp < 2; ++mp) {
                f32x4 xv[2][2][2];
#pragma unroll
                for (int mm = 0; mm < 2; ++mm) { const size_t off = (size_t)(u.pm * BM + ai * HALF + wr * 64 + (2 * mp + mm) * 16 + fr) * D + col0;
#pragma unroll
                    for (int bj = 0; bj < 2; ++bj)
#pragma unroll
                        for (int n = 0; n < 2; ++n) xv[mm][bj][n] = *(const f32x4*)(xin + off + bj * HALF + n * 16); }
#pragma unroll
                for (int mm = 0; mm < 2; ++mm) { const int m = 2 * mp + mm; const size_t off = (size_t)(u.pm * BM + ai * HALF + wr * 64 + m * 16 + fr) * D + col0;
#pragma unroll
                    for (int bj = 0; bj < 2; ++bj)
#pragma unroll
                        for (int n = 0; n < 2; ++n) *(f32x4*)(out + off + bj * HALF + n * 16) = xv[mm][bj][n] + gv[bj][n] * acc[ai][bj][m][n]; }
                asm volatile("" ::: "memory");
            }
    }
};
struct EpiRes16 {
    static constexpr bool PERM = true; static constexpr bool SIGNAL = false;
    const float* xin32; bf16* x16; const float* gt;
    __device__ __forceinline__ void operator()(const f32x4 (&acc)[2][2][4][2], const Unit& u, int wr, int wc, int fr, int fq) const {
        const int row0 = u.pm * BM + wr * 64 + fr, col0 = u.pn * BM + wc * 32 + 8 * fq;
        const float* g = gt + ((u.pm * BM) / S) * 6 * D;
        f32x4 gv[2][2];
#pragma unroll
        for (int bj = 0; bj < 2; ++bj)
#pragma unroll
            for (int n = 0; n < 2; ++n) gv[bj][n] = *(const f32x4*)(g + col0 + bj * HALF + n * 4);
#pragma unroll
        for (int ai = 0; ai < 2; ++ai)
#pragma unroll
            for (int mp = 0; mp < 2; ++mp) {
                f32x4 xv[2][2][2];
#pragma unroll
                for (int mm = 0; mm < 2; ++mm) { const size_t off = (size_t)(row0 + ai * HALF + (2 * mp + mm) * 16) * D + col0;
#pragma unroll
                    for (int bj = 0; bj < 2; ++bj) {
                        if (xin32) { xv[mm][bj][0] = *(const f32x4*)(xin32 + off + bj * HALF); xv[mm][bj][1] = *(const f32x4*)(xin32 + off + bj * HALF + 4); }
                        else { const bf16x8 t = *(const bf16x8*)(x16 + off + bj * HALF);
#pragma unroll
                            for (int e = 0; e < 4; ++e) { xv[mm][bj][0][e] = bf2f(t[e]); xv[mm][bj][1][e] = bf2f(t[4 + e]); } } } }
#pragma unroll
                for (int mm = 0; mm < 2; ++mm) { const int m = 2 * mp + mm; const size_t off = (size_t)(row0 + ai * HALF + m * 16) * D + col0;
#pragma unroll
                    for (int bj = 0; bj < 2; ++bj) *(v4u*)(x16 + off + bj * HALF) = pack8(xv[mm][bj][0] + gv[bj][0] * acc[ai][bj][m][0], xv[mm][bj][1] + gv[bj][1] * acc[ai][bj][m][1]); }
                asm volatile("" ::: "memory");
            }
    }
};
struct EpiAct {
    static constexpr bool PERM = true; static constexpr bool SIGNAL = true;
    bf16* a2; const float* tokw; unsigned* flags;
    __device__ __forceinline__ void operator()(const f32x4 (&acc)[2][2][4][2], const Unit& u, int wr, int wc, int fr, int fq) const {
        const int col0 = u.pn * HALF + wc * 32 + 8 * fq;
#pragma unroll
        for (int ai = 0; ai < 2; ++ai)
#pragma unroll
            for (int m = 0; m < 4; ++m) { const int rl = ai * HALF + wr * 64 + m * 16 + fr;
                float w = 1.f; if (u.list) w = rl < u.rows ? tokw[u.list[rl]] : 0.f;
                f32x4 v0, v1;
#pragma unroll
                for (int e = 0; e < 4; ++e) { const float g0 = acc[ai][0][m][0][e], g1 = acc[ai][0][m][1][e];
                    v0[e] = g0 / (1.f + __expf(-g0)) * acc[ai][1][m][0][e] * w; v1[e] = g1 / (1.f + __expf(-g1)) * acc[ai][1][m][1][e] * w; }
                const GAS bf16* dst = (const GAS bf16*)(a2 + (size_t)(u.pm * BM + rl) * DE + col0); const v4u pv = pack8(v0, v1);
                asm volatile("global_store_dwordx4 %0, %1, off sc1" :: "v"(dst), "v"(pv) : "memory"); }
    }
    __device__ __forceinline__ void signal(const Unit& u, bool leader) const { if (leader) (void)xb_add(flags + u.pm, 1u); }
};

template <class Epi, class Sched, bool GATHER>
__device__ __forceinline__ void gemm_phase(LAS unsigned char* lds, const int tid, const Gemm g, const Sched& S, const Epi& E) {
    const int wid = __builtin_amdgcn_readfirstlane(tid >> 6), lane = tid & 63, wr = wid >> 2, wc = wid & 3, fr = lane & 15, fq = lane >> 4;
    const int K = g.K, nt = K / BK; const unsigned lda = g.lda;
    unsigned voffA[2], voffB[2]; int RA[2], CA2[2];
#pragma unroll
    for (int i = 0; i < 2; ++i) { int R, C; stage_rc(tid * 16 + i * 8192, R, C); const int Rb = Epi::PERM ? ((R & ~31) + perm32(R & 31)) : R;
        voffA[i] = (unsigned)R * lda + (unsigned)C * 2u; voffB[i] = (unsigned)(Rb * K + C) * 2u; RA[i] = R; CA2[i] = C * 2; }
    const size_t kstep = (size_t)(BK * 2);
    const size_t hstepA = (size_t)HALF * lda, hstepB = (size_t)HALF * K * 2;
    const unsigned ldsw = (unsigned)wid * 1024u;
    const int aoff = lds_byte(wr * 64 + fr, fq * 8), boff = lds_byte(wc * 32 + fr, fq * 8);
    unsigned offC[2][2], offN[2][2];
#define PG8_GOFF(dst, U) do { _Pragma("unroll") for (int h_ = 0; h_ < 2; ++h_) _Pragma("unroll") for (int i_ = 0; i_ < 2; ++i_) { const int rl_ = h_ * HALF + RA[i_]; \
        int tok_; if ((U).list) tok_ = rl_ < (U).rows ? ((U).list[rl_] >> 1) : 0; else tok_ = (U).tok0 + rl_; dst[h_][i_] = (unsigned)tok_ * lda + (unsigned)CA2[i_]; } } while (0)
#define PG8_SA(b, h) (((b) * 2 + (h)) * HTB)
#define PG8_SB(b, h) ((4 + (b) * 2 + (h)) * HTB)
#define PG8_GLDS(gp, bufoff, i_) __builtin_amdgcn_global_load_lds((const unsigned*)(gp), (LAS unsigned*)(lds + (bufoff) + ldsw + (i_) * 8192), 16, 0, 0)
#define PG8_STAGE_B(bufoff, gbase) do { _Pragma("unroll") for (int _i = 0; _i < 2; ++_i) PG8_GLDS((const char*)(gbase) + voffB[_i], bufoff, _i); } while (0)
#define PG8_STAGE_A(bufoff, ub, NX, h, koff) do { if constexpr (GATHER) { _Pragma("unroll") for (int _i = 0; _i < 2; ++_i) { const unsigned o_ = (NX) ? offN[h][_i] : offC[h][_i]; PG8_GLDS((ub) + (koff) + o_, bufoff, _i); } } \
        else { _Pragma("unroll") for (int _i = 0; _i < 2; ++_i) PG8_GLDS((ub) + (size_t)(h) * hstepA + (koff) + voffA[_i], bufoff, _i); } } while (0)
#define PG8_LDA(dst, b, h) do { _Pragma("unroll") for (int m = 0; m < 4; ++m) _Pragma("unroll") for (int k = 0; k < 2; ++k) dst[m][k] = *(const LAS sbf16x8*)(lds + PG8_SA(b, h) + aoff + m * 2048 + k * 1024); } while (0)
#define PG8_LDB(dst, b, h) do { _Pragma("unroll") for (int n = 0; n < 2; ++n) _Pragma("unroll") for (int k = 0; k < 2; ++k) dst[n][k] = *(const LAS sbf16x8*)(lds + PG8_SB(b, h) + boff + n * 2048 + k * 1024); } while (0)
#define PG8_MMA(ai, bj, At, Bt) do { __builtin_amdgcn_s_setprio(1); _Pragma("unroll") for (int m = 0; m < 4; ++m) _Pragma("unroll") for (int n = 0; n < 2; ++n) _Pragma("unroll") for (int k = 0; k < 2; ++k) \
        acc[ai][bj][m][n] = __builtin_amdgcn_mfma_f32_16x16x32_bf16(Bt[n][k], At[m][k], acc[ai][bj][m][n], 0, 0, 0); __builtin_amdgcn_s_setprio(0); } while (0)
#define PG8_WAIT_V(n) asm volatile("s_waitcnt vmcnt(" #n ")" ::: "memory")
#define PG8_WAIT_L(n) asm volatile("s_waitcnt lgkmcnt(" #n ")" ::: "memory")
#define PG8_BAR __builtin_amdgcn_s_barrier()
#define PG8_SCHED __builtin_amdgcn_sched_barrier(0)
    Unit cur, nxt; int ui = 0;
    if (!S.next(0, cur, wid)) return;
    if constexpr (Sched::WAITS) PG8_BAR;
    f32x4 acc[2][2][4][2];
#define PG8_ZERO_ACC() do { float z_ = 0.f; asm volatile("" : "+v"(z_)); _Pragma("unroll") for (int a = 0; a < 2; ++a) _Pragma("unroll") for (int b = 0; b < 2; ++b) _Pragma("unroll") for (int m = 0; m < 4; ++m) \
        _Pragma("unroll") for (int n = 0; n < 2; ++n) acc[a][b][m][n] = (f32x4){z_, z_, z_, z_}; } while (0)
    PG8_ZERO_ACC();
    sbf16x8 At[4][2], B0[2][2], B1[2][2];
    const char* cA = cur.a; const char* cB = cur.b;
    if constexpr (GATHER) { PG8_GOFF(offC, cur); PG8_WAIT_V(0); }
    PG8_STAGE_B(PG8_SB(0, 0), cB); PG8_STAGE_B(PG8_SB(0, 1), cB + hstepB); PG8_STAGE_A(PG8_SA(0, 0), cA, false, 0, 0); PG8_STAGE_A(PG8_SA(0, 1), cA, false, 1, 0);
    if (wr == 1) PG8_BAR;
    PG8_WAIT_V(2); PG8_BAR;
    PG8_STAGE_B(PG8_SB(1, 0), cB + kstep); PG8_STAGE_A(PG8_SA(1, 0), cA, false, 0, kstep); PG8_STAGE_B(PG8_SB(1, 1), cB + hstepB + kstep);
    PG8_WAIT_V(6); PG8_BAR;
    for (;;) {
        const bool has_next = S.next(ui + 1, nxt, wid);
        if constexpr (GATHER) { if (has_next) { PG8_GOFF(offN, nxt); PG8_WAIT_V(0); } else {
#pragma unroll
            for (int h_ = 0; h_ < 2; ++h_)
#pragma unroll
                for (int i_ = 0; i_ < 2; ++i_) offN[h_][i_] = offC[h_][i_]; } }
        const char* nA = has_next ? nxt.a : cA; const char* nB = has_next ? nxt.b : cB;
#pragma unroll 1
        for (int t = 0; t < nt; t += 2) {
            const bool last = (t == nt - 2);
            const size_t k1 = (size_t)(t + 1) * kstep;
            const char* a2 = last ? nA : cA; const char* b2 = last ? nB : cB + (size_t)(t + 2) * kstep;
            const size_t k2 = last ? 0 : (size_t)(t + 2) * kstep;
            const char* b3 = b2 + kstep;
            PG8_LDB(B0, 0, 0); PG8_LDB(B1, 0, 1); PG8_SCHED; PG8_LDA(At, 0, 0); PG8_STAGE_A(PG8_SA(1, 1), cA, false, 1, k1);
            PG8_WAIT_V(8); PG8_WAIT_L(0); PG8_BAR; PG8_MMA(0, 0, At, B0); PG8_MMA(0, 1, At, B1); PG8_BAR; PG8_SCHED;
            PG8_LDA(At, 0, 1); PG8_STAGE_B(PG8_SB(0, 0), b2); PG8_STAGE_B(PG8_SB(0, 1), b2 + hstepB); PG8_STAGE_A(PG8_SA(0, 0), a2, last, 0, k2);
            PG8_WAIT_V(8); PG8_WAIT_L(0); PG8_BAR; PG8_MMA(1, 0, At, B0); PG8_MMA(1, 1, At, B1); PG8_BAR; PG8_SCHED;
            PG8_LDB(B0, 1, 0); PG8_LDB(B1, 1, 1); PG8_SCHED; PG8_LDA(At, 1, 0); PG8_STAGE_A(PG8_SA(0, 1), a2, last, 1, k2);
            PG8_WAIT_V(8); PG8_WAIT_L(0); PG8_BAR; PG8_MMA(0, 0, At, B0); PG8_MMA(0, 1, At, B1); PG8_BAR; PG8_SCHED;
            PG8_LDA(At, 1, 1); PG8_STAGE_B(PG8_SB(1, 0), b3); PG8_STAGE_B(PG8_SB(1, 1), b3 + hstepB); PG8_STAGE_A(PG8_SA(1, 0), a2, last, 0, k2 + kstep);
            PG8_WAIT_V(8); PG8_WAIT_L(0); PG8_BAR; PG8_MMA(1, 0, At, B0); PG8_MMA(1, 1, At, B1); PG8_BAR; PG8_SCHED;
        }
        if (wr == 0) PG8_BAR;
        { unsigned z_ = 0u; asm volatile("" : "+v"(z_)); const int l2_ = (int)__builtin_amdgcn_mbcnt_hi(~0u, __builtin_amdgcn_mbcnt_lo(~0u, z_));
          E(acc, cur, wr, wc, l2_ & 15, l2_ >> 4);
          if constexpr (Epi::SIGNAL) { PG8_WAIT_V(0); PG8_BAR; E.signal(cur, wid == 0 && l2_ == 0); } }
        if (!has_next) break;
        PG8_ZERO_ACC();
        cur = nxt; cA = nA; cB = nB; ++ui;
        if constexpr (GATHER) {
#pragma unroll
            for (int h_ = 0; h_ < 2; ++h_)
#pragma unroll
                for (int i_ = 0; i_ < 2; ++i_) offC[h_][i_] = offN[h_][i_]; }
        if (wr == 1) PG8_BAR;
    }
    PG8_WAIT_V(0);
    PG8_BAR;
#undef PG8_GOFF
#undef PG8_ZERO_ACC
#undef PG8_SA
#undef PG8_SB
#undef PG8_GLDS
#undef PG8_STAGE_A
#undef PG8_STAGE_B
#undef PG8_LDA
#undef PG8_LDB
#undef PG8_MMA
#undef PG8_WAIT_V
#undef PG8_WAIT_L
#undef PG8_BAR
#undef PG8_SCHED
}
}

template <class Epi>
__device__ __forceinline__ void run_dense(Frame& F, const bf16* A, int lda_elems, const bf16* Bt, int M, int N, int K, const Epi& E) {
    pg8::StaticOrder S; S.A = (const char*)A; S.Bt = (const char*)Bt; S.lda = (unsigned)lda_elems * 2u; S.K = K; S.nM = M / 256; S.nN = N / 256; S.nwg = S.nM * S.nN; S.G = F.G; S.c = F.bid;
    pg8::Gemm g{(unsigned)lda_elems * 2u, K};
    fresh_tid(F);
    pg8::gemm_phase<Epi, pg8::StaticOrder, false>(F.lds, F.tid, g, S, E);
}

constexpr int TB_OFF = 131072;
__device__ __forceinline__ void compute_bases(Frame& F, int l) {
    fresh_tid(F);
    LAS unsigned* tb = (LAS unsigned*)(F.lds + TB_OFF); LAS unsigned* lc = tb + 32;
    if (F.tid == 0) { const unsigned* cnt = F.ctl + CW_CNT + CNT_LS * l; unsigned acc = 0;
        for (int e = 0; e < NE; ++e) { const unsigned c = cnt[CNT_ES * e]; lc[e] = c; tb[e] = acc; acc += (c + 255u) >> 8; }
        tb[16] = acc; tb[17] = acc + T / 256;
        if (F.bid == 0) { unsigned* base = F.ctl + CW_BASE + 32 * l; for (int e = 0; e < 18; ++e) base[e] = tb[e] * 256u; } }
    __syncthreads();
}

struct Args { const GAS void* in[26]; GAS float* out; GAS unsigned char* ws; int lo, hi; };
constexpr int NSTEPS = 21;

__global__ void __launch_bounds__(NTHREADS, 2) mk_fwd(Args args) {
    extern __shared__ __attribute__((aligned(16))) unsigned char lds_raw[];
    Frame F;
    F.lds = (LAS unsigned char*)lds_raw; F.MISC = (volatile LAS unsigned*)(F.lds + MISC_OFF);
    F.tid = threadIdx.x; F.lane = F.tid & 63; F.wave = __builtin_amdgcn_readfirstlane(F.tid >> 6); F.bid = blockIdx.x; F.G = gridDim.x;
    F.ws = args.ws; F.ctl = (unsigned*)(GAS unsigned*)(args.ws + WS_CTL); F.out = (float*)args.out;
    F.in = args.in; const int wave0 = F.wave;
    if (F.tid < 32) F.MISC[F.tid] = 0u;
    __syncthreads();
    XcdBarrier bar; bar.bar = F.ctl + CW_BAR; bar.x = 0; bar.st = nullptr;
    if (!MK_SPLIT) bar = xcd_barrier_post(F.ctl + CW_BAR, F.MISC + 8);

    for (int step_ = args.lo; step_ < args.hi; ++step_) {
        int step = step_; asm volatile("" : "+s"(step));
        { GAS unsigned char* w_ = args.ws; asm volatile("" : "+s"(w_)); F.ws = w_; F.ctl = (unsigned*)(GAS unsigned*)(w_ + WS_CTL);
          int b_ = blockIdx.x, g_ = gridDim.x, wv_ = wave0; GAS float* o_ = args.out; asm volatile("" : "+s"(b_), "+s"(g_), "+s"(wv_), "+s"(o_)); F.bid = b_; F.G = g_; F.wave = wv_; F.out = (float*)o_;
          F.tid = 0; F.lane = 0; }
#ifdef ONLY_PH
#define PHON(p) ((p) == ONLY_PH)
#else
#define PHON(p) true
#endif
        if (step == 0) { step_p0(F); if (FAST_ANY) convert_weights(F, 0); }
        else if (step == 1) step_p0_reduce(F);
        else if (step == NSTEPS - 1) { if (PHON(0)) step_a(F, 2); }
        else {
            const int l = (step - 2) / 9, ph = (step - 2) % 9, phx = ph == 2 ? 23 : ph;
            bf16* const XNp = WSP(bf16, WS_XN); const float* const MODp = WSP(float, WS_MOD);
            if (!PHON(ph)) {} else
            if (ph == 0) { if (FAST_ANY && l > 0) convert_weights(F, l); if (l == 0) for (int rep_ = 1; rep_ < REP_A0; ++rep_) step_a(F, 0); step_a(F, l); }
            else if (ph == 1) {
#if FAST_B
                for (int rep_ = 0; rep_ < REP_B; ++rep_) run_dense(F, XNp, D, WSP(bf16, WT_IN), T, NPROJ, D, pg8::EpiBf16{(bf16*)F.ws, 0, 1, GBP(F)});
#else
                EpiProj E{WSP(bf16, WS_CONV), WSP(bf16, WS_SMALL), WSP(bf16, WS_GA), GBP(F)};
                ngemm<8, false>(F, T, NIN, D, RowLin{XNp, D}, ((const float*)(const GAS float*)F.in[7]) + (size_t)l * D * NIN, nullptr, NIN, nullptr, E);
#endif
            } else if (phx == 23) { for (int rep_ = 0; rep_ < REP_C; ++rep_) step_c(F, l);
#if FAST_D
                for (int rep_ = 0; rep_ < REP_D; ++rep_) {
                run_dense(F, WSP(bf16, WS_SMALL), 512, WSP(bf16, WT_UQ), T, 768, QL, pg8::EpiBf16{WSP(bf16, WS_QRAW), 768, 0, nullptr});
                run_dense(F, WSP(bf16, WS_SMALL) + 256, 512, WSP(bf16, WT_UKV), T, 1024, KVL, pg8::EpiKV{WSP(bf16, WS_K), WSP(bf16, WS_V), WSP(bf16, WS_SMALL), WSP(f32x2, WS_ROPE), ((const float*)(const GAS float*)F.in[14]) + l * DQK}); }
#else
                ngemm<8, false>(F, T, 768, QL, RowLin{WSP(bf16, WS_SMALL), 512}, ((const float*)(const GAS float*)F.in[10]) + (size_t)l * QL * 768, nullptr, 768, ((const float*)(const GAS float*)F.in[9]) + l * QL, EpiStore{WSP(bf16, WS_QRAW), 768});
                ngemm<8, false>(F, T, 1024, KVL, RowLin{WSP(bf16, WS_SMALL) + 256, 512}, ((const float*)(const GAS float*)F.in[12]) + (size_t)l * KVL * 1024, nullptr, 1024, ((const float*)(const GAS float*)F.in[11]) + l * KVL, EpiStore{WSP(bf16, WS_KVRAW), 1024});
#endif
            } else if (ph == 3) {
                for (int rep_ = 0; rep_ < REP_E; ++rep_) step_e(F, l);
#if FAST_G
                run_dense(F, WSP(bf16, WS_U), CW, WSP(bf16, WT_CO), T, D, CW, pg8::EpiGate<1>{WSP(bf16, WS_GA), nullptr});
#else
                ngemm<8, false>(F, T, D, CW, RowLin{WSP(bf16, WS_U), CW}, ((const float*)(const GAS float*)F.in[15]) + (size_t)l * CW * D, nullptr, D, nullptr, EpiGate1{WSP(bf16, WS_GA)});
#endif
            } else if (ph == 4) { for (int rep_ = 0; rep_ < REP_F; ++rep_) { if (FAST_ATTN && attn_static_ok(F, l)) step_f_fast(F); else step_f(F); }
            } else if (ph == 5) {
#if FAST_H
                run_dense(F, WSP(bf16, WS_O), 512, WSP(bf16, WT_AO), T, D, 512, pg8::EpiGate<2>{WSP(bf16, WS_GA), GBP(F)});
#else
                ngemm<8, false>(F, T, D, 512, RowLin{WSP(bf16, WS_O), 512}, ((const float*)(const GAS float*)F.in[16]) + (size_t)l * 512 * D, nullptr, D, nullptr, EpiGate2{WSP(bf16, WS_GA), GBP(F)});
#endif
            } else if (ph == 6) {
#if FAST_I
                run_dense(F, WSP(bf16, WS_GA), D, WSP(bf16, WT_O), T, D, D, pg8::EpiRes16{l == 0 ? ((const float*)(const GAS float*)F.in[0]) : nullptr, WSP(bf16, WS_X16), MODp + (size_t)l * 2 * 6 * D + 2 * D});
#else
                ngemm<8, false>(F, T, D, D, RowLin{WSP(bf16, WS_GA), D}, ((const float*)(const GAS float*)F.in[17]) + (size_t)l * D * D, nullptr, D, nullptr,
                                EpiRes{l == 0 ? ((const float*)(const GAS float*)F.in[0]) : F.out, F.out, MODp + (size_t)l * 2 * 6 * D + 2 * D});
#endif
            } else if (ph == 7) { for (int rep_ = 1; rep_ < REP_J; ++rep_) step_j(F, l, true); if (USE_OLD_J) step_j_old(F, l); else step_j(F, l);
            } else {
                compute_bases(F, l);
                const LAS unsigned* tb = (const LAS unsigned*)(F.lds + TB_OFF); const LAS unsigned* cnt = tb + 32;
                unsigned* kf = F.ctl + CW_KF + 256 * l;
                pg8::MoeOrderX S; S.MT = (int)__builtin_amdgcn_readfirstlane(tb[17]); S.G = F.G; S.c = F.bid; S.tb = tb; S.cnt = cnt; S.LIST = WSP(int, WS_LIST); S.kN = 2; S.flags = kf; S.bar = F.ctl + CW_BAR;
                S.A = (const char*)XNp; S.Bt = (const char*)WSP(bf16, WT_GU); S.estride = (size_t)512 * D * 2; S.lda = D * 2; S.K = D; S.nN = 2; S.gather = true; S.mode = 0;
                fresh_tid(F);
                pg8::gemm_phase<pg8::EpiAct, pg8::MoeOrderX, true>(F.lds, F.tid, pg8::Gemm{(unsigned)D * 2u, D}, S, pg8::EpiAct{WSP(bf16, WS_A2), WSP(float, WS_TOKW), kf});
                S.A = (const char*)WSP(bf16, WS_A2); S.Bt = (const char*)WSP(bf16, WT_DN); S.estride = (size_t)D * DE * 2; S.lda = DE * 2; S.K = DE; S.nN = 4; S.gather = false; S.mode = 1;
                fresh_tid(F);
                pg8::gemm_phase<pg8::EpiY8, pg8::MoeOrderX, false>(F.lds, F.tid, pg8::Gemm{(unsigned)DE * 2u, DE}, S, pg8::EpiY8{WSP(unsigned char, WS_Y)});
            }
        }
        if (step_ + 1 < args.hi) for (int rep_ = 0; rep_ < REP_BAR; ++rep_) xcd_barrier(bar);
    }
}

extern "C" void kernel_launch(void* const* d_in, const int* in_sizes, int n_in, void* d_out, int out_size, void* d_ws, size_t ws_size, hipStream_t stream) {
    static int grid = 0;
    if (grid == 0) {
        if (n_in != 26 || in_sizes[0] != T * D || out_size != T * D || ws_size < WS_END) {
            fprintf(stderr, "kernel_launch: unexpected shapes: n_in %d in0 %d out %d ws %zu (need >= %zu)\n", n_in, n_in > 0 ? in_sizes[0] : -1, out_size, ws_size, (size_t)WS_END); grid = -1; return; }
        int dev = 0, cus = 0;
        if (hipGetDevice(&dev) != hipSuccess || hipDeviceGetAttribute(&cus, hipDeviceAttributeMultiprocessorCount, dev) != hipSuccess) { grid = -1; return; }
        if (hipFuncSetAttribute((const void*)mk_fwd, hipFuncAttributeMaxDynamicSharedMemorySize, LDS_BYTES) != hipSuccess) { fprintf(stderr, "kernel_launch: hipFuncSetAttribute failed\n"); grid = -1; return; }
        int per_cu = 0;
        if (hipOccupancyMaxActiveBlocksPerMultiprocessor(&per_cu, (const void*)mk_fwd, NTHREADS, LDS_BYTES) != hipSuccess || per_cu < 1)
            fprintf(stderr, "kernel_launch: note: occupancy query reports %d blocks/CU\n", per_cu);
        (void)hipGetLastError();
        grid = cus;
    }
    if (grid < 0) return;
    if (hipMemsetAsync((char*)d_ws + WS_CTL, 0, CTL_ZERO_BYTES, stream) != hipSuccess) { fprintf(stderr, "kernel_launch: memset failed\n"); return; }
    Args a{};
    for (int i = 0; i < 26; ++i) a.in[i] = (const GAS void*)d_in[i];
    a.out = (GAS float*)d_out; a.ws = (GAS unsigned char*)d_ws;
#if MK_SPLIT
    for (int s = 0; s < NSTEPS; ++s) { a.lo = s; a.hi = s + 1; hipLaunchKernelGGL(mk_fwd, dim3(grid), dim3(NTHREADS), LDS_BYTES, stream, a); }
#else
    a.lo = 0; a.hi = NSTEPS;
    hipLaunchKernelGGL(mk_fwd, dim3(grid), dim3(NTHREADS), LDS_BYTES, stream, a);
#endif
    const hipError_t le = hipPeekAtLastError();
    if (le != hipSuccess) fprintf(stderr, "kernel_launch: launch failed: %s\n", hipGetErrorName(le));
}
```

```cpp
#include <hip/hip_runtime.h>
#include <cstdio>
#include <cstdint>

#ifndef FAST_GEMM
#define FAST_GEMM 1
#endif
#ifndef FAST_B
#define FAST_B FAST_GEMM
#endif
#ifndef FAST_D
#define FAST_D FAST_GEMM
#endif
#ifndef FAST_G
#define FAST_G FAST_GEMM
#endif
#ifndef FAST_H
#define FAST_H FAST_GEMM
#endif
#ifndef FAST_I
#define FAST_I FAST_GEMM
#endif
#ifndef FAST_K
#define FAST_K FAST_GEMM
#endif
#ifndef FAST_L
#define FAST_L FAST_GEMM
#endif
#define FAST_ANY (FAST_B || FAST_D || FAST_G || FAST_H || FAST_I || FAST_K || FAST_L)
#ifndef USE_OLD_J
#define USE_OLD_J 0
#endif
#ifndef DBG_SHFL
#define DBG_SHFL 1
#endif
#ifndef FAST_ATTN
#define FAST_ATTN 1
#endif
#ifndef REP_F
#define REP_F 1
#endif
#ifndef REP_CVT
#define REP_CVT 1
#endif
#ifndef REP_B
#define REP_B 1
#endif
#ifndef REP_C
#define REP_C 1
#endif
#ifndef REP_D
#define REP_D 1
#endif
#ifndef REP_E
#define REP_E 1
#endif
#ifndef REP_K
#define REP_K 1
#endif
#ifndef REP_L
#define REP_L 1
#endif
#ifndef REP_J
#define REP_J 1
#endif
#ifndef REP_A0
#define REP_A0 1
#endif
#ifndef REP_P0
#define REP_P0 1
#endif
#ifndef REP_BAR
#define REP_BAR 1
#endif
#ifndef ATTN_W64
#define ATTN_W64 1
#endif
#ifndef MK_SPLIT
#define MK_SPLIT 0
#endif

#define GAS __attribute__((address_space(1)))
#define LAS __attribute__((address_space(3)))
typedef unsigned short bf16;
typedef unsigned v4u __attribute__((ext_vector_type(4)));
typedef unsigned v2u __attribute__((ext_vector_type(2)));
typedef float f32x4 __attribute__((ext_vector_type(4)));
typedef float f32x2 __attribute__((ext_vector_type(2)));
typedef unsigned short bf16x8 __attribute__((ext_vector_type(8)));
typedef unsigned short bf16x4 __attribute__((ext_vector_type(4)));
typedef GAS unsigned gu32;

constexpr int NB = 2, S = 8192, T = NB * S, D = 1024, H = 8, DQK = 96, DV = 64;
constexpr int NIN = 4000, CW = 512, QL = 256, KVL = 128, NE = 16, DE = 256, NEX = NE + 1;
constexpr float EPS = 1e-6f;
constexpr float QSCALE = 0.10206207261596577f * 1.4426950408889634f;
constexpr int NWAVES = 8, NTHREADS = 512;

constexpr size_t MiB = 1u << 20, KiB = 1u << 10;
constexpr size_t WS_CTL = 0, CTL_ZERO_BYTES = 64 * KiB;
constexpr size_t WS_MOD = 1 * MiB;
constexpr size_t WS_TOKS = WS_MOD + 128 * KiB;
constexpr size_t WS_TOKW = WS_TOKS + 128 * KiB;
constexpr size_t WS_RS = WS_TOKW + 128 * KiB;
constexpr size_t WS_ROPE = 2 * MiB;
constexpr size_t WS_LIST = 4 * MiB;
constexpr size_t WS_WT = 5 * MiB;
constexpr size_t WS_XN = 45 * MiB;
constexpr size_t WS_R1 = 109 * MiB;
constexpr size_t WS_R2 = 157 * MiB;
constexpr size_t WS_GA = 173 * MiB;
constexpr size_t WS_X16 = 77 * MiB;
#define GBP(F_) ((bf16*)((unsigned char*)(F_).out + 32 * MiB))
constexpr size_t WS_U = 205 * MiB;
constexpr size_t WS_K = WS_XN;
constexpr size_t WS_V = 245 * MiB;
constexpr size_t WS_END = 261 * MiB;
constexpr size_t WS_KVRAW = WS_XN, WS_CONV = WS_R1, WS_QRAW = 221 * MiB  , WS_Q = WS_R1 + 24 * MiB, WS_SMALL = WS_R2, WS_O = WS_R2;
constexpr size_t WS_A2 = WS_R1;
constexpr size_t WS_Y = WS_R1 + 26 * MiB;
constexpr int SLOTS_MAX = 3 * T + NE * 256;
static_assert(WS_Y + (size_t)SLOTS_MAX * 2048 <= WS_END, "MoE overlay");
constexpr int CW_CNT = 8192, CNT_LS = 2048, CNT_ES = 64;
static_assert((CW_CNT + 2 * CNT_LS) * 4 <= (int)CTL_ZERO_BYTES && (4096 + 3456) * 4 <= (int)CTL_ZERO_BYTES, "control words (barrier region at word 4096, 3456 words; counters) inside the per-call memset");
constexpr int CW_BASE = 192;
constexpr int CW_BAR = 4096;
constexpr int CW_KF = 12288;
static_assert((CW_KF + 2 * 256) * 4 <= (int)CTL_ZERO_BYTES && CW_KF >= CW_CNT + 2 * CNT_LS, "slot-tile flags inside the per-call memset");

#define RLX_AGENT __ATOMIC_RELAXED, __HIP_MEMORY_SCOPE_AGENT
__device__ __forceinline__ unsigned f2bf(float f) { unsigned u = __builtin_bit_cast(unsigned, f); return (u + 0x7fffu + ((u >> 16) & 1u)) >> 16; }
typedef __bf16 hwbf16x2 __attribute__((ext_vector_type(2)));
__device__ __forceinline__ unsigned pk2(float lo, float hi) { f32x2 v = {lo, hi}; hwbf16x2 b = __builtin_convertvector(v, hwbf16x2); return __builtin_bit_cast(unsigned, b); }
__device__ __forceinline__ float bf2f(unsigned short b) { return __builtin_bit_cast(float, (unsigned)b << 16); }
template <int CTRL> __device__ __forceinline__ float dpp_mov(float v) { return __builtin_bit_cast(float, __builtin_amdgcn_update_dpp(0, __builtin_bit_cast(int, v), CTRL, 0xF, 0xF, false)); }
template <int K> __device__ __forceinline__ float xor_lane(float v) {
    if constexpr (K == 1) return dpp_mov<0xB1>(v);
    else if constexpr (K == 2) return dpp_mov<0x4E>(v);
    else return __builtin_bit_cast(float, __builtin_amdgcn_ds_swizzle(__builtin_bit_cast(int, v), (K << 10) | 0x1f)); }
__device__ __forceinline__ float row16_sum_dpp(float v) { v += dpp_mov<0x121>(v); v += dpp_mov<0x122>(v); v += dpp_mov<0x124>(v); v += dpp_mov<0x128>(v); return v; }
__device__ __forceinline__ float add_xor32(float v) {
    auto r = __builtin_amdgcn_permlane32_swap(__builtin_bit_cast(unsigned, v), __builtin_bit_cast(unsigned, v), false, false);
    return __builtin_bit_cast(float, r[0]) + __builtin_bit_cast(float, r[1]); }
__device__ __forceinline__ float bperm_xor(float v, int lane, int k) { return __builtin_bit_cast(float, __builtin_amdgcn_ds_bpermute((lane ^ k) << 2, __builtin_bit_cast(int, v))); }
__device__ __forceinline__ float wave_sum(float v, int lane) {
    v = row16_sum_dpp(v);
    const float r0 = __builtin_bit_cast(float, __builtin_amdgcn_readlane(__builtin_bit_cast(int, v), 0)), r1 = __builtin_bit_cast(float, __builtin_amdgcn_readlane(__builtin_bit_cast(int, v), 16));
    const float r2 = __builtin_bit_cast(float, __builtin_amdgcn_readlane(__builtin_bit_cast(int, v), 32)), r3 = __builtin_bit_cast(float, __builtin_amdgcn_readlane(__builtin_bit_cast(int, v), 48));
    return (r0 + r1) + (r2 + r3);
}
__device__ __forceinline__ float sigmoidf_(float x) { return 1.f / (1.f + __expf(-x)); }

#define XB_TMO      128
#define XB_XCNT(j)  (256  + 64 * (j))
#define XB_XSUB(j)  (1280 + 64 * (j))
#define XB_XGEN(j)  (2304 + 64 * (j))
#define XB_TOP      3328
#define XB_TOPGEN   3392
#define XCD_BAR_WORDS 3456
#define XB_SPIN_CAP (1u << 22)
__device__ __forceinline__ unsigned xb_ld(unsigned* p)              { return __hip_atomic_load(p, __ATOMIC_RELAXED, __HIP_MEMORY_SCOPE_AGENT); }
__device__ __forceinline__ unsigned xb_add(unsigned* p, unsigned v) { return __hip_atomic_fetch_add(p, v, __ATOMIC_RELAXED, __HIP_MEMORY_SCOPE_AGENT); }
__device__ __forceinline__ unsigned xb_xcc_id() { return (unsigned)__builtin_amdgcn_s_getreg((3 << 11) | 20) & 0xFu; }
#define XB_SPIN(cond, bar) do { unsigned _sp = 0; while (cond) { __builtin_amdgcn_s_sleep(1); \
    if ((++_sp & 255u) == 0u) { if (xb_ld(&(bar)[XB_TMO])) break; if (_sp > XB_SPIN_CAP) { atomicAdd(&(bar)[XB_TMO], 1u); break; } } } } while (0)
struct XcdBarrier { unsigned* bar; unsigned x; volatile LAS unsigned* st; };
__device__ __forceinline__ XcdBarrier xcd_barrier_post(unsigned* bar, volatile LAS unsigned* st) {
    XcdBarrier b; b.bar = bar; b.x = xb_xcc_id(); b.st = st;
    if (threadIdx.x == 0) (void)xb_add(&bar[XB_XCNT(b.x)], 1u);
    return b;
}
__device__ __forceinline__ void xcd_barrier_complete(unsigned* bar, unsigned x, unsigned& nloc, unsigned& nx) {
    const unsigned G = gridDim.x * gridDim.y * gridDim.z;
    unsigned sum, cnt, mine, sp = 0u;
    for (;;) {
        sum = 0u; cnt = 0u; mine = 0u;
#pragma unroll
        for (unsigned j = 0; j < 16; ++j) { const unsigned c = xb_ld(&bar[XB_XCNT(j)]); sum += c; cnt += (c > 0u) ? 1u : 0u; mine = (j == x) ? c : mine; }
        if (sum == G) break;
        __builtin_amdgcn_s_sleep(1);
        if ((++sp & 255u) == 0u) { if (xb_ld(&bar[XB_TMO])) break; if (sp > XB_SPIN_CAP) { atomicAdd(&bar[XB_TMO], 1u); break; } }
    }
    nloc = mine > 0u ? mine : 1u; nx = cnt > 0u ? cnt : 1u;
}
__device__ __forceinline__ void xcd_barrier(const XcdBarrier& b) {
    asm volatile("s_waitcnt vmcnt(0)" ::: "memory");
    __syncthreads();
    if (threadIdx.x == 0) {
        unsigned* bar = b.bar;
        __builtin_amdgcn_s_waitcnt(0);
        unsigned nloc = b.st[0], nx = b.st[1];
        if (nloc == 0u) { xcd_barrier_complete(bar, b.x, nloc, nx); b.st[0] = nloc; b.st[1] = nx; }
        const unsigned old = xb_add(&bar[XB_XSUB(b.x)], 1u);
        const unsigned gen = old / nloc;
        if (old + 1u == (gen + 1u) * nloc) {
            __builtin_amdgcn_fence(__ATOMIC_RELEASE, "agent");
            asm volatile("s_waitcnt vmcnt(0)" ::: "memory");
            const unsigned og = xb_add(&bar[XB_TOP], 1u);
            const unsigned tg = og / nx;
            if (og + 1u == (tg + 1u) * nx) xb_add(&bar[XB_TOPGEN], 1u);
            else XB_SPIN(xb_ld(&bar[XB_TOPGEN]) == tg, bar);
            __builtin_amdgcn_fence(__ATOMIC_ACQUIRE, "agent");
            xb_add(&bar[XB_XGEN(b.x)], 1u);
            asm volatile("s_waitcnt vmcnt(0)" ::: "memory");
        } else {
            XB_SPIN(xb_ld(&bar[XB_XGEN(b.x)]) == gen, bar);
            __builtin_amdgcn_fence(__ATOMIC_ACQUIRE, "agent");
            asm volatile("s_waitcnt vmcnt(0)" ::: "memory");
        }
    }
    __syncthreads();
}

constexpr int LDS_BYTES = 147456;
constexpr int MISC_OFF = 131072 + 320;
struct Frame {
    LAS unsigned char* lds; volatile LAS unsigned* MISC; unsigned* ctl;
    int tid, lane, wave, bid, G;
    const GAS void* const* in;
    float* out; GAS unsigned char* ws;
};
#define WSP(T_, off) ((T_*)(GAS T_*)(F.ws + (off)))
__device__ __forceinline__ void fresh_tid(Frame& F) { unsigned z_ = 0u; asm volatile("" : "+v"(z_)); const int l_ = (int)__builtin_amdgcn_mbcnt_hi(~0u, __builtin_amdgcn_mbcnt_lo(~0u, z_)); F.lane = l_; F.tid = F.wave * 64 + l_; }

__constant__ double INVF[16] = {1.0, 0.5623413251903491, 0.31622776601683794, 0.1778279410038923, 0.1, 0.05623413251903491, 0.03162277660168379, 0.01778279410038923,
                                0.01, 0.005623413251903491, 0.0031622776601683794, 0.001778279410038923, 0.001, 0.0005623413251903491, 0.00031622776601683794, 0.0001778279410038923};

constexpr size_t WS_MODP = WS_XN;
__device__ __forceinline__ void step_p0(Frame& F) {
    fresh_tid(F);
    const int gw = F.bid * NWAVES + F.wave, NGW = F.G * NWAVES;
    float* MODP = WSP(float, WS_MODP);
    const float* cin = (const float*)F.in[1];
    for (int it = gw; it < 2 * 96 * 16; it += NGW) {
        const int kc = it & 15, nc = (it >> 4) % 96, l = (it >> 4) / 96, n = nc * 64 + F.lane;
        const float* w = ((const float*)(const GAS float*)F.in[3]) + ((size_t)l * D + kc * 64) * (6 * D) + n;
        float a0 = 0.f, a1 = 0.f;
#pragma unroll
        for (int kh = 0; kh < 2; ++kh) {
            float wv[32];
#pragma unroll
            for (int k = 0; k < 32; ++k) wv[k] = w[(size_t)(kh * 32 + k) * (6 * D)];
#pragma unroll
            for (int k = 0; k < 32; ++k) {
                const float c0 = cin[kc * 64 + kh * 32 + k], c1 = cin[D + kc * 64 + kh * 32 + k];
                const float s0 = c0 / (1.f + __expf(-c0)), s1 = c1 / (1.f + __expf(-c1));
                a0 += s0 * wv[k]; a1 += s1 * wv[k];
            }
        }
        MODP[((size_t)(kc * 2 + l) * 2 + 0) * 6 * D + n] = a0; MODP[((size_t)(kc * 2 + l) * 2 + 1) * 6 * D + n] = a1;
    }
    f32x2* ROPE = WSP(f32x2, WS_ROPE);
    for (int idx = F.bid * NTHREADS + F.tid; idx < T * 16; idx += F.G * NTHREADS) {
        const int t = idx >> 4, i = idx & 15;
        const double a = (double)((const int*)(const GAS int*)F.in[2])[t] * INVF[i];
        const double n = __builtin_rint(a * 0.15915494309189535);
        double r = __builtin_fma(-n, 6.283185307179586, a); r = __builtin_fma(-n, 2.4492935982947064e-16, r);
        const float rf = (float)r;
        f32x2 cs; cs.x = __cosf(rf); cs.y = __sinf(rf);
        ROPE[idx] = cs;
    }
}
__device__ __forceinline__ void step_p0_reduce(Frame& F) {
    fresh_tid(F);
    const float* MODP = WSP(float, WS_MODP); float* MOD = WSP(float, WS_MOD);
    for (int idx = F.bid * NTHREADS + F.tid; idx < 2 * 2 * 6 * D; idx += F.G * NTHREADS) {
        const int n = idx % (6 * D), l = idx / (2 * 6 * D);
        float a = ((const float*)(const GAS float*)F.in[4])[l * 6 * D + n];
#pragma unroll
        for (int kc = 0; kc < 16; ++kc) a += MODP[(size_t)kc * (2 * 2 * 6 * D) + idx];
        MOD[idx] = a;
    }
}

__device__ __forceinline__ void step_a(Frame& F, int l) {
    fresh_tid(F);
    const int gw = F.bid * NWAVES + F.wave, NGW = F.G * NWAVES;
    const float* MOD = WSP(float, WS_MOD);
    const unsigned char* Y = WSP(unsigned char, WS_Y);
    const int* TOKS = WSP(int, WS_TOKS);
    bf16* XN = WSP(bf16, WS_XN); bf16* X16 = WSP(bf16, WS_X16);
    for (int row0 = gw; row0 < T; row0 += 2 * NGW) {
        const bool has1 = row0 + NGW < T;
        int rr[2]; rr[0] = row0; rr[1] = has1 ? row0 + NGW : row0;
        f32x4 v[2][4];
        if (l == 0) {
#pragma unroll
            for (int k = 0; k < 2; ++k)
#pragma unroll
                for (int j = 0; j < 4; ++j) v[k][j] = *(const f32x4*)(((const float*)(const GAS float*)F.in[0]) + (size_t)rr[k] * D + 4 * F.lane + 256 * j);
        } else {
            const unsigned* base = F.ctl + CW_BASE + 32 * (l - 1);
            int tk[2][2];
#pragma unroll
            for (int k = 0; k < 2; ++k) { tk[k][0] = TOKS[2 * rr[k]]; tk[k][1] = TOKS[2 * rr[k] + 1]; }
            size_t sl[2][3];
#pragma unroll
            for (int k = 0; k < 2; ++k) { sl[k][0] = base[tk[k][0] >> 16] + (tk[k][0] & 0xffff); sl[k][1] = base[tk[k][1] >> 16] + (tk[k][1] & 0xffff); sl[k][2] = base[16] + rr[k]; }
            f32x4 xo[2][4], gg[2][4]; unsigned ya[2][4], yb[2][4], yc[2][4];
#pragma unroll
            for (int k = 0; k < 2; ++k) { const float* gt2 = MOD + ((l - 1) * 2 + rr[k] / S) * 6 * D + 5 * D;
#pragma unroll
                for (int j = 0; j < 4; ++j) { const int col = 4 * F.lane + 256 * j;
                    { const bf16x4 t = *(const bf16x4*)(X16 + (size_t)rr[k] * D + col); xo[k][j] = (f32x4){bf2f(t[0]), bf2f(t[1]), bf2f(t[2]), bf2f(t[3])}; } gg[k][j] = *(const f32x4*)(gt2 + col);
                    ya[k][j] = *(const unsigned*)(Y + sl[k][0] * D + col); yb[k][j] = *(const unsigned*)(Y + sl[k][1] * D + col); yc[k][j] = *(const unsigned*)(Y + sl[k][2] * D + col); } }
#pragma unroll
            for (int k = 0; k < 2; ++k)
#pragma unroll
                for (int j = 0; j < 4; ++j) { f32x4 r;
                    const f32x2 a0 = __builtin_amdgcn_cvt_pk_f32_fp8((int)ya[k][j], false), a1 = __builtin_amdgcn_cvt_pk_f32_fp8((int)ya[k][j], true);
                    const f32x2 b0 = __builtin_amdgcn_cvt_pk_f32_fp8((int)yb[k][j], false), b1 = __builtin_amdgcn_cvt_pk_f32_fp8((int)yb[k][j], true);
                    const f32x2 c0 = __builtin_amdgcn_cvt_pk_f32_fp8((int)yc[k][j], false), c1 = __builtin_amdgcn_cvt_pk_f32_fp8((int)yc[k][j], true);
                    const f32x4 ys = (f32x4){a0.x + b0.x + c0.x, a0.y + b0.y + c0.y, a1.x + b1.x + c1.x, a1.y + b1.y + c1.y};
#pragma unroll
                    for (int e = 0; e < 4; ++e) r[e] = xo[k][j][e] + gg[k][j][e] * ys[e];
                    v[k][j] = r;
                    if (k == 0 || has1) { if (l == 2) *(f32x4*)(F.out + (size_t)rr[k] * D + 4 * F.lane + 256 * j) = r;
                        else { v2u o_; o_.x = pk2(r[0], r[1]); o_.y = pk2(r[2], r[3]); *(v2u*)(X16 + (size_t)rr[k] * D + 4 * F.lane + 256 * j) = o_; } } }
        }
        if (l < 2) {
            f32x4 g[4], sc[2][4], sh[2][4];
#pragma unroll
            for (int j = 0; j < 4; ++j) g[j] = *(const f32x4*)(((const float*)(const GAS float*)F.in[5]) + l * D + 4 * F.lane + 256 * j);
#pragma unroll
            for (int k = 0; k < 2; ++k) { const float* m = MOD + (l * 2 + rr[k] / S) * 6 * D;
#pragma unroll
                for (int j = 0; j < 4; ++j) { sc[k][j] = *(const f32x4*)(m + D + 4 * F.lane + 256 * j); sh[k][j] = *(const f32x4*)(m + 4 * F.lane + 256 * j); } }
            float ss[2];
#pragma unroll
            for (int k = 0; k < 2; ++k) { float a = 0.f;
#pragma unroll
                for (int j = 0; j < 4; ++j) a += (v[k][j].x * v[k][j].x + v[k][j].y * v[k][j].y) + (v[k][j].z * v[k][j].z + v[k][j].w * v[k][j].w);
                ss[k] = a; }
            const float rs0 = 1.0f / sqrtf(wave_sum(ss[0], F.lane) * (1.f / D) + EPS), rs1 = 1.0f / sqrtf(wave_sum(ss[1], F.lane) * (1.f / D) + EPS);
#pragma unroll
            for (int k = 0; k < 2; ++k) { const float rs = k ? rs1 : rs0;
#pragma unroll
                for (int j = 0; j < 4; ++j) { f32x4 h;
#pragma unroll
                    for (int e = 0; e < 4; ++e) h[e] = v[k][j][e] * rs * g[j][e] * (1.f + sc[k][j][e]) + sh[k][j][e];
                    v2u o; o.x = pk2(h[0], h[1]); o.y = pk2(h[2], h[3]);
                    if (k == 0 || has1) *(v2u*)(XN + (size_t)rr[k] * D + 4 * F.lane + 256 * j) = o; } }
        }
    }
}

template <int RPT, bool DUAL, class RowF, class Epi>
__device__ __forceinline__ void ngemm(Frame& F, int M, int N, int K, RowF rowf, const float* W, const float* W2, int ldw, const float* ksc, Epi epi) {
    fresh_tid(F);
    const int gw = F.bid * NWAVES + F.wave, NGW = F.G * NWAVES;
    const int nrb = (M + RPT - 1) / RPT, ncc = (N + 255) / 256;
    for (int it = gw; it < nrb * ncc; it += NGW) {
        const int cc = it / nrb, rb = it % nrb;
        const int n4 = cc * 256 + F.lane * 4;
        const bool nv = n4 < N;
        const int n4c = nv ? n4 : 0;
        const bf16* rp[RPT];
#pragma unroll
        for (int r = 0; r < RPT; ++r) { int m = rb * RPT + r; if (m >= M) m = M - 1; rp[r] = rowf(m); }
        f32x4 acc[RPT], acc2[RPT];
#pragma unroll
        for (int r = 0; r < RPT; ++r) { acc[r] = (f32x4){0.f, 0.f, 0.f, 0.f}; acc2[r] = (f32x4){0.f, 0.f, 0.f, 0.f}; }
        for (int k0 = 0; k0 < K; k0 += 8) {
            bf16x8 a[RPT];
#pragma unroll
            for (int r = 0; r < RPT; ++r) a[r] = *(const bf16x8*)(rp[r] + k0);
#pragma unroll
            for (int j = 0; j < 8; ++j) {
                f32x4 w = *(const f32x4*)(W + (size_t)(k0 + j) * ldw + n4c);
                f32x4 w2 = (f32x4){0.f, 0.f, 0.f, 0.f};
                if (DUAL) w2 = *(const f32x4*)(W2 + (size_t)(k0 + j) * ldw + n4c);
                if (ksc) { const float s = ksc[k0 + j]; w = w * s; }
#pragma unroll
                for (int r = 0; r < RPT; ++r) { const float av = bf2f(a[r][j]); acc[r] += av * w; if (DUAL) acc2[r] += av * w2; }
            }
        }
        if (nv) {
#pragma unroll
            for (int r = 0; r < RPT; ++r) { const int m = rb * RPT + r; if (m < M) epi(m, n4, acc[r], acc2[r]); }
        }
    }
}
struct RowLin { const bf16* p; int ld; __device__ __forceinline__ const bf16* operator()(int m) const { return p + (size_t)m * ld; } };
struct RowGather { const bf16* p; int ld; const int* list; __device__ __forceinline__ const bf16* operator()(int m) const { return p + (size_t)(list[m] >> 1) * ld; } };
__device__ __forceinline__ void st_bf4(bf16* p, f32x4 v) { v2u o; o.x = pk2(v[0], v[1]); o.y = pk2(v[2], v[3]); *(v2u*)p = o; }

struct EpiProj { bf16 *conv, *small, *ga, *gb;
    __device__ __forceinline__ void operator()(int m, int n, f32x4 a, f32x4) const {
        bf16* p;
        if (n < 1536) p = conv + (size_t)m * 1536 + n;
        else if (n < 1952) p = small + (size_t)m * 512 + (n - 1536);
        else if (n < 2976) p = ga + (size_t)m * 1024 + (n - 1952);
        else p = gb + (size_t)m * 1024 + (n - 2976);
        st_bf4(p, a);
    } };
struct EpiStore { bf16* o; int ld; __device__ __forceinline__ void operator()(int m, int n, f32x4 a, f32x4) const { st_bf4(o + (size_t)m * ld + n, a); } };
struct EpiGate1 { bf16* ga; __device__ __forceinline__ void operator()(int m, int n, f32x4 a, f32x4) const {
        bf16* p = ga + (size_t)m * D + n; const bf16x4 g = *(const bf16x4*)p; f32x4 r;
#pragma unroll
        for (int e = 0; e < 4; ++e) r[e] = sigmoidf_(bf2f(g[e])) * a[e];
        st_bf4(p, r); } };
struct EpiGate2 { bf16* t1; const bf16* gb; __device__ __forceinline__ void operator()(int m, int n, f32x4 a, f32x4) const {
        bf16* p = t1 + (size_t)m * D + n; const bf16x4 t = *(const bf16x4*)p; const bf16x4 g = *(const bf16x4*)(gb + (size_t)m * D + n); f32x4 r;
#pragma unroll
        for (int e = 0; e < 4; ++e) r[e] = bf2f(t[e]) + sigmoidf_(bf2f(g[e])) * a[e];
        st_bf4(p, r); } };
struct EpiRes { const float* xin; float* out; const float* gt; __device__ __forceinline__ void operator()(int m, int n, f32x4 a, f32x4) const {
        const f32x4 xv = *(const f32x4*)(xin + (size_t)m * D + n); const f32x4 g = *(const f32x4*)(gt + (m / S) * 6 * D + n);
        *(f32x4*)(out + (size_t)m * D + n) = xv + g * a; } };
struct EpiAct { bf16* a2; size_t slot0; const int* list; const float* tokw; __device__ __forceinline__ void operator()(int m, int n, f32x4 g, f32x4 u) const {
        const float w = list ? tokw[list[m]] : 1.f; f32x4 r;
#pragma unroll
        for (int e = 0; e < 4; ++e) r[e] = g[e] / (1.f + __expf(-g[e])) * u[e] * w;
        st_bf4(a2 + (slot0 + m) * DE + n, r); } };

__device__ __forceinline__ void step_c(Frame& F, int l) {
    fresh_tid(F);
    const bf16* CONV = WSP(bf16, WS_CONV); bf16* U = WSP(bf16, WS_U);
    const int gt = F.bid * NTHREADS + F.tid, NT = F.G * NTHREADS;
    for (int idx = gt; idx < T * 64; idx += NT) {
        const int t = idx >> 6, c8 = (idx & 63) * 8, s = t % S;
        const bf16* r0 = CONV + (size_t)t * 1024;
        const bf16x8 cb = *(const bf16x8*)(r0 + c8), p0v = *(const bf16x8*)(r0 + 512 + c8);
        bf16x8 pmv = (bf16x8){0, 0, 0, 0, 0, 0, 0, 0}, ppv = pmv;
        if (s > 0) pmv = *(const bf16x8*)(r0 - 1024 + 512 + c8);
        if (s < S - 1) ppv = *(const bf16x8*)(r0 + 1024 + 512 + c8);
        const float* cw = ((const float*)(const GAS float*)F.in[8]) + l * 3 * CW + c8;
        float o[8];
#pragma unroll
        for (int e = 0; e < 8; ++e) o[e] = bf2f(cb[e]) * (cw[e] * bf2f(pmv[e]) + cw[CW + e] * bf2f(p0v[e]) + cw[2 * CW + e] * bf2f(ppv[e]));
        v4u w; w.x = pk2(o[0], o[1]); w.y = pk2(o[2], o[3]); w.z = pk2(o[4], o[5]); w.w = pk2(o[6], o[7]);
        *(v4u*)(U + (size_t)t * CW + c8) = w;
    }
}

__device__ __forceinline__ float row16_sum(float v) { return row16_sum_dpp(v); }
__device__ __forceinline__ void step_e(Frame& F, int l) {
    fresh_tid(F);
    const bf16* QRAW = WSP(bf16, WS_QRAW); const bf16* SMALL = WSP(bf16, WS_SMALL);
    const f32x2* ROPE = WSP(f32x2, WS_ROPE);
    bf16* Q = WSP(bf16, WS_Q);
    const int gw = F.bid * NWAVES + F.wave, NGW = F.G * NWAVES;
    const int j = F.lane & 15, hh = F.lane >> 4; const bool act = j < 12, isrope = j >= 8 && act;
    const int jc = act ? j : 0;
    const float* gqp = ((const float*)(const GAS float*)F.in[13]) + l * DQK + 8 * jc;
    const f32x4 gq0 = *(const f32x4*)gqp, gq1 = *(const f32x4*)(gqp + 4);
    const float sgn = (j >= 10) ? 1.f : -1.f;
    for (int t = gw; t < T; t += NGW) {
        const int b = t / S, s = t % S;
        const bf16x8 xs = *(const bf16x8*)(SMALL + (size_t)t * 512 + 8 * (F.lane & 31));
        const f32x4* rp = (const f32x4*)(ROPE + (size_t)t * 16 + 8 * (j & 1));
        const f32x4 r0 = rp[0], r1 = rp[1], r2 = rp[2], r3 = rp[3];
        bf16x8 xq[2];
#pragma unroll
        for (int pass = 0; pass < 2; ++pass) xq[pass] = *(const bf16x8*)(QRAW + (size_t)t * 768 + (pass * 4 + hh) * 96 + 8 * jc);
        float sq = 0.f;
#pragma unroll
        for (int e = 0; e < 8; ++e) { const float f = bf2f(xs[e]); sq += f * f; }
        const float rsq = 1.0f / sqrtf(wave_sum(F.lane < 32 ? sq : 0.f, F.lane) * (1.f / 256.f) + EPS);
        float cs[8], sn[8];
        cs[0] = r0.x; sn[0] = r0.y; cs[1] = r0.z; sn[1] = r0.w; cs[2] = r1.x; sn[2] = r1.y; cs[3] = r1.z; sn[3] = r1.w;
        cs[4] = r2.x; sn[4] = r2.y; cs[5] = r2.z; sn[5] = r2.w; cs[6] = r3.x; sn[6] = r3.y; cs[7] = r3.z; sn[7] = r3.w;
#pragma unroll
        for (int pass = 0; pass < 2; ++pass) {
            const int h = pass * 4 + hh;
            const size_t orow = ((size_t)(b * H + h) * S + s);
            const bf16x8 x = xq[pass];
            float v[8]; float ss = 0.f;
#pragma unroll
            for (int e = 0; e < 8; ++e) { v[e] = act ? bf2f(x[e]) * rsq : 0.f; ss += v[e] * v[e]; }
            const float r = 1.0f / sqrtf(row16_sum(ss) * (1.f / 96.f) + EPS);
#pragma unroll
            for (int e = 0; e < 8; ++e) v[e] = v[e] * r * (e < 4 ? gq0[e & 3] : gq1[e & 3]);
#pragma unroll
            for (int e = 0; e < 8; ++e) { const float p = xor_lane<2>(v[e]); if (isrope) v[e] = v[e] * cs[e] + sgn * p * sn[e]; }
            if (act) { v4u w; w.x = pk2(v[0] * QSCALE, v[1] * QSCALE); w.y = pk2(v[2] * QSCALE, v[3] * QSCALE); w.z = pk2(v[4] * QSCALE, v[5] * QSCALE); w.w = pk2(v[6] * QSCALE, v[7] * QSCALE);
                *(v4u*)(Q + orow * 96 + 8 * j) = w; }
        }
    }
}

__device__ __forceinline__ void step_f(Frame& F) {
    fresh_tid(F);
    const bf16* Q = WSP(bf16, WS_Q); const bf16* K = WSP(bf16, WS_K); const bf16* V = WSP(bf16, WS_V); bf16* O = WSP(bf16, WS_O);
    const int gw = F.bid * NWAVES + F.wave, NGW = F.G * NWAVES;
    for (int it = gw; it < NB * H * (S / 64) * 2; it += NGW) {
        const int half = it & 1, it2 = it >> 1;
        const int bh = it2 / (S / 64), qi = (it2 % (S / 64)) * 64 + F.lane;
        bf16x8 q[12]; float o[32];
#pragma unroll
        for (int c = 0; c < 12; ++c) q[c] = *(const bf16x8*)(Q + ((size_t)bh * S + qi) * 96 + c * 8);
#pragma unroll
        for (int d = 0; d < 32; ++d) o[d] = 0.f;
        float m = -1e30f, lsum = 0.f;
        const bf16* kb = K + (size_t)bh * S * 96; const bf16* vb = V + (size_t)bh * S * 64 + half * 32;
#pragma unroll 1
        for (int j = 0; j < S; j += 2) {
            float sc[2];
#pragma unroll
            for (int i = 0; i < 2; ++i) { float a = 0.f;
#pragma unroll
                for (int c = 0; c < 12; ++c) { const bf16x8 kk = *(const bf16x8*)(kb + (size_t)(j + i) * 96 + c * 8);
#pragma unroll
                    for (int e = 0; e < 8; ++e) a += bf2f(q[c][e]) * bf2f(kk[e]); }
                sc[i] = a; asm volatile("" ::: "memory"); }
            const float mn = fmaxf(m, fmaxf(sc[0], sc[1]));
            const float alpha = exp2f(m - mn), p0 = exp2f(sc[0] - mn), p1 = exp2f(sc[1] - mn);
            lsum = lsum * alpha + (p0 + p1); m = mn;
#pragma unroll
            for (int c = 0; c < 4; ++c) {
                const bf16x8 v0 = *(const bf16x8*)(vb + (size_t)(j + 0) * 64 + c * 8), v1 = *(const bf16x8*)(vb + (size_t)(j + 1) * 64 + c * 8);
#pragma unroll
                for (int e = 0; e < 8; ++e) o[c * 8 + e] = o[c * 8 + e] * alpha + (p0 * bf2f(v0[e]) + p1 * bf2f(v1[e]));
                asm volatile("" ::: "memory");
            }
        }
        const float inv = 1.f / lsum; const int b = bh / H, h = bh % H;
        bf16* op = O + ((size_t)(b * S + qi)) * 512 + h * 64 + half * 32;
#pragma unroll
        for (int c = 0; c < 4; ++c) { v4u w; w.x = pk2(o[c * 8] * inv, o[c * 8 + 1] * inv); w.y = pk2(o[c * 8 + 2] * inv, o[c * 8 + 3] * inv); w.z = pk2(o[c * 8 + 4] * inv, o[c * 8 + 5] * inv);
            w.w = pk2(o[c * 8 + 6] * inv, o[c * 8 + 7] * inv); *(v4u*)(op + c * 8) = w; }
    }
}

__device__ __forceinline__ void route16(float myscore, float mybiased, int& e1, int& e2, float& w1, float& w2) {
    float scv[16], bi[16];
#pragma unroll
    for (int e = 0; e < 16; ++e) { scv[e] = __builtin_bit_cast(float, __builtin_amdgcn_readlane(__builtin_bit_cast(int, myscore), e)); bi[e] = __builtin_bit_cast(float, __builtin_amdgcn_readlane(__builtin_bit_cast(int, mybiased), e)); }
    float gs[4];
#pragma unroll
    for (int g = 0; g < 4; ++g) { const float a0 = bi[4 * g], a1 = bi[4 * g + 1], a2 = bi[4 * g + 2], a3 = bi[4 * g + 3];
        const float h1 = fmaxf(a0, a1), l1 = fminf(a0, a1), h2 = fmaxf(a2, a3), l2 = fminf(a2, a3);
        gs[g] = fmaxf(h1, h2) + fmaxf(fminf(h1, h2), fmaxf(l1, l2)); }
    int sg = 0; float bg = gs[0];
#pragma unroll
    for (int g = 1; g < 4; ++g) if (gs[g] > bg) { bg = gs[g]; sg = g; }
    float b0 = bi[0], b1 = bi[1], b2 = bi[2], b3 = bi[3], s0 = scv[0], s1 = scv[1], s2 = scv[2], s3 = scv[3];
#pragma unroll
    for (int g = 1; g < 4; ++g) if (sg == g) { b0 = bi[4 * g]; b1 = bi[4 * g + 1]; b2 = bi[4 * g + 2]; b3 = bi[4 * g + 3]; s0 = scv[4 * g]; s1 = scv[4 * g + 1]; s2 = scv[4 * g + 2]; s3 = scv[4 * g + 3]; }
    int i1 = 0; float m1 = b0, q1 = s0;
    if (b1 > m1) { m1 = b1; i1 = 1; q1 = s1; } if (b2 > m1) { m1 = b2; i1 = 2; q1 = s2; } if (b3 > m1) { m1 = b3; i1 = 3; q1 = s3; }
    int i2 = -1; float m2 = -1e30f, q2 = 0.f;
    if (i1 != 0 && (i2 < 0 || b0 > m2)) { m2 = b0; i2 = 0; q2 = s0; }
    if (i1 != 1 && (i2 < 0 || b1 > m2)) { m2 = b1; i2 = 1; q2 = s1; }
    if (i1 != 2 && (i2 < 0 || b2 > m2)) { m2 = b2; i2 = 2; q2 = s2; }
    if (i1 != 3 && (i2 < 0 || b3 > m2)) { m2 = b3; i2 = 3; q2 = s3; }
    const float inv = 1.f / (q1 + q2);
    e1 = 4 * sg + i1; e2 = 4 * sg + i2; w1 = q1 * inv; w2 = q2 * inv;
}
__device__ __forceinline__ void step_j(Frame& F, int l, bool dry = false) {
    fresh_tid(F);
    const bf16* X16 = WSP(bf16, WS_X16);
    const int gw = F.bid * NWAVES + F.wave, NGW = F.G * NWAVES;
    const float* MOD = WSP(float, WS_MOD); bf16* XN = WSP(bf16, WS_XN);
    int* TOKS = WSP(int, WS_TOKS); float* TOKW = WSP(float, WS_TOKW); int* LIST = WSP(int, WS_LIST);
    unsigned* cnt = F.ctl + CW_CNT + CNT_LS * l;
    LAS unsigned* lcnt = (LAS unsigned*)(F.lds + 65536); LAS unsigned* gbase = lcnt + 16; LAS unsigned* rinfo = (LAS unsigned*)(F.lds + 65536 + 256) + F.wave * 512;
    if (F.tid < 16) lcnt[F.tid] = 0u;
    __syncthreads();
    int ri = 0;
    LAS float* hrow = (LAS float*)(F.lds + F.wave * 8192);
    const int re = F.lane & 15, rq = F.lane >> 4;
    const float* wr = ((const float*)(const GAS float*)F.in[18]) + (size_t)(rq * 256) * NE + re;
    const float brt = ((const float*)(const GAS float*)F.in[19])[re];
    for (int row0 = gw; row0 < T; row0 += 2 * NGW) {
        const bool has1 = row0 + NGW < T;
        int rr[2]; rr[0] = row0; rr[1] = has1 ? row0 + NGW : row0;
        f32x4 v[2][4], g[4], sc[2][4], sh[2][4];
#pragma unroll
        for (int k = 0; k < 2; ++k)
#pragma unroll
            for (int j = 0; j < 4; ++j) { const bf16x4 t = *(const bf16x4*)(X16 + (size_t)rr[k] * D + 4 * F.lane + 256 * j); v[k][j] = (f32x4){bf2f(t[0]), bf2f(t[1]), bf2f(t[2]), bf2f(t[3])}; }
#pragma unroll
        for (int j = 0; j < 4; ++j) g[j] = *(const f32x4*)(((const float*)(const GAS float*)F.in[6]) + l * D + 4 * F.lane + 256 * j);
#pragma unroll
        for (int k = 0; k < 2; ++k) { const float* m = MOD + (l * 2 + rr[k] / S) * 6 * D;
#pragma unroll
            for (int j = 0; j < 4; ++j) { sc[k][j] = *(const f32x4*)(m + 4 * D + 4 * F.lane + 256 * j); sh[k][j] = *(const f32x4*)(m + 3 * D + 4 * F.lane + 256 * j); } }
        float ss[2];
#pragma unroll
        for (int k = 0; k < 2; ++k) { float a = 0.f;
#pragma unroll
            for (int j = 0; j < 4; ++j) a += (v[k][j].x * v[k][j].x + v[k][j].y * v[k][j].y) + (v[k][j].z * v[k][j].z + v[k][j].w * v[k][j].w);
            ss[k] = a; }
        const float rs0 = 1.0f / sqrtf(wave_sum(ss[0], F.lane) * (1.f / D) + EPS), rs1 = 1.0f / sqrtf(wave_sum(ss[1], F.lane) * (1.f / D) + EPS);
#pragma unroll
        for (int k = 0; k < 2; ++k) { const float rs = k ? rs1 : rs0;
#pragma unroll
            for (int j = 0; j < 4; ++j) { const int col = 4 * F.lane + 256 * j; f32x4 hh;
#pragma unroll
                for (int e = 0; e < 4; ++e) hh[e] = v[k][j][e] * rs * g[j][e] * (1.f + sc[k][j][e]) + sh[k][j][e];
                v2u o; o.x = pk2(hh[0], hh[1]); o.y = pk2(hh[2], hh[3]);
                if (k == 0 || has1) *(v2u*)(XN + (size_t)rr[k] * D + col) = o;
                *(LAS f32x4*)(hrow + k * 1024 + col) = hh; } }
        asm volatile("s_waitcnt lgkmcnt(0)" ::: "memory");
        float a0 = 0.f, a1 = 0.f, a2 = 0.f, a3 = 0.f, c0 = 0.f, c1 = 0.f, c2 = 0.f, c3 = 0.f;
#pragma unroll 4
        for (int c = 0; c < 256; c += 4) {
            const f32x4 h0 = *(const LAS f32x4*)(hrow + rq * 256 + c), h1 = *(const LAS f32x4*)(hrow + 1024 + rq * 256 + c);
            const float w0 = wr[(size_t)(c + 0) * NE], w1 = wr[(size_t)(c + 1) * NE], w2 = wr[(size_t)(c + 2) * NE], w3 = wr[(size_t)(c + 3) * NE];
            a0 += h0.x * w0; a1 += h0.y * w1; a2 += h0.z * w2; a3 += h0.w * w3;
            c0 += h1.x * w0; c1 += h1.y * w1; c2 += h1.z * w2; c3 += h1.w * w3;
        }
        float z0 = (a0 + a1) + (a2 + a3), z1 = (c0 + c1) + (c2 + c3);
        z0 += bperm_xor(z0, F.lane, 16); z0 += bperm_xor(z0, F.lane, 32);
        z1 += bperm_xor(z1, F.lane, 16); z1 += bperm_xor(z1, F.lane, 32);
        asm volatile("s_waitcnt lgkmcnt(0)" ::: "memory");
#pragma unroll
        for (int k = 0; k < 2; ++k) {
            const float z = k ? z1 : z0;
            const float myscore = 1.f / (1.f + expf(-z)), mybiased = myscore + brt;
            int e1, e2; float w1, w2;
            route16(myscore, mybiased, e1, e2, w1, w2);
            if (F.lane == 0 && !dry && (k == 0 || has1)) {
                const unsigned p1 = __hip_atomic_fetch_add(lcnt + e1, 1u, __ATOMIC_RELAXED, __HIP_MEMORY_SCOPE_WORKGROUP), p2 = __hip_atomic_fetch_add(lcnt + e2, 1u, __ATOMIC_RELAXED, __HIP_MEMORY_SCOPE_WORKGROUP);
                LAS unsigned* r = rinfo + ri * 8;
                r[0] = (unsigned)rr[k]; r[1] = (unsigned)e1; r[2] = p1; r[3] = (unsigned)e2; r[4] = p2; r[5] = __builtin_bit_cast(unsigned, w1); r[6] = __builtin_bit_cast(unsigned, w2);
            }
            if (k == 0 || has1) ++ri;
        }
    }
    if (dry) return;
    __syncthreads();
    if (F.tid < 16) { const unsigned c = lcnt[F.tid]; gbase[F.tid] = c ? __hip_atomic_fetch_add(cnt + CNT_ES * F.tid, c, RLX_AGENT) : 0u; }
    __syncthreads();
    if (F.lane < ri) {
        const LAS unsigned* r = rinfo + F.lane * 8;
        const int row = (int)r[0], e1 = (int)r[1], e2 = (int)r[3]; const unsigned p1 = gbase[e1] + r[2], p2 = gbase[e2] + r[4];
        LIST[(size_t)e1 * T + p1] = 2 * row; LIST[(size_t)e2 * T + p2] = 2 * row + 1;
        TOKS[2 * row] = (e1 << 16) | (int)p1; TOKS[2 * row + 1] = (e2 << 16) | (int)p2;
        TOKW[2 * row] = __builtin_bit_cast(float, r[5]); TOKW[2 * row + 1] = __builtin_bit_cast(float, r[6]);
    }
}

__device__ __forceinline__ void step_j_old(Frame& F, int l, bool dry = false) {
    fresh_tid(F);
    const int gw = F.bid * NWAVES + F.wave, NGW = F.G * NWAVES;
    const float* MOD = WSP(float, WS_MOD); bf16* XN = WSP(bf16, WS_XN);
    int* TOKS = WSP(int, WS_TOKS); float* TOKW = WSP(float, WS_TOKW); int* LIST = WSP(int, WS_LIST);
    unsigned* cnt = F.ctl + CW_CNT + CNT_LS * l;
    for (int row = gw; row < T; row += NGW) {
        const int b = row / S;
        float ss = 0.f;
#pragma unroll
        for (int j = 0; j < 4; ++j) { const f32x4 vv = *(const f32x4*)(F.out + (size_t)row * D + 4 * F.lane + 256 * j); ss += (vv.x * vv.x + vv.y * vv.y) + (vv.z * vv.z + vv.w * vv.w); }
        const float rs = 1.0f / sqrtf(wave_sum(ss, F.lane) * (1.f / D) + EPS);
        const float* m = MOD + (l * 2 + b) * 6 * D;
        float lg[16];
#pragma unroll
        for (int e = 0; e < 16; ++e) lg[e] = 0.f;
#pragma unroll 1
        for (int j = 0; j < 4; ++j) {
            const int col = 4 * F.lane + 256 * j;
            const f32x4 vj = *(const f32x4*)(F.out + (size_t)row * D + col);
            const f32x4 g = *(const f32x4*)(((const float*)(const GAS float*)F.in[6]) + l * D + col), sc = *(const f32x4*)(m + 4 * D + col), sh = *(const f32x4*)(m + 3 * D + col);
            f32x4 hh;
#pragma unroll
            for (int e = 0; e < 4; ++e) hh[e] = vj[e] * rs * g[e] * (1.f + sc[e]) + sh[e];
            v2u o; o.x = pk2(hh[0], hh[1]); o.y = pk2(hh[2], hh[3]);
            *(v2u*)(XN + (size_t)row * D + col) = o;
#pragma unroll
            for (int i = 0; i < 4; ++i) {
                const float* wr = ((const float*)(const GAS float*)F.in[18]) + (size_t)(col + i) * NE;
                const f32x4 w0 = *(const f32x4*)(wr), w1 = *(const f32x4*)(wr + 4), w2 = *(const f32x4*)(wr + 8), w3 = *(const f32x4*)(wr + 12);
#pragma unroll
                for (int e = 0; e < 4; ++e) { lg[e] += hh[i] * w0[e]; lg[4 + e] += hh[i] * w1[e]; lg[8 + e] += hh[i] * w2[e]; lg[12 + e] += hh[i] * w3[e]; }
            }
        }
        float scv[16], bi[16];
#pragma unroll
        for (int e = 0; e < 16; ++e) { const float z = wave_sum(lg[e], F.lane); scv[e] = 1.f / (1.f + expf(-z)); bi[e] = scv[e] + ((const float*)(const GAS float*)F.in[19])[e]; }
        float gs[4];
#pragma unroll
        for (int g = 0; g < 4; ++g) { const float a0 = bi[4 * g], a1 = bi[4 * g + 1], a2 = bi[4 * g + 2], a3 = bi[4 * g + 3];
            const float h1 = fmaxf(a0, a1), l1 = fminf(a0, a1), h2 = fmaxf(a2, a3), l2 = fminf(a2, a3);
            gs[g] = fmaxf(h1, h2) + fmaxf(fminf(h1, h2), fmaxf(l1, l2)); }
        int sg = 0; float bg = gs[0];
#pragma unroll
        for (int g = 1; g < 4; ++g) if (gs[g] > bg) { bg = gs[g]; sg = g; }
        float b0 = bi[0], b1 = bi[1], b2 = bi[2], b3 = bi[3], s0 = scv[0], s1 = scv[1], s2 = scv[2], s3 = scv[3];
#pragma unroll
        for (int g = 1; g < 4; ++g) if (sg == g) { b0 = bi[4 * g]; b1 = bi[4 * g + 1]; b2 = bi[4 * g + 2]; b3 = bi[4 * g + 3]; s0 = scv[4 * g]; s1 = scv[4 * g + 1]; s2 = scv[4 * g + 2]; s3 = scv[4 * g + 3]; }
        int i1 = 0; float m1 = b0, q1 = s0;
        if (b1 > m1) { m1 = b1; i1 = 1; q1 = s1; } if (b2 > m1) { m1 = b2; i1 = 2; q1 = s2; } if (b3 > m1) { m1 = b3; i1 = 3; q1 = s3; }
        int i2 = -1; float m2 = -1e30f, q2 = 0.f;
        if (i1 != 0 && (i2 < 0 || b0 > m2)) { m2 = b0; i2 = 0; q2 = s0; }
        if (i1 != 1 && (i2 < 0 || b1 > m2)) { m2 = b1; i2 = 1; q2 = s1; }
        if (i1 != 2 && (i2 < 0 || b2 > m2)) { m2 = b2; i2 = 2; q2 = s2; }
        if (i1 != 3 && (i2 < 0 || b3 > m2)) { m2 = b3; i2 = 3; q2 = s3; }
        if (F.lane == 0 && !dry) {
            const int e1 = 4 * sg + i1, e2 = 4 * sg + i2; const float inv = 1.f / (q1 + q2);
            const unsigned p1 = __hip_atomic_fetch_add(cnt + CNT_ES * e1, 1u, RLX_AGENT), p2 = __hip_atomic_fetch_add(cnt + CNT_ES * e2, 1u, RLX_AGENT);
            LIST[(size_t)e1 * T + p1] = 2 * row; LIST[(size_t)e2 * T + p2] = 2 * row + 1;
            TOKS[2 * row] = (e1 << 16) | (int)p1; TOKS[2 * row + 1] = (e2 << 16) | (int)p2;
            TOKW[2 * row] = q1 * inv; TOKW[2 * row + 1] = q2 * inv;
        }
    }
}


namespace att {
typedef short sbf16x8 __attribute__((ext_vector_type(8)));
typedef short s16x4 __attribute__((ext_vector_type(4)));
typedef float f32x16 __attribute__((ext_vector_type(16)));
constexpr int NW = 8, QBLK = 32, KVBLK = 64;
constexpr int SHM_K = KVBLK * 256, SHM_V = KVBLK * 256;
constexpr int OFF_V = 0, OFF_K = 2 * SHM_V, OFF_WS = 2 * SHM_V + 2 * SHM_K, OFF_OST = OFF_WS + NW * 64 * 4, LDS_NEED = OFF_OST + NW * 4096;
static_assert(LDS_NEED <= 131072, "attention LDS");
constexpr float THR2 = 11.f;
#define ATT_KSWZ(row, colB) ((row) * 256 + ((colB) ^ (((row) & 15) << 4)))
#define ATT_SBAR() __builtin_amdgcn_sched_barrier(0)
__device__ __forceinline__ int crow(int r, int hi) { return (r & 3) + 8 * (r >> 2) + 4 * hi; }
__device__ __forceinline__ void partialSM(f32x16& p0, f32x16& p1) {
#pragma unroll
    for (int r = 0; r < 16; ++r) p0[r] = __builtin_amdgcn_exp2f(p0[r]);
}
__device__ __forceinline__ void finishSM(f32x16& p0, f32x16& p1, float& l_reg, sbf16x8& pa0, sbf16x8& pa1, sbf16x8& pa2, sbf16x8& pa3) {
#pragma unroll
    for (int r = 0; r < 16; ++r) p1[r] = __builtin_amdgcn_exp2f(p1[r]);
    float ps0 = 0.f, ps1 = 0.f;
#pragma unroll
    for (int r = 0; r < 16; ++r) { ps0 += p0[r]; ps1 += p1[r]; }
    l_reg += ps0 + ps1;
#define ATT_PK4(P, BASE, OUT) do { unsigned a0 = pk2(P[BASE + 0], P[BASE + 1]), a1 = pk2(P[BASE + 2], P[BASE + 3]);   \
    unsigned b0 = pk2(P[BASE + 4], P[BASE + 5]), b1 = pk2(P[BASE + 6], P[BASE + 7]);                              \
    auto r0 = __builtin_amdgcn_permlane32_swap(a0, b0, false, false); auto r1 = __builtin_amdgcn_permlane32_swap(a1, b1, false, false); \
    v4u w = {r0[0], r1[0], r0[1], r1[1]}; OUT = __builtin_bit_cast(sbf16x8, w); } while (0)
    ATT_PK4(p0, 0, pa0); ATT_PK4(p0, 8, pa1); ATT_PK4(p1, 0, pa2); ATT_PK4(p1, 8, pa3);
#undef ATT_PK4
}
__device__ __forceinline__ void qkt(f32x16& p0, f32x16& p1, const LAS char* Ks, const sbf16x8* qr, int r32, int hi) {
    asm volatile("" : "+v"(r32));
    p0 = f32x16{}; p1 = f32x16{};
    sbf16x8 c0 = *(const LAS sbf16x8*)(Ks + ATT_KSWZ(r32, (hi * 8) * 2)), c1 = *(const LAS sbf16x8*)(Ks + ATT_KSWZ(32 + r32, (hi * 8) * 2));
#pragma unroll
    for (int d0 = 0; d0 < 6; ++d0) {
        sbf16x8 n0 = c0, n1 = c1;
        if (d0 < 5) { const int cb = ((d0 + 1) * 16 + hi * 8) * 2; n0 = *(const LAS sbf16x8*)(Ks + ATT_KSWZ(r32, cb)); n1 = *(const LAS sbf16x8*)(Ks + ATT_KSWZ(32 + r32, cb)); }
        p0 = __builtin_amdgcn_mfma_f32_32x32x16_bf16(c0, qr[d0], p0, 0, 0, 0);
        p1 = __builtin_amdgcn_mfma_f32_32x32x16_bf16(c1, qr[d0], p1, 0, 0, 0);
        c0 = n0; c1 = n1;
    }
}
__device__ __forceinline__ int v_st(int k, int c) { const int kk = (k & ~0xC) | ((k & 4) << 1) | ((k & 8) >> 1); return ((kk >> 3) * 4 + (c >> 5)) * 512 + ((kk & 7) * 32 + (c & 31)) * 2; }
__device__ __forceinline__ int v_rd_base(int lane) { return ((lane & 3) << 3) | (((lane >> 2) & 3) << 6) | (((lane >> 4) & 1) << 5) | (((lane >> 5) & 1) << 8); }
constexpr int v_rd_off(int d0, int ks, int half) { return d0 * 512 + ks * 4096 + half * 2048; }
template <int OFF> __device__ __forceinline__ s16x4 tr_read(int vb) { s16x4 r; asm volatile("ds_read_b64_tr_b16 %0, %1 offset:%2" : "=&v"(r) : "v"(vb), "i"(OFF) : "memory"); return r; }
template <int D0> __device__ __forceinline__ void pv_one(f32x16& od, int vb, sbf16x8 pa0, sbf16x8 pa1, sbf16x8 pa2, sbf16x8 pa3) {
    const s16x4 l0 = tr_read<v_rd_off(D0, 0, 0)>(vb), h0 = tr_read<v_rd_off(D0, 0, 1)>(vb), l1 = tr_read<v_rd_off(D0, 1, 0)>(vb), h1 = tr_read<v_rd_off(D0, 1, 1)>(vb);
    const s16x4 l2 = tr_read<v_rd_off(D0, 2, 0)>(vb), h2 = tr_read<v_rd_off(D0, 2, 1)>(vb), l3 = tr_read<v_rd_off(D0, 3, 0)>(vb), h3 = tr_read<v_rd_off(D0, 3, 1)>(vb);
    asm volatile("s_waitcnt lgkmcnt(0)" ::: "memory"); ATT_SBAR();
#define ATT_PK(L, H) (sbf16x8){L[0], L[1], L[2], L[3], H[0], H[1], H[2], H[3]}
    od = __builtin_amdgcn_mfma_f32_32x32x16_bf16(pa0, ATT_PK(l0, h0), od, 0, 0, 0);
    od = __builtin_amdgcn_mfma_f32_32x32x16_bf16(pa1, ATT_PK(l1, h1), od, 0, 0, 0);
    od = __builtin_amdgcn_mfma_f32_32x32x16_bf16(pa2, ATT_PK(l2, h2), od, 0, 0, 0);
    od = __builtin_amdgcn_mfma_f32_32x32x16_bf16(pa3, ATT_PK(l3, h3), od, 0, 0, 0);
#undef ATT_PK
}
__device__ __forceinline__ void pv2(f32x16* o, int vb, sbf16x8 pa0, sbf16x8 pa1, sbf16x8 pa2, sbf16x8 pa3) { pv_one<0>(o[0], vb, pa0, pa1, pa2, pa3); pv_one<1>(o[1], vb, pa0, pa1, pa2, pa3); }

__device__ __forceinline__ void attn_unit(const bf16* Qb, const bf16* Kh, const bf16* Vh, bf16* Ob, int seq, LAS char* lds, int tid) {
    const int wid = __builtin_amdgcn_readfirstlane(tid >> 6), lane = tid & 63, r32 = lane & 31, hi = lane >> 5; int lane2;
    LAS char* V_lds = lds + OFF_V; LAS char* K_lds = lds + OFF_K;
    LAS float* ws = (LAS float*)(lds + OFF_WS) + wid * 64; LAS float* li_l = ws;
    float l_reg = 0.f; f32x16 o[2]; o[0] = f32x16{}; o[1] = f32x16{}; sbf16x8 qr[6];
    const bf16* Qw = Qb + (size_t)(wid * QBLK + r32) * 96 + hi * 8;
#pragma unroll
    for (int d0 = 0; d0 < 6; ++d0) qr[d0] = *(const GAS sbf16x8*)((const GAS bf16*)Qw + d0 * 16);
    const int kc1 = 512 + (tid & 255), kr0 = tid / 12, kq0 = (tid % 12) * 8, kr1 = kc1 / 12, kq1 = (kc1 % 12) * 8;
    const int ksto0 = ATT_KSWZ(kr0, kq0 * 2), ksto1 = ATT_KSWZ(kr1, kq1 * 2);
    const int vr = tid >> 3, vq = (tid & 7) * 8, vsto = v_st(vr, vq);
    const int vb0 = (int)(unsigned)(size_t)V_lds + v_rd_base(lane);
    const unsigned ko0 = (unsigned)(kr0 * 96 + kq0) * 2u, ko1 = (unsigned)(kr1 * 96 + kq1) * 2u, vo = (unsigned)(vr * 64 + vq) * 2u;
    sbf16x8 sk0[2], sk1[2], sv[2];
    const GAS char* Kg = (const GAS char*)Kh; const GAS char* Vg = (const GAS char*)Vh;
#define ATT_SLOAD(i, k0) do { sk0[i] = *(const GAS sbf16x8*)(Kg + (ko0 + (unsigned)(k0) * 192u)); sk1[i] = *(const GAS sbf16x8*)(Kg + (ko1 + (unsigned)(k0) * 192u)); sv[i] = *(const GAS sbf16x8*)(Vg + (vo + (unsigned)(k0) * 128u)); } while (0)
#define ATT_SWRITE(b, i) do { *(LAS sbf16x8*)(K_lds + (b) * SHM_K + ksto0) = sk0[i]; *(LAS sbf16x8*)(K_lds + (b) * SHM_K + ksto1) = sk1[i]; *(LAS sbf16x8*)(V_lds + (b) * SHM_V + vsto) = sv[i]; } while (0)
#define ATT_SWAIT() asm volatile("s_waitcnt vmcnt(3)" ::: "memory")
    f32x16 pA0, pA1, pB0, pB1; sbf16x8 pa0, pa1, pa2, pa3; const int NT = seq / KVBLK;
    ATT_SLOAD(0, 0); asm volatile("s_waitcnt vmcnt(0)" ::: "memory"); ATT_SWRITE(0, 0); __syncthreads();
    qkt(pA0, pA1, K_lds, qr, r32, hi); partialSM(pA0, pA1);
    ATT_SLOAD(1, KVBLK); if (2 < NT) ATT_SLOAD(0, 2 * KVBLK);
    ATT_SWAIT(); ATT_SWRITE(1, 1); __syncthreads();
#pragma unroll 1
    for (int j = 1; j + 1 < NT; j += 2) {
        ATT_SBAR(); qkt(pB0, pB1, K_lds + SHM_K, qr, r32, hi);
        finishSM(pA0, pA1, l_reg, pa0, pa1, pa2, pa3); ATT_SBAR();
        ATT_SLOAD(1, (j + 2) * KVBLK); ATT_SBAR();
        pv2(o, vb0, pa0, pa1, pa2, pa3); partialSM(pB0, pB1);
        __syncthreads(); ATT_SWAIT(); ATT_SWRITE(0, 0);
        __syncthreads();
        ATT_SBAR(); qkt(pA0, pA1, K_lds, qr, r32, hi);
        finishSM(pB0, pB1, l_reg, pa0, pa1, pa2, pa3); ATT_SBAR();
        if (j + 3 < NT) ATT_SLOAD(0, (j + 3) * KVBLK); ATT_SBAR();
        pv2(o, vb0 + SHM_V, pa0, pa1, pa2, pa3); partialSM(pA0, pA1);
        __syncthreads(); ATT_SWAIT(); ATT_SWRITE(1, 1);
        __syncthreads();
    }
    ATT_SBAR(); qkt(pB0, pB1, K_lds + SHM_K, qr, r32, hi);
    finishSM(pA0, pA1, l_reg, pa0, pa1, pa2, pa3); ATT_SBAR();
    pv2(o, vb0, pa0, pa1, pa2, pa3); partialSM(pB0, pB1);
    __syncthreads();
    finishSM(pB0, pB1, l_reg, pa0, pa1, pa2, pa3); ATT_SBAR();
    pv2(o, vb0 + SHM_V, pa0, pa1, pa2, pa3);
    { auto rr = __builtin_amdgcn_permlane32_swap(__float_as_uint(l_reg), __float_as_uint(l_reg), false, false); l_reg = __uint_as_float(rr[0]) + __uint_as_float(rr[1]); }
    { unsigned z_ = 0u; asm volatile("" : "+v"(z_)); lane2 = (int)__builtin_amdgcn_mbcnt_hi(~0u, __builtin_amdgcn_mbcnt_lo(~0u, z_)); }
    const int r32e = lane2 & 31, hie = lane2 >> 5;
    if (hie == 0) li_l[r32e] = l_reg; asm volatile("s_waitcnt lgkmcnt(0)" ::: "memory");
    float rli[16];
#pragma unroll
    for (int r = 0; r < 16; ++r) rli[r] = __builtin_amdgcn_rcpf(li_l[crow(r, hie)]);
    LAS bf16* stg = (LAS bf16*)(lds + OFF_OST) + wid * 2048;
#pragma unroll
    for (int r = 0; r < 16; ++r) { const int orow = crow(r, hie);
#pragma unroll
        for (int d0 = 0; d0 < 2; ++d0) stg[orow * 64 + d0 * 32 + r32e] = (bf16)(pk2(o[d0][r] * rli[r], 0.f) & 0xffffu); }
    asm volatile("s_waitcnt lgkmcnt(0)" ::: "memory");
    bf16* Ow = Ob + (size_t)(wid * QBLK) * 512;
#pragma unroll
    for (int i = 0; i < 4; ++i) { const int row = i * 8 + (lane2 >> 3), ch = lane2 & 7; const v4u v = *(const LAS v4u*)(stg + row * 64 + ch * 8); *(GAS v4u*)((GAS bf16*)Ow + (size_t)row * 512 + ch * 8) = v; }
    asm volatile("s_waitcnt lgkmcnt(0)" ::: "memory");
#undef ATT_SLOAD
#undef ATT_SWRITE
#undef ATT_SWAIT
}
__device__ __forceinline__ void softmax_pack(f32x16& p0, f32x16& p1, float& l_reg, sbf16x8& pa0, sbf16x8& pa1, sbf16x8& pa2, sbf16x8& pa3) {
#pragma unroll
    for (int r = 0; r < 16; ++r) p0[r] = __builtin_amdgcn_exp2f(p0[r]);
#pragma unroll
    for (int r = 0; r < 16; ++r) p1[r] = __builtin_amdgcn_exp2f(p1[r]);
    float ps0 = 0.f, ps1 = 0.f;
#pragma unroll
    for (int r = 0; r < 16; ++r) { ps0 += p0[r]; ps1 += p1[r]; }
    l_reg += ps0 + ps1;
#define ATT_PK4(P, BASE, OUT) do { unsigned a0 = pk2(P[BASE + 0], P[BASE + 1]), a1 = pk2(P[BASE + 2], P[BASE + 3]);   \
    unsigned b0 = pk2(P[BASE + 4], P[BASE + 5]), b1 = pk2(P[BASE + 6], P[BASE + 7]);                              \
    auto r0 = __builtin_amdgcn_permlane32_swap(a0, b0, false, false); auto r1 = __builtin_amdgcn_permlane32_swap(a1, b1, false, false); \
    v4u w = {r0[0], r1[0], r0[1], r1[1]}; OUT = __builtin_bit_cast(sbf16x8, w); } while (0)
    ATT_PK4(p0, 0, pa0); ATT_PK4(p0, 8, pa1); ATT_PK4(p1, 0, pa2); ATT_PK4(p1, 8, pa3);
#undef ATT_PK4
}
__device__ __forceinline__ void qkt2(f32x16& x0, f32x16& x1, f32x16& y0, f32x16& y1, const LAS char* Ks, const sbf16x8* qx, const sbf16x8* qy, int r32, int hi) {
    asm volatile("" : "+v"(r32));
    x0 = f32x16{}; x1 = f32x16{}; y0 = f32x16{}; y1 = f32x16{};
    sbf16x8 c0 = *(const LAS sbf16x8*)(Ks + ATT_KSWZ(r32, (hi * 8) * 2)), c1 = *(const LAS sbf16x8*)(Ks + ATT_KSWZ(32 + r32, (hi * 8) * 2));
#pragma unroll
    for (int d0 = 0; d0 < 6; ++d0) {
        sbf16x8 n0 = c0, n1 = c1;
        if (d0 < 5) { const int cb = ((d0 + 1) * 16 + hi * 8) * 2; n0 = *(const LAS sbf16x8*)(Ks + ATT_KSWZ(r32, cb)); n1 = *(const LAS sbf16x8*)(Ks + ATT_KSWZ(32 + r32, cb)); }
        x0 = __builtin_amdgcn_mfma_f32_32x32x16_bf16(c0, qx[d0], x0, 0, 0, 0);
        x1 = __builtin_amdgcn_mfma_f32_32x32x16_bf16(c1, qx[d0], x1, 0, 0, 0);
        y0 = __builtin_amdgcn_mfma_f32_32x32x16_bf16(c0, qy[d0], y0, 0, 0, 0);
        y1 = __builtin_amdgcn_mfma_f32_32x32x16_bf16(c1, qy[d0], y1, 0, 0, 0);
        c0 = n0; c1 = n1;
    }
}
template <int D0> __device__ __forceinline__ void pv_one2(f32x16& ox, f32x16& oy, int vb, const sbf16x8 (&px)[4], const sbf16x8 (&py)[4]) {
    const s16x4 l0 = tr_read<v_rd_off(D0, 0, 0)>(vb), h0 = tr_read<v_rd_off(D0, 0, 1)>(vb), l1 = tr_read<v_rd_off(D0, 1, 0)>(vb), h1 = tr_read<v_rd_off(D0, 1, 1)>(vb);
    const s16x4 l2 = tr_read<v_rd_off(D0, 2, 0)>(vb), h2 = tr_read<v_rd_off(D0, 2, 1)>(vb), l3 = tr_read<v_rd_off(D0, 3, 0)>(vb), h3 = tr_read<v_rd_off(D0, 3, 1)>(vb);
    asm volatile("s_waitcnt lgkmcnt(0)" ::: "memory"); ATT_SBAR();
#define ATT_PK(L, H) (sbf16x8){L[0], L[1], L[2], L[3], H[0], H[1], H[2], H[3]}
    ox = __builtin_amdgcn_mfma_f32_32x32x16_bf16(px[0], ATT_PK(l0, h0), ox, 0, 0, 0);
    oy = __builtin_amdgcn_mfma_f32_32x32x16_bf16(py[0], ATT_PK(l0, h0), oy, 0, 0, 0);
    ox = __builtin_amdgcn_mfma_f32_32x32x16_bf16(px[1], ATT_PK(l1, h1), ox, 0, 0, 0);
    oy = __builtin_amdgcn_mfma_f32_32x32x16_bf16(py[1], ATT_PK(l1, h1), oy, 0, 0, 0);
    ox = __builtin_amdgcn_mfma_f32_32x32x16_bf16(px[2], ATT_PK(l2, h2), ox, 0, 0, 0);
    oy = __builtin_amdgcn_mfma_f32_32x32x16_bf16(py[2], ATT_PK(l2, h2), oy, 0, 0, 0);
    ox = __builtin_amdgcn_mfma_f32_32x32x16_bf16(px[3], ATT_PK(l3, h3), ox, 0, 0, 0);
    oy = __builtin_amdgcn_mfma_f32_32x32x16_bf16(py[3], ATT_PK(l3, h3), oy, 0, 0, 0);
#undef ATT_PK
}
__device__ __forceinline__ void softmax_half(f32x16& p, float& l_reg, sbf16x8& pa, sbf16x8& pb) {
#pragma unroll
    for (int r = 0; r < 16; ++r) p[r] = __builtin_amdgcn_exp2f(p[r]);
    float ps0 = 0.f, ps1 = 0.f;
#pragma unroll
    for (int r = 0; r < 8; ++r) { ps0 += p[r]; ps1 += p[8 + r]; }
    l_reg += ps0 + ps1;
    { v4u w; w.x = pk2(p[0], p[1]); w.y = pk2(p[2], p[3]); w.z = pk2(p[4], p[5]); w.w = pk2(p[6], p[7]); pa = __builtin_bit_cast(sbf16x8, w); }
    { v4u w; w.x = pk2(p[8], p[9]); w.y = pk2(p[10], p[11]); w.z = pk2(p[12], p[13]); w.w = pk2(p[14], p[15]); pb = __builtin_bit_cast(sbf16x8, w); }
}
template <int ROW0> __device__ __forceinline__ void qk_half(f32x16& x, f32x16& y, const LAS char* Ks, const sbf16x8* qx, const sbf16x8* qy, int r32, int hi) {
    asm volatile("" : "+v"(r32));
    x = f32x16{}; y = f32x16{};
    sbf16x8 c = *(const LAS sbf16x8*)(Ks + ATT_KSWZ(ROW0 + r32, (hi * 8) * 2));
#pragma unroll
    for (int d0 = 0; d0 < 6; ++d0) {
        sbf16x8 n = c;
        if (d0 < 5) n = *(const LAS sbf16x8*)(Ks + ATT_KSWZ(ROW0 + r32, ((d0 + 1) * 16 + hi * 8) * 2));
        x = __builtin_amdgcn_mfma_f32_32x32x16_bf16(c, qx[d0], x, 0, 0, 0);
        y = __builtin_amdgcn_mfma_f32_32x32x16_bf16(c, qy[d0], y, 0, 0, 0);
        c = n;
    }
}
template <int KS0> __device__ __forceinline__ void pv_half(f32x16* ox, f32x16* oy, int vb, sbf16x8 pxa, sbf16x8 pxb, sbf16x8 pya, sbf16x8 pyb) {
    const s16x4 l00 = tr_read<v_rd_off(0, KS0, 0)>(vb), h00 = tr_read<v_rd_off(0, KS0, 1)>(vb), l01 = tr_read<v_rd_off(0, KS0 + 1, 0)>(vb), h01 = tr_read<v_rd_off(0, KS0 + 1, 1)>(vb);
    const s16x4 l10 = tr_read<v_rd_off(1, KS0, 0)>(vb), h10 = tr_read<v_rd_off(1, KS0, 1)>(vb), l11 = tr_read<v_rd_off(1, KS0 + 1, 0)>(vb), h11 = tr_read<v_rd_off(1, KS0 + 1, 1)>(vb);
    asm volatile("s_waitcnt lgkmcnt(0)" ::: "memory"); ATT_SBAR();
#define ATT_PK(L, H) (sbf16x8){L[0], L[1], L[2], L[3], H[0], H[1], H[2], H[3]}
    ox[0] = __builtin_amdgcn_mfma_f32_32x32x16_bf16(ATT_PK(l00, h00), pxa, ox[0], 0, 0, 0);
    oy[0] = __builtin_amdgcn_mfma_f32_32x32x16_bf16(ATT_PK(l00, h00), pya, oy[0], 0, 0, 0);
    ox[1] = __builtin_amdgcn_mfma_f32_32x32x16_bf16(ATT_PK(l10, h10), pxa, ox[1], 0, 0, 0);
    oy[1] = __builtin_amdgcn_mfma_f32_32x32x16_bf16(ATT_PK(l10, h10), pya, oy[1], 0, 0, 0);
    ox[0] = __builtin_amdgcn_mfma_f32_32x32x16_bf16(ATT_PK(l01, h01), pxb, ox[0], 0, 0, 0);
    oy[0] = __builtin_amdgcn_mfma_f32_32x32x16_bf16(ATT_PK(l01, h01), pyb, oy[0], 0, 0, 0);
    ox[1] = __builtin_amdgcn_mfma_f32_32x32x16_bf16(ATT_PK(l11, h11), pxb, ox[1], 0, 0, 0);
    oy[1] = __builtin_amdgcn_mfma_f32_32x32x16_bf16(ATT_PK(l11, h11), pyb, oy[1], 0, 0, 0);
#undef ATT_PK
}
constexpr int OFF2_V = 0, OFF2_K = 2 * SHM_V, OFF2_WS = 2 * SHM_V + 2 * SHM_K;
__device__ __forceinline__ void attn_unit2(const bf16* Qb, const bf16* Kh, const bf16* Vh, bf16* Ob, int seq, LAS char* lds, int tid) {
    const int wid = __builtin_amdgcn_readfirstlane(tid >> 6), lane = tid & 63, r32 = lane & 31, hi = lane >> 5; int lane2;
    LAS char* V_lds = lds + OFF2_V; LAS char* K_lds = lds + OFF2_K;
    LAS float* ws = (LAS float*)(lds + OFF2_WS) + wid * 64;
    float lx = 0.f, ly = 0.f; f32x16 ox[2], oy[2]; ox[0] = f32x16{}; ox[1] = f32x16{}; oy[0] = f32x16{}; oy[1] = f32x16{}; sbf16x8 qx[6], qy[6];
    { const GAS bf16* Qw = (const GAS bf16*)Qb + (size_t)(wid * 64 + r32) * 96 + hi * 8;
#pragma unroll
      for (int d0 = 0; d0 < 6; ++d0) { qx[d0] = *(const GAS sbf16x8*)(Qw + d0 * 16); qy[d0] = *(const GAS sbf16x8*)(Qw + 32 * 96 + d0 * 16); } }
    const int kc1 = 512 + (tid & 255), kr0 = tid / 12, kq0 = (tid % 12) * 8, kr1 = kc1 / 12, kq1 = (kc1 % 12) * 8;
    const int ksto0 = ATT_KSWZ(kr0, kq0 * 2), ksto1 = ATT_KSWZ(kr1, kq1 * 2);
    const int vr = tid >> 3, vq = (tid & 7) * 8, vsto = v_st(vr, vq);
    const int vb0 = (int)(unsigned)(size_t)V_lds + v_rd_base(lane);
    const unsigned ko0 = (unsigned)(kr0 * 96 + kq0) * 2u, ko1 = (unsigned)(kr1 * 96 + kq1) * 2u, vo = (unsigned)(vr * 64 + vq) * 2u;
    const GAS char* Kg = (const GAS char*)Kh; const GAS char* Vg = (const GAS char*)Vh;
    sbf16x8 sk0, sk1, sv;
#define ATT2_SLOAD(k0) do { sk0 = *(const GAS sbf16x8*)(Kg + (ko0 + (unsigned)(k0) * 192u)); sk1 = *(const GAS sbf16x8*)(Kg + (ko1 + (unsigned)(k0) * 192u)); sv = *(const GAS sbf16x8*)(Vg + (vo + (unsigned)(k0) * 128u)); } while (0)
#define ATT2_SWRITE(b) do { *(LAS sbf16x8*)(K_lds + (b) * SHM_K + ksto0) = sk0; *(LAS sbf16x8*)(K_lds + (b) * SHM_K + ksto1) = sk1; *(LAS sbf16x8*)(V_lds + (b) * SHM_V + vsto) = sv; } while (0)
    const int NT = seq / KVBLK;
    ATT2_SLOAD(0); ATT2_SWRITE(0); __syncthreads();
    f32x16 x0, x1, y0, y1; sbf16x8 px[4], py[4];
#pragma unroll 1
    for (int j = 0; j < NT; ++j) {
        const int b = j & 1;
        if (j + 1 < NT) ATT2_SLOAD((j + 1) * KVBLK);
        ATT_SBAR();
        qk_half<0>(x0, y0, K_lds + b * SHM_K, qx, qy, r32, hi);
        ATT_SBAR();
        qk_half<32>(x1, y1, K_lds + b * SHM_K, qx, qy, r32, hi);
        softmax_half(x0, lx, px[0], px[1]); softmax_half(y0, ly, py[0], py[1]);
        ATT_SBAR();
        pv_half<0>(ox, oy, vb0 + b * SHM_V, px[0], px[1], py[0], py[1]);
        softmax_half(x1, lx, px[2], px[3]); softmax_half(y1, ly, py[2], py[3]);
        ATT_SBAR();
        pv_half<2>(ox, oy, vb0 + b * SHM_V, px[2], px[3], py[2], py[3]);
        ATT_SBAR();
        if (j + 1 < NT) ATT2_SWRITE(b ^ 1);
        __syncthreads();
    }
#undef ATT2_SLOAD
#undef ATT2_SWRITE
    { auto rr = __builtin_amdgcn_permlane32_swap(__float_as_uint(lx), __float_as_uint(lx), false, false); lx = __uint_as_float(rr[0]) + __uint_as_float(rr[1]); }
    { auto rr = __builtin_amdgcn_permlane32_swap(__float_as_uint(ly), __float_as_uint(ly), false, false); ly = __uint_as_float(rr[0]) + __uint_as_float(rr[1]); }
    { unsigned z_ = 0u; asm volatile("" : "+v"(z_)); lane2 = (int)__builtin_amdgcn_mbcnt_hi(~0u, __builtin_amdgcn_mbcnt_lo(~0u, z_)); }
    const int r32e = lane2 & 31, hie = lane2 >> 5;
    if (hie == 0) { ws[r32e] = lx; ws[32 + r32e] = ly; }
    asm volatile("s_waitcnt lgkmcnt(0)" ::: "memory");
    LAS bf16* stg = (LAS bf16*)(lds + wid * 8192);
#pragma unroll
    for (int r = 0; r < 16; ++r) { const int orow = crow(r, hie); const float rlx = __builtin_amdgcn_rcpf(ws[orow]), rly = __builtin_amdgcn_rcpf(ws[32 + orow]);
#pragma unroll
        for (int d0 = 0; d0 < 2; ++d0) { stg[orow * 64 + d0 * 32 + r32e] = (bf16)(pk2(ox[d0][r] * rlx, 0.f) & 0xffffu); stg[(32 + orow) * 64 + d0 * 32 + r32e] = (bf16)(pk2(oy[d0][r] * rly, 0.f) & 0xffffu); } }
    asm volatile("s_waitcnt lgkmcnt(0)" ::: "memory");
    GAS bf16* Ow = (GAS bf16*)Ob + (size_t)(wid * 64) * 512;
#pragma unroll
    for (int i = 0; i < 8; ++i) { const int row = i * 8 + (lane2 >> 3), ch = lane2 & 7; const v4u v = *(const LAS v4u*)(stg + row * 64 + ch * 8); *(GAS v4u*)(Ow + (size_t)row * 512 + ch * 8) = v; }
    asm volatile("s_waitcnt lgkmcnt(0)" ::: "memory");
}
constexpr int OFF4_K = 0, OFF4_V = 3 * SHM_K, OFF4_WS = 3 * SHM_K + 3 * SHM_V;
static_assert(OFF4_WS + NW * 64 * 4 <= 131072, "attention LDS");
__device__ __forceinline__ void attn_unit4(const bf16* Qb, const bf16* Kh, const bf16* Vh, bf16* Ob, int seq, LAS char* lds, int tid) {
    const int wid = __builtin_amdgcn_readfirstlane(tid >> 6), lane = tid & 63, r32 = lane & 31, hi = lane >> 5; int lane2;
    LAS char* K_lds = lds + OFF4_K; LAS char* V_lds = lds + OFF4_V;
    LAS float* ws = (LAS float*)(lds + OFF4_WS) + wid * 64;
    float lx = 0.f, ly = 0.f; f32x16 ox[2], oy[2]; ox[0] = f32x16{}; ox[1] = f32x16{}; oy[0] = f32x16{}; oy[1] = f32x16{}; sbf16x8 qx[6], qy[6];
    { const GAS bf16* Qw = (const GAS bf16*)Qb + (size_t)(wid * 64 + r32) * 96 + hi * 8;
#pragma unroll
      for (int d0 = 0; d0 < 6; ++d0) { qx[d0] = *(const GAS sbf16x8*)(Qw + d0 * 16); qy[d0] = *(const GAS sbf16x8*)(Qw + 32 * 96 + d0 * 16); } }
    const int rowA = 4 * wid + (lane >> 4), chA = (lane & 15) ^ (rowA & 15);
    const unsigned kofA = (unsigned)(rowA * 96 + (chA < 12 ? chA * 8 : 0)) * 2u, kofB = kofA + 32u * 192u;
    const int kkv = wid * 8 + ((lane & 31) >> 2), kv = kkv;
    const unsigned vof = (unsigned)(kv * 64 + (lane >> 5) * 32 + (lane & 3) * 8) * 2u;
    const GAS char* Kg = (const GAS char*)Kh; const GAS char* Vg = (const GAS char*)Vh;
    const int vb0 = (int)(unsigned)(size_t)V_lds + v_rd_base(lane);
#define ATT4_DMA(t, slot) do { \
    __builtin_amdgcn_global_load_lds((const GAS unsigned*)(Kg + (kofA + (unsigned)(t) * (64u * 192u))), (LAS unsigned*)(K_lds + (slot) * SHM_K + wid * 1024), 16, 0, 0); \
    __builtin_amdgcn_global_load_lds((const GAS unsigned*)(Kg + (kofB + (unsigned)(t) * (64u * 192u))), (LAS unsigned*)(K_lds + (slot) * SHM_K + (wid + 8) * 1024), 16, 0, 0); \
    __builtin_amdgcn_global_load_lds((const GAS unsigned*)(Vg + (vof + (unsigned)(t) * (64u * 128u))), (LAS unsigned*)(V_lds + (slot) * SHM_V + wid * 2048), 16, 0, 0); } while (0)
    const int NT = seq / KVBLK;
    ATT4_DMA(0, 0);
    asm volatile("s_waitcnt vmcnt(0)" ::: "memory"); __syncthreads();
    f32x16 x0, x1, y0, y1; sbf16x8 px[4], py[4];
    x1 = f32x16{}; y1 = f32x16{};
#pragma unroll
    for (int i = 0; i < 4; ++i) { px[i] = sbf16x8{}; py[i] = sbf16x8{}; }
    int s_prev = 2, s_cur = 0, s_next = 1;
#pragma unroll 1
    for (int j = 0; j < NT; ++j) {
        if (j + 1 < NT) ATT4_DMA(j + 1, s_next);
        ATT_SBAR();
        qk_half<0>(x0, y0, K_lds + s_cur * SHM_K, qx, qy, r32, hi);
        qk_half<32>(x1, y1, K_lds + s_cur * SHM_K, qx, qy, r32, hi);
        softmax_half(x0, lx, px[0], px[1]); softmax_half(y0, ly, py[0], py[1]);
        pv_half<0>(ox, oy, vb0 + s_cur * SHM_V, px[0], px[1], py[0], py[1]);
        softmax_half(x1, lx, px[2], px[3]); softmax_half(y1, ly, py[2], py[3]);
        pv_half<2>(ox, oy, vb0 + s_cur * SHM_V, px[2], px[3], py[2], py[3]);
        asm volatile("s_waitcnt vmcnt(0)" ::: "memory");
        __syncthreads();
        { const int t_ = s_prev; s_prev = s_cur; s_cur = s_next; s_next = t_; }
    }
#undef ATT4_DMA
    { auto rr = __builtin_amdgcn_permlane32_swap(__float_as_uint(lx), __float_as_uint(lx), false, false); lx = __uint_as_float(rr[0]) + __uint_as_float(rr[1]); }
    { auto rr = __builtin_amdgcn_permlane32_swap(__float_as_uint(ly), __float_as_uint(ly), false, false); ly = __uint_as_float(rr[0]) + __uint_as_float(rr[1]); }
    { unsigned z_ = 0u; asm volatile("" : "+v"(z_)); lane2 = (int)__builtin_amdgcn_mbcnt_hi(~0u, __builtin_amdgcn_mbcnt_lo(~0u, z_)); }
    const int r32e = lane2 & 31, hie = lane2 >> 5;
    const float rlx = __builtin_amdgcn_rcpf(lx), rly = __builtin_amdgcn_rcpf(ly);
    LAS bf16* stg = (LAS bf16*)(lds + wid * 8192);
#pragma unroll
    for (int d0 = 0; d0 < 2; ++d0)
#pragma unroll
        for (int g = 0; g < 4; ++g) {
            v2u wx, wy; wx.x = pk2(ox[d0][4 * g] * rlx, ox[d0][4 * g + 1] * rlx); wx.y = pk2(ox[d0][4 * g + 2] * rlx, ox[d0][4 * g + 3] * rlx);
            wy.x = pk2(oy[d0][4 * g] * rly, oy[d0][4 * g + 1] * rly); wy.y = pk2(oy[d0][4 * g + 2] * rly, oy[d0][4 * g + 3] * rly);
            *(LAS v2u*)(stg + r32e * 64 + d0 * 32 + 8 * g + 4 * hie) = wx; *(LAS v2u*)(stg + (32 + r32e) * 64 + d0 * 32 + 8 * g + 4 * hie) = wy; }
    asm volatile("s_waitcnt lgkmcnt(0)" ::: "memory");
    GAS bf16* Ow = (GAS bf16*)Ob + (size_t)(wid * 64) * 512;
#pragma unroll
    for (int i = 0; i < 8; ++i) { const int row = i * 8 + (lane2 >> 3), ch = lane2 & 7; const v4u v = *(const LAS v4u*)(stg + row * 64 + ch * 8); *(GAS v4u*)(Ow + (size_t)row * 512 + ch * 8) = v; }
    asm volatile("s_waitcnt lgkmcnt(0)" ::: "memory");
}
}

__device__ __forceinline__ bool attn_static_ok(Frame& F, int l) {
    const float* gq = ((const float*)(const GAS float*)F.in[13]) + l * DQK; const float* gk = ((const float*)(const GAS float*)F.in[14]) + l * DQK; float mq = 0.f, mk = 0.f;
    for (int d = 0; d < DQK; ++d) { mq = fmaxf(mq, fabsf(gq[d])); mk = fmaxf(mk, fabsf(gk[d])); }
    return 96.f * mq * mk * QSCALE <= 60.f;
}
__device__ __forceinline__ void step_f_fast(Frame& F) {
    fresh_tid(F);
    const bf16* Q = WSP(bf16, WS_Q); const bf16* K = WSP(bf16, WS_K); const bf16* V = WSP(bf16, WS_V); bf16* O = WSP(bf16, WS_O);
    const int vcu = (F.G % 8 == 0) ? (F.bid % 8) * (F.G / 8) + F.bid / 8 : F.bid;
#if ATTN_W64
    for (int u = vcu; u < NB * H * (S / 512); u += F.G) {
        const int qb = u % 16, bh = (u / 16), b = bh / H, h = bh % H;
        fresh_tid(F);
        att::attn_unit4(Q + ((size_t)bh * S + qb * 512) * 96, K + (size_t)bh * S * 96, V + (size_t)bh * S * 64, O + ((size_t)(b * S + qb * 512)) * 512 + h * 64, S, (LAS char*)F.lds, F.tid);
        __syncthreads();
    }
#else
    for (int u = vcu; u < NB * H * (S / 256); u += F.G) {
        const int qb = u % 32, bh = (u / 32), b = bh / H, h = bh % H;
        fresh_tid(F);
        att::attn_unit(Q + ((size_t)bh * S + qb * 256) * 96, K + (size_t)bh * S * 96, V + (size_t)bh * S * 64, O + ((size_t)(b * S + qb * 256)) * 512 + h * 64, S, (LAS char*)F.lds, F.tid);
        __syncthreads();
    }
#endif
}
constexpr size_t WT_IN = WS_WT, WT_UQ = WS_WT + 8 * MiB, WT_UKV = WT_UQ + 384 * KiB, WT_CO = WS_WT + 9 * MiB, WT_AO = WS_WT + 10 * MiB, WT_O = WS_WT + 11 * MiB,
                 WT_GU = WS_WT + 13 * MiB, WT_DN = WS_WT + 30 * MiB;
constexpr int NPROJ = 4096;
static_assert(WT_DN + (size_t)NEX * 1024 * 256 * 2 <= WS_WT + 40 * MiB, "weight region");
__device__ __forceinline__ void cvt_item(const float* W, int K, int N, bf16* WT, int drow0, const float* ksc, LAS float* scr, int k0, int n0, int lane) {
    float wv[32];
#pragma unroll
    for (int i = 0; i < 32; ++i) wv[i] = W[(size_t)(k0 + 2 * i + (lane >> 5)) * N + n0 + (lane & 31)];
#pragma unroll
    for (int i = 0; i < 32; ++i) { const int kk = 2 * i + (lane >> 5); float v = wv[i]; if (ksc) v *= ksc[k0 + kk]; scr[kk * 33 + (lane & 31)] = v; }
    asm volatile("s_waitcnt lgkmcnt(0)" ::: "memory");
    const int c = lane & 7;
#pragma unroll
    for (int j = 0; j < 4; ++j) { const int n = (lane >> 3) + 8 * j; const LAS float* s = scr + (8 * c) * 33 + n;
        v4u o; o.x = pk2(s[0 * 33], s[1 * 33]); o.y = pk2(s[2 * 33], s[3 * 33]); o.z = pk2(s[4 * 33], s[5 * 33]); o.w = pk2(s[6 * 33], s[7 * 33]);
        *(v4u*)(WT + (size_t)(drow0 + n) * K + k0 + 8 * c) = o; }
    asm volatile("s_waitcnt lgkmcnt(0)" ::: "memory");
}
__device__ __forceinline__ int proj_dest(int n0) {
    if (n0 < 512) return n0;
    if (n0 < 1024) return 512 + ((n0 - 512) >> 7) * 256 + ((n0 - 512) & 127);
    if (n0 < 1536) return 512 + ((n0 - 1024) >> 7) * 256 + 128 + ((n0 - 1024) & 127);
    if (n0 < 1952) return n0;
    return n0 + 96;
}
__device__ __forceinline__ int ukv_dest(int n0) { const int h = n0 >> 7, j0 = n0 & 127, kind = j0 >> 6, d0 = j0 & 63; return (kind * 2 + (h >> 2)) * 256 + (d0 >> 5) * 128 + (h & 3) * 32; }
__device__ __forceinline__ void convert_weights(Frame& F, int l) {
    fresh_tid(F);
    LAS float* scr = (LAS float*)(F.lds + F.wave * 16384);
    const int gw = F.bid * NWAVES + F.wave, NGW = F.G * NWAVES;
    constexpr int I_IN = 16 * 125, I_UQ = 4 * 24, I_UKV = 2 * 32, I_CO = 8 * 32, I_O = 16 * 32, I_GU = NEX * 16 * 8, I_DN = NEX * 4 * 32;
    constexpr int NITEMS = I_IN + I_UQ + I_UKV + 2 * I_CO + I_O + 2 * I_GU + I_DN;
    for (int it = gw; it < NITEMS; it += NGW) {
        int r = it;
        if (r < I_IN) { const int kb = r / 125, nb = r % 125, n0 = 32 * nb; cvt_item(((const float*)(const GAS float*)F.in[7]) + (size_t)l * D * NIN, D, NIN, WSP(bf16, WT_IN), proj_dest(n0), nullptr, scr, 64 * kb, n0, F.lane); continue; } r -= I_IN;
        if (r < I_UQ) { const int kb = r / 24, nb = r % 24; cvt_item(((const float*)(const GAS float*)F.in[10]) + (size_t)l * QL * 768, QL, 768, WSP(bf16, WT_UQ), 32 * nb, ((const float*)(const GAS float*)F.in[9]) + l * QL, scr, 64 * kb, 32 * nb, F.lane); continue; } r -= I_UQ;
        if (r < I_UKV) { const int kb = r / 32, nb = r % 32; cvt_item(((const float*)(const GAS float*)F.in[12]) + (size_t)l * KVL * 1024, KVL, 1024, WSP(bf16, WT_UKV), ukv_dest(32 * nb), ((const float*)(const GAS float*)F.in[11]) + l * KVL, scr, 64 * kb, 32 * nb, F.lane); continue; } r -= I_UKV;
        if (r < I_CO) { const int kb = r / 32, nb = r % 32; cvt_item(((const float*)(const GAS float*)F.in[15]) + (size_t)l * CW * D, CW, D, WSP(bf16, WT_CO), 32 * nb, nullptr, scr, 64 * kb, 32 * nb, F.lane); continue; } r -= I_CO;
        if (r < I_CO) { const int kb = r / 32, nb = r % 32; cvt_item(((const float*)(const GAS float*)F.in[16]) + (size_t)l * 512 * D, 512, D, WSP(bf16, WT_AO), 32 * nb, nullptr, scr, 64 * kb, 32 * nb, F.lane); continue; } r -= I_CO;
        if (r < I_O) { const int kb = r / 32, nb = r % 32; cvt_item(((const float*)(const GAS float*)F.in[17]) + (size_t)l * D * D, D, D, WSP(bf16, WT_O), 32 * nb, nullptr, scr, 64 * kb, 32 * nb, F.lane); continue; } r -= I_O;
        if (r < 2 * I_GU) { const int up = r >= I_GU ? 1 : 0; r -= up * I_GU; const int e = r / 128, q = r % 128, kb = q / 8, nb = q % 8, n0 = 32 * nb;
            const float* W = e < NE ? ((const float*)(const GAS float*)F.in[20 + up]) + ((size_t)l * NE + e) * D * DE : ((const float*)(const GAS float*)F.in[23 + up]) + (size_t)l * D * DE;
            cvt_item(W, D, DE, WSP(bf16, WT_GU) + (size_t)e * 512 * D, (n0 >> 7) * 256 + up * 128 + (n0 & 127), nullptr, scr, 64 * kb, n0, F.lane); continue; } r -= 2 * I_GU;
        { const int e = r / 128, q = r % 128, kb = q / 32, nb = q % 32;
            const float* W = e < NE ? ((const float*)(const GAS float*)F.in[22]) + ((size_t)l * NE + e) * DE * D : ((const float*)(const GAS float*)F.in[25]) + (size_t)l * DE * D;
            cvt_item(W, DE, D, WSP(bf16, WT_DN) + (size_t)e * D * DE, 32 * nb, nullptr, scr, 64 * kb, 32 * nb, F.lane); }
    }
    v4u* z = (v4u*)(WSP(bf16, WT_IN) + (size_t)1952 * D);
    unsigned z0 = 0u; asm volatile("" : "+v"(z0));
    for (int i = F.bid * NTHREADS + F.tid; i < 96 * D * 2 / 16; i += F.G * NTHREADS) z[i] = (v4u){z0, z0, z0, z0};
}

namespace pg8 {
typedef short sbf16x8 __attribute__((ext_vector_type(8)));
constexpr int BM = 256, BK = 64, HALF = 128, HTB = HALF * BK * 2, STAGE_BYTES = 8 * HTB, NXCD = 8, WGM = 8;
__device__ __forceinline__ int lds_byte(int r, int c) { const int st = (r >> 4) * 2 + (c >> 5), rr = r & 15, cc = c & 31, ob = rr * 64 + cc * 2; return st * 1024 + (ob ^ (((ob >> 9) & 1) << 5)); }
__device__ __forceinline__ void stage_rc(int b, int& R, int& C) { const int st = b / 1024, sb = b % 1024, swz = sb ^ (((sb >> 9) & 1) << 5); R = (st >> 1) * 16 + swz / 64; C = (st & 1) * 32 + (swz % 64) / 2; }
__device__ __forceinline__ int perm32(int rho) { const int n = rho >> 4, i = rho & 15; return 8 * (i >> 2) + 4 * n + (i & 3); }
__device__ __forceinline__ int xcd_remap(int L, int nwg) { const int q = nwg / NXCD, r = nwg % NXCD, xcd = L % NXCD, off = L / NXCD; return (xcd < r ? xcd * (q + 1) : r * (q + 1) + (xcd - r) * q) + off; }

struct Unit { int pm, pn; const char* a; const char* b; const int* list; int rows, tok0, e; };
struct Gemm { unsigned lda; int K; };

struct StaticOrder {
    const char* A; const char* Bt; unsigned lda; int K, nM, nN, nwg, G, c;
    static constexpr bool WAITS = false;
    __device__ __forceinline__ bool next(int i, Unit& u, int) const {
        const long L = (long)i * G + c; if (L >= nwg) return false;
        const int wgid = xcd_remap((int)L, nwg);
        const int nig = WGM * nN, gid = wgid / nig, fm = gid * WGM, gsz = (nM - fm) < WGM ? (nM - fm) : WGM;
        u.pm = fm + ((wgid % nig) % gsz); u.pn = (wgid % nig) / gsz;
        u.a = A + (size_t)u.pm * BM * lda; u.b = Bt + (size_t)u.pn * BM * K * 2; u.list = nullptr; u.rows = BM; u.tok0 = u.pm * BM; u.e = 0; return true;
    }
};
struct MoeOrder {
    const char* A; const char* Bt; size_t estride; unsigned lda; int K, nN, MT, G, c; const LAS unsigned* tb; const LAS unsigned* cnt; const int* LIST; bool gather;
    static constexpr bool WAITS = false;
    __device__ __forceinline__ bool next(int i, Unit& u, int) const {
        const int nwg = MT * nN; const long L = (long)i * G + c; if (L >= nwg) return false;
        const int wgid = xcd_remap((int)L, nwg);
        const int mt = wgid / nN, pn = wgid % nN; int e = 0;
#pragma unroll 1
        for (int j = 1; j <= NE; ++j) if ((unsigned)mt >= (unsigned)__builtin_amdgcn_readfirstlane(tb[j])) e = j;
        const int lt = mt - (int)__builtin_amdgcn_readfirstlane(tb[e]);
        u.pm = mt; u.pn = pn; u.e = e; u.tok0 = lt * BM;
        if (e < NE) { const int left = (int)__builtin_amdgcn_readfirstlane(cnt[e]) - lt * BM; u.rows = left < BM ? left : BM; u.list = LIST + (size_t)e * T + lt * BM; } else { u.rows = BM; u.list = nullptr; }
        u.a = gather ? A : A + (size_t)mt * BM * lda; u.b = Bt + (size_t)e * estride + (size_t)pn * BM * K * 2; return true;
    }
};

#ifndef KL_R
#define KL_R 3
#endif
struct MoeOrderX {
    static constexpr bool WAITS = true;
    const char* A; const char* Bt; size_t estride; unsigned lda; int K, nN, MT, G, c; const LAS unsigned* tb; const LAS unsigned* cnt; const LAS unsigned* te; const int* LIST; bool gather;
    int mode, kN; unsigned* flags; unsigned* bar;
    __device__ __forceinline__ bool next(int i, Unit& u, int wid) const {
        const int NX = (G % NXCD == 0) ? NXCD : 1, x = c % NX, cl = c / NX, GX = G / NX;
        const int qm = MT / NX, rm = MT % NX, sz = qm + (x < rm ? 1 : 0), m0 = x * qm + (x < rm ? x : rm);
        if (sz == 0) return false;
        int off;
        if (mode == 0) off = cl + i * GX;
        else {
            const int ku = kN * sz, kmax = (ku + GX - 1) / GX, hx = ku - (kmax - 1) * GX, nl = GX - hx;
            if (cl >= hx && i < KL_R) off = (cl - hx) + i * nl;
            else { const int p = cl + (cl >= hx ? i - KL_R : i) * GX; off = KL_R * nl + (p < GX ? (p >= hx ? p - hx : nl + p) : p); }
        }
        const int sl = off / nN, pn = off % nN; if (sl >= sz) return false;
        const int mt = m0 + sl; const unsigned pe = (unsigned)__builtin_amdgcn_readfirstlane(te[mt]); const int e = (int)(pe & 255u), lt = (int)(pe >> 8);
        u.pm = mt; u.pn = pn; u.e = e; u.tok0 = lt * BM;
        if (e < NE) { const int left = (int)__builtin_amdgcn_readfirstlane(cnt[e]) - lt * BM; u.rows = left < BM ? left : BM; u.list = LIST + (size_t)e * T + lt * BM; } else { u.rows = BM; u.list = nullptr; }
        u.a = gather ? A : A + (size_t)mt * BM * lda; u.b = Bt + (size_t)e * estride + (size_t)pn * BM * K * 2;
        if (mode == 1 && wid == 0) {
            XB_SPIN(xb_ld(flags + mt) < (unsigned)kN, bar);
            __builtin_amdgcn_fence(__ATOMIC_ACQUIRE, "agent");
        }
        return true;
    }
};

__device__ __forceinline__ v4u pack8(f32x4 v0, f32x4 v1) { v4u w; w.x = pk2(v0[0], v0[1]); w.y = pk2(v0[2], v0[3]); w.z = pk2(v1[0], v1[1]); w.w = pk2(v1[2], v1[3]); return w; }
struct EpiBf16 {
    static constexpr bool PERM = true; static constexpr bool SIGNAL = false;
    bf16* O; int ldc; int split; bf16* gbp;
    __device__ __forceinline__ void operator()(const f32x4 (&acc)[2][2][4][2], const Unit& u, int wr, int wc, int fr, int fq) const {
        bf16* base = O; int ld = ldc, c0 = u.pn * BM;
        if (split) { const int pn = u.pn; unsigned char* w = (unsigned char*)O;
            if (pn >= 2 && pn < 6) {
                bf16* pb = (bf16*)(w + WS_CONV) + 512 + (pn - 2) * 128 + wc * 32 + 8 * fq; const int row0 = u.pm * BM + wr * 64 + fr;
#pragma unroll
                for (int ai = 0; ai < 2; ++ai)
#pragma unroll
                    for (int m = 0; m < 4; ++m) { *(v4u*)(pb + (size_t)(row0 + ai * HALF + m * 16) * 1024) = pack8(acc[ai][0][m][0] * acc[ai][1][m][0], acc[ai][0][m][1] * acc[ai][1][m][1]);
                        asm volatile("" ::: "memory"); }
                return; }
            if (pn < 2) { base = (bf16*)(w + WS_CONV); ld = 1024; c0 = pn * 256; }
            else if (pn < 8) { base = (bf16*)(w + WS_SMALL); ld = 512; c0 = (pn - 6) * 256; }
            else if (pn < 12) { base = (bf16*)(w + WS_GA); ld = 1024; c0 = (pn - 8) * 256; }
            else { base = gbp; ld = 1024; c0 = (pn - 12) * 256; } }
        const int row0 = u.pm * BM + wr * 64 + fr, col0 = c0 + wc * 32 + 8 * fq;
#pragma unroll
        for (int ai = 0; ai < 2; ++ai)
#pragma unroll
            for (int m = 0; m < 4; ++m) { bf16* rowp = base + (size_t)(row0 + ai * HALF + m * 16) * ld + col0;
#pragma unroll
                for (int bj = 0; bj < 2; ++bj) *(v4u*)(rowp + bj * HALF) = pack8(acc[ai][bj][m][0], acc[ai][bj][m][1]);
                asm volatile("" ::: "memory"); }
    }
};
__device__ __forceinline__ unsigned pk4_fp8(f32x4 v) {
#pragma unroll
    for (int e = 0; e < 4; ++e) v[e] = __builtin_fminf(__builtin_fmaxf(v[e], -448.f), 448.f);
    int w = __builtin_amdgcn_cvt_pk_fp8_f32(v[0], v[1], 0, false); w = __builtin_amdgcn_cvt_pk_fp8_f32(v[2], v[3], w, true); return (unsigned)w;
}
struct EpiY8 {
    static constexpr bool PERM = true; static constexpr bool SIGNAL = false;
    unsigned char* Y8;
    __device__ __forceinline__ void operator()(const f32x4 (&acc)[2][2][4][2], const Unit& u, int wr, int wc, int fr, int fq) const {
        const int row0 = u.pm * BM + wr * 64 + fr, col0 = u.pn * BM + wc * 32 + 8 * fq;
#pragma unroll
        for (int ai = 0; ai < 2; ++ai)
#pragma unroll
            for (int m = 0; m < 4; ++m) { unsigned char* rowp = Y8 + (size_t)(row0 + ai * HALF + m * 16) * D + col0;
#pragma unroll
                for (int bj = 0; bj < 2; ++bj) { v2u w; w.x = pk4_fp8(acc[ai][bj][m][0]); w.y = pk4_fp8(acc[ai][bj][m][1]); *(v2u*)(rowp + bj * HALF) = w; }
                asm volatile("" ::: "memory"); }
    }
};
struct EpiKV {
    static constexpr bool PERM = true; static constexpr bool SIGNAL = false;
    bf16* Kb; bf16* Vb; const bf16* small; const f32x2* rope; const float* gk;
    __device__ __forceinline__ void operator()(const f32x4 (&acc)[2][2][4][2], const Unit& u, int wr, int wc, int fr, int fq) const {
        const int lane = fq * 16 + fr; const bool isK = u.pn < 2; const int h = (u.pn & 1) * 4 + wc, i0 = 8 * (fq & 1);
#pragma unroll
        for (int ai = 0; ai < 2; ++ai)
#pragma unroll
            for (int m = 0; m < 4; ++m) {
                const int t = u.pm * BM + ai * HALF + wr * 64 + m * 16 + fr, b = t / S, sq = t % S;
                const bf16* sm = small + (size_t)t * 512;
                const size_t orow = (size_t)(b * H + h) * S + sq;
                float ss = 0.f;
#pragma unroll
                for (int c = 0; c < 4; ++c) { const bf16x8 x = *(const bf16x8*)(sm + 256 + 32 * fq + 8 * c);
#pragma unroll
                    for (int e = 0; e < 8; ++e) { const float f = bf2f(x[e]); ss += f * f; } }
                ss += bperm_xor(ss, lane, 16); ss += bperm_xor(ss, lane, 32);
                const float rs = 1.0f / sqrtf(ss * (1.f / 128.f) + EPS);
                if (isK) {
                    f32x4 gn[2][2], gr1[2], gr2[2];
#pragma unroll
                    for (int bj = 0; bj < 2; ++bj)
#pragma unroll
                        for (int n = 0; n < 2; ++n) gn[bj][n] = *(const f32x4*)(gk + 32 * bj + 8 * fq + 4 * n);
#pragma unroll
                    for (int n = 0; n < 2; ++n) { gr1[n] = *(const f32x4*)(gk + 64 + i0 + 4 * n); gr2[n] = *(const f32x4*)(gk + 80 + i0 + 4 * n); }
                    const bf16x8 x1v = *(const bf16x8*)(sm + 384 + i0), x2v = *(const bf16x8*)(sm + 384 + 16 + i0);
                    const f32x4* rp = (const f32x4*)(rope + (size_t)t * 16 + i0);
                    const f32x4 rp0 = rp[0], rp1 = rp[1], rp2 = rp[2], rp3 = rp[3];
                    float sk = 0.f, sn = 0.f;
#pragma unroll
                    for (int e = 0; e < 8; ++e) { const float f = bf2f(fq < 2 ? x1v[e] : x2v[e]); sk += f * f; }
                    f32x4 v[2][2];
#pragma unroll
                    for (int bj = 0; bj < 2; ++bj)
#pragma unroll
                        for (int n = 0; n < 2; ++n) { v[bj][n] = acc[ai][bj][m][n] * rs;
#pragma unroll
                            for (int e = 0; e < 4; ++e) sn += v[bj][n][e] * v[bj][n][e]; }
                    sk += bperm_xor(sk, lane, 16); sk += bperm_xor(sk, lane, 32);
                    sn += bperm_xor(sn, lane, 16); sn += bperm_xor(sn, lane, 32);
                    const float r = 1.0f / sqrtf((sn + sk) * (1.f / 96.f) + EPS);
#pragma unroll
                    for (int bj = 0; bj < 2; ++bj) *(v4u*)(Kb + orow * 96 + 32 * bj + 8 * fq) = pack8(v[bj][0] * r * gn[bj][0], v[bj][1] * r * gn[bj][1]);
                    f32x4 o0, o1;
#pragma unroll
                    for (int e = 0; e < 8; ++e) {
                        const float a = bf2f(x1v[e]) * r * (e < 4 ? gr1[0][e & 3] : gr1[1][e & 3]), bb = bf2f(x2v[e]) * r * (e < 4 ? gr2[0][e & 3] : gr2[1][e & 3]);
                        const f32x4 cq = e < 2 ? rp0 : e < 4 ? rp1 : e < 6 ? rp2 : rp3; const float cs = (e & 1) ? cq.z : cq.x, sn_ = (e & 1) ? cq.w : cq.y;
                        const float o = fq < 2 ? a * cs - bb * sn_ : bb * cs + a * sn_;
                        if (e < 4) o0[e & 3] = o; else o1[e & 3] = o; }
                    *(v4u*)(Kb + orow * 96 + 64 + 8 * fq) = pack8(o0, o1);
                } else {
#pragma unroll
                    for (int bj = 0; bj < 2; ++bj) *(v4u*)(Vb + orow * 64 + 32 * bj + 8 * fq) = pack8(acc[ai][bj][m][0] * rs, acc[ai][bj][m][1] * rs);
                }
                asm volatile("" ::: "memory");
            }
    }
};
template <int MODE> struct EpiGate {
    static constexpr bool PERM = true; static constexpr bool SIGNAL = false;
    bf16* ga; const bf16* gb;
    __device__ __forceinline__ void operator()(const f32x4 (&acc)[2][2][4][2], const Unit& u, int wr, int wc, int fr, int fq) const {
        const int row0 = u.pm * BM + wr * 64 + fr, col0 = u.pn * BM + wc * 32 + 8 * fq;
#pragma unroll
        for (int ai = 0; ai < 2; ++ai) {
            bf16x8 g[4][2], t[4][2];
#pragma unroll
            for (int m = 0; m < 4; ++m) { const size_t off = (size_t)(row0 + ai * HALF + m * 16) * D + col0;
#pragma unroll
                for (int bj = 0; bj < 2; ++bj) { g[m][bj] = *(const bf16x8*)((MODE == 1 ? ga : gb) + off + bj * HALF);
                    t[m][bj] = (bf16x8){0, 0, 0, 0, 0, 0, 0, 0}; if (MODE == 2) t[m][bj] = *(const bf16x8*)(ga + off + bj * HALF); } }
#pragma unroll
            for (int m = 0; m < 4; ++m) { const size_t off = (size_t)(row0 + ai * HALF + m * 16) * D + col0;
#pragma unroll
                for (int bj = 0; bj < 2; ++bj) {
                    f32x4 v0 = acc[ai][bj][m][0], v1 = acc[ai][bj][m][1];
#pragma unroll
                    for (int e = 0; e < 4; ++e) { v0[e] = sigmoidf_(bf2f(g[m][bj][e])) * v0[e]; v1[e] = sigmoidf_(bf2f(g[m][bj][4 + e])) * v1[e];
                        if (MODE == 2) { v0[e] += bf2f(t[m][bj][e]); v1[e] += bf2f(t[m][bj][4 + e]); } }
                    *(v4u*)(ga + off + bj * HALF) = pack8(v0, v1); } }
            asm volatile("" ::: "memory");
        }
    }
};
struct EpiRes {
    static constexpr bool PERM = false; static constexpr bool SIGNAL = false;
    const float* xin; float* out; const float* gt;
    __device__ __forceinline__ void operator()(const f32x4 (&acc)[2][2][4][2], const Unit& u, int wr, int wc, int fr, int fq) const {
        const int col0 = u.pn * BM + wc * 32 + 4 * fq;
        const float* g = gt + ((u.pm * BM) / S) * 6 * D;
        f32x4 gv[2][2];
#pragma unroll
        for (int bj = 0; bj < 2; ++bj)
#pragma unroll
            for (int n = 0; n < 2; ++n) gv[bj][n] = *(const f32x4*)(g + col0 + bj * HALF + n * 16);
#pragma unroll
        for (int ai = 0; ai < 2; ++ai)
#pragma unroll
            for (int mp = 0; mp < 2; ++mp) {
                f32x4 xv[2][2][2];
#pragma unroll
                for (int mm = 0; mm < 2; ++mm) { const size_t off = (size_t)(u.pm * BM + ai * HALF + wr * 64 + (2 * mp + mm) * 16 + fr) * D + col0;
#pragma unroll
                    for (int bj = 0; bj < 2; ++bj)
#pragma unroll
                        for (int n = 0; n < 2; ++n) xv[mm][bj][n] = *(const f32x4*)(xin + off + bj * HALF + n * 16); }
#pragma unroll
                for (int mm = 0; mm < 2; ++mm) { const int m = 2 * mp + mm; const size_t off = (size_t)(u.pm * BM + ai * HALF + wr * 64 + m * 16 + fr) * D + col0;
#pragma unroll
                    for (int bj = 0; bj < 2; ++bj)
#pragma unroll
                        for (int n = 0; n < 2; ++n) *(f32x4*)(out + off + bj * HALF + n * 16) = xv[mm][bj][n] + gv[bj][n] * acc[ai][bj][m][n]; }
                asm volatile("" ::: "memory");
            }
    }
};
struct EpiRes16 {
    static constexpr bool PERM = true; static constexpr bool SIGNAL = false;
    const float* xin32; bf16* x16; const float* gt;
    __device__ __forceinline__ void operator()(const f32x4 (&acc)[2][2][4][2], const Unit& u, int wr, int wc, int fr, int fq) const {
        const int row0 = u.pm * BM + wr * 64 + fr, col0 = u.pn * BM + wc * 32 + 8 * fq;
        const float* g = gt + ((u.pm * BM) / S) * 6 * D;
        f32x4 gv[2][2];
#pragma unroll
        for (int bj = 0; bj < 2; ++bj)
#pragma unroll
            for (int n = 0; n < 2; ++n) gv[bj][n] = *(const f32x4*)(g + col0 + bj * HALF + n * 4);
#pragma unroll
        for (int ai = 0; ai < 2; ++ai)
#pragma unroll
            for (int mp = 0; mp < 2; ++mp) {
                f32x4 xv[2][2][2];
#pragma unroll
                for (int mm = 0; mm < 2; ++mm) { const size_t off = (size_t)(row0 + ai * HALF + (2 * mp + mm) * 16) * D + col0;
#pragma unroll
                    for (int bj = 0; bj < 2; ++bj) {
                        if (xin32) { xv[mm][bj][0] = *(const f32x4*)(xin32 + off + bj * HALF); xv[mm][bj][1] = *(const f32x4*)(xin32 + off + bj * HALF + 4); }
                        else { const bf16x8 t = *(const bf16x8*)(x16 + off + bj * HALF);
#pragma unroll
                            for (int e = 0; e < 4; ++e) { xv[mm][bj][0][e] = bf2f(t[e]); xv[mm][bj][1][e] = bf2f(t[4 + e]); } } } }
#pragma unroll
                for (int mm = 0; mm < 2; ++mm) { const int m = 2 * mp + mm; const size_t off = (size_t)(row0 + ai * HALF + m * 16) * D + col0;
#pragma unroll
                    for (int bj = 0; bj < 2; ++bj) *(v4u*)(x16 + off + bj * HALF) = pack8(xv[mm][bj][0] + gv[bj][0] * acc[ai][bj][m][0], xv[mm][bj][1] + gv[bj][1] * acc[ai][bj][m][1]); }
                asm volatile("" ::: "memory");
            }
    }
};
struct EpiAct {
    static constexpr bool PERM = true; static constexpr bool SIGNAL = true;
    bf16* a2; const float* tokw; unsigned* flags;
    __device__ __forceinline__ void operator()(const f32x4 (&acc)[2][2][4][2], const Unit& u, int wr, int wc, int fr, int fq) const {
        const int col0 = u.pn * HALF + wc * 32 + 8 * fq;
#pragma unroll
        for (int ai = 0; ai < 2; ++ai)
#pragma unroll
            for (int m = 0; m < 4; ++m) { const int rl = ai * HALF + wr * 64 + m * 16 + fr;
                float w = 1.f; if (u.list) w = rl < u.rows ? tokw[u.list[rl]] : 0.f;
                f32x4 v0, v1;
#pragma unroll
                for (int e = 0; e < 4; ++e) { const float g0 = acc[ai][0][m][0][e], g1 = acc[ai][0][m][1][e];
                    v0[e] = g0 / (1.f + __expf(-g0)) * acc[ai][1][m][0][e] * w; v1[e] = g1 / (1.f + __expf(-g1)) * acc[ai][1][m][1][e] * w; }
                const GAS bf16* dst = (const GAS bf16*)(a2 + (size_t)(u.pm * BM + rl) * DE + col0); const v4u pv = pack8(v0, v1);
                asm volatile("global_store_dwordx4 %0, %1, off sc1" :: "v"(dst), "v"(pv) : "memory"); }
    }
    __device__ __forceinline__ void signal(const Unit& u, bool leader) const { if (leader) (void)xb_add(flags + u.pm, 1u); }
};

template <class Epi, class Sched, bool GATHER>
__device__ __forceinline__ void gemm_phase(LAS unsigned char* lds, const int tid, const Gemm g, const Sched& S, const Epi& E) {
    const int wid = __builtin_amdgcn_readfirstlane(tid >> 6), lane = tid & 63, wr = wid >> 2, wc = wid & 3, fr = lane & 15, fq = lane >> 4;
    const int K = g.K, nt = K / BK; const unsigned lda = g.lda;
    unsigned voffA[2], voffB[2]; int RA[2], CA2[2];
#pragma unroll
    for (int i = 0; i < 2; ++i) { int R, C; stage_rc(tid * 16 + i * 8192, R, C); const int Rb = Epi::PERM ? ((R & ~31) + perm32(R & 31)) : R;
        voffA[i] = (unsigned)R * lda + (unsigned)C * 2u; voffB[i] = (unsigned)(Rb * K + C) * 2u; RA[i] = R; CA2[i] = C * 2; }
    const size_t kstep = (size_t)(BK * 2);
    const size_t hstepA = (size_t)HALF * lda, hstepB = (size_t)HALF * K * 2;
    const unsigned ldsw = (unsigned)wid * 1024u;
    const int aoff = lds_byte(wr * 64 + fr, fq * 8), boff = lds_byte(wc * 32 + fr, fq * 8);
    unsigned offC[2][2], offN[2][2];
#define PG8_GOFF(dst, U) do { _Pragma("unroll") for (int h_ = 0; h_ < 2; ++h_) _Pragma("unroll") for (int i_ = 0; i_ < 2; ++i_) { const int rl_ = h_ * HALF + RA[i_]; \
        int tok_; if ((U).list) tok_ = rl_ < (U).rows ? ((U).list[rl_] >> 1) : 0; else tok_ = (U).tok0 + rl_; dst[h_][i_] = (unsigned)tok_ * lda + (unsigned)CA2[i_]; } } while (0)
#define PG8_SA(b, h) (((b) * 2 + (h)) * HTB)
#define PG8_SB(b, h) ((4 + (b) * 2 + (h)) * HTB)
#define PG8_GLDS(gp, bufoff, i_) __builtin_amdgcn_global_load_lds((const unsigned*)(gp), (LAS unsigned*)(lds + (bufoff) + ldsw + (i_) * 8192), 16, 0, 0)
#define PG8_STAGE_B(bufoff, gbase) do { _Pragma("unroll") for (int _i = 0; _i < 2; ++_i) PG8_GLDS((const char*)(gbase) + voffB[_i], bufoff, _i); } while (0)
#define PG8_STAGE_A(bufoff, ub, NX, h, koff) do { if constexpr (GATHER) { _Pragma("unroll") for (int _i = 0; _i < 2; ++_i) { const unsigned o_ = (NX) ? offN[h][_i] : offC[h][_i]; PG8_GLDS((ub) + (koff) + o_, bufoff, _i); } } \
        else { _Pragma("unroll") for (int _i = 0; _i < 2; ++_i) PG8_GLDS((ub) + (size_t)(h) * hstepA + (koff) + voffA[_i], bufoff, _i); } } while (0)
#define PG8_LDA(dst, b, h) do { _Pragma("unroll") for (int m = 0; m < 4; ++m) _Pragma("unroll") for (int k = 0; k < 2; ++k) dst[m][k] = *(const LAS sbf16x8*)(lds + PG8_SA(b, h) + aoff + m * 2048 + k * 1024); } while (0)
#define PG8_LDB(dst, b, h) do { _Pragma("unroll") for (int n = 0; n < 2; ++n) _Pragma("unroll") for (int k = 0; k < 2; ++k) dst[n][k] = *(const LAS sbf16x8*)(lds + PG8_SB(b, h) + boff + n * 2048 + k * 1024); } while (0)
#define PG8_MMA(ai, bj, At, Bt) do { __builtin_amdgcn_s_setprio(1); _Pragma("unroll") for (int m = 0; m < 4; ++m) _Pragma("unroll") for (int n = 0; n < 2; ++n) _Pragma("unroll") for (int k = 0; k < 2; ++k) \
        acc[ai][bj][m][n] = __builtin_amdgcn_mfma_f32_16x16x32_bf16(Bt[n][k], At[m][k], acc[ai][bj][m][n], 0, 0, 0); __builtin_amdgcn_s_setprio(0); } while (0)
#define PG8_WAIT_V(n) asm volatile("s_waitcnt vmcnt(" #n ")" ::: "memory")
#define PG8_WAIT_L(n) asm volatile("s_waitcnt lgkmcnt(" #n ")" ::: "memory")
#define PG8_BAR __builtin_amdgcn_s_barrier()
#define PG8_SCHED __builtin_amdgcn_sched_barrier(0)
    Unit cur, nxt; int ui = 0;
    if (!S.next(0, cur, wid)) return;
    if constexpr (Sched::WAITS) PG8_BAR;
    f32x4 acc[2][2][4][2];
#define PG8_ZERO_ACC() do { float z_ = 0.f; asm volatile("" : "+v"(z_)); _Pragma("unroll") for (int a = 0; a < 2; ++a) _Pragma("unroll") for (int b = 0; b < 2; ++b) _Pragma("unroll") for (int m = 0; m < 4; ++m) \
        _Pragma("unroll") for (int n = 0; n < 2; ++n) acc[a][b][m][n] = (f32x4){z_, z_, z_, z_}; } while (0)
    PG8_ZERO_ACC();
    sbf16x8 At[4][2], B0[2][2], B1[2][2];
    const char* cA = cur.a; const char* cB = cur.b;
    if constexpr (GATHER) { PG8_GOFF(offC, cur); PG8_WAIT_V(0); }
    PG8_STAGE_B(PG8_SB(0, 0), cB); PG8_STAGE_B(PG8_SB(0, 1), cB + hstepB); PG8_STAGE_A(PG8_SA(0, 0), cA, false, 0, 0); PG8_STAGE_A(PG8_SA(0, 1), cA, false, 1, 0);
    if (wr == 1) PG8_BAR;
    PG8_WAIT_V(2); PG8_BAR;
    PG8_STAGE_B(PG8_SB(1, 0), cB + kstep); PG8_STAGE_A(PG8_SA(1, 0), cA, false, 0, kstep); PG8_STAGE_B(PG8_SB(1, 1), cB + hstepB + kstep);
    PG8_WAIT_V(6); PG8_BAR;
    for (;;) {
        const bool has_next = S.next(ui + 1, nxt, wid);
        if constexpr (GATHER) { if (has_next) { PG8_GOFF(offN, nxt); PG8_WAIT_V(0); } else {
#pragma unroll
            for (int h_ = 0; h_ < 2; ++h_)
#pragma unroll
                for (int i_ = 0; i_ < 2; ++i_) offN[h_][i_] = offC[h_][i_]; } }
        const char* nA = has_next ? nxt.a : cA; const char* nB = has_next ? nxt.b : cB;
#pragma unroll 1
        for (int t = 0; t < nt; t += 2) {
            const bool last = (t == nt - 2);
            const size_t k1 = (size_t)(t + 1) * kstep;
            const char* a2 = last ? nA : cA; const char* b2 = last ? nB : cB + (size_t)(t + 2) * kstep;
            const size_t k2 = last ? 0 : (size_t)(t + 2) * kstep;
            const char* b3 = b2 + kstep;
            PG8_LDB(B0, 0, 0); PG8_LDB(B1, 0, 1); PG8_SCHED; PG8_LDA(At, 0, 0); PG8_STAGE_A(PG8_SA(1, 1), cA, false, 1, k1);
            PG8_WAIT_V(8); PG8_WAIT_L(0); PG8_BAR; PG8_MMA(0, 0, At, B0); PG8_MMA(0, 1, At, B1); PG8_BAR; PG8_SCHED;
            PG8_LDA(At, 0, 1); PG8_STAGE_B(PG8_SB(0, 0), b2); PG8_STAGE_B(PG8_SB(0, 1), b2 + hstepB); PG8_STAGE_A(PG8_SA(0, 0), a2, last, 0, k2);
            PG8_WAIT_V(8); PG8_WAIT_L(0); PG8_BAR; PG8_MMA(1, 0, At, B0); PG8_MMA(1, 1, At, B1); PG8_BAR; PG8_SCHED;
            PG8_LDB(B0, 1, 0); PG8_LDB(B1, 1, 1); PG8_SCHED; PG8_LDA(At, 1, 0); PG8_STAGE_A(PG8_SA(0, 1), a2, last, 1, k2);
            PG8_WAIT_V(8); PG8_WAIT_L(0); PG8_BAR; PG8_MMA(0, 0, At, B0); PG8_MMA(0, 1, At, B1); PG8_BAR; PG8_SCHED;
            PG8_LDA(At, 1, 1); PG8_STAGE_B(PG8_SB(1, 0), b3); PG8_STAGE_B(PG8_SB(1, 1), b3 + hstepB); PG8_STAGE_A(PG8_SA(1, 0), a2, last, 0, k2 + kstep);
            PG8_WAIT_V(8); PG8_WAIT_L(0); PG8_BAR; PG8_MMA(1, 0, At, B0); PG8_MMA(1, 1, At, B1); PG8_BAR; PG8_SCHED;
        }
        if (wr == 0) PG8_BAR;
        { unsigned z_ = 0u; asm volatile("" : "+v"(z_)); const int l2_ = (int)__builtin_amdgcn_mbcnt_hi(~0u, __builtin_amdgcn_mbcnt_lo(~0u, z_));
          E(acc, cur, wr, wc, l2_ & 15, l2_ >> 4);
          if constexpr (Epi::SIGNAL) { PG8_WAIT_V(0); PG8_BAR; E.signal(cur, wid == 0 && l2_ == 0); } }
        if (!has_next) break;
        PG8_ZERO_ACC();
        cur = nxt; cA = nA; cB = nB; ++ui;
        if constexpr (GATHER) {
#pragma unroll
            for (int h_ = 0; h_ < 2; ++h_)
#pragma unroll
                for (int i_ = 0; i_ < 2; ++i_) offC[h_][i_] = offN[h_][i_]; }
        if (wr == 1) PG8_BAR;
    }
    PG8_WAIT_V(0);
    PG8_BAR;
#undef PG8_GOFF
#undef PG8_ZERO_ACC
#undef PG8_SA
#undef PG8_SB
#undef PG8_GLDS
#undef PG8_STAGE_A
#undef PG8_STAGE_B
#undef PG8_LDA
#undef PG8_LDB
#undef PG8_MMA
#undef PG8_WAIT_V
#undef PG8_WAIT_L
#undef PG8_BAR
#undef PG8_SCHED
}
}

template <class Epi>
__device__ __forceinline__ void run_dense(Frame& F, const bf16* A, int lda_elems, const bf16* Bt, int M, int N, int K, const Epi& E) {
    pg8::StaticOrder S; S.A = (const char*)A; S.Bt = (const char*)Bt; S.lda = (unsigned)lda_elems * 2u; S.K = K; S.nM = M / 256; S.nN = N / 256; S.nwg = S.nM * S.nN; S.G = F.G; S.c = F.bid;
    pg8::Gemm g{(unsigned)lda_elems * 2u, K};
    fresh_tid(F);
    pg8::gemm_phase<Epi, pg8::StaticOrder, false>(F.lds, F.tid, g, S, E);
}

constexpr int TB_OFF = 131072;
constexpr int TE_OFF = TB_OFF + 1024;
__device__ __forceinline__ void compute_bases(Frame& F, int l) {
    fresh_tid(F);
    LAS unsigned* tb = (LAS unsigned*)(F.lds + TB_OFF); LAS unsigned* lc = tb + 32;
    if (F.tid == 0) { const unsigned* cnt = F.ctl + CW_CNT + CNT_LS * l; unsigned acc = 0;
        for (int e = 0; e < NE; ++e) { const unsigned c = cnt[CNT_ES * e]; lc[e] = c; tb[e] = acc; acc += (c + 255u) >> 8; }
        tb[16] = acc; tb[17] = acc + T / 256;
        if (F.bid == 0) { unsigned* base = F.ctl + CW_BASE + 32 * l; for (int e = 0; e < 18; ++e) base[e] = tb[e] * 256u; } }
    __syncthreads();
    if (F.tid < 256) { LAS unsigned* te = (LAS unsigned*)(F.lds + TE_OFF); unsigned e = 0;
        for (int j = 1; j <= NE; ++j) if ((unsigned)F.tid >= tb[j]) e = (unsigned)j;
        te[F.tid] = e | (((unsigned)F.tid - tb[e]) << 8); }
    __syncthreads();
}

struct Args { const GAS void* in[26]; GAS float* out; GAS unsigned char* ws; int lo, hi; };
constexpr int NSTEPS = 21;

__global__ void __launch_bounds__(NTHREADS, 2) mk_fwd(Args args) {
    extern __shared__ __attribute__((aligned(16))) unsigned char lds_raw[];
    Frame F;
    F.lds = (LAS unsigned char*)lds_raw; F.MISC = (volatile LAS unsigned*)(F.lds + MISC_OFF);
    F.tid = threadIdx.x; F.lane = F.tid & 63; F.wave = __builtin_amdgcn_readfirstlane(F.tid >> 6); F.bid = blockIdx.x; F.G = gridDim.x;
    F.ws = args.ws; F.ctl = (unsigned*)(GAS unsigned*)(args.ws + WS_CTL); F.out = (float*)args.out;
    F.in = args.in; const int wave0 = F.wave;
    if (F.tid < 32) F.MISC[F.tid] = 0u;
    __syncthreads();
    XcdBarrier bar; bar.bar = F.ctl + CW_BAR; bar.x = 0; bar.st = nullptr;
    if (!MK_SPLIT) bar = xcd_barrier_post(F.ctl + CW_BAR, F.MISC + 8);

    for (int step_ = args.lo; step_ < args.hi; ++step_) {
        int step = step_; asm volatile("" : "+s"(step));
        { GAS unsigned char* w_ = args.ws; asm volatile("" : "+s"(w_)); F.ws = w_; F.ctl = (unsigned*)(GAS unsigned*)(w_ + WS_CTL);
          int b_ = blockIdx.x, g_ = gridDim.x, wv_ = wave0; GAS float* o_ = args.out; asm volatile("" : "+s"(b_), "+s"(g_), "+s"(wv_), "+s"(o_)); F.bid = b_; F.G = g_; F.wave = wv_; F.out = (float*)o_;
          F.tid = 0; F.lane = 0; }
#ifdef ONLY_PH
#define PHON(p) ((p) == ONLY_PH)
#else
#define PHON(p) true
#endif
        if (step == 0) { step_p0(F); if (FAST_ANY) convert_weights(F, 0); }
        else if (step == 1) step_p0_reduce(F);
        else if (step == NSTEPS - 1) { if (PHON(0)) step_a(F, 2); }
        else {
            const int l = (step - 2) / 9, ph = (step - 2) % 9, phx = ph == 2 ? 23 : ph;
            bf16* const XNp = WSP(bf16, WS_XN); const float* const MODp = WSP(float, WS_MOD);
            if (!PHON(ph)) {} else
            if (ph == 0) { if (FAST_ANY && l > 0) convert_weights(F, l); if (l == 0) for (int rep_ = 1; rep_ < REP_A0; ++rep_) step_a(F, 0); step_a(F, l); }
            else if (ph == 1) {
#if FAST_B
                for (int rep_ = 0; rep_ < REP_B; ++rep_) run_dense(F, XNp, D, WSP(bf16, WT_IN), T, NPROJ, D, pg8::EpiBf16{(bf16*)F.ws, 0, 1, GBP(F)});
#else
                EpiProj E{WSP(bf16, WS_CONV), WSP(bf16, WS_SMALL), WSP(bf16, WS_GA), GBP(F)};
                ngemm<8, false>(F, T, NIN, D, RowLin{XNp, D}, ((const float*)(const GAS float*)F.in[7]) + (size_t)l * D * NIN, nullptr, NIN, nullptr, E);
#endif
            } else if (phx == 23) { for (int rep_ = 0; rep_ < REP_C; ++rep_) step_c(F, l);
#if FAST_D
                for (int rep_ = 0; rep_ < REP_D; ++rep_) {
                run_dense(F, WSP(bf16, WS_SMALL), 512, WSP(bf16, WT_UQ), T, 768, QL, pg8::EpiBf16{WSP(bf16, WS_QRAW), 768, 0, nullptr});
                run_dense(F, WSP(bf16, WS_SMALL) + 256, 512, WSP(bf16, WT_UKV), T, 1024, KVL, pg8::EpiKV{WSP(bf16, WS_K), WSP(bf16, WS_V), WSP(bf16, WS_SMALL), WSP(f32x2, WS_ROPE), ((const float*)(const GAS float*)F.in[14]) + l * DQK}); }
#else
                ngemm<8, false>(F, T, 768, QL, RowLin{WSP(bf16, WS_SMALL), 512}, ((const float*)(const GAS float*)F.in[10]) + (size_t)l * QL * 768, nullptr, 768, ((const float*)(const GAS float*)F.in[9]) + l * QL, EpiStore{WSP(bf16, WS_QRAW), 768});
                ngemm<8, false>(F, T, 1024, KVL, RowLin{WSP(bf16, WS_SMALL) + 256, 512}, ((const float*)(const GAS float*)F.in[12]) + (size_t)l * KVL * 1024, nullptr, 1024, ((const float*)(const GAS float*)F.in[11]) + l * KVL, EpiStore{WSP(bf16, WS_KVRAW), 1024});
#endif
            } else if (ph == 3) {
                for (int rep_ = 0; rep_ < REP_E; ++rep_) step_e(F, l);
#if FAST_G
                run_dense(F, WSP(bf16, WS_U), CW, WSP(bf16, WT_CO), T, D, CW, pg8::EpiGate<1>{WSP(bf16, WS_GA), nullptr});
#else
                ngemm<8, false>(F, T, D, CW, RowLin{WSP(bf16, WS_U), CW}, ((const float*)(const GAS float*)F.in[15]) + (size_t)l * CW * D, nullptr, D, nullptr, EpiGate1{WSP(bf16, WS_GA)});
#endif
            } else if (ph == 4) { for (int rep_ = 0; rep_ < REP_F; ++rep_) { if (FAST_ATTN && attn_static_ok(F, l)) step_f_fast(F); else step_f(F); }
            } else if (ph == 5) {
#if FAST_H
                run_dense(F, WSP(bf16, WS_O), 512, WSP(bf16, WT_AO), T, D, 512, pg8::EpiGate<2>{WSP(bf16, WS_GA), GBP(F)});
#else
                ngemm<8, false>(F, T, D, 512, RowLin{WSP(bf16, WS_O), 512}, ((const float*)(const GAS float*)F.in[16]) + (size_t)l * 512 * D, nullptr, D, nullptr, EpiGate2{WSP(bf16, WS_GA), GBP(F)});
#endif
            } else if (ph == 6) {
#if FAST_I
                run_dense(F, WSP(bf16, WS_GA), D, WSP(bf16, WT_O), T, D, D, pg8::EpiRes16{l == 0 ? ((const float*)(const GAS float*)F.in[0]) : nullptr, WSP(bf16, WS_X16), MODp + (size_t)l * 2 * 6 * D + 2 * D});
#else
                ngemm<8, false>(F, T, D, D, RowLin{WSP(bf16, WS_GA), D}, ((const float*)(const GAS float*)F.in[17]) + (size_t)l * D * D, nullptr, D, nullptr,
                                EpiRes{l == 0 ? ((const float*)(const GAS float*)F.in[0]) : F.out, F.out, MODp + (size_t)l * 2 * 6 * D + 2 * D});
#endif
            } else if (ph == 7) { for (int rep_ = 1; rep_ < REP_J; ++rep_) step_j(F, l, true); if (USE_OLD_J) step_j_old(F, l); else step_j(F, l);
            } else {
                compute_bases(F, l);
                const LAS unsigned* tb = (const LAS unsigned*)(F.lds + TB_OFF); const LAS unsigned* cnt = tb + 32;
                unsigned* kf = F.ctl + CW_KF + 256 * l;
                pg8::MoeOrderX S; S.MT = (int)__builtin_amdgcn_readfirstlane(tb[17]); S.G = F.G; S.c = F.bid; S.tb = tb; S.cnt = cnt; S.te = (const LAS unsigned*)(F.lds + TE_OFF); S.LIST = WSP(int, WS_LIST); S.kN = 2; S.flags = kf; S.bar = F.ctl + CW_BAR;
                S.A = (const char*)XNp; S.Bt = (const char*)WSP(bf16, WT_GU); S.estride = (size_t)512 * D * 2; S.lda = D * 2; S.K = D; S.nN = 2; S.gather = true; S.mode = 0;
                fresh_tid(F);
                pg8::gemm_phase<pg8::EpiAct, pg8::MoeOrderX, true>(F.lds, F.tid, pg8::Gemm{(unsigned)D * 2u, D}, S, pg8::EpiAct{WSP(bf16, WS_A2), WSP(float, WS_TOKW), kf});
                S.A = (const char*)WSP(bf16, WS_A2); S.Bt = (const char*)WSP(bf16, WT_DN); S.estride = (size_t)D * DE * 2; S.lda = DE * 2; S.K = DE; S.nN = 4; S.gather = false; S.mode = 1;
                fresh_tid(F);
                pg8::gemm_phase<pg8::EpiY8, pg8::MoeOrderX, false>(F.lds, F.tid, pg8::Gemm{(unsigned)DE * 2u, DE}, S, pg8::EpiY8{WSP(unsigned char, WS_Y)});
            }
        }
        if (step_ + 1 < args.hi) for (int rep_ = 0; rep_ < REP_BAR; ++rep_) xcd_barrier(bar);
    }
}

extern "C" void kernel_launch(void* const* d_in, const int* in_sizes, int n_in, void* d_out, int out_size, void* d_ws, size_t ws_size, hipStream_t stream) {
    static int grid = 0;
    if (grid == 0) {
        if (n_in != 26 || in_sizes[0] != T * D || out_size != T * D || ws_size < WS_END) {
            fprintf(stderr, "kernel_launch: unexpected shapes: n_in %d in0 %d out %d ws %zu (need >= %zu)\n", n_in, n_in > 0 ? in_sizes[0] : -1, out_size, ws_size, (size_t)WS_END); grid = -1; return; }
        int dev = 0, cus = 0;
        if (hipGetDevice(&dev) != hipSuccess || hipDeviceGetAttribute(&cus, hipDeviceAttributeMultiprocessorCount, dev) != hipSuccess) { grid = -1; return; }
        if (hipFuncSetAttribute((const void*)mk_fwd, hipFuncAttributeMaxDynamicSharedMemorySize, LDS_BYTES) != hipSuccess) { fprintf(stderr, "kernel_launch: hipFuncSetAttribute failed\n"); grid = -1; return; }
        int per_cu = 0;
        if (hipOccupancyMaxActiveBlocksPerMultiprocessor(&per_cu, (const void*)mk_fwd, NTHREADS, LDS_BYTES) != hipSuccess || per_cu < 1)
            fprintf(stderr, "kernel_launch: note: occupancy query reports %d blocks/CU\n", per_cu);
        (void)hipGetLastError();
        grid = cus;
    }
    if (grid < 0) return;
    if (hipMemsetAsync((char*)d_ws + WS_CTL, 0, CTL_ZERO_BYTES, stream) != hipSuccess) { fprintf(stderr, "kernel_launch: memset failed\n"); return; }
    Args a{};
    for (int i = 0; i < 26; ++i) a.in[i] = (const GAS void*)d_in[i];
    a.out = (GAS float*)d_out; a.ws = (GAS unsigned char*)d_ws;
#if MK_SPLIT
    for (int s = 0; s < NSTEPS; ++s) { a.lo = s; a.hi = s + 1; hipLaunchKernelGGL(mk_fwd, dim3(grid), dim3(NTHREADS), LDS_BYTES, stream, a); }
#else
    a.lo = 0; a.hi = NSTEPS;
    hipLaunchKernelGGL(mk_fwd, dim3(grid), dim3(NTHREADS), LDS_BYTES, stream, a);
#endif
    const hipError_t le = hipPeekAtLastError();
    if (le != hipSuccess) fprintf(stderr, "kernel_launch: launch failed: %s\n", hipGetErrorName(le));
}
```

```cpp
#include <hip/hip_runtime.h>
#include <cstdio>
#include <cstdint>

#ifndef FAST_GEMM
#define FAST_GEMM 1
#endif
#ifndef FAST_B
#define FAST_B FAST_GEMM
#endif
#ifndef FAST_D
#define FAST_D FAST_GEMM
#endif
#ifndef FAST_G
#define FAST_G FAST_GEMM
#endif
#ifndef FAST_H
#define FAST_H FAST_GEMM
#endif
#ifndef FAST_I
#define FAST_I FAST_GEMM
#endif
#ifndef FAST_K
#define FAST_K FAST_GEMM
#endif
#ifndef FAST_L
#define FAST_L FAST_GEMM
#endif
#define FAST_ANY (FAST_B || FAST_D || FAST_G || FAST_H || FAST_I || FAST_K || FAST_L)
#ifndef USE_OLD_J
#define USE_OLD_J 0
#endif
#ifndef DBG_SHFL
#define DBG_SHFL 1
#endif
#ifndef FAST_ATTN
#define FAST_ATTN 1
#endif
#ifndef REP_F
#define REP_F 1
#endif
#ifndef REP_CVT
#define REP_CVT 1
#endif
#ifndef REP_B
#define REP_B 1
#endif
#ifndef REP_C
#define REP_C 1
#endif
#ifndef REP_D
#define REP_D 1
#endif
#ifndef REP_E
#define REP_E 1
#endif
#ifndef REP_K
#define REP_K 1
#endif
#ifndef REP_L
#define REP_L 1
#endif
#ifndef REP_J
#define REP_J 1
#endif
#ifndef REP_A0
#define REP_A0 1
#endif
#ifndef REP_P0
#define REP_P0 1
#endif
#ifndef REP_BAR
#define REP_BAR 1
#endif
#ifndef ATTN_W64
#define ATTN_W64 1
#endif
#ifndef MK_SPLIT
#define MK_SPLIT 0
#endif

#define GAS __attribute__((address_space(1)))
#define LAS __attribute__((address_space(3)))
typedef unsigned short bf16;
typedef unsigned v4u __attribute__((ext_vector_type(4)));
typedef unsigned v2u __attribute__((ext_vector_type(2)));
typedef float f32x4 __attribute__((ext_vector_type(4)));
typedef float f32x2 __attribute__((ext_vector_type(2)));
typedef unsigned short bf16x8 __attribute__((ext_vector_type(8)));
typedef unsigned short bf16x4 __attribute__((ext_vector_type(4)));
typedef GAS unsigned gu32;

constexpr int NB = 2, S = 8192, T = NB * S, D = 1024, H = 8, DQK = 96, DV = 64;
constexpr int NIN = 4000, CW = 512, QL = 256, KVL = 128, NE = 16, DE = 256, NEX = NE + 1;
constexpr float EPS = 1e-6f;
constexpr float QSCALE = 0.10206207261596577f * 1.4426950408889634f;
constexpr int NWAVES = 8, NTHREADS = 512;

constexpr size_t MiB = 1u << 20, KiB = 1u << 10;
constexpr size_t WS_CTL = 0, CTL_ZERO_BYTES = 64 * KiB;
constexpr size_t WS_MOD = 1 * MiB;
constexpr size_t WS_TOKS = WS_MOD + 128 * KiB;
constexpr size_t WS_TOKW = WS_TOKS + 128 * KiB;
constexpr size_t WS_RS = WS_TOKW + 128 * KiB;
constexpr size_t WS_ROPE = 2 * MiB;
constexpr size_t WS_LIST = 4 * MiB;
constexpr size_t WS_WT = 5 * MiB;
constexpr size_t WS_XN = 45 * MiB;
constexpr size_t WS_R1 = 109 * MiB;
constexpr size_t WS_R2 = 157 * MiB;
constexpr size_t WS_GA = 173 * MiB;
constexpr size_t WS_X16 = 77 * MiB;
#define GBP(F_) ((bf16*)((unsigned char*)(F_).out + 32 * MiB))
constexpr size_t WS_U = 205 * MiB;
constexpr size_t WS_K = WS_XN;
constexpr size_t WS_V = 245 * MiB;
constexpr size_t WS_END = 261 * MiB;
constexpr size_t WS_KVRAW = WS_XN, WS_CONV = WS_R1, WS_QRAW = 221 * MiB  , WS_Q = WS_R1 + 24 * MiB, WS_SMALL = WS_R2, WS_O = WS_R2;
constexpr size_t WS_A2 = WS_R1;
constexpr size_t WS_Y = WS_R1 + 26 * MiB;
constexpr int SLOTS_MAX = 3 * T + NE * 256;
static_assert(WS_Y + (size_t)SLOTS_MAX * 2048 <= WS_END, "MoE overlay");
constexpr int CW_CNT = 8192, CNT_LS = 2048, CNT_ES = 64;
static_assert((CW_CNT + 2 * CNT_LS) * 4 <= (int)CTL_ZERO_BYTES && (4096 + 3456) * 4 <= (int)CTL_ZERO_BYTES, "control words (barrier region at word 4096, 3456 words; counters) inside the per-call memset");
constexpr int CW_BASE = 192;
constexpr int CW_BAR = 4096;
constexpr int CW_KF = 12288;
static_assert((CW_KF + 2 * 256) * 4 <= (int)CTL_ZERO_BYTES && CW_KF >= CW_CNT + 2 * CNT_LS, "slot-tile flags inside the per-call memset");

#define RLX_AGENT __ATOMIC_RELAXED, __HIP_MEMORY_SCOPE_AGENT
__device__ __forceinline__ unsigned f2bf(float f) { unsigned u = __builtin_bit_cast(unsigned, f); return (u + 0x7fffu + ((u >> 16) & 1u)) >> 16; }
typedef __bf16 hwbf16x2 __attribute__((ext_vector_type(2)));
__device__ __forceinline__ unsigned pk2(float lo, float hi) { f32x2 v = {lo, hi}; hwbf16x2 b = __builtin_convertvector(v, hwbf16x2); return __builtin_bit_cast(unsigned, b); }
__device__ __forceinline__ float bf2f(unsigned short b) { return __builtin_bit_cast(float, (unsigned)b << 16); }
template <int CTRL> __device__ __forceinline__ float dpp_mov(float v) { return __builtin_bit_cast(float, __builtin_amdgcn_update_dpp(0, __builtin_bit_cast(int, v), CTRL, 0xF, 0xF, false)); }
template <int K> __device__ __forceinline__ float xor_lane(float v) {
    if constexpr (K == 1) return dpp_mov<0xB1>(v);
    else if constexpr (K == 2) return dpp_mov<0x4E>(v);
    else return __builtin_bit_cast(float, __builtin_amdgcn_ds_swizzle(__builtin_bit_cast(int, v), (K << 10) | 0x1f)); }
__device__ __forceinline__ float row16_sum_dpp(float v) { v += dpp_mov<0x121>(v); v += dpp_mov<0x122>(v); v += dpp_mov<0x124>(v); v += dpp_mov<0x128>(v); return v; }
__device__ __forceinline__ float add_xor32(float v) {
    auto r = __builtin_amdgcn_permlane32_swap(__builtin_bit_cast(unsigned, v), __builtin_bit_cast(unsigned, v), false, false);
    return __builtin_bit_cast(float, r[0]) + __builtin_bit_cast(float, r[1]); }
__device__ __forceinline__ float bperm_xor(float v, int lane, int k) { return __builtin_bit_cast(float, __builtin_amdgcn_ds_bpermute((lane ^ k) << 2, __builtin_bit_cast(int, v))); }
__device__ __forceinline__ float wave_sum(float v, int lane) {
    v = row16_sum_dpp(v);
    const float r0 = __builtin_bit_cast(float, __builtin_amdgcn_readlane(__builtin_bit_cast(int, v), 0)), r1 = __builtin_bit_cast(float, __builtin_amdgcn_readlane(__builtin_bit_cast(int, v), 16));
    const float r2 = __builtin_bit_cast(float, __builtin_amdgcn_readlane(__builtin_bit_cast(int, v), 32)), r3 = __builtin_bit_cast(float, __builtin_amdgcn_readlane(__builtin_bit_cast(int, v), 48));
    return (r0 + r1) + (r2 + r3);
}
__device__ __forceinline__ float sigmoidf_(float x) { return 1.f / (1.f + __expf(-x)); }

#define XB_TMO      128
#define XB_XCNT(j)  (256  + 64 * (j))
#define XB_XSUB(j)  (1280 + 64 * (j))
#define XB_XGEN(j)  (2304 + 64 * (j))
#define XB_TOP      3328
#define XB_TOPGEN   3392
#define XCD_BAR_WORDS 3456
#define XB_SPIN_CAP (1u << 22)
__device__ __forceinline__ unsigned xb_ld(unsigned* p)              { return __hip_atomic_load(p, __ATOMIC_RELAXED, __HIP_MEMORY_SCOPE_AGENT); }
__device__ __forceinline__ unsigned xb_add(unsigned* p, unsigned v) { return __hip_atomic_fetch_add(p, v, __ATOMIC_RELAXED, __HIP_MEMORY_SCOPE_AGENT); }
__device__ __forceinline__ unsigned xb_xcc_id() { return (unsigned)__builtin_amdgcn_s_getreg((3 << 11) | 20) & 0xFu; }
#define XB_SPIN(cond, bar) do { unsigned _sp = 0; while (cond) { __builtin_amdgcn_s_sleep(1); \
    if ((++_sp & 255u) == 0u) { if (xb_ld(&(bar)[XB_TMO])) break; if (_sp > XB_SPIN_CAP) { atomicAdd(&(bar)[XB_TMO], 1u); break; } } } } while (0)
struct XcdBarrier { unsigned* bar; unsigned x; volatile LAS unsigned* st; };
__device__ __forceinline__ XcdBarrier xcd_barrier_post(unsigned* bar, volatile LAS unsigned* st) {
    XcdBarrier b; b.bar = bar; b.x = xb_xcc_id(); b.st = st;
    if (threadIdx.x == 0) (void)xb_add(&bar[XB_XCNT(b.x)], 1u);
    return b;
}
__device__ __forceinline__ void xcd_barrier_complete(unsigned* bar, unsigned x, unsigned& nloc, unsigned& nx) {
    const unsigned G = gridDim.x * gridDim.y * gridDim.z;
    unsigned sum, cnt, mine, sp = 0u;
    for (;;) {
        sum = 0u; cnt = 0u; mine = 0u;
#pragma unroll
        for (unsigned j = 0; j < 16; ++j) { const unsigned c = xb_ld(&bar[XB_XCNT(j)]); sum += c; cnt += (c > 0u) ? 1u : 0u; mine = (j == x) ? c : mine; }
        if (sum == G) break;
        __builtin_amdgcn_s_sleep(1);
        if ((++sp & 255u) == 0u) { if (xb_ld(&bar[XB_TMO])) break; if (sp > XB_SPIN_CAP) { atomicAdd(&bar[XB_TMO], 1u); break; } }
    }
    nloc = mine > 0u ? mine : 1u; nx = cnt > 0u ? cnt : 1u;
}
__device__ __forceinline__ void xcd_barrier(const XcdBarrier& b) {
    asm volatile("s_waitcnt vmcnt(0)" ::: "memory");
    __syncthreads();
    if (threadIdx.x == 0) {
        unsigned* bar = b.bar;
        __builtin_amdgcn_s_waitcnt(0);
        unsigned nloc = b.st[0], nx = b.st[1];
        if (nloc == 0u) { xcd_barrier_complete(bar, b.x, nloc, nx); b.st[0] = nloc; b.st[1] = nx; }
        const unsigned old = xb_add(&bar[XB_XSUB(b.x)], 1u);
        const unsigned gen = old / nloc;
        if (old + 1u == (gen + 1u) * nloc) {
            __builtin_amdgcn_fence(__ATOMIC_RELEASE, "agent");
            asm volatile("s_waitcnt vmcnt(0)" ::: "memory");
            const unsigned og = xb_add(&bar[XB_TOP], 1u);
            const unsigned tg = og / nx;
            if (og + 1u == (tg + 1u) * nx) xb_add(&bar[XB_TOPGEN], 1u);
            else XB_SPIN(xb_ld(&bar[XB_TOPGEN]) == tg, bar);
            __builtin_amdgcn_fence(__ATOMIC_ACQUIRE, "agent");
            xb_add(&bar[XB_XGEN(b.x)], 1u);
            asm volatile("s_waitcnt vmcnt(0)" ::: "memory");
        } else {
            XB_SPIN(xb_ld(&bar[XB_XGEN(b.x)]) == gen, bar);
            __builtin_amdgcn_fence(__ATOMIC_ACQUIRE, "agent");
            asm volatile("s_waitcnt vmcnt(0)" ::: "memory");
        }
    }
    __syncthreads();
}

constexpr int LDS_BYTES = 155648;
constexpr int MISC_OFF = 131072 + 320;
struct Frame {
    LAS unsigned char* lds; volatile LAS unsigned* MISC; unsigned* ctl;
    int tid, lane, wave, bid, G;
    const GAS void* const* in;
    float* out; GAS unsigned char* ws;
};
#define WSP(T_, off) ((T_*)(GAS T_*)(F.ws + (off)))
__device__ __forceinline__ void fresh_tid(Frame& F) { unsigned z_ = 0u; asm volatile("" : "+v"(z_)); const int l_ = (int)__builtin_amdgcn_mbcnt_hi(~0u, __builtin_amdgcn_mbcnt_lo(~0u, z_)); F.lane = l_; F.tid = F.wave * 64 + l_; }

__constant__ double INVF[16] = {1.0, 0.5623413251903491, 0.31622776601683794, 0.1778279410038923, 0.1, 0.05623413251903491, 0.03162277660168379, 0.01778279410038923,
                                0.01, 0.005623413251903491, 0.0031622776601683794, 0.001778279410038923, 0.001, 0.0005623413251903491, 0.00031622776601683794, 0.0001778279410038923};

constexpr size_t WS_MODP = WS_XN;
__device__ __forceinline__ void step_p0(Frame& F) {
    fresh_tid(F);
    const int gw = F.bid * NWAVES + F.wave, NGW = F.G * NWAVES;
    float* MODP = WSP(float, WS_MODP);
    const float* cin = (const float*)F.in[1];
    for (int it = gw; it < 2 * 96 * 16; it += NGW) {
        const int kc = it & 15, nc = (it >> 4) % 96, l = (it >> 4) / 96, n = nc * 64 + F.lane;
        const float* w = ((const float*)(const GAS float*)F.in[3]) + ((size_t)l * D + kc * 64) * (6 * D) + n;
        float a0 = 0.f, a1 = 0.f;
#pragma unroll
        for (int kh = 0; kh < 2; ++kh) {
            float wv[32];
#pragma unroll
            for (int k = 0; k < 32; ++k) wv[k] = w[(size_t)(kh * 32 + k) * (6 * D)];
#pragma unroll
            for (int k = 0; k < 32; ++k) {
                const float c0 = cin[kc * 64 + kh * 32 + k], c1 = cin[D + kc * 64 + kh * 32 + k];
                const float s0 = c0 / (1.f + __expf(-c0)), s1 = c1 / (1.f + __expf(-c1));
                a0 += s0 * wv[k]; a1 += s1 * wv[k];
            }
        }
        MODP[((size_t)(kc * 2 + l) * 2 + 0) * 6 * D + n] = a0; MODP[((size_t)(kc * 2 + l) * 2 + 1) * 6 * D + n] = a1;
    }
    f32x2* ROPE = WSP(f32x2, WS_ROPE);
    for (int idx = F.bid * NTHREADS + F.tid; idx < T * 16; idx += F.G * NTHREADS) {
        const int t = idx >> 4, i = idx & 15;
        const double a = (double)((const int*)(const GAS int*)F.in[2])[t] * INVF[i];
        const double n = __builtin_rint(a * 0.15915494309189535);
        double r = __builtin_fma(-n, 6.283185307179586, a); r = __builtin_fma(-n, 2.4492935982947064e-16, r);
        const float rf = (float)r;
        f32x2 cs; cs.x = __cosf(rf); cs.y = __sinf(rf);
        ROPE[idx] = cs;
    }
}
__device__ __forceinline__ void step_p0_reduce(Frame& F) {
    fresh_tid(F);
    const float* MODP = WSP(float, WS_MODP); float* MOD = WSP(float, WS_MOD);
    for (int idx = F.bid * NTHREADS + F.tid; idx < 2 * 2 * 6 * D; idx += F.G * NTHREADS) {
        const int n = idx % (6 * D), l = idx / (2 * 6 * D);
        float a = ((const float*)(const GAS float*)F.in[4])[l * 6 * D + n];
#pragma unroll
        for (int kc = 0; kc < 16; ++kc) a += MODP[(size_t)kc * (2 * 2 * 6 * D) + idx];
        MOD[idx] = a;
    }
}

__device__ __forceinline__ void step_a(Frame& F, int l) {
    fresh_tid(F);
    const int gw = F.bid * NWAVES + F.wave, NGW = F.G * NWAVES;
    const float* MOD = WSP(float, WS_MOD);
    const unsigned char* Y = WSP(unsigned char, WS_Y);
    const int* TOKS = WSP(int, WS_TOKS);
    bf16* XN = WSP(bf16, WS_XN); bf16* X16 = WSP(bf16, WS_X16);
    for (int row0 = gw; row0 < T; row0 += 2 * NGW) {
        const bool has1 = row0 + NGW < T;
        int rr[2]; rr[0] = row0; rr[1] = has1 ? row0 + NGW : row0;
        f32x4 v[2][4];
        if (l == 0) {
#pragma unroll
            for (int k = 0; k < 2; ++k)
#pragma unroll
                for (int j = 0; j < 4; ++j) v[k][j] = *(const f32x4*)(((const float*)(const GAS float*)F.in[0]) + (size_t)rr[k] * D + 4 * F.lane + 256 * j);
        } else {
            const unsigned* base = F.ctl + CW_BASE + 32 * (l - 1);
            int tk[2][2];
#pragma unroll
            for (int k = 0; k < 2; ++k) { tk[k][0] = TOKS[2 * rr[k]]; tk[k][1] = TOKS[2 * rr[k] + 1]; }
            size_t sl[2][3];
#pragma unroll
            for (int k = 0; k < 2; ++k) { sl[k][0] = base[tk[k][0] >> 16] + (tk[k][0] & 0xffff); sl[k][1] = base[tk[k][1] >> 16] + (tk[k][1] & 0xffff); sl[k][2] = base[16] + rr[k]; }
            f32x4 xo[2][4], gg[2][4]; unsigned ya[2][4], yb[2][4], yc[2][4];
#pragma unroll
            for (int k = 0; k < 2; ++k) { const float* gt2 = MOD + ((l - 1) * 2 + rr[k] / S) * 6 * D + 5 * D;
#pragma unroll
                for (int j = 0; j < 4; ++j) { const int col = 4 * F.lane + 256 * j;
                    { const bf16x4 t = *(const bf16x4*)(X16 + (size_t)rr[k] * D + col); xo[k][j] = (f32x4){bf2f(t[0]), bf2f(t[1]), bf2f(t[2]), bf2f(t[3])}; } gg[k][j] = *(const f32x4*)(gt2 + col);
                    ya[k][j] = *(const unsigned*)(Y + sl[k][0] * D + col); yb[k][j] = *(const unsigned*)(Y + sl[k][1] * D + col); yc[k][j] = *(const unsigned*)(Y + sl[k][2] * D + col); } }
#pragma unroll
            for (int k = 0; k < 2; ++k)
#pragma unroll
                for (int j = 0; j < 4; ++j) { f32x4 r;
                    const f32x2 a0 = __builtin_amdgcn_cvt_pk_f32_fp8((int)ya[k][j], false), a1 = __builtin_amdgcn_cvt_pk_f32_fp8((int)ya[k][j], true);
                    const f32x2 b0 = __builtin_amdgcn_cvt_pk_f32_fp8((int)yb[k][j], false), b1 = __builtin_amdgcn_cvt_pk_f32_fp8((int)yb[k][j], true);
                    const f32x2 c0 = __builtin_amdgcn_cvt_pk_f32_fp8((int)yc[k][j], false), c1 = __builtin_amdgcn_cvt_pk_f32_fp8((int)yc[k][j], true);
                    const f32x4 ys = (f32x4){a0.x + b0.x + c0.x, a0.y + b0.y + c0.y, a1.x + b1.x + c1.x, a1.y + b1.y + c1.y};
#pragma unroll
                    for (int e = 0; e < 4; ++e) r[e] = xo[k][j][e] + gg[k][j][e] * ys[e];
                    v[k][j] = r;
                    if (k == 0 || has1) { if (l == 2) *(f32x4*)(F.out + (size_t)rr[k] * D + 4 * F.lane + 256 * j) = r;
                        else { v2u o_; o_.x = pk2(r[0], r[1]); o_.y = pk2(r[2], r[3]); *(v2u*)(X16 + (size_t)rr[k] * D + 4 * F.lane + 256 * j) = o_; } } }
        }
        if (l < 2) {
            f32x4 g[4], sc[2][4], sh[2][4];
#pragma unroll
            for (int j = 0; j < 4; ++j) g[j] = *(const f32x4*)(((const float*)(const GAS float*)F.in[5]) + l * D + 4 * F.lane + 256 * j);
#pragma unroll
            for (int k = 0; k < 2; ++k) { const float* m = MOD + (l * 2 + rr[k] / S) * 6 * D;
#pragma unroll
                for (int j = 0; j < 4; ++j) { sc[k][j] = *(const f32x4*)(m + D + 4 * F.lane + 256 * j); sh[k][j] = *(const f32x4*)(m + 4 * F.lane + 256 * j); } }
            float ss[2];
#pragma unroll
            for (int k = 0; k < 2; ++k) { float a = 0.f;
#pragma unroll
                for (int j = 0; j < 4; ++j) a += (v[k][j].x * v[k][j].x + v[k][j].y * v[k][j].y) + (v[k][j].z * v[k][j].z + v[k][j].w * v[k][j].w);
                ss[k] = a; }
            const float rs0 = 1.0f / sqrtf(wave_sum(ss[0], F.lane) * (1.f / D) + EPS), rs1 = 1.0f / sqrtf(wave_sum(ss[1], F.lane) * (1.f / D) + EPS);
#pragma unroll
            for (int k = 0; k < 2; ++k) { const float rs = k ? rs1 : rs0;
#pragma unroll
                for (int j = 0; j < 4; ++j) { f32x4 h;
#pragma unroll
                    for (int e = 0; e < 4; ++e) h[e] = v[k][j][e] * rs * g[j][e] * (1.f + sc[k][j][e]) + sh[k][j][e];
                    v2u o; o.x = pk2(h[0], h[1]); o.y = pk2(h[2], h[3]);
                    if (k == 0 || has1) *(v2u*)(XN + (size_t)rr[k] * D + 4 * F.lane + 256 * j) = o; } }
        }
    }
}

template <int RPT, bool DUAL, class RowF, class Epi>
__device__ __forceinline__ void ngemm(Frame& F, int M, int N, int K, RowF rowf, const float* W, const float* W2, int ldw, const float* ksc, Epi epi) {
    fresh_tid(F);
    const int gw = F.bid * NWAVES + F.wave, NGW = F.G * NWAVES;
    const int nrb = (M + RPT - 1) / RPT, ncc = (N + 255) / 256;
    for (int it = gw; it < nrb * ncc; it += NGW) {
        const int cc = it / nrb, rb = it % nrb;
        const int n4 = cc * 256 + F.lane * 4;
        const bool nv = n4 < N;
        const int n4c = nv ? n4 : 0;
        const bf16* rp[RPT];
#pragma unroll
        for (int r = 0; r < RPT; ++r) { int m = rb * RPT + r; if (m >= M) m = M - 1; rp[r] = rowf(m); }
        f32x4 acc[RPT], acc2[RPT];
#pragma unroll
        for (int r = 0; r < RPT; ++r) { acc[r] = (f32x4){0.f, 0.f, 0.f, 0.f}; acc2[r] = (f32x4){0.f, 0.f, 0.f, 0.f}; }
        for (int k0 = 0; k0 < K; k0 += 8) {
            bf16x8 a[RPT];
#pragma unroll
            for (int r = 0; r < RPT; ++r) a[r] = *(const bf16x8*)(rp[r] + k0);
#pragma unroll
            for (int j = 0; j < 8; ++j) {
                f32x4 w = *(const f32x4*)(W + (size_t)(k0 + j) * ldw + n4c);
                f32x4 w2 = (f32x4){0.f, 0.f, 0.f, 0.f};
                if (DUAL) w2 = *(const f32x4*)(W2 + (size_t)(k0 + j) * ldw + n4c);
                if (ksc) { const float s = ksc[k0 + j]; w = w * s; }
#pragma unroll
                for (int r = 0; r < RPT; ++r) { const float av = bf2f(a[r][j]); acc[r] += av * w; if (DUAL) acc2[r] += av * w2; }
            }
        }
        if (nv) {
#pragma unroll
            for (int r = 0; r < RPT; ++r) { const int m = rb * RPT + r; if (m < M) epi(m, n4, acc[r], acc2[r]); }
        }
    }
}
struct RowLin { const bf16* p; int ld; __device__ __forceinline__ const bf16* operator()(int m) const { return p + (size_t)m * ld; } };
struct RowGather { const bf16* p; int ld; const int* list; __device__ __forceinline__ const bf16* operator()(int m) const { return p + (size_t)(list[m] >> 1) * ld; } };
__device__ __forceinline__ void st_bf4(bf16* p, f32x4 v) { v2u o; o.x = pk2(v[0], v[1]); o.y = pk2(v[2], v[3]); *(v2u*)p = o; }

struct EpiProj { bf16 *conv, *small, *ga, *gb;
    __device__ __forceinline__ void operator()(int m, int n, f32x4 a, f32x4) const {
        bf16* p;
        if (n < 1536) p = conv + (size_t)m * 1536 + n;
        else if (n < 1952) p = small + (size_t)m * 512 + (n - 1536);
        else if (n < 2976) p = ga + (size_t)m * 1024 + (n - 1952);
        else p = gb + (size_t)m * 1024 + (n - 2976);
        st_bf4(p, a);
    } };
struct EpiStore { bf16* o; int ld; __device__ __forceinline__ void operator()(int m, int n, f32x4 a, f32x4) const { st_bf4(o + (size_t)m * ld + n, a); } };
struct EpiGate1 { bf16* ga; __device__ __forceinline__ void operator()(int m, int n, f32x4 a, f32x4) const {
        bf16* p = ga + (size_t)m * D + n; const bf16x4 g = *(const bf16x4*)p; f32x4 r;
#pragma unroll
        for (int e = 0; e < 4; ++e) r[e] = sigmoidf_(bf2f(g[e])) * a[e];
        st_bf4(p, r); } };
struct EpiGate2 { bf16* t1; const bf16* gb; __device__ __forceinline__ void operator()(int m, int n, f32x4 a, f32x4) const {
        bf16* p = t1 + (size_t)m * D + n; const bf16x4 t = *(const bf16x4*)p; const bf16x4 g = *(const bf16x4*)(gb + (size_t)m * D + n); f32x4 r;
#pragma unroll
        for (int e = 0; e < 4; ++e) r[e] = bf2f(t[e]) + sigmoidf_(bf2f(g[e])) * a[e];
        st_bf4(p, r); } };
struct EpiRes { const float* xin; float* out; const float* gt; __device__ __forceinline__ void operator()(int m, int n, f32x4 a, f32x4) const {
        const f32x4 xv = *(const f32x4*)(xin + (size_t)m * D + n); const f32x4 g = *(const f32x4*)(gt + (m / S) * 6 * D + n);
        *(f32x4*)(out + (size_t)m * D + n) = xv + g * a; } };
struct EpiAct { bf16* a2; size_t slot0; const int* list; const float* tokw; __device__ __forceinline__ void operator()(int m, int n, f32x4 g, f32x4 u) const {
        const float w = list ? tokw[list[m]] : 1.f; f32x4 r;
#pragma unroll
        for (int e = 0; e < 4; ++e) r[e] = g[e] / (1.f + __expf(-g[e])) * u[e] * w;
        st_bf4(a2 + (slot0 + m) * DE + n, r); } };

__device__ __forceinline__ void step_c(Frame& F, int l) {
    fresh_tid(F);
    const bf16* CONV = WSP(bf16, WS_CONV); bf16* U = WSP(bf16, WS_U);
    const int gt = F.bid * NTHREADS + F.tid, NT = F.G * NTHREADS;
    for (int idx = gt; idx < T * 64; idx += NT) {
        const int t = idx >> 6, c8 = (idx & 63) * 8, s = t % S;
        const bf16* r0 = CONV + (size_t)t * 1024;
        const bf16x8 cb = *(const bf16x8*)(r0 + c8), p0v = *(const bf16x8*)(r0 + 512 + c8);
        bf16x8 pmv = (bf16x8){0, 0, 0, 0, 0, 0, 0, 0}, ppv = pmv;
        if (s > 0) pmv = *(const bf16x8*)(r0 - 1024 + 512 + c8);
        if (s < S - 1) ppv = *(const bf16x8*)(r0 + 1024 + 512 + c8);
        const float* cw = ((const float*)(const GAS float*)F.in[8]) + l * 3 * CW + c8;
        float o[8];
#pragma unroll
        for (int e = 0; e < 8; ++e) o[e] = bf2f(cb[e]) * (cw[e] * bf2f(pmv[e]) + cw[CW + e] * bf2f(p0v[e]) + cw[2 * CW + e] * bf2f(ppv[e]));
        v4u w; w.x = pk2(o[0], o[1]); w.y = pk2(o[2], o[3]); w.z = pk2(o[4], o[5]); w.w = pk2(o[6], o[7]);
        *(v4u*)(U + (size_t)t * CW + c8) = w;
    }
}

__device__ __forceinline__ float row16_sum(float v) { return row16_sum_dpp(v); }
__device__ __forceinline__ void step_e(Frame& F, int l) {
    fresh_tid(F);
    const bf16* QRAW = WSP(bf16, WS_QRAW); const bf16* SMALL = WSP(bf16, WS_SMALL);
    const f32x2* ROPE = WSP(f32x2, WS_ROPE);
    bf16* Q = WSP(bf16, WS_Q);
    const int gw = F.bid * NWAVES + F.wave, NGW = F.G * NWAVES;
    const int j = F.lane & 15, hh = F.lane >> 4; const bool act = j < 12, isrope = j >= 8 && act;
    const int jc = act ? j : 0;
    const float* gqp = ((const float*)(const GAS float*)F.in[13]) + l * DQK + 8 * jc;
    const f32x4 gq0 = *(const f32x4*)gqp, gq1 = *(const f32x4*)(gqp + 4);
    const float sgn = (j >= 10) ? 1.f : -1.f;
    for (int t = gw; t < T; t += NGW) {
        const int b = t / S, s = t % S;
        const bf16x8 xs = *(const bf16x8*)(SMALL + (size_t)t * 512 + 8 * (F.lane & 31));
        const f32x4* rp = (const f32x4*)(ROPE + (size_t)t * 16 + 8 * (j & 1));
        const f32x4 r0 = rp[0], r1 = rp[1], r2 = rp[2], r3 = rp[3];
        bf16x8 xq[2];
#pragma unroll
        for (int pass = 0; pass < 2; ++pass) xq[pass] = *(const bf16x8*)(QRAW + (size_t)t * 768 + (pass * 4 + hh) * 96 + 8 * jc);
        float sq = 0.f;
#pragma unroll
        for (int e = 0; e < 8; ++e) { const float f = bf2f(xs[e]); sq += f * f; }
        const float rsq = 1.0f / sqrtf(wave_sum(F.lane < 32 ? sq : 0.f, F.lane) * (1.f / 256.f) + EPS);
        float cs[8], sn[8];
        cs[0] = r0.x; sn[0] = r0.y; cs[1] = r0.z; sn[1] = r0.w; cs[2] = r1.x; sn[2] = r1.y; cs[3] = r1.z; sn[3] = r1.w;
        cs[4] = r2.x; sn[4] = r2.y; cs[5] = r2.z; sn[5] = r2.w; cs[6] = r3.x; sn[6] = r3.y; cs[7] = r3.z; sn[7] = r3.w;
#pragma unroll
        for (int pass = 0; pass < 2; ++pass) {
            const int h = pass * 4 + hh;
            const size_t orow = ((size_t)(b * H + h) * S + s);
            const bf16x8 x = xq[pass];
            float v[8]; float ss = 0.f;
#pragma unroll
            for (int e = 0; e < 8; ++e) { v[e] = act ? bf2f(x[e]) * rsq : 0.f; ss += v[e] * v[e]; }
            const float r = 1.0f / sqrtf(row16_sum(ss) * (1.f / 96.f) + EPS);
#pragma unroll
            for (int e = 0; e < 8; ++e) v[e] = v[e] * r * (e < 4 ? gq0[e & 3] : gq1[e & 3]);
#pragma unroll
            for (int e = 0; e < 8; ++e) { const float p = xor_lane<2>(v[e]); if (isrope) v[e] = v[e] * cs[e] + sgn * p * sn[e]; }
            if (act) { v4u w; w.x = pk2(v[0] * QSCALE, v[1] * QSCALE); w.y = pk2(v[2] * QSCALE, v[3] * QSCALE); w.z = pk2(v[4] * QSCALE, v[5] * QSCALE); w.w = pk2(v[6] * QSCALE, v[7] * QSCALE);
                *(v4u*)(Q + orow * 96 + 8 * j) = w; }
        }
    }
}

__device__ __forceinline__ void step_f(Frame& F) {
    fresh_tid(F);
    const bf16* Q = WSP(bf16, WS_Q); const bf16* K = WSP(bf16, WS_K); const bf16* V = WSP(bf16, WS_V); bf16* O = WSP(bf16, WS_O);
    const int gw = F.bid * NWAVES + F.wave, NGW = F.G * NWAVES;
    for (int it = gw; it < NB * H * (S / 64) * 2; it += NGW) {
        const int half = it & 1, it2 = it >> 1;
        const int bh = it2 / (S / 64), qi = (it2 % (S / 64)) * 64 + F.lane;
        bf16x8 q[12]; float o[32];
#pragma unroll
        for (int c = 0; c < 12; ++c) q[c] = *(const bf16x8*)(Q + ((size_t)bh * S + qi) * 96 + c * 8);
#pragma unroll
        for (int d = 0; d < 32; ++d) o[d] = 0.f;
        float m = -1e30f, lsum = 0.f;
        const bf16* kb = K + (size_t)bh * S * 96; const bf16* vb = V + (size_t)bh * S * 64 + half * 32;
#pragma unroll 1
        for (int j = 0; j < S; j += 2) {
            float sc[2];
#pragma unroll
            for (int i = 0; i < 2; ++i) { float a = 0.f;
#pragma unroll
                for (int c = 0; c < 12; ++c) { const bf16x8 kk = *(const bf16x8*)(kb + (size_t)(j + i) * 96 + c * 8);
#pragma unroll
                    for (int e = 0; e < 8; ++e) a += bf2f(q[c][e]) * bf2f(kk[e]); }
                sc[i] = a; asm volatile("" ::: "memory"); }
            const float mn = fmaxf(m, fmaxf(sc[0], sc[1]));
            const float alpha = exp2f(m - mn), p0 = exp2f(sc[0] - mn), p1 = exp2f(sc[1] - mn);
            lsum = lsum * alpha + (p0 + p1); m = mn;
#pragma unroll
            for (int c = 0; c < 4; ++c) {
                const bf16x8 v0 = *(const bf16x8*)(vb + (size_t)(j + 0) * 64 + c * 8), v1 = *(const bf16x8*)(vb + (size_t)(j + 1) * 64 + c * 8);
#pragma unroll
                for (int e = 0; e < 8; ++e) o[c * 8 + e] = o[c * 8 + e] * alpha + (p0 * bf2f(v0[e]) + p1 * bf2f(v1[e]));
                asm volatile("" ::: "memory");
            }
        }
        const float inv = 1.f / lsum; const int b = bh / H, h = bh % H;
        bf16* op = O + ((size_t)(b * S + qi)) * 512 + h * 64 + half * 32;
#pragma unroll
        for (int c = 0; c < 4; ++c) { v4u w; w.x = pk2(o[c * 8] * inv, o[c * 8 + 1] * inv); w.y = pk2(o[c * 8 + 2] * inv, o[c * 8 + 3] * inv); w.z = pk2(o[c * 8 + 4] * inv, o[c * 8 + 5] * inv);
            w.w = pk2(o[c * 8 + 6] * inv, o[c * 8 + 7] * inv); *(v4u*)(op + c * 8) = w; }
    }
}

__device__ __forceinline__ void route16(float myscore, float mybiased, int& e1, int& e2, float& w1, float& w2) {
    float scv[16], bi[16];
#pragma unroll
    for (int e = 0; e < 16; ++e) { scv[e] = __builtin_bit_cast(float, __builtin_amdgcn_readlane(__builtin_bit_cast(int, myscore), e)); bi[e] = __builtin_bit_cast(float, __builtin_amdgcn_readlane(__builtin_bit_cast(int, mybiased), e)); }
    float gs[4];
#pragma unroll
    for (int g = 0; g < 4; ++g) { const float a0 = bi[4 * g], a1 = bi[4 * g + 1], a2 = bi[4 * g + 2], a3 = bi[4 * g + 3];
        const float h1 = fmaxf(a0, a1), l1 = fminf(a0, a1), h2 = fmaxf(a2, a3), l2 = fminf(a2, a3);
        gs[g] = fmaxf(h1, h2) + fmaxf(fminf(h1, h2), fmaxf(l1, l2)); }
    int sg = 0; float bg = gs[0];
#pragma unroll
    for (int g = 1; g < 4; ++g) if (gs[g] > bg) { bg = gs[g]; sg = g; }
    float b0 = bi[0], b1 = bi[1], b2 = bi[2], b3 = bi[3], s0 = scv[0], s1 = scv[1], s2 = scv[2], s3 = scv[3];
#pragma unroll
    for (int g = 1; g < 4; ++g) if (sg == g) { b0 = bi[4 * g]; b1 = bi[4 * g + 1]; b2 = bi[4 * g + 2]; b3 = bi[4 * g + 3]; s0 = scv[4 * g]; s1 = scv[4 * g + 1]; s2 = scv[4 * g + 2]; s3 = scv[4 * g + 3]; }
    int i1 = 0; float m1 = b0, q1 = s0;
    if (b1 > m1) { m1 = b1; i1 = 1; q1 = s1; } if (b2 > m1) { m1 = b2; i1 = 2; q1 = s2; } if (b3 > m1) { m1 = b3; i1 = 3; q1 = s3; }
    int i2 = -1; float m2 = -1e30f, q2 = 0.f;
    if (i1 != 0 && (i2 < 0 || b0 > m2)) { m2 = b0; i2 = 0; q2 = s0; }
    if (i1 != 1 && (i2 < 0 || b1 > m2)) { m2 = b1; i2 = 1; q2 = s1; }
    if (i1 != 2 && (i2 < 0 || b2 > m2)) { m2 = b2; i2 = 2; q2 = s2; }
    if (i1 != 3 && (i2 < 0 || b3 > m2)) { m2 = b3; i2 = 3; q2 = s3; }
    const float inv = 1.f / (q1 + q2);
    e1 = 4 * sg + i1; e2 = 4 * sg + i2; w1 = q1 * inv; w2 = q2 * inv;
}
__device__ __forceinline__ void step_j(Frame& F, int l, bool dry = false) {
    fresh_tid(F);
    const bf16* X16 = WSP(bf16, WS_X16);
    const int gw = F.bid * NWAVES + F.wave, NGW = F.G * NWAVES;
    const float* MOD = WSP(float, WS_MOD); bf16* XN = WSP(bf16, WS_XN);
    int* TOKS = WSP(int, WS_TOKS); float* TOKW = WSP(float, WS_TOKW); int* LIST = WSP(int, WS_LIST);
    unsigned* cnt = F.ctl + CW_CNT + CNT_LS * l;
    LAS unsigned* lcnt = (LAS unsigned*)(F.lds + 65536); LAS unsigned* gbase = lcnt + 16; LAS unsigned* rinfo = (LAS unsigned*)(F.lds + 65536 + 256) + F.wave * 512;
    if (F.tid < 16) lcnt[F.tid] = 0u;
    __syncthreads();
    int ri = 0;
    LAS float* hrow = (LAS float*)(F.lds + F.wave * 8192);
    const int re = F.lane & 15, rq = F.lane >> 4;
    const float* wr = ((const float*)(const GAS float*)F.in[18]) + (size_t)(rq * 256) * NE + re;
    const float brt = ((const float*)(const GAS float*)F.in[19])[re];
    for (int row0 = gw; row0 < T; row0 += 2 * NGW) {
        const bool has1 = row0 + NGW < T;
        int rr[2]; rr[0] = row0; rr[1] = has1 ? row0 + NGW : row0;
        f32x4 v[2][4], g[4], sc[2][4], sh[2][4];
#pragma unroll
        for (int k = 0; k < 2; ++k)
#pragma unroll
            for (int j = 0; j < 4; ++j) { const bf16x4 t = *(const bf16x4*)(X16 + (size_t)rr[k] * D + 4 * F.lane + 256 * j); v[k][j] = (f32x4){bf2f(t[0]), bf2f(t[1]), bf2f(t[2]), bf2f(t[3])}; }
#pragma unroll
        for (int j = 0; j < 4; ++j) g[j] = *(const f32x4*)(((const float*)(const GAS float*)F.in[6]) + l * D + 4 * F.lane + 256 * j);
#pragma unroll
        for (int k = 0; k < 2; ++k) { const float* m = MOD + (l * 2 + rr[k] / S) * 6 * D;
#pragma unroll
            for (int j = 0; j < 4; ++j) { sc[k][j] = *(const f32x4*)(m + 4 * D + 4 * F.lane + 256 * j); sh[k][j] = *(const f32x4*)(m + 3 * D + 4 * F.lane + 256 * j); } }
        float ss[2];
#pragma unroll
        for (int k = 0; k < 2; ++k) { float a = 0.f;
#pragma unroll
            for (int j = 0; j < 4; ++j) a += (v[k][j].x * v[k][j].x + v[k][j].y * v[k][j].y) + (v[k][j].z * v[k][j].z + v[k][j].w * v[k][j].w);
            ss[k] = a; }
        const float rs0 = 1.0f / sqrtf(wave_sum(ss[0], F.lane) * (1.f / D) + EPS), rs1 = 1.0f / sqrtf(wave_sum(ss[1], F.lane) * (1.f / D) + EPS);
#pragma unroll
        for (int k = 0; k < 2; ++k) { const float rs = k ? rs1 : rs0;
#pragma unroll
            for (int j = 0; j < 4; ++j) { const int col = 4 * F.lane + 256 * j; f32x4 hh;
#pragma unroll
                for (int e = 0; e < 4; ++e) hh[e] = v[k][j][e] * rs * g[j][e] * (1.f + sc[k][j][e]) + sh[k][j][e];
                v2u o; o.x = pk2(hh[0], hh[1]); o.y = pk2(hh[2], hh[3]);
                if (k == 0 || has1) *(v2u*)(XN + (size_t)rr[k] * D + col) = o;
                *(LAS f32x4*)(hrow + k * 1024 + col) = hh; } }
        asm volatile("s_waitcnt lgkmcnt(0)" ::: "memory");
        float a0 = 0.f, a1 = 0.f, a2 = 0.f, a3 = 0.f, c0 = 0.f, c1 = 0.f, c2 = 0.f, c3 = 0.f;
#pragma unroll 4
        for (int c = 0; c < 256; c += 4) {
            const f32x4 h0 = *(const LAS f32x4*)(hrow + rq * 256 + c), h1 = *(const LAS f32x4*)(hrow + 1024 + rq * 256 + c);
            const float w0 = wr[(size_t)(c + 0) * NE], w1 = wr[(size_t)(c + 1) * NE], w2 = wr[(size_t)(c + 2) * NE], w3 = wr[(size_t)(c + 3) * NE];
            a0 += h0.x * w0; a1 += h0.y * w1; a2 += h0.z * w2; a3 += h0.w * w3;
            c0 += h1.x * w0; c1 += h1.y * w1; c2 += h1.z * w2; c3 += h1.w * w3;
        }
        float z0 = (a0 + a1) + (a2 + a3), z1 = (c0 + c1) + (c2 + c3);
        z0 += bperm_xor(z0, F.lane, 16); z0 += bperm_xor(z0, F.lane, 32);
        z1 += bperm_xor(z1, F.lane, 16); z1 += bperm_xor(z1, F.lane, 32);
        asm volatile("s_waitcnt lgkmcnt(0)" ::: "memory");
#pragma unroll
        for (int k = 0; k < 2; ++k) {
            const float z = k ? z1 : z0;
            const float myscore = 1.f / (1.f + expf(-z)), mybiased = myscore + brt;
            int e1, e2; float w1, w2;
            route16(myscore, mybiased, e1, e2, w1, w2);
            if (F.lane == 0 && !dry && (k == 0 || has1)) {
                const unsigned p1 = __hip_atomic_fetch_add(lcnt + e1, 1u, __ATOMIC_RELAXED, __HIP_MEMORY_SCOPE_WORKGROUP), p2 = __hip_atomic_fetch_add(lcnt + e2, 1u, __ATOMIC_RELAXED, __HIP_MEMORY_SCOPE_WORKGROUP);
                LAS unsigned* r = rinfo + ri * 8;
                r[0] = (unsigned)rr[k]; r[1] = (unsigned)e1; r[2] = p1; r[3] = (unsigned)e2; r[4] = p2; r[5] = __builtin_bit_cast(unsigned, w1); r[6] = __builtin_bit_cast(unsigned, w2);
            }
            if (k == 0 || has1) ++ri;
        }
    }
    if (dry) return;
    __syncthreads();
    if (F.tid < 16) { const unsigned c = lcnt[F.tid]; gbase[F.tid] = c ? __hip_atomic_fetch_add(cnt + CNT_ES * F.tid, c, RLX_AGENT) : 0u; }
    __syncthreads();
    if (F.lane < ri) {
        const LAS unsigned* r = rinfo + F.lane * 8;
        const int row = (int)r[0], e1 = (int)r[1], e2 = (int)r[3]; const unsigned p1 = gbase[e1] + r[2], p2 = gbase[e2] + r[4];
        LIST[(size_t)e1 * T + p1] = 2 * row; LIST[(size_t)e2 * T + p2] = 2 * row + 1;
        TOKS[2 * row] = (e1 << 16) | (int)p1; TOKS[2 * row + 1] = (e2 << 16) | (int)p2;
        TOKW[2 * row] = __builtin_bit_cast(float, r[5]); TOKW[2 * row + 1] = __builtin_bit_cast(float, r[6]);
    }
}

__device__ __forceinline__ void step_j_old(Frame& F, int l, bool dry = false) {
    fresh_tid(F);
    const int gw = F.bid * NWAVES + F.wave, NGW = F.G * NWAVES;
    const float* MOD = WSP(float, WS_MOD); bf16* XN = WSP(bf16, WS_XN);
    int* TOKS = WSP(int, WS_TOKS); float* TOKW = WSP(float, WS_TOKW); int* LIST = WSP(int, WS_LIST);
    unsigned* cnt = F.ctl + CW_CNT + CNT_LS * l;
    for (int row = gw; row < T; row += NGW) {
        const int b = row / S;
        float ss = 0.f;
#pragma unroll
        for (int j = 0; j < 4; ++j) { const f32x4 vv = *(const f32x4*)(F.out + (size_t)row * D + 4 * F.lane + 256 * j); ss += (vv.x * vv.x + vv.y * vv.y) + (vv.z * vv.z + vv.w * vv.w); }
        const float rs = 1.0f / sqrtf(wave_sum(ss, F.lane) * (1.f / D) + EPS);
        const float* m = MOD + (l * 2 + b) * 6 * D;
        float lg[16];
#pragma unroll
        for (int e = 0; e < 16; ++e) lg[e] = 0.f;
#pragma unroll 1
        for (int j = 0; j < 4; ++j) {
            const int col = 4 * F.lane + 256 * j;
            const f32x4 vj = *(const f32x4*)(F.out + (size_t)row * D + col);
            const f32x4 g = *(const f32x4*)(((const float*)(const GAS float*)F.in[6]) + l * D + col), sc = *(const f32x4*)(m + 4 * D + col), sh = *(const f32x4*)(m + 3 * D + col);
            f32x4 hh;
#pragma unroll
            for (int e = 0; e < 4; ++e) hh[e] = vj[e] * rs * g[e] * (1.f + sc[e]) + sh[e];
            v2u o; o.x = pk2(hh[0], hh[1]); o.y = pk2(hh[2], hh[3]);
            *(v2u*)(XN + (size_t)row * D + col) = o;
#pragma unroll
            for (int i = 0; i < 4; ++i) {
                const float* wr = ((const float*)(const GAS float*)F.in[18]) + (size_t)(col + i) * NE;
                const f32x4 w0 = *(const f32x4*)(wr), w1 = *(const f32x4*)(wr + 4), w2 = *(const f32x4*)(wr + 8), w3 = *(const f32x4*)(wr + 12);
#pragma unroll
                for (int e = 0; e < 4; ++e) { lg[e] += hh[i] * w0[e]; lg[4 + e] += hh[i] * w1[e]; lg[8 + e] += hh[i] * w2[e]; lg[12 + e] += hh[i] * w3[e]; }
            }
        }
        float scv[16], bi[16];
#pragma unroll
        for (int e = 0; e < 16; ++e) { const float z = wave_sum(lg[e], F.lane); scv[e] = 1.f / (1.f + expf(-z)); bi[e] = scv[e] + ((const float*)(const GAS float*)F.in[19])[e]; }
        float gs[4];
#pragma unroll
        for (int g = 0; g < 4; ++g) { const float a0 = bi[4 * g], a1 = bi[4 * g + 1], a2 = bi[4 * g + 2], a3 = bi[4 * g + 3];
            const float h1 = fmaxf(a0, a1), l1 = fminf(a0, a1), h2 = fmaxf(a2, a3), l2 = fminf(a2, a3);
            gs[g] = fmaxf(h1, h2) + fmaxf(fminf(h1, h2), fmaxf(l1, l2)); }
        int sg = 0; float bg = gs[0];
#pragma unroll
        for (int g = 1; g < 4; ++g) if (gs[g] > bg) { bg = gs[g]; sg = g; }
        float b0 = bi[0], b1 = bi[1], b2 = bi[2], b3 = bi[3], s0 = scv[0], s1 = scv[1], s2 = scv[2], s3 = scv[3];
#pragma unroll
        for (int g = 1; g < 4; ++g) if (sg == g) { b0 = bi[4 * g]; b1 = bi[4 * g + 1]; b2 = bi[4 * g + 2]; b3 = bi[4 * g + 3]; s0 = scv[4 * g]; s1 = scv[4 * g + 1]; s2 = scv[4 * g + 2]; s3 = scv[4 * g + 3]; }
        int i1 = 0; float m1 = b0, q1 = s0;
        if (b1 > m1) { m1 = b1; i1 = 1; q1 = s1; } if (b2 > m1) { m1 = b2; i1 = 2; q1 = s2; } if (b3 > m1) { m1 = b3; i1 = 3; q1 = s3; }
        int i2 = -1; float m2 = -1e30f, q2 = 0.f;
        if (i1 != 0 && (i2 < 0 || b0 > m2)) { m2 = b0; i2 = 0; q2 = s0; }
        if (i1 != 1 && (i2 < 0 || b1 > m2)) { m2 = b1; i2 = 1; q2 = s1; }
        if (i1 != 2 && (i2 < 0 || b2 > m2)) { m2 = b2; i2 = 2; q2 = s2; }
        if (i1 != 3 && (i2 < 0 || b3 > m2)) { m2 = b3; i2 = 3; q2 = s3; }
        if (F.lane == 0 && !dry) {
            const int e1 = 4 * sg + i1, e2 = 4 * sg + i2; const float inv = 1.f / (q1 + q2);
            const unsigned p1 = __hip_atomic_fetch_add(cnt + CNT_ES * e1, 1u, RLX_AGENT), p2 = __hip_atomic_fetch_add(cnt + CNT_ES * e2, 1u, RLX_AGENT);
            LIST[(size_t)e1 * T + p1] = 2 * row; LIST[(size_t)e2 * T + p2] = 2 * row + 1;
            TOKS[2 * row] = (e1 << 16) | (int)p1; TOKS[2 * row + 1] = (e2 << 16) | (int)p2;
            TOKW[2 * row] = q1 * inv; TOKW[2 * row + 1] = q2 * inv;
        }
    }
}


namespace att {
typedef short sbf16x8 __attribute__((ext_vector_type(8)));
typedef short s16x4 __attribute__((ext_vector_type(4)));
typedef float f32x16 __attribute__((ext_vector_type(16)));
constexpr int NW = 8, QBLK = 32, KVBLK = 64;
constexpr int SHM_K = KVBLK * 256, SHM_V = KVBLK * 256;
constexpr int OFF_V = 0, OFF_K = 2 * SHM_V, OFF_WS = 2 * SHM_V + 2 * SHM_K, OFF_OST = OFF_WS + NW * 64 * 4, LDS_NEED = OFF_OST + NW * 4096;
static_assert(LDS_NEED <= 131072, "attention LDS");
constexpr float THR2 = 11.f;
#define ATT_KSWZ(row, colB) ((row) * 256 + ((colB) ^ (((row) & 15) << 4)))
#define ATT_SBAR() __builtin_amdgcn_sched_barrier(0)
__device__ __forceinline__ int crow(int r, int hi) { return (r & 3) + 8 * (r >> 2) + 4 * hi; }
__device__ __forceinline__ void partialSM(f32x16& p0, f32x16& p1) {
#pragma unroll
    for (int r = 0; r < 16; ++r) p0[r] = __builtin_amdgcn_exp2f(p0[r]);
}
__device__ __forceinline__ void finishSM(f32x16& p0, f32x16& p1, float& l_reg, sbf16x8& pa0, sbf16x8& pa1, sbf16x8& pa2, sbf16x8& pa3) {
#pragma unroll
    for (int r = 0; r < 16; ++r) p1[r] = __builtin_amdgcn_exp2f(p1[r]);
    float ps0 = 0.f, ps1 = 0.f;
#pragma unroll
    for (int r = 0; r < 16; ++r) { ps0 += p0[r]; ps1 += p1[r]; }
    l_reg += ps0 + ps1;
#define ATT_PK4(P, BASE, OUT) do { unsigned a0 = pk2(P[BASE + 0], P[BASE + 1]), a1 = pk2(P[BASE + 2], P[BASE + 3]);   \
    unsigned b0 = pk2(P[BASE + 4], P[BASE + 5]), b1 = pk2(P[BASE + 6], P[BASE + 7]);                              \
    auto r0 = __builtin_amdgcn_permlane32_swap(a0, b0, false, false); auto r1 = __builtin_amdgcn_permlane32_swap(a1, b1, false, false); \
    v4u w = {r0[0], r1[0], r0[1], r1[1]}; OUT = __builtin_bit_cast(sbf16x8, w); } while (0)
    ATT_PK4(p0, 0, pa0); ATT_PK4(p0, 8, pa1); ATT_PK4(p1, 0, pa2); ATT_PK4(p1, 8, pa3);
#undef ATT_PK4
}
__device__ __forceinline__ void qkt(f32x16& p0, f32x16& p1, const LAS char* Ks, const sbf16x8* qr, int r32, int hi) {
    asm volatile("" : "+v"(r32));
    p0 = f32x16{}; p1 = f32x16{};
    sbf16x8 c0 = *(const LAS sbf16x8*)(Ks + ATT_KSWZ(r32, (hi * 8) * 2)), c1 = *(const LAS sbf16x8*)(Ks + ATT_KSWZ(32 + r32, (hi * 8) * 2));
#pragma unroll
    for (int d0 = 0; d0 < 6; ++d0) {
        sbf16x8 n0 = c0, n1 = c1;
        if (d0 < 5) { const int cb = ((d0 + 1) * 16 + hi * 8) * 2; n0 = *(const LAS sbf16x8*)(Ks + ATT_KSWZ(r32, cb)); n1 = *(const LAS sbf16x8*)(Ks + ATT_KSWZ(32 + r32, cb)); }
        p0 = __builtin_amdgcn_mfma_f32_32x32x16_bf16(c0, qr[d0], p0, 0, 0, 0);
        p1 = __builtin_amdgcn_mfma_f32_32x32x16_bf16(c1, qr[d0], p1, 0, 0, 0);
        c0 = n0; c1 = n1;
    }
}
__device__ __forceinline__ int v_st(int k, int c) { const int kk = (k & ~0xC) | ((k & 4) << 1) | ((k & 8) >> 1); return ((kk >> 3) * 4 + (c >> 5)) * 512 + ((kk & 7) * 32 + (c & 31)) * 2; }
__device__ __forceinline__ int v_rd_base(int lane) { return ((lane & 3) << 3) | (((lane >> 2) & 3) << 6) | (((lane >> 4) & 1) << 5) | (((lane >> 5) & 1) << 8); }
constexpr int v_rd_off(int d0, int ks, int half) { return d0 * 512 + ks * 4096 + half * 2048; }
template <int OFF> __device__ __forceinline__ s16x4 tr_read(int vb) { s16x4 r; asm volatile("ds_read_b64_tr_b16 %0, %1 offset:%2" : "=&v"(r) : "v"(vb), "i"(OFF) : "memory"); return r; }
template <int D0> __device__ __forceinline__ void pv_one(f32x16& od, int vb, sbf16x8 pa0, sbf16x8 pa1, sbf16x8 pa2, sbf16x8 pa3) {
    const s16x4 l0 = tr_read<v_rd_off(D0, 0, 0)>(vb), h0 = tr_read<v_rd_off(D0, 0, 1)>(vb), l1 = tr_read<v_rd_off(D0, 1, 0)>(vb), h1 = tr_read<v_rd_off(D0, 1, 1)>(vb);
    const s16x4 l2 = tr_read<v_rd_off(D0, 2, 0)>(vb), h2 = tr_read<v_rd_off(D0, 2, 1)>(vb), l3 = tr_read<v_rd_off(D0, 3, 0)>(vb), h3 = tr_read<v_rd_off(D0, 3, 1)>(vb);
    asm volatile("s_waitcnt lgkmcnt(0)" ::: "memory"); ATT_SBAR();
#define ATT_PK(L, H) (sbf16x8){L[0], L[1], L[2], L[3], H[0], H[1], H[2], H[3]}
    od = __builtin_amdgcn_mfma_f32_32x32x16_bf16(pa0, ATT_PK(l0, h0), od, 0, 0, 0);
    od = __builtin_amdgcn_mfma_f32_32x32x16_bf16(pa1, ATT_PK(l1, h1), od, 0, 0, 0);
    od = __builtin_amdgcn_mfma_f32_32x32x16_bf16(pa2, ATT_PK(l2, h2), od, 0, 0, 0);
    od = __builtin_amdgcn_mfma_f32_32x32x16_bf16(pa3, ATT_PK(l3, h3), od, 0, 0, 0);
#undef ATT_PK
}
__device__ __forceinline__ void pv2(f32x16* o, int vb, sbf16x8 pa0, sbf16x8 pa1, sbf16x8 pa2, sbf16x8 pa3) { pv_one<0>(o[0], vb, pa0, pa1, pa2, pa3); pv_one<1>(o[1], vb, pa0, pa1, pa2, pa3); }

__device__ __forceinline__ void attn_unit(const bf16* Qb, const bf16* Kh, const bf16* Vh, bf16* Ob, int seq, LAS char* lds, int tid) {
    const int wid = __builtin_amdgcn_readfirstlane(tid >> 6), lane = tid & 63, r32 = lane & 31, hi = lane >> 5; int lane2;
    LAS char* V_lds = lds + OFF_V; LAS char* K_lds = lds + OFF_K;
    LAS float* ws = (LAS float*)(lds + OFF_WS) + wid * 64; LAS float* li_l = ws;
    float l_reg = 0.f; f32x16 o[2]; o[0] = f32x16{}; o[1] = f32x16{}; sbf16x8 qr[6];
    const bf16* Qw = Qb + (size_t)(wid * QBLK + r32) * 96 + hi * 8;
#pragma unroll
    for (int d0 = 0; d0 < 6; ++d0) qr[d0] = *(const GAS sbf16x8*)((const GAS bf16*)Qw + d0 * 16);
    const int kc1 = 512 + (tid & 255), kr0 = tid / 12, kq0 = (tid % 12) * 8, kr1 = kc1 / 12, kq1 = (kc1 % 12) * 8;
    const int ksto0 = ATT_KSWZ(kr0, kq0 * 2), ksto1 = ATT_KSWZ(kr1, kq1 * 2);
    const int vr = tid >> 3, vq = (tid & 7) * 8, vsto = v_st(vr, vq);
    const int vb0 = (int)(unsigned)(size_t)V_lds + v_rd_base(lane);
    const unsigned ko0 = (unsigned)(kr0 * 96 + kq0) * 2u, ko1 = (unsigned)(kr1 * 96 + kq1) * 2u, vo = (unsigned)(vr * 64 + vq) * 2u;
    sbf16x8 sk0[2], sk1[2], sv[2];
    const GAS char* Kg = (const GAS char*)Kh; const GAS char* Vg = (const GAS char*)Vh;
#define ATT_SLOAD(i, k0) do { sk0[i] = *(const GAS sbf16x8*)(Kg + (ko0 + (unsigned)(k0) * 192u)); sk1[i] = *(const GAS sbf16x8*)(Kg + (ko1 + (unsigned)(k0) * 192u)); sv[i] = *(const GAS sbf16x8*)(Vg + (vo + (unsigned)(k0) * 128u)); } while (0)
#define ATT_SWRITE(b, i) do { *(LAS sbf16x8*)(K_lds + (b) * SHM_K + ksto0) = sk0[i]; *(LAS sbf16x8*)(K_lds + (b) * SHM_K + ksto1) = sk1[i]; *(LAS sbf16x8*)(V_lds + (b) * SHM_V + vsto) = sv[i]; } while (0)
#define ATT_SWAIT() asm volatile("s_waitcnt vmcnt(3)" ::: "memory")
    f32x16 pA0, pA1, pB0, pB1; sbf16x8 pa0, pa1, pa2, pa3; const int NT = seq / KVBLK;
    ATT_SLOAD(0, 0); asm volatile("s_waitcnt vmcnt(0)" ::: "memory"); ATT_SWRITE(0, 0); __syncthreads();
    qkt(pA0, pA1, K_lds, qr, r32, hi); partialSM(pA0, pA1);
    ATT_SLOAD(1, KVBLK); if (2 < NT) ATT_SLOAD(0, 2 * KVBLK);
    ATT_SWAIT(); ATT_SWRITE(1, 1); __syncthreads();
#pragma unroll 1
    for (int j = 1; j + 1 < NT; j += 2) {
        ATT_SBAR(); qkt(pB0, pB1, K_lds + SHM_K, qr, r32, hi);
        finishSM(pA0, pA1, l_reg, pa0, pa1, pa2, pa3); ATT_SBAR();
        ATT_SLOAD(1, (j + 2) * KVBLK); ATT_SBAR();
        pv2(o, vb0, pa0, pa1, pa2, pa3); partialSM(pB0, pB1);
        __syncthreads(); ATT_SWAIT(); ATT_SWRITE(0, 0);
        __syncthreads();
        ATT_SBAR(); qkt(pA0, pA1, K_lds, qr, r32, hi);
        finishSM(pB0, pB1, l_reg, pa0, pa1, pa2, pa3); ATT_SBAR();
        if (j + 3 < NT) ATT_SLOAD(0, (j + 3) * KVBLK); ATT_SBAR();
        pv2(o, vb0 + SHM_V, pa0, pa1, pa2, pa3); partialSM(pA0, pA1);
        __syncthreads(); ATT_SWAIT(); ATT_SWRITE(1, 1);
        __syncthreads();
    }
    ATT_SBAR(); qkt(pB0, pB1, K_lds + SHM_K, qr, r32, hi);
    finishSM(pA0, pA1, l_reg, pa0, pa1, pa2, pa3); ATT_SBAR();
    pv2(o, vb0, pa0, pa1, pa2, pa3); partialSM(pB0, pB1);
    __syncthreads();
    finishSM(pB0, pB1, l_reg, pa0, pa1, pa2, pa3); ATT_SBAR();
    pv2(o, vb0 + SHM_V, pa0, pa1, pa2, pa3);
    { auto rr = __builtin_amdgcn_permlane32_swap(__float_as_uint(l_reg), __float_as_uint(l_reg), false, false); l_reg = __uint_as_float(rr[0]) + __uint_as_float(rr[1]); }
    { unsigned z_ = 0u; asm volatile("" : "+v"(z_)); lane2 = (int)__builtin_amdgcn_mbcnt_hi(~0u, __builtin_amdgcn_mbcnt_lo(~0u, z_)); }
    const int r32e = lane2 & 31, hie = lane2 >> 5;
    if (hie == 0) li_l[r32e] = l_reg; asm volatile("s_waitcnt lgkmcnt(0)" ::: "memory");
    float rli[16];
#pragma unroll
    for (int r = 0; r < 16; ++r) rli[r] = __builtin_amdgcn_rcpf(li_l[crow(r, hie)]);
    LAS bf16* stg = (LAS bf16*)(lds + OFF_OST) + wid * 2048;
#pragma unroll
    for (int r = 0; r < 16; ++r) { const int orow = crow(r, hie);
#pragma unroll
        for (int d0 = 0; d0 < 2; ++d0) stg[orow * 64 + d0 * 32 + r32e] = (bf16)(pk2(o[d0][r] * rli[r], 0.f) & 0xffffu); }
    asm volatile("s_waitcnt lgkmcnt(0)" ::: "memory");
    bf16* Ow = Ob + (size_t)(wid * QBLK) * 512;
#pragma unroll
    for (int i = 0; i < 4; ++i) { const int row = i * 8 + (lane2 >> 3), ch = lane2 & 7; const v4u v = *(const LAS v4u*)(stg + row * 64 + ch * 8); *(GAS v4u*)((GAS bf16*)Ow + (size_t)row * 512 + ch * 8) = v; }
    asm volatile("s_waitcnt lgkmcnt(0)" ::: "memory");
#undef ATT_SLOAD
#undef ATT_SWRITE
#undef ATT_SWAIT
}
__device__ __forceinline__ void softmax_pack(f32x16& p0, f32x16& p1, float& l_reg, sbf16x8& pa0, sbf16x8& pa1, sbf16x8& pa2, sbf16x8& pa3) {
#pragma unroll
    for (int r = 0; r < 16; ++r) p0[r] = __builtin_amdgcn_exp2f(p0[r]);
#pragma unroll
    for (int r = 0; r < 16; ++r) p1[r] = __builtin_amdgcn_exp2f(p1[r]);
    float ps0 = 0.f, ps1 = 0.f;
#pragma unroll
    for (int r = 0; r < 16; ++r) { ps0 += p0[r]; ps1 += p1[r]; }
    l_reg += ps0 + ps1;
#define ATT_PK4(P, BASE, OUT) do { unsigned a0 = pk2(P[BASE + 0], P[BASE + 1]), a1 = pk2(P[BASE + 2], P[BASE + 3]);   \
    unsigned b0 = pk2(P[BASE + 4], P[BASE + 5]), b1 = pk2(P[BASE + 6], P[BASE + 7]);                              \
    auto r0 = __builtin_amdgcn_permlane32_swap(a0, b0, false, false); auto r1 = __builtin_amdgcn_permlane32_swap(a1, b1, false, false); \
    v4u w = {r0[0], r1[0], r0[1], r1[1]}; OUT = __builtin_bit_cast(sbf16x8, w); } while (0)
    ATT_PK4(p0, 0, pa0); ATT_PK4(p0, 8, pa1); ATT_PK4(p1, 0, pa2); ATT_PK4(p1, 8, pa3);
#undef ATT_PK4
}
__device__ __forceinline__ void qkt2(f32x16& x0, f32x16& x1, f32x16& y0, f32x16& y1, const LAS char* Ks, const sbf16x8* qx, const sbf16x8* qy, int r32, int hi) {
    asm volatile("" : "+v"(r32));
    x0 = f32x16{}; x1 = f32x16{}; y0 = f32x16{}; y1 = f32x16{};
    sbf16x8 c0 = *(const LAS sbf16x8*)(Ks + ATT_KSWZ(r32, (hi * 8) * 2)), c1 = *(const LAS sbf16x8*)(Ks + ATT_KSWZ(32 + r32, (hi * 8) * 2));
#pragma unroll
    for (int d0 = 0; d0 < 6; ++d0) {
        sbf16x8 n0 = c0, n1 = c1;
        if (d0 < 5) { const int cb = ((d0 + 1) * 16 + hi * 8) * 2; n0 = *(const LAS sbf16x8*)(Ks + ATT_KSWZ(r32, cb)); n1 = *(const LAS sbf16x8*)(Ks + ATT_KSWZ(32 + r32, cb)); }
        x0 = __builtin_amdgcn_mfma_f32_32x32x16_bf16(c0, qx[d0], x0, 0, 0, 0);
        x1 = __builtin_amdgcn_mfma_f32_32x32x16_bf16(c1, qx[d0], x1, 0, 0, 0);
        y0 = __builtin_amdgcn_mfma_f32_32x32x16_bf16(c0, qy[d0], y0, 0, 0, 0);
        y1 = __builtin_amdgcn_mfma_f32_32x32x16_bf16(c1, qy[d0], y1, 0, 0, 0);
        c0 = n0; c1 = n1;
    }
}
template <int D0> __device__ __forceinline__ void pv_one2(f32x16& ox, f32x16& oy, int vb, const sbf16x8 (&px)[4], const sbf16x8 (&py)[4]) {
    const s16x4 l0 = tr_read<v_rd_off(D0, 0, 0)>(vb), h0 = tr_read<v_rd_off(D0, 0, 1)>(vb), l1 = tr_read<v_rd_off(D0, 1, 0)>(vb), h1 = tr_read<v_rd_off(D0, 1, 1)>(vb);
    const s16x4 l2 = tr_read<v_rd_off(D0, 2, 0)>(vb), h2 = tr_read<v_rd_off(D0, 2, 1)>(vb), l3 = tr_read<v_rd_off(D0, 3, 0)>(vb), h3 = tr_read<v_rd_off(D0, 3, 1)>(vb);
    asm volatile("s_waitcnt lgkmcnt(0)" ::: "memory"); ATT_SBAR();
#define ATT_PK(L, H) (sbf16x8){L[0], L[1], L[2], L[3], H[0], H[1], H[2], H[3]}
    ox = __builtin_amdgcn_mfma_f32_32x32x16_bf16(px[0], ATT_PK(l0, h0), ox, 0, 0, 0);
    oy = __builtin_amdgcn_mfma_f32_32x32x16_bf16(py[0], ATT_PK(l0, h0), oy, 0, 0, 0);
    ox = __builtin_amdgcn_mfma_f32_32x32x16_bf16(px[1], ATT_PK(l1, h1), ox, 0, 0, 0);
    oy = __builtin_amdgcn_mfma_f32_32x32x16_bf16(py[1], ATT_PK(l1, h1), oy, 0, 0, 0);
    ox = __builtin_amdgcn_mfma_f32_32x32x16_bf16(px[2], ATT_PK(l2, h2), ox, 0, 0, 0);
    oy = __builtin_amdgcn_mfma_f32_32x32x16_bf16(py[2], ATT_PK(l2, h2), oy, 0, 0, 0);
    ox = __builtin_amdgcn_mfma_f32_32x32x16_bf16(px[3], ATT_PK(l3, h3), ox, 0, 0, 0);
    oy = __builtin_amdgcn_mfma_f32_32x32x16_bf16(py[3], ATT_PK(l3, h3), oy, 0, 0, 0);
#undef ATT_PK
}
__device__ __forceinline__ void softmax_half(f32x16& p, float& l_reg, sbf16x8& pa, sbf16x8& pb) {
#pragma unroll
    for (int r = 0; r < 16; ++r) p[r] = __builtin_amdgcn_exp2f(p[r]);
    float ps0 = 0.f, ps1 = 0.f;
#pragma unroll
    for (int r = 0; r < 8; ++r) { ps0 += p[r]; ps1 += p[8 + r]; }
    l_reg += ps0 + ps1;
    { v4u w; w.x = pk2(p[0], p[1]); w.y = pk2(p[2], p[3]); w.z = pk2(p[4], p[5]); w.w = pk2(p[6], p[7]); pa = __builtin_bit_cast(sbf16x8, w); }
    { v4u w; w.x = pk2(p[8], p[9]); w.y = pk2(p[10], p[11]); w.z = pk2(p[12], p[13]); w.w = pk2(p[14], p[15]); pb = __builtin_bit_cast(sbf16x8, w); }
}
template <int ROW0> __device__ __forceinline__ void qk_half(f32x16& x, f32x16& y, const LAS char* Ks, const sbf16x8* qx, const sbf16x8* qy, int r32, int hi) {
    asm volatile("" : "+v"(r32));
    x = f32x16{}; y = f32x16{};
    sbf16x8 c = *(const LAS sbf16x8*)(Ks + ATT_KSWZ(ROW0 + r32, (hi * 8) * 2));
#pragma unroll
    for (int d0 = 0; d0 < 6; ++d0) {
        sbf16x8 n = c;
        if (d0 < 5) n = *(const LAS sbf16x8*)(Ks + ATT_KSWZ(ROW0 + r32, ((d0 + 1) * 16 + hi * 8) * 2));
        x = __builtin_amdgcn_mfma_f32_32x32x16_bf16(c, qx[d0], x, 0, 0, 0);
        y = __builtin_amdgcn_mfma_f32_32x32x16_bf16(c, qy[d0], y, 0, 0, 0);
        c = n;
    }
}
template <int KS0> __device__ __forceinline__ void pv_half(f32x16* ox, f32x16* oy, int vb, sbf16x8 pxa, sbf16x8 pxb, sbf16x8 pya, sbf16x8 pyb) {
    const s16x4 l00 = tr_read<v_rd_off(0, KS0, 0)>(vb), h00 = tr_read<v_rd_off(0, KS0, 1)>(vb), l01 = tr_read<v_rd_off(0, KS0 + 1, 0)>(vb), h01 = tr_read<v_rd_off(0, KS0 + 1, 1)>(vb);
    const s16x4 l10 = tr_read<v_rd_off(1, KS0, 0)>(vb), h10 = tr_read<v_rd_off(1, KS0, 1)>(vb), l11 = tr_read<v_rd_off(1, KS0 + 1, 0)>(vb), h11 = tr_read<v_rd_off(1, KS0 + 1, 1)>(vb);
    asm volatile("s_waitcnt lgkmcnt(0)" ::: "memory"); ATT_SBAR();
#define ATT_PK(L, H) (sbf16x8){L[0], L[1], L[2], L[3], H[0], H[1], H[2], H[3]}
    ox[0] = __builtin_amdgcn_mfma_f32_32x32x16_bf16(ATT_PK(l00, h00), pxa, ox[0], 0, 0, 0);
    oy[0] = __builtin_amdgcn_mfma_f32_32x32x16_bf16(ATT_PK(l00, h00), pya, oy[0], 0, 0, 0);
    ox[1] = __builtin_amdgcn_mfma_f32_32x32x16_bf16(ATT_PK(l10, h10), pxa, ox[1], 0, 0, 0);
    oy[1] = __builtin_amdgcn_mfma_f32_32x32x16_bf16(ATT_PK(l10, h10), pya, oy[1], 0, 0, 0);
    ox[0] = __builtin_amdgcn_mfma_f32_32x32x16_bf16(ATT_PK(l01, h01), pxb, ox[0], 0, 0, 0);
    oy[0] = __builtin_amdgcn_mfma_f32_32x32x16_bf16(ATT_PK(l01, h01), pyb, oy[0], 0, 0, 0);
    ox[1] = __builtin_amdgcn_mfma_f32_32x32x16_bf16(ATT_PK(l11, h11), pxb, ox[1], 0, 0, 0);
    oy[1] = __builtin_amdgcn_mfma_f32_32x32x16_bf16(ATT_PK(l11, h11), pyb, oy[1], 0, 0, 0);
#undef ATT_PK
}
constexpr int OFF2_V = 0, OFF2_K = 2 * SHM_V, OFF2_WS = 2 * SHM_V + 2 * SHM_K;
__device__ __forceinline__ void attn_unit2(const bf16* Qb, const bf16* Kh, const bf16* Vh, bf16* Ob, int seq, LAS char* lds, int tid) {
    const int wid = __builtin_amdgcn_readfirstlane(tid >> 6), lane = tid & 63, r32 = lane & 31, hi = lane >> 5; int lane2;
    LAS char* V_lds = lds + OFF2_V; LAS char* K_lds = lds + OFF2_K;
    LAS float* ws = (LAS float*)(lds + OFF2_WS) + wid * 64;
    float lx = 0.f, ly = 0.f; f32x16 ox[2], oy[2]; ox[0] = f32x16{}; ox[1] = f32x16{}; oy[0] = f32x16{}; oy[1] = f32x16{}; sbf16x8 qx[6], qy[6];
    { const GAS bf16* Qw = (const GAS bf16*)Qb + (size_t)(wid * 64 + r32) * 96 + hi * 8;
#pragma unroll
      for (int d0 = 0; d0 < 6; ++d0) { qx[d0] = *(const GAS sbf16x8*)(Qw + d0 * 16); qy[d0] = *(const GAS sbf16x8*)(Qw + 32 * 96 + d0 * 16); } }
    const int kc1 = 512 + (tid & 255), kr0 = tid / 12, kq0 = (tid % 12) * 8, kr1 = kc1 / 12, kq1 = (kc1 % 12) * 8;
    const int ksto0 = ATT_KSWZ(kr0, kq0 * 2), ksto1 = ATT_KSWZ(kr1, kq1 * 2);
    const int vr = tid >> 3, vq = (tid & 7) * 8, vsto = v_st(vr, vq);
    const int vb0 = (int)(unsigned)(size_t)V_lds + v_rd_base(lane);
    const unsigned ko0 = (unsigned)(kr0 * 96 + kq0) * 2u, ko1 = (unsigned)(kr1 * 96 + kq1) * 2u, vo = (unsigned)(vr * 64 + vq) * 2u;
    const GAS char* Kg = (const GAS char*)Kh; const GAS char* Vg = (const GAS char*)Vh;
    sbf16x8 sk0, sk1, sv;
#define ATT2_SLOAD(k0) do { sk0 = *(const GAS sbf16x8*)(Kg + (ko0 + (unsigned)(k0) * 192u)); sk1 = *(const GAS sbf16x8*)(Kg + (ko1 + (unsigned)(k0) * 192u)); sv = *(const GAS sbf16x8*)(Vg + (vo + (unsigned)(k0) * 128u)); } while (0)
#define ATT2_SWRITE(b) do { *(LAS sbf16x8*)(K_lds + (b) * SHM_K + ksto0) = sk0; *(LAS sbf16x8*)(K_lds + (b) * SHM_K + ksto1) = sk1; *(LAS sbf16x8*)(V_lds + (b) * SHM_V + vsto) = sv; } while (0)
    const int NT = seq / KVBLK;
    ATT2_SLOAD(0); ATT2_SWRITE(0); __syncthreads();
    f32x16 x0, x1, y0, y1; sbf16x8 px[4], py[4];
#pragma unroll 1
    for (int j = 0; j < NT; ++j) {
        const int b = j & 1;
        if (j + 1 < NT) ATT2_SLOAD((j + 1) * KVBLK);
        ATT_SBAR();
        qk_half<0>(x0, y0, K_lds + b * SHM_K, qx, qy, r32, hi);
        ATT_SBAR();
        qk_half<32>(x1, y1, K_lds + b * SHM_K, qx, qy, r32, hi);
        softmax_half(x0, lx, px[0], px[1]); softmax_half(y0, ly, py[0], py[1]);
        ATT_SBAR();
        pv_half<0>(ox, oy, vb0 + b * SHM_V, px[0], px[1], py[0], py[1]);
        softmax_half(x1, lx, px[2], px[3]); softmax_half(y1, ly, py[2], py[3]);
        ATT_SBAR();
        pv_half<2>(ox, oy, vb0 + b * SHM_V, px[2], px[3], py[2], py[3]);
        ATT_SBAR();
        if (j + 1 < NT) ATT2_SWRITE(b ^ 1);
        __syncthreads();
    }
#undef ATT2_SLOAD
#undef ATT2_SWRITE
    { auto rr = __builtin_amdgcn_permlane32_swap(__float_as_uint(lx), __float_as_uint(lx), false, false); lx = __uint_as_float(rr[0]) + __uint_as_float(rr[1]); }
    { auto rr = __builtin_amdgcn_permlane32_swap(__float_as_uint(ly), __float_as_uint(ly), false, false); ly = __uint_as_float(rr[0]) + __uint_as_float(rr[1]); }
    { unsigned z_ = 0u; asm volatile("" : "+v"(z_)); lane2 = (int)__builtin_amdgcn_mbcnt_hi(~0u, __builtin_amdgcn_mbcnt_lo(~0u, z_)); }
    const int r32e = lane2 & 31, hie = lane2 >> 5;
    if (hie == 0) { ws[r32e] = lx; ws[32 + r32e] = ly; }
    asm volatile("s_waitcnt lgkmcnt(0)" ::: "memory");
    LAS bf16* stg = (LAS bf16*)(lds + wid * 8192);
#pragma unroll
    for (int r = 0; r < 16; ++r) { const int orow = crow(r, hie); const float rlx = __builtin_amdgcn_rcpf(ws[orow]), rly = __builtin_amdgcn_rcpf(ws[32 + orow]);
#pragma unroll
        for (int d0 = 0; d0 < 2; ++d0) { stg[orow * 64 + d0 * 32 + r32e] = (bf16)(pk2(ox[d0][r] * rlx, 0.f) & 0xffffu); stg[(32 + orow) * 64 + d0 * 32 + r32e] = (bf16)(pk2(oy[d0][r] * rly, 0.f) & 0xffffu); } }
    asm volatile("s_waitcnt lgkmcnt(0)" ::: "memory");
    GAS bf16* Ow = (GAS bf16*)Ob + (size_t)(wid * 64) * 512;
#pragma unroll
    for (int i = 0; i < 8; ++i) { const int row = i * 8 + (lane2 >> 3), ch = lane2 & 7; const v4u v = *(const LAS v4u*)(stg + row * 64 + ch * 8); *(GAS v4u*)(Ow + (size_t)row * 512 + ch * 8) = v; }
    asm volatile("s_waitcnt lgkmcnt(0)" ::: "memory");
}
constexpr int OFF4_K = 0, OFF4_V = 3 * SHM_K, OFF4_WS = 3 * SHM_K + 3 * SHM_V;
static_assert(OFF4_WS + NW * 64 * 4 <= 131072, "attention LDS");
__device__ __forceinline__ void attn_unit4(const bf16* Qb, const bf16* Kh, const bf16* Vh, bf16* Ob, int seq, LAS char* lds, int tid) {
    const int wid = __builtin_amdgcn_readfirstlane(tid >> 6), lane = tid & 63, r32 = lane & 31, hi = lane >> 5; int lane2;
    LAS char* K_lds = lds + OFF4_K; LAS char* V_lds = lds + OFF4_V;
    LAS float* ws = (LAS float*)(lds + OFF4_WS) + wid * 64;
    float lx = 0.f, ly = 0.f; f32x16 ox[2], oy[2]; ox[0] = f32x16{}; ox[1] = f32x16{}; oy[0] = f32x16{}; oy[1] = f32x16{}; sbf16x8 qx[6], qy[6];
    { const GAS bf16* Qw = (const GAS bf16*)Qb + (size_t)(wid * 64 + r32) * 96 + hi * 8;
#pragma unroll
      for (int d0 = 0; d0 < 6; ++d0) { qx[d0] = *(const GAS sbf16x8*)(Qw + d0 * 16); qy[d0] = *(const GAS sbf16x8*)(Qw + 32 * 96 + d0 * 16); } }
    const int rowA = 4 * wid + (lane >> 4), chA = (lane & 15) ^ (rowA & 15);
    const unsigned kofA = (unsigned)(rowA * 96 + (chA < 12 ? chA * 8 : 0)) * 2u, kofB = kofA + 32u * 192u;
    const int kkv = wid * 8 + ((lane & 31) >> 2), kv = kkv;
    const unsigned vof = (unsigned)(kv * 64 + (lane >> 5) * 32 + (lane & 3) * 8) * 2u;
    const GAS char* Kg = (const GAS char*)Kh; const GAS char* Vg = (const GAS char*)Vh;
    const int vb0 = (int)(unsigned)(size_t)V_lds + v_rd_base(lane);
#define ATT4_DMA(t, slot) do { \
    __builtin_amdgcn_global_load_lds((const GAS unsigned*)(Kg + (kofA + (unsigned)(t) * (64u * 192u))), (LAS unsigned*)(K_lds + (slot) * SHM_K + wid * 1024), 16, 0, 0); \
    __builtin_amdgcn_global_load_lds((const GAS unsigned*)(Kg + (kofB + (unsigned)(t) * (64u * 192u))), (LAS unsigned*)(K_lds + (slot) * SHM_K + (wid + 8) * 1024), 16, 0, 0); \
    __builtin_amdgcn_global_load_lds((const GAS unsigned*)(Vg + (vof + (unsigned)(t) * (64u * 128u))), (LAS unsigned*)(V_lds + (slot) * SHM_V + wid * 2048), 16, 0, 0); } while (0)
    const int NT = seq / KVBLK;
    ATT4_DMA(0, 0);
    asm volatile("s_waitcnt vmcnt(0)" ::: "memory"); __syncthreads();
    f32x16 x0, x1, y0, y1; sbf16x8 px[4], py[4];
    x1 = f32x16{}; y1 = f32x16{};
#pragma unroll
    for (int i = 0; i < 4; ++i) { px[i] = sbf16x8{}; py[i] = sbf16x8{}; }
    int s_prev = 2, s_cur = 0, s_next = 1;
#pragma unroll 1
    for (int j = 0; j < NT; ++j) {
        if (j + 1 < NT) ATT4_DMA(j + 1, s_next);
        ATT_SBAR();
        qk_half<0>(x0, y0, K_lds + s_cur * SHM_K, qx, qy, r32, hi);
        qk_half<32>(x1, y1, K_lds + s_cur * SHM_K, qx, qy, r32, hi);
        softmax_half(x0, lx, px[0], px[1]); softmax_half(y0, ly, py[0], py[1]);
        pv_half<0>(ox, oy, vb0 + s_cur * SHM_V, px[0], px[1], py[0], py[1]);
        softmax_half(x1, lx, px[2], px[3]); softmax_half(y1, ly, py[2], py[3]);
        pv_half<2>(ox, oy, vb0 + s_cur * SHM_V, px[2], px[3], py[2], py[3]);
        asm volatile("s_waitcnt vmcnt(0)" ::: "memory");
        __syncthreads();
        { const int t_ = s_prev; s_prev = s_cur; s_cur = s_next; s_next = t_; }
    }
#undef ATT4_DMA
    { auto rr = __builtin_amdgcn_permlane32_swap(__float_as_uint(lx), __float_as_uint(lx), false, false); lx = __uint_as_float(rr[0]) + __uint_as_float(rr[1]); }
    { auto rr = __builtin_amdgcn_permlane32_swap(__float_as_uint(ly), __float_as_uint(ly), false, false); ly = __uint_as_float(rr[0]) + __uint_as_float(rr[1]); }
    { unsigned z_ = 0u; asm volatile("" : "+v"(z_)); lane2 = (int)__builtin_amdgcn_mbcnt_hi(~0u, __builtin_amdgcn_mbcnt_lo(~0u, z_)); }
    const int r32e = lane2 & 31, hie = lane2 >> 5;
    const float rlx = __builtin_amdgcn_rcpf(lx), rly = __builtin_amdgcn_rcpf(ly);
    LAS bf16* stg = (LAS bf16*)(lds + wid * 8192);
#pragma unroll
    for (int d0 = 0; d0 < 2; ++d0)
#pragma unroll
        for (int g = 0; g < 4; ++g) {
            v2u wx, wy; wx.x = pk2(ox[d0][4 * g] * rlx, ox[d0][4 * g + 1] * rlx); wx.y = pk2(ox[d0][4 * g + 2] * rlx, ox[d0][4 * g + 3] * rlx);
            wy.x = pk2(oy[d0][4 * g] * rly, oy[d0][4 * g + 1] * rly); wy.y = pk2(oy[d0][4 * g + 2] * rly, oy[d0][4 * g + 3] * rly);
            *(LAS v2u*)(stg + r32e * 64 + d0 * 32 + 8 * g + 4 * hie) = wx; *(LAS v2u*)(stg + (32 + r32e) * 64 + d0 * 32 + 8 * g + 4 * hie) = wy; }
    asm volatile("s_waitcnt lgkmcnt(0)" ::: "memory");
    GAS bf16* Ow = (GAS bf16*)Ob + (size_t)(wid * 64) * 512;
#pragma unroll
    for (int i = 0; i < 8; ++i) { const int row = i * 8 + (lane2 >> 3), ch = lane2 & 7; const v4u v = *(const LAS v4u*)(stg + row * 64 + ch * 8); *(GAS v4u*)(Ow + (size_t)row * 512 + ch * 8) = v; }
    asm volatile("s_waitcnt lgkmcnt(0)" ::: "memory");
}
}

__device__ __forceinline__ bool attn_static_ok(Frame& F, int l) {
    const float* gq = ((const float*)(const GAS float*)F.in[13]) + l * DQK; const float* gk = ((const float*)(const GAS float*)F.in[14]) + l * DQK; float mq = 0.f, mk = 0.f;
    for (int d = 0; d < DQK; ++d) { mq = fmaxf(mq, fabsf(gq[d])); mk = fmaxf(mk, fabsf(gk[d])); }
    return 96.f * mq * mk * QSCALE <= 60.f;
}
__device__ __forceinline__ void step_f_fast(Frame& F) {
    fresh_tid(F);
    const bf16* Q = WSP(bf16, WS_Q); const bf16* K = WSP(bf16, WS_K); const bf16* V = WSP(bf16, WS_V); bf16* O = WSP(bf16, WS_O);
    const int vcu = (F.G % 8 == 0) ? (F.bid % 8) * (F.G / 8) + F.bid / 8 : F.bid;
#if ATTN_W64
    for (int u = vcu; u < NB * H * (S / 512); u += F.G) {
        const int qb = u % 16, bh = (u / 16), b = bh / H, h = bh % H;
        fresh_tid(F);
        att::attn_unit4(Q + ((size_t)bh * S + qb * 512) * 96, K + (size_t)bh * S * 96, V + (size_t)bh * S * 64, O + ((size_t)(b * S + qb * 512)) * 512 + h * 64, S, (LAS char*)F.lds, F.tid);
        __syncthreads();
    }
#else
    for (int u = vcu; u < NB * H * (S / 256); u += F.G) {
        const int qb = u % 32, bh = (u / 32), b = bh / H, h = bh % H;
        fresh_tid(F);
        att::attn_unit(Q + ((size_t)bh * S + qb * 256) * 96, K + (size_t)bh * S * 96, V + (size_t)bh * S * 64, O + ((size_t)(b * S + qb * 256)) * 512 + h * 64, S, (LAS char*)F.lds, F.tid);
        __syncthreads();
    }
#endif
}
constexpr size_t WT_IN = WS_WT, WT_UQ = WS_WT + 8 * MiB, WT_UKV = WT_UQ + 384 * KiB, WT_CO = WS_WT + 9 * MiB, WT_AO = WS_WT + 10 * MiB, WT_O = WS_WT + 11 * MiB,
                 WT_GU = WS_WT + 13 * MiB, WT_DN = WS_WT + 30 * MiB;
constexpr int NPROJ = 4096;
static_assert(WT_DN + (size_t)NEX * 1024 * 256 * 2 <= WS_WT + 40 * MiB, "weight region");
__device__ __forceinline__ void cvt_item(const float* W, int K, int N, bf16* WT, int drow0, const float* ksc, LAS float* scr, int k0, int n0, int lane) {
    float wv[32];
#pragma unroll
    for (int i = 0; i < 32; ++i) wv[i] = W[(size_t)(k0 + 2 * i + (lane >> 5)) * N + n0 + (lane & 31)];
#pragma unroll
    for (int i = 0; i < 32; ++i) { const int kk = 2 * i + (lane >> 5); float v = wv[i]; if (ksc) v *= ksc[k0 + kk]; scr[kk * 33 + (lane & 31)] = v; }
    asm volatile("s_waitcnt lgkmcnt(0)" ::: "memory");
    const int c = lane & 7;
#pragma unroll
    for (int j = 0; j < 4; ++j) { const int n = (lane >> 3) + 8 * j; const LAS float* s = scr + (8 * c) * 33 + n;
        v4u o; o.x = pk2(s[0 * 33], s[1 * 33]); o.y = pk2(s[2 * 33], s[3 * 33]); o.z = pk2(s[4 * 33], s[5 * 33]); o.w = pk2(s[6 * 33], s[7 * 33]);
        *(v4u*)(WT + (size_t)(drow0 + n) * K + k0 + 8 * c) = o; }
    asm volatile("s_waitcnt lgkmcnt(0)" ::: "memory");
}
__device__ __forceinline__ int proj_dest(int n0) {
    if (n0 < 512) return n0;
    if (n0 < 1024) return 512 + ((n0 - 512) >> 7) * 256 + ((n0 - 512) & 127);
    if (n0 < 1536) return 512 + ((n0 - 1024) >> 7) * 256 + 128 + ((n0 - 1024) & 127);
    if (n0 < 1952) return n0;
    return n0 + 96;
}
__device__ __forceinline__ int ukv_dest(int n0) { const int h = n0 >> 7, j0 = n0 & 127, kind = j0 >> 6, d0 = j0 & 63; return (kind * 2 + (h >> 2)) * 256 + (d0 >> 5) * 128 + (h & 3) * 32; }
__device__ __forceinline__ void convert_weights(Frame& F, int l) {
    fresh_tid(F);
    LAS float* scr = (LAS float*)(F.lds + F.wave * 16384);
    const int gw = F.bid * NWAVES + F.wave, NGW = F.G * NWAVES;
    constexpr int I_IN = 16 * 125, I_UQ = 4 * 24, I_UKV = 2 * 32, I_CO = 8 * 32, I_O = 16 * 32, I_GU = NEX * 16 * 8, I_DN = NEX * 4 * 32;
    constexpr int NITEMS = I_IN + I_UQ + I_UKV + 2 * I_CO + I_O + 2 * I_GU + I_DN;
    for (int it = gw; it < NITEMS; it += NGW) {
        int r = it;
        if (r < I_IN) { const int kb = r / 125, nb = r % 125, n0 = 32 * nb; cvt_item(((const float*)(const GAS float*)F.in[7]) + (size_t)l * D * NIN, D, NIN, WSP(bf16, WT_IN), proj_dest(n0), nullptr, scr, 64 * kb, n0, F.lane); continue; } r -= I_IN;
        if (r < I_UQ) { const int kb = r / 24, nb = r % 24; cvt_item(((const float*)(const GAS float*)F.in[10]) + (size_t)l * QL * 768, QL, 768, WSP(bf16, WT_UQ), 32 * nb, ((const float*)(const GAS float*)F.in[9]) + l * QL, scr, 64 * kb, 32 * nb, F.lane); continue; } r -= I_UQ;
        if (r < I_UKV) { const int kb = r / 32, nb = r % 32; cvt_item(((const float*)(const GAS float*)F.in[12]) + (size_t)l * KVL * 1024, KVL, 1024, WSP(bf16, WT_UKV), ukv_dest(32 * nb), ((const float*)(const GAS float*)F.in[11]) + l * KVL, scr, 64 * kb, 32 * nb, F.lane); continue; } r -= I_UKV;
        if (r < I_CO) { const int kb = r / 32, nb = r % 32; cvt_item(((const float*)(const GAS float*)F.in[15]) + (size_t)l * CW * D, CW, D, WSP(bf16, WT_CO), 32 * nb, nullptr, scr, 64 * kb, 32 * nb, F.lane); continue; } r -= I_CO;
        if (r < I_CO) { const int kb = r / 32, nb = r % 32; cvt_item(((const float*)(const GAS float*)F.in[16]) + (size_t)l * 512 * D, 512, D, WSP(bf16, WT_AO), 32 * nb, nullptr, scr, 64 * kb, 32 * nb, F.lane); continue; } r -= I_CO;
        if (r < I_O) { const int kb = r / 32, nb = r % 32; cvt_item(((const float*)(const GAS float*)F.in[17]) + (size_t)l * D * D, D, D, WSP(bf16, WT_O), 32 * nb, nullptr, scr, 64 * kb, 32 * nb, F.lane); continue; } r -= I_O;
        if (r < 2 * I_GU) { const int up = r >= I_GU ? 1 : 0; r -= up * I_GU; const int e = r / 128, q = r % 128, kb = q / 8, nb = q % 8, n0 = 32 * nb;
            const float* W = e < NE ? ((const float*)(const GAS float*)F.in[20 + up]) + ((size_t)l * NE + e) * D * DE : ((const float*)(const GAS float*)F.in[23 + up]) + (size_t)l * D * DE;
            cvt_item(W, D, DE, WSP(bf16, WT_GU) + (size_t)e * 512 * D, (n0 >> 7) * 256 + up * 128 + (n0 & 127), nullptr, scr, 64 * kb, n0, F.lane); continue; } r -= 2 * I_GU;
        { const int e = r / 128, q = r % 128, kb = q / 32, nb = q % 32;
            const float* W = e < NE ? ((const float*)(const GAS float*)F.in[22]) + ((size_t)l * NE + e) * DE * D : ((const float*)(const GAS float*)F.in[25]) + (size_t)l * DE * D;
            cvt_item(W, DE, D, WSP(bf16, WT_DN) + (size_t)e * D * DE, 32 * nb, nullptr, scr, 64 * kb, 32 * nb, F.lane); }
    }
    v4u* z = (v4u*)(WSP(bf16, WT_IN) + (size_t)1952 * D);
    unsigned z0 = 0u; asm volatile("" : "+v"(z0));
    for (int i = F.bid * NTHREADS + F.tid; i < 96 * D * 2 / 16; i += F.G * NTHREADS) z[i] = (v4u){z0, z0, z0, z0};
}

namespace pg8 {
typedef short sbf16x8 __attribute__((ext_vector_type(8)));
constexpr int BM = 256, BK = 64, HALF = 128, HTB = HALF * BK * 2, STAGE_BYTES = 8 * HTB, NXCD = 8, WGM = 8;
__device__ __forceinline__ int lds_byte(int r, int c) { const int st = (r >> 4) * 2 + (c >> 5), rr = r & 15, cc = c & 31, ob = rr * 64 + cc * 2; return st * 1024 + (ob ^ (((ob >> 9) & 1) << 5)); }
__device__ __forceinline__ void stage_rc(int b, int& R, int& C) { const int st = b / 1024, sb = b % 1024, swz = sb ^ (((sb >> 9) & 1) << 5); R = (st >> 1) * 16 + swz / 64; C = (st & 1) * 32 + (swz % 64) / 2; }
__device__ __forceinline__ int perm32(int rho) { const int n = rho >> 4, i = rho & 15; return 8 * (i >> 2) + 4 * n + (i & 3); }
__device__ __forceinline__ int xcd_remap(int L, int nwg) { const int q = nwg / NXCD, r = nwg % NXCD, xcd = L % NXCD, off = L / NXCD; return (xcd < r ? xcd * (q + 1) : r * (q + 1) + (xcd - r) * q) + off; }

struct Unit { int pm, pn; const char* a; const char* b; const int* list; int rows, tok0, e; };
struct Gemm { unsigned lda; int K; };

struct StaticOrder {
    const char* A; const char* Bt; unsigned lda; int K, nM, nN, nwg, G, c;
    static constexpr bool WAITS = false;
    __device__ __forceinline__ bool next(int i, Unit& u, int) const {
        const long L = (long)i * G + c; if (L >= nwg) return false;
        const int wgid = xcd_remap((int)L, nwg);
        const int nig = WGM * nN, gid = wgid / nig, fm = gid * WGM, gsz = (nM - fm) < WGM ? (nM - fm) : WGM;
        u.pm = fm + ((wgid % nig) % gsz); u.pn = (wgid % nig) / gsz;
        u.a = A + (size_t)u.pm * BM * lda; u.b = Bt + (size_t)u.pn * BM * K * 2; u.list = nullptr; u.rows = BM; u.tok0 = u.pm * BM; u.e = 0; return true;
    }
};
struct MoeOrder {
    const char* A; const char* Bt; size_t estride; unsigned lda; int K, nN, MT, G, c; const LAS unsigned* tb; const LAS unsigned* cnt; const int* LIST; bool gather;
    static constexpr bool WAITS = false;
    __device__ __forceinline__ bool next(int i, Unit& u, int) const {
        const int nwg = MT * nN; const long L = (long)i * G + c; if (L >= nwg) return false;
        const int wgid = xcd_remap((int)L, nwg);
        const int mt = wgid / nN, pn = wgid % nN; int e = 0;
#pragma unroll 1
        for (int j = 1; j <= NE; ++j) if ((unsigned)mt >= (unsigned)__builtin_amdgcn_readfirstlane(tb[j])) e = j;
        const int lt = mt - (int)__builtin_amdgcn_readfirstlane(tb[e]);
        u.pm = mt; u.pn = pn; u.e = e; u.tok0 = lt * BM;
        if (e < NE) { const int left = (int)__builtin_amdgcn_readfirstlane(cnt[e]) - lt * BM; u.rows = left < BM ? left : BM; u.list = LIST + (size_t)e * T + lt * BM; } else { u.rows = BM; u.list = nullptr; }
        u.a = gather ? A : A + (size_t)mt * BM * lda; u.b = Bt + (size_t)e * estride + (size_t)pn * BM * K * 2; return true;
    }
};

#ifndef KL_R
#define KL_R 3
#endif
struct MoeOrderX {
    static constexpr bool WAITS = true;
    const char* A; const char* Bt; size_t estride; unsigned lda; int K, nN, MT, G, c; const LAS unsigned* tb; const LAS unsigned* cnt; const LAS unsigned* te; const int* LIST; bool gather;
    int mode, kN; unsigned* flags; unsigned* bar;
    __device__ __forceinline__ bool next(int i, Unit& u, int wid) const {
        const int NX = (G % NXCD == 0) ? NXCD : 1, x = c % NX, cl = c / NX, GX = G / NX;
        const int qm = MT / NX, rm = MT % NX, sz = qm + (x < rm ? 1 : 0), m0 = x * qm + (x < rm ? x : rm);
        if (sz == 0) return false;
        int off;
        if (mode == 0) off = cl + i * GX;
        else {
            const int ku = kN * sz, kmax = (ku + GX - 1) / GX, hx = ku - (kmax - 1) * GX, nl = GX - hx;
            if (cl >= hx && i < KL_R) off = (cl - hx) + i * nl;
            else { const int p = cl + (cl >= hx ? i - KL_R : i) * GX; off = KL_R * nl + (p < GX ? (p >= hx ? p - hx : nl + p) : p); }
        }
        const int sl = off / nN, pn = off % nN; if (sl >= sz) return false;
        const int mt = m0 + sl; const unsigned pe = (unsigned)__builtin_amdgcn_readfirstlane(te[mt]); const int e = (int)(pe & 255u), lt = (int)(pe >> 8);
        u.pm = mt; u.pn = pn; u.e = e; u.tok0 = lt * BM;
        if (e < NE) { const int left = (int)__builtin_amdgcn_readfirstlane(cnt[e]) - lt * BM; u.rows = left < BM ? left : BM; u.list = LIST + (size_t)e * T + lt * BM; } else { u.rows = BM; u.list = nullptr; }
        u.a = gather ? A : A + (size_t)mt * BM * lda; u.b = Bt + (size_t)e * estride + (size_t)pn * BM * K * 2;
        if (mode == 1 && wid == 0) {
            XB_SPIN(xb_ld(flags + mt) < (unsigned)kN, bar);
            __builtin_amdgcn_fence(__ATOMIC_ACQUIRE, "agent");
        }
        return true;
    }
};

__device__ __forceinline__ v4u pack8(f32x4 v0, f32x4 v1) { v4u w; w.x = pk2(v0[0], v0[1]); w.y = pk2(v0[2], v0[3]); w.z = pk2(v1[0], v1[1]); w.w = pk2(v1[2], v1[3]); return w; }
struct EpiBf16 {
    static constexpr bool PERM = true; static constexpr bool SIGNAL = false; static constexpr bool PRE = false;
    bf16* O; int ldc; int split; bf16* gbp;
    __device__ __forceinline__ void operator()(const f32x4 (&acc)[2][2][4][2], const Unit& u, int wr, int wc, int fr, int fq) const {
        bf16* base = O; int ld = ldc, c0 = u.pn * BM;
        if (split) { const int pn = u.pn; unsigned char* w = (unsigned char*)O;
            if (pn >= 2 && pn < 6) {
                bf16* pb = (bf16*)(w + WS_CONV) + 512 + (pn - 2) * 128 + wc * 32 + 8 * fq; const int row0 = u.pm * BM + wr * 64 + fr;
#pragma unroll
                for (int ai = 0; ai < 2; ++ai)
#pragma unroll
                    for (int m = 0; m < 4; ++m) { *(v4u*)(pb + (size_t)(row0 + ai * HALF + m * 16) * 1024) = pack8(acc[ai][0][m][0] * acc[ai][1][m][0], acc[ai][0][m][1] * acc[ai][1][m][1]);
                        asm volatile("" ::: "memory"); }
                return; }
            if (pn < 2) { base = (bf16*)(w + WS_CONV); ld = 1024; c0 = pn * 256; }
            else if (pn < 8) { base = (bf16*)(w + WS_SMALL); ld = 512; c0 = (pn - 6) * 256; }
            else if (pn < 12) { base = (bf16*)(w + WS_GA); ld = 1024; c0 = (pn - 8) * 256; }
            else { base = gbp; ld = 1024; c0 = (pn - 12) * 256; } }
        const int row0 = u.pm * BM + wr * 64 + fr, col0 = c0 + wc * 32 + 8 * fq;
#pragma unroll
        for (int ai = 0; ai < 2; ++ai)
#pragma unroll
            for (int m = 0; m < 4; ++m) { bf16* rowp = base + (size_t)(row0 + ai * HALF + m * 16) * ld + col0;
#pragma unroll
                for (int bj = 0; bj < 2; ++bj) *(v4u*)(rowp + bj * HALF) = pack8(acc[ai][bj][m][0], acc[ai][bj][m][1]);
                asm volatile("" ::: "memory"); }
    }
};
__device__ __forceinline__ unsigned pk4_fp8(f32x4 v) {
#pragma unroll
    for (int e = 0; e < 4; ++e) v[e] = __builtin_fminf(__builtin_fmaxf(v[e], -448.f), 448.f);
    int w = __builtin_amdgcn_cvt_pk_fp8_f32(v[0], v[1], 0, false); w = __builtin_amdgcn_cvt_pk_fp8_f32(v[2], v[3], w, true); return (unsigned)w;
}
struct EpiY8 {
    static constexpr bool PERM = true; static constexpr bool SIGNAL = false; static constexpr bool PRE = false;
    unsigned char* Y8;
    __device__ __forceinline__ void operator()(const f32x4 (&acc)[2][2][4][2], const Unit& u, int wr, int wc, int fr, int fq) const {
        const int row0 = u.pm * BM + wr * 64 + fr, col0 = u.pn * BM + wc * 32 + 8 * fq;
#pragma unroll
        for (int ai = 0; ai < 2; ++ai)
#pragma unroll
            for (int m = 0; m < 4; ++m) { unsigned char* rowp = Y8 + (size_t)(row0 + ai * HALF + m * 16) * D + col0;
#pragma unroll
                for (int bj = 0; bj < 2; ++bj) { v2u w; w.x = pk4_fp8(acc[ai][bj][m][0]); w.y = pk4_fp8(acc[ai][bj][m][1]); *(v2u*)(rowp + bj * HALF) = w; }
                asm volatile("" ::: "memory"); }
    }
};
constexpr int KVE_RSK = 131072 + 2048, KVE_RP = KVE_RSK + 2048, KVE_GN = KVE_RP + 16384, KVE_END = KVE_GN + 256;
__device__ __forceinline__ float add_xor16(float v) {
    auto r = __builtin_amdgcn_permlane16_swap(__builtin_bit_cast(unsigned, v), __builtin_bit_cast(unsigned, v), false, false);
    return __builtin_bit_cast(float, r[0]) + __builtin_bit_cast(float, r[1]); }
struct EpiKV {
    static constexpr bool PERM = true; static constexpr bool SIGNAL = false; static constexpr bool PRE = true;
    bf16* Kb; bf16* Vb; const bf16* small; const f32x2* rope; const float* gk; LAS unsigned char* lds;
    __device__ __forceinline__ void pre(const Unit& u, int wid) const {
        unsigned z_ = 0u; asm volatile("" : "+v"(z_)); const int lane = (int)__builtin_amdgcn_mbcnt_hi(~0u, __builtin_amdgcn_mbcnt_lo(~0u, z_)), tid = wid * 64 + lane;
        const bool isK = u.pn < 2; const int q = lane & 3, i0 = 8 * (q & 1);
        if (isK && tid < 16) *(LAS f32x4*)(lds + KVE_GN + tid * 16) = *(const f32x4*)(gk + 4 * tid);
        f32x4 g1[2], g2[2];
#pragma unroll
        for (int n = 0; n < 2; ++n) { g1[n] = *(const f32x4*)(gk + 64 + i0 + 4 * n); g2[n] = *(const f32x4*)(gk + 80 + i0 + 4 * n); }
#pragma unroll 1
        for (int it = 0; it < 2; ++it) {
            const int rl = it * HALF + (tid >> 2), t = u.pm * BM + rl;
            const bf16* sm = small + (size_t)t * 512;
            float ss = 0.f;
#pragma unroll
            for (int c = 0; c < 4; ++c) { const bf16x8 x = *(const bf16x8*)(sm + 256 + 32 * q + 8 * c);
#pragma unroll
                for (int e = 0; e < 8; ++e) { const float f = bf2f(x[e]); ss += f * f; } }
            ss += xor_lane<1>(ss); ss += xor_lane<2>(ss);
            float sk = 0.f;
            if (isK) {
                const bf16x8 x1v = *(const bf16x8*)(sm + 384 + i0), x2v = *(const bf16x8*)(sm + 384 + 16 + i0);
                const f32x4* rp = (const f32x4*)(rope + (size_t)t * 16 + i0);
                const f32x4 rp0 = rp[0], rp1 = rp[1], rp2 = rp[2], rp3 = rp[3];
#pragma unroll
                for (int e = 0; e < 8; ++e) { const float f = bf2f(q < 2 ? x1v[e] : x2v[e]); sk += f * f; }
                sk += xor_lane<1>(sk); sk += xor_lane<2>(sk);
                f32x4 o0, o1;
#pragma unroll
                for (int e = 0; e < 8; ++e) {
                    const float a = bf2f(x1v[e]) * (e < 4 ? g1[0][e & 3] : g1[1][e & 3]), bb = bf2f(x2v[e]) * (e < 4 ? g2[0][e & 3] : g2[1][e & 3]);
                    const f32x4 cq = e < 2 ? rp0 : e < 4 ? rp1 : e < 6 ? rp2 : rp3; const float cs = (e & 1) ? cq.z : cq.x, sn_ = (e & 1) ? cq.w : cq.y;
                    const float o = q < 2 ? a * cs - bb * sn_ : bb * cs + a * sn_;
                    if (e < 4) o0[e & 3] = o; else o1[e & 3] = o; }
                *(LAS v4u*)(lds + KVE_RP + rl * 64 + q * 16) = pack8(o0, o1);
            }
            if (q == 0) { f32x2 w; w.x = 1.0f / sqrtf(ss * (1.f / 128.f) + EPS); w.y = sk; *(LAS f32x2*)(lds + KVE_RSK + rl * 8) = w; }
        }
    }
    __device__ __forceinline__ void operator()(const f32x4 (&acc)[2][2][4][2], const Unit& u, int wr, int wc, int fr, int fq) const {
        const bool isK = u.pn < 2; const int h = (u.pn & 1) * 4 + wc;
#pragma unroll
        for (int ai = 0; ai < 2; ++ai)
#pragma unroll
            for (int m = 0; m < 4; ++m) {
                const int rl = ai * HALF + wr * 64 + m * 16 + fr, t = u.pm * BM + rl, b = t / S, sq = t % S;
                const size_t orow = (size_t)(b * H + h) * S + sq;
                const f32x2 rsk = *(const LAS f32x2*)(lds + KVE_RSK + rl * 8);
                const float rs = rsk.x;
                if (isK) {
                    const v4u rpv = *(const LAS v4u*)(lds + KVE_RP + rl * 64 + fq * 16);
                    f32x4 gn[2][2];
#pragma unroll
                    for (int bj = 0; bj < 2; ++bj)
#pragma unroll
                        for (int n = 0; n < 2; ++n) gn[bj][n] = *(const LAS f32x4*)(lds + KVE_GN + (32 * bj + 8 * fq + 4 * n) * 4);
                    float sn = 0.f; f32x4 v[2][2];
#pragma unroll
                    for (int bj = 0; bj < 2; ++bj)
#pragma unroll
                        for (int n = 0; n < 2; ++n) { v[bj][n] = acc[ai][bj][m][n] * rs;
#pragma unroll
                            for (int e = 0; e < 4; ++e) sn += v[bj][n][e] * v[bj][n][e]; }
                    sn = add_xor16(sn); sn = add_xor32(sn);
                    const float r = 1.0f / sqrtf((sn + rsk.y) * (1.f / 96.f) + EPS);
#pragma unroll
                    for (int bj = 0; bj < 2; ++bj) *(v4u*)(Kb + orow * 96 + 32 * bj + 8 * fq) = pack8(v[bj][0] * r * gn[bj][0], v[bj][1] * r * gn[bj][1]);
                    f32x4 o0, o1;
                    o0[0] = bf2f((unsigned short)(rpv.x & 0xffffu)) * r; o0[1] = bf2f((unsigned short)(rpv.x >> 16)) * r; o0[2] = bf2f((unsigned short)(rpv.y & 0xffffu)) * r; o0[3] = bf2f((unsigned short)(rpv.y >> 16)) * r;
                    o1[0] = bf2f((unsigned short)(rpv.z & 0xffffu)) * r; o1[1] = bf2f((unsigned short)(rpv.z >> 16)) * r; o1[2] = bf2f((unsigned short)(rpv.w & 0xffffu)) * r; o1[3] = bf2f((unsigned short)(rpv.w >> 16)) * r;
                    *(v4u*)(Kb + orow * 96 + 64 + 8 * fq) = pack8(o0, o1);
                } else {
#pragma unroll
                    for (int bj = 0; bj < 2; ++bj) *(v4u*)(Vb + orow * 64 + 32 * bj + 8 * fq) = pack8(acc[ai][bj][m][0] * rs, acc[ai][bj][m][1] * rs);
                }
                asm volatile("" ::: "memory");
            }
    }
};
template <int MODE> struct EpiGate {
    static constexpr bool PERM = true; static constexpr bool SIGNAL = false; static constexpr bool PRE = false;
    bf16* ga; const bf16* gb;
    __device__ __forceinline__ void operator()(const f32x4 (&acc)[2][2][4][2], const Unit& u, int wr, int wc, int fr, int fq) const {
        const int row0 = u.pm * BM + wr * 64 + fr, col0 = u.pn * BM + wc * 32 + 8 * fq;
#pragma unroll
        for (int ai = 0; ai < 2; ++ai) {
            bf16x8 g[4][2], t[4][2];
#pragma unroll
            for (int m = 0; m < 4; ++m) { const size_t off = (size_t)(row0 + ai * HALF + m * 16) * D + col0;
#pragma unroll
                for (int bj = 0; bj < 2; ++bj) { g[m][bj] = *(const bf16x8*)((MODE == 1 ? ga : gb) + off + bj * HALF);
                    t[m][bj] = (bf16x8){0, 0, 0, 0, 0, 0, 0, 0}; if (MODE == 2) t[m][bj] = *(const bf16x8*)(ga + off + bj * HALF); } }
#pragma unroll
            for (int m = 0; m < 4; ++m) { const size_t off = (size_t)(row0 + ai * HALF + m * 16) * D + col0;
#pragma unroll
                for (int bj = 0; bj < 2; ++bj) {
                    f32x4 v0 = acc[ai][bj][m][0], v1 = acc[ai][bj][m][1];
#pragma unroll
                    for (int e = 0; e < 4; ++e) { v0[e] = sigmoidf_(bf2f(g[m][bj][e])) * v0[e]; v1[e] = sigmoidf_(bf2f(g[m][bj][4 + e])) * v1[e];
                        if (MODE == 2) { v0[e] += bf2f(t[m][bj][e]); v1[e] += bf2f(t[m][bj][4 + e]); } }
                    *(v4u*)(ga + off + bj * HALF) = pack8(v0, v1); } }
            asm volatile("" ::: "memory");
        }
    }
};
struct EpiRes {
    static constexpr bool PERM = false; static constexpr bool SIGNAL = false; static constexpr bool PRE = false;
    const float* xin; float* out; const float* gt;
    __device__ __forceinline__ void operator()(const f32x4 (&acc)[2][2][4][2], const Unit& u, int wr, int wc, int fr, int fq) const {
        const int col0 = u.pn * BM + wc * 32 + 4 * fq;
        const float* g = gt + ((u.pm * BM) / S) * 6 * D;
        f32x4 gv[2][2];
#pragma unroll
        for (int bj = 0; bj < 2; ++bj)
#pragma unroll
            for (int n = 0; n < 2; ++n) gv[bj][n] = *(const f32x4*)(g + col0 + bj * HALF + n * 16);
#pragma unroll
        for (int ai = 0; ai < 2; ++ai)
#pragma unroll
            for (int mp = 0; mp < 2; ++mp) {
                f32x4 xv[2][2][2];
#pragma unroll
                for (int mm = 0; mm < 2; ++mm) { const size_t off = (size_t)(u.pm * BM + ai * HALF + wr * 64 + (2 * mp + mm) * 16 + fr) * D + col0;
#pragma unroll
                    for (int bj = 0; bj < 2; ++bj)
#pragma unroll
                        for (int n = 0; n < 2; ++n) xv[mm][bj][n] = *(const f32x4*)(xin + off + bj * HALF + n * 16); }
#pragma unroll
                for (int mm = 0; mm < 2; ++mm) { const int m = 2 * mp + mm; const size_t off = (size_t)(u.pm * BM + ai * HALF + wr * 64 + m * 16 + fr) * D + col0;
#pragma unroll
                    for (int bj = 0; bj < 2; ++bj)
#pragma unroll
                        for (int n = 0; n < 2; ++n) *(f32x4*)(out + off + bj * HALF + n * 16) = xv[mm][bj][n] + gv[bj][n] * acc[ai][bj][m][n]; }
                asm volatile("" ::: "memory");
            }
    }
};
struct EpiRes16 {
    static constexpr bool PERM = true; static constexpr bool SIGNAL = false; static constexpr bool PRE = false;
    const float* xin32; bf16* x16; const float* gt;
    __device__ __forceinline__ void operator()(const f32x4 (&acc)[2][2][4][2], const Unit& u, int wr, int wc, int fr, int fq) const {
        const int row0 = u.pm * BM + wr * 64 + fr, col0 = u.pn * BM + wc * 32 + 8 * fq;
        const float* g = gt + ((u.pm * BM) / S) * 6 * D;
        f32x4 gv[2][2];
#pragma unroll
        for (int bj = 0; bj < 2; ++bj)
#pragma unroll
            for (int n = 0; n < 2; ++n) gv[bj][n] = *(const f32x4*)(g + col0 + bj * HALF + n * 4);
#pragma unroll
        for (int ai = 0; ai < 2; ++ai)
#pragma unroll
            for (int mp = 0; mp < 2; ++mp) {
                f32x4 xv[2][2][2];
#pragma unroll
                for (int mm = 0; mm < 2; ++mm) { const size_t off = (size_t)(row0 + ai * HALF + (2 * mp + mm) * 16) * D + col0;
#pragma unroll
                    for (int bj = 0; bj < 2; ++bj) {
                        if (xin32) { xv[mm][bj][0] = *(const f32x4*)(xin32 + off + bj * HALF); xv[mm][bj][1] = *(const f32x4*)(xin32 + off + bj * HALF + 4); }
                        else { const bf16x8 t = *(const bf16x8*)(x16 + off + bj * HALF);
#pragma unroll
                            for (int e = 0; e < 4; ++e) { xv[mm][bj][0][e] = bf2f(t[e]); xv[mm][bj][1][e] = bf2f(t[4 + e]); } } } }
#pragma unroll
                for (int mm = 0; mm < 2; ++mm) { const int m = 2 * mp + mm; const size_t off = (size_t)(row0 + ai * HALF + m * 16) * D + col0;
#pragma unroll
                    for (int bj = 0; bj < 2; ++bj) *(v4u*)(x16 + off + bj * HALF) = pack8(xv[mm][bj][0] + gv[bj][0] * acc[ai][bj][m][0], xv[mm][bj][1] + gv[bj][1] * acc[ai][bj][m][1]); }
                asm volatile("" ::: "memory");
            }
    }
};
struct EpiAct {
    static constexpr bool PERM = true; static constexpr bool SIGNAL = true; static constexpr bool PRE = false;
    bf16* a2; const float* tokw; unsigned* flags;
    __device__ __forceinline__ void operator()(const f32x4 (&acc)[2][2][4][2], const Unit& u, int wr, int wc, int fr, int fq) const {
        const int col0 = u.pn * HALF + wc * 32 + 8 * fq;
#pragma unroll
        for (int ai = 0; ai < 2; ++ai)
#pragma unroll
            for (int m = 0; m < 4; ++m) { const int rl = ai * HALF + wr * 64 + m * 16 + fr;
                float w = 1.f; if (u.list) w = rl < u.rows ? tokw[u.list[rl]] : 0.f;
                f32x4 v0, v1;
#pragma unroll
                for (int e = 0; e < 4; ++e) { const float g0 = acc[ai][0][m][0][e], g1 = acc[ai][0][m][1][e];
                    v0[e] = g0 / (1.f + __expf(-g0)) * acc[ai][1][m][0][e] * w; v1[e] = g1 / (1.f + __expf(-g1)) * acc[ai][1][m][1][e] * w; }
                const GAS bf16* dst = (const GAS bf16*)(a2 + (size_t)(u.pm * BM + rl) * DE + col0); const v4u pv = pack8(v0, v1);
                asm volatile("global_store_dwordx4 %0, %1, off sc1" :: "v"(dst), "v"(pv) : "memory"); }
    }
    __device__ __forceinline__ void signal(const Unit& u, bool leader) const { if (leader) (void)xb_add(flags + u.pm, 1u); }
};

template <class Epi, class Sched, bool GATHER>
__device__ __forceinline__ void gemm_phase(LAS unsigned char* lds, const int tid, const Gemm g, const Sched& S, const Epi& E) {
    const int wid = __builtin_amdgcn_readfirstlane(tid >> 6), lane = tid & 63, wr = wid >> 2, wc = wid & 3, fr = lane & 15, fq = lane >> 4;
    const int K = g.K, nt = K / BK; const unsigned lda = g.lda;
    unsigned voffA[2], voffB[2]; int RA[2], CA2[2];
#pragma unroll
    for (int i = 0; i < 2; ++i) { int R, C; stage_rc(tid * 16 + i * 8192, R, C); const int Rb = Epi::PERM ? ((R & ~31) + perm32(R & 31)) : R;
        voffA[i] = (unsigned)R * lda + (unsigned)C * 2u; voffB[i] = (unsigned)(Rb * K + C) * 2u; RA[i] = R; CA2[i] = C * 2; }
    const size_t kstep = (size_t)(BK * 2);
    const size_t hstepA = (size_t)HALF * lda, hstepB = (size_t)HALF * K * 2;
    const unsigned ldsw = (unsigned)wid * 1024u;
    const int aoff = lds_byte(wr * 64 + fr, fq * 8), boff = lds_byte(wc * 32 + fr, fq * 8);
    unsigned offC[2][2], offN[2][2];
#define PG8_GOFF(dst, U) do { _Pragma("unroll") for (int h_ = 0; h_ < 2; ++h_) _Pragma("unroll") for (int i_ = 0; i_ < 2; ++i_) { const int rl_ = h_ * HALF + RA[i_]; \
        int tok_; if ((U).list) tok_ = rl_ < (U).rows ? ((U).list[rl_] >> 1) : 0; else tok_ = (U).tok0 + rl_; dst[h_][i_] = (unsigned)tok_ * lda + (unsigned)CA2[i_]; } } while (0)
#define PG8_SA(b, h) (((b) * 2 + (h)) * HTB)
#define PG8_SB(b, h) ((4 + (b) * 2 + (h)) * HTB)
#define PG8_GLDS(gp, bufoff, i_) __builtin_amdgcn_global_load_lds((const unsigned*)(gp), (LAS unsigned*)(lds + (bufoff) + ldsw + (i_) * 8192), 16, 0, 0)
#define PG8_STAGE_B(bufoff, gbase) do { _Pragma("unroll") for (int _i = 0; _i < 2; ++_i) PG8_GLDS((const char*)(gbase) + voffB[_i], bufoff, _i); } while (0)
#define PG8_STAGE_A(bufoff, ub, NX, h, koff) do { if constexpr (GATHER) { _Pragma("unroll") for (int _i = 0; _i < 2; ++_i) { const unsigned o_ = (NX) ? offN[h][_i] : offC[h][_i]; PG8_GLDS((ub) + (koff) + o_, bufoff, _i); } } \
        else { _Pragma("unroll") for (int _i = 0; _i < 2; ++_i) PG8_GLDS((ub) + (size_t)(h) * hstepA + (koff) + voffA[_i], bufoff, _i); } } while (0)
#define PG8_LDA(dst, b, h) do { _Pragma("unroll") for (int m = 0; m < 4; ++m) _Pragma("unroll") for (int k = 0; k < 2; ++k) dst[m][k] = *(const LAS sbf16x8*)(lds + PG8_SA(b, h) + aoff + m * 2048 + k * 1024); } while (0)
#define PG8_LDB(dst, b, h) do { _Pragma("unroll") for (int n = 0; n < 2; ++n) _Pragma("unroll") for (int k = 0; k < 2; ++k) dst[n][k] = *(const LAS sbf16x8*)(lds + PG8_SB(b, h) + boff + n * 2048 + k * 1024); } while (0)
#define PG8_MMA(ai, bj, At, Bt) do { __builtin_amdgcn_s_setprio(1); _Pragma("unroll") for (int m = 0; m < 4; ++m) _Pragma("unroll") for (int n = 0; n < 2; ++n) _Pragma("unroll") for (int k = 0; k < 2; ++k) \
        acc[ai][bj][m][n] = __builtin_amdgcn_mfma_f32_16x16x32_bf16(Bt[n][k], At[m][k], acc[ai][bj][m][n], 0, 0, 0); __builtin_amdgcn_s_setprio(0); } while (0)
#define PG8_WAIT_V(n) asm volatile("s_waitcnt vmcnt(" #n ")" ::: "memory")
#define PG8_WAIT_L(n) asm volatile("s_waitcnt lgkmcnt(" #n ")" ::: "memory")
#define PG8_BAR __builtin_amdgcn_s_barrier()
#define PG8_SCHED __builtin_amdgcn_sched_barrier(0)
    Unit cur, nxt; int ui = 0;
    if (!S.next(0, cur, wid)) return;
    if constexpr (Sched::WAITS) PG8_BAR;
    f32x4 acc[2][2][4][2];
#define PG8_ZERO_ACC() do { float z_ = 0.f; asm volatile("" : "+v"(z_)); _Pragma("unroll") for (int a = 0; a < 2; ++a) _Pragma("unroll") for (int b = 0; b < 2; ++b) _Pragma("unroll") for (int m = 0; m < 4; ++m) \
        _Pragma("unroll") for (int n = 0; n < 2; ++n) acc[a][b][m][n] = (f32x4){z_, z_, z_, z_}; } while (0)
    PG8_ZERO_ACC();
    sbf16x8 At[4][2], B0[2][2], B1[2][2];
    const char* cA = cur.a; const char* cB = cur.b;
    if constexpr (GATHER) { PG8_GOFF(offC, cur); PG8_WAIT_V(0); }
    PG8_STAGE_B(PG8_SB(0, 0), cB); PG8_STAGE_B(PG8_SB(0, 1), cB + hstepB); PG8_STAGE_A(PG8_SA(0, 0), cA, false, 0, 0); PG8_STAGE_A(PG8_SA(0, 1), cA, false, 1, 0);
    if constexpr (Epi::PRE) E.pre(cur, wid);
    if (wr == 1) PG8_BAR;
    PG8_WAIT_V(2); PG8_BAR;
    PG8_STAGE_B(PG8_SB(1, 0), cB + kstep); PG8_STAGE_A(PG8_SA(1, 0), cA, false, 0, kstep); PG8_STAGE_B(PG8_SB(1, 1), cB + hstepB + kstep);
    PG8_WAIT_V(6); PG8_BAR;
    for (;;) {
        const bool has_next = S.next(ui + 1, nxt, wid);
        if constexpr (GATHER) { if (has_next) { PG8_GOFF(offN, nxt); PG8_WAIT_V(0); } else {
#pragma unroll
            for (int h_ = 0; h_ < 2; ++h_)
#pragma unroll
                for (int i_ = 0; i_ < 2; ++i_) offN[h_][i_] = offC[h_][i_]; } }
        const char* nA = has_next ? nxt.a : cA; const char* nB = has_next ? nxt.b : cB;
#pragma unroll 1
        for (int t = 0; t < nt; t += 2) {
            const bool last = (t == nt - 2);
            const size_t k1 = (size_t)(t + 1) * kstep;
            const char* a2 = last ? nA : cA; const char* b2 = last ? nB : cB + (size_t)(t + 2) * kstep;
            const size_t k2 = last ? 0 : (size_t)(t + 2) * kstep;
            const char* b3 = b2 + kstep;
            PG8_LDB(B0, 0, 0); PG8_LDB(B1, 0, 1); PG8_SCHED; PG8_LDA(At, 0, 0); PG8_STAGE_A(PG8_SA(1, 1), cA, false, 1, k1);
            PG8_WAIT_V(8); PG8_WAIT_L(0); PG8_BAR; PG8_MMA(0, 0, At, B0); PG8_MMA(0, 1, At, B1); PG8_BAR; PG8_SCHED;
            PG8_LDA(At, 0, 1); PG8_STAGE_B(PG8_SB(0, 0), b2); PG8_STAGE_B(PG8_SB(0, 1), b2 + hstepB); PG8_STAGE_A(PG8_SA(0, 0), a2, last, 0, k2);
            PG8_WAIT_V(8); PG8_WAIT_L(0); PG8_BAR; PG8_MMA(1, 0, At, B0); PG8_MMA(1, 1, At, B1); PG8_BAR; PG8_SCHED;
            PG8_LDB(B0, 1, 0); PG8_LDB(B1, 1, 1); PG8_SCHED; PG8_LDA(At, 1, 0); PG8_STAGE_A(PG8_SA(0, 1), a2, last, 1, k2);
            PG8_WAIT_V(8); PG8_WAIT_L(0); PG8_BAR; PG8_MMA(0, 0, At, B0); PG8_MMA(0, 1, At, B1); PG8_BAR; PG8_SCHED;
            PG8_LDA(At, 1, 1); PG8_STAGE_B(PG8_SB(1, 0), b3); PG8_STAGE_B(PG8_SB(1, 1), b3 + hstepB); PG8_STAGE_A(PG8_SA(1, 0), a2, last, 0, k2 + kstep);
            PG8_WAIT_V(8); PG8_WAIT_L(0); PG8_BAR; PG8_MMA(1, 0, At, B0); PG8_MMA(1, 1, At, B1); PG8_BAR; PG8_SCHED;
        }
        if (wr == 0) PG8_BAR;
        { unsigned z_ = 0u; asm volatile("" : "+v"(z_)); const int l2_ = (int)__builtin_amdgcn_mbcnt_hi(~0u, __builtin_amdgcn_mbcnt_lo(~0u, z_));
          E(acc, cur, wr, wc, l2_ & 15, l2_ >> 4);
          if constexpr (Epi::SIGNAL) { PG8_WAIT_V(0); PG8_BAR; E.signal(cur, wid == 0 && l2_ == 0); } }
        if (!has_next) break;
        PG8_ZERO_ACC();
        cur = nxt; cA = nA; cB = nB; ++ui;
        if constexpr (GATHER) {
#pragma unroll
            for (int h_ = 0; h_ < 2; ++h_)
#pragma unroll
                for (int i_ = 0; i_ < 2; ++i_) offC[h_][i_] = offN[h_][i_]; }
        if constexpr (Epi::PRE) { PG8_BAR; E.pre(cur, wid); }
        if (wr == 1) PG8_BAR;
    }
    PG8_WAIT_V(0);
    PG8_BAR;
#undef PG8_GOFF
#undef PG8_ZERO_ACC
#undef PG8_SA
#undef PG8_SB
#undef PG8_GLDS
#undef PG8_STAGE_A
#undef PG8_STAGE_B
#undef PG8_LDA
#undef PG8_LDB
#undef PG8_MMA
#undef PG8_WAIT_V
#undef PG8_WAIT_L
#undef PG8_BAR
#undef PG8_SCHED
}
}

template <class Epi>
__device__ __forceinline__ void run_dense(Frame& F, const bf16* A, int lda_elems, const bf16* Bt, int M, int N, int K, const Epi& E) {
    pg8::StaticOrder S; S.A = (const char*)A; S.Bt = (const char*)Bt; S.lda = (unsigned)lda_elems * 2u; S.K = K; S.nM = M / 256; S.nN = N / 256; S.nwg = S.nM * S.nN; S.G = F.G; S.c = F.bid;
    pg8::Gemm g{(unsigned)lda_elems * 2u, K};
    fresh_tid(F);
    pg8::gemm_phase<Epi, pg8::StaticOrder, false>(F.lds, F.tid, g, S, E);
}

constexpr int TB_OFF = 131072;
static_assert(pg8::KVE_END <= LDS_BYTES && TB_OFF + 2048 <= pg8::KVE_RSK, "LDS side tables");
constexpr int TE_OFF = TB_OFF + 1024;
__device__ __forceinline__ void compute_bases(Frame& F, int l) {
    fresh_tid(F);
    LAS unsigned* tb = (LAS unsigned*)(F.lds + TB_OFF); LAS unsigned* lc = tb + 32;
    if (F.tid == 0) { const unsigned* cnt = F.ctl + CW_CNT + CNT_LS * l; unsigned acc = 0;
        for (int e = 0; e < NE; ++e) { const unsigned c = cnt[CNT_ES * e]; lc[e] = c; tb[e] = acc; acc += (c + 255u) >> 8; }
        tb[16] = acc; tb[17] = acc + T / 256;
        if (F.bid == 0) { unsigned* base = F.ctl + CW_BASE + 32 * l; for (int e = 0; e < 18; ++e) base[e] = tb[e] * 256u; } }
    __syncthreads();
    if (F.tid < 256) { LAS unsigned* te = (LAS unsigned*)(F.lds + TE_OFF); unsigned e = 0;
        for (int j = 1; j <= NE; ++j) if ((unsigned)F.tid >= tb[j]) e = (unsigned)j;
        te[F.tid] = e | (((unsigned)F.tid - tb[e]) << 8); }
    __syncthreads();
}

struct Args { const GAS void* in[26]; GAS float* out; GAS unsigned char* ws; int lo, hi; };
constexpr int NSTEPS = 21;

__global__ void __launch_bounds__(NTHREADS, 2) mk_fwd(Args args) {
    extern __shared__ __attribute__((aligned(16))) unsigned char lds_raw[];
    Frame F;
    F.lds = (LAS unsigned char*)lds_raw; F.MISC = (volatile LAS unsigned*)(F.lds + MISC_OFF);
    F.tid = threadIdx.x; F.lane = F.tid & 63; F.wave = __builtin_amdgcn_readfirstlane(F.tid >> 6); F.bid = blockIdx.x; F.G = gridDim.x;
    F.ws = args.ws; F.ctl = (unsigned*)(GAS unsigned*)(args.ws + WS_CTL); F.out = (float*)args.out;
    F.in = args.in; const int wave0 = F.wave;
    if (F.tid < 32) F.MISC[F.tid] = 0u;
    __syncthreads();
    XcdBarrier bar; bar.bar = F.ctl + CW_BAR; bar.x = 0; bar.st = nullptr;
    if (!MK_SPLIT) bar = xcd_barrier_post(F.ctl + CW_BAR, F.MISC + 8);

    for (int step_ = args.lo; step_ < args.hi; ++step_) {
        int step = step_; asm volatile("" : "+s"(step));
        { GAS unsigned char* w_ = args.ws; asm volatile("" : "+s"(w_)); F.ws = w_; F.ctl = (unsigned*)(GAS unsigned*)(w_ + WS_CTL);
          int b_ = blockIdx.x, g_ = gridDim.x, wv_ = wave0; GAS float* o_ = args.out; asm volatile("" : "+s"(b_), "+s"(g_), "+s"(wv_), "+s"(o_)); F.bid = b_; F.G = g_; F.wave = wv_; F.out = (float*)o_;
          F.tid = 0; F.lane = 0; }
#ifdef ONLY_PH
#define PHON(p) ((p) == ONLY_PH)
#else
#define PHON(p) true
#endif
        if (step == 0) { step_p0(F); if (FAST_ANY) convert_weights(F, 0); }
        else if (step == 1) step_p0_reduce(F);
        else if (step == NSTEPS - 1) { if (PHON(0)) step_a(F, 2); }
        else {
            const int l = (step - 2) / 9, ph = (step - 2) % 9, phx = ph == 2 ? 23 : ph;
            bf16* const XNp = WSP(bf16, WS_XN); const float* const MODp = WSP(float, WS_MOD);
            if (!PHON(ph)) {} else
            if (ph == 0) { if (FAST_ANY && l > 0) convert_weights(F, l); if (l == 0) for (int rep_ = 1; rep_ < REP_A0; ++rep_) step_a(F, 0); step_a(F, l); }
            else if (ph == 1) {
#if FAST_B
                for (int rep_ = 0; rep_ < REP_B; ++rep_) run_dense(F, XNp, D, WSP(bf16, WT_IN), T, NPROJ, D, pg8::EpiBf16{(bf16*)F.ws, 0, 1, GBP(F)});
#else
                EpiProj E{WSP(bf16, WS_CONV), WSP(bf16, WS_SMALL), WSP(bf16, WS_GA), GBP(F)};
                ngemm<8, false>(F, T, NIN, D, RowLin{XNp, D}, ((const float*)(const GAS float*)F.in[7]) + (size_t)l * D * NIN, nullptr, NIN, nullptr, E);
#endif
            } else if (phx == 23) { for (int rep_ = 0; rep_ < REP_C; ++rep_) step_c(F, l);
#if FAST_D
                for (int rep_ = 0; rep_ < REP_D; ++rep_) {
                run_dense(F, WSP(bf16, WS_SMALL), 512, WSP(bf16, WT_UQ), T, 768, QL, pg8::EpiBf16{WSP(bf16, WS_QRAW), 768, 0, nullptr});
                run_dense(F, WSP(bf16, WS_SMALL) + 256, 512, WSP(bf16, WT_UKV), T, 1024, KVL, pg8::EpiKV{WSP(bf16, WS_K), WSP(bf16, WS_V), WSP(bf16, WS_SMALL), WSP(f32x2, WS_ROPE), ((const float*)(const GAS float*)F.in[14]) + l * DQK, F.lds}); }
#else
                ngemm<8, false>(F, T, 768, QL, RowLin{WSP(bf16, WS_SMALL), 512}, ((const float*)(const GAS float*)F.in[10]) + (size_t)l * QL * 768, nullptr, 768, ((const float*)(const GAS float*)F.in[9]) + l * QL, EpiStore{WSP(bf16, WS_QRAW), 768});
                ngemm<8, false>(F, T, 1024, KVL, RowLin{WSP(bf16, WS_SMALL) + 256, 512}, ((const float*)(const GAS float*)F.in[12]) + (size_t)l * KVL * 1024, nullptr, 1024, ((const float*)(const GAS float*)F.in[11]) + l * KVL, EpiStore{WSP(bf16, WS_KVRAW), 1024});
#endif
            } else if (ph == 3) {
                for (int rep_ = 0; rep_ < REP_E; ++rep_) step_e(F, l);
#if FAST_G
                run_dense(F, WSP(bf16, WS_U), CW, WSP(bf16, WT_CO), T, D, CW, pg8::EpiGate<1>{WSP(bf16, WS_GA), nullptr});
#else
                ngemm<8, false>(F, T, D, CW, RowLin{WSP(bf16, WS_U), CW}, ((const float*)(const GAS float*)F.in[15]) + (size_t)l * CW * D, nullptr, D, nullptr, EpiGate1{WSP(bf16, WS_GA)});
#endif
            } else if (ph == 4) { for (int rep_ = 0; rep_ < REP_F; ++rep_) { if (FAST_ATTN && attn_static_ok(F, l)) step_f_fast(F); else step_f(F); }
            } else if (ph == 5) {
#if FAST_H
                run_dense(F, WSP(bf16, WS_O), 512, WSP(bf16, WT_AO), T, D, 512, pg8::EpiGate<2>{WSP(bf16, WS_GA), GBP(F)});
#else
                ngemm<8, false>(F, T, D, 512, RowLin{WSP(bf16, WS_O), 512}, ((const float*)(const GAS float*)F.in[16]) + (size_t)l * 512 * D, nullptr, D, nullptr, EpiGate2{WSP(bf16, WS_GA), GBP(F)});
#endif
            } else if (ph == 6) {
#if FAST_I
                run_dense(F, WSP(bf16, WS_GA), D, WSP(bf16, WT_O), T, D, D, pg8::EpiRes16{l == 0 ? ((const float*)(const GAS float*)F.in[0]) : nullptr, WSP(bf16, WS_X16), MODp + (size_t)l * 2 * 6 * D + 2 * D});
#else
                ngemm<8, false>(F, T, D, D, RowLin{WSP(bf16, WS_GA), D}, ((const float*)(const GAS float*)F.in[17]) + (size_t)l * D * D, nullptr, D, nullptr,
                                EpiRes{l == 0 ? ((const float*)(const GAS float*)F.in[0]) : F.out, F.out, MODp + (size_t)l * 2 * 6 * D + 2 * D});
#endif
            } else if (ph == 7) { for (int rep_ = 1; rep_ < REP_J; ++rep_) step_j(F, l, true); if (USE_OLD_J) step_j_old(F, l); else step_j(F, l);
            } else {
                compute_bases(F, l);
                const LAS unsigned* tb = (const LAS unsigned*)(F.lds + TB_OFF); const LAS unsigned* cnt = tb + 32;
                unsigned* kf = F.ctl + CW_KF + 256 * l;
                pg8::MoeOrderX S; S.MT = (int)__builtin_amdgcn_readfirstlane(tb[17]); S.G = F.G; S.c = F.bid; S.tb = tb; S.cnt = cnt; S.te = (const LAS unsigned*)(F.lds + TE_OFF); S.LIST = WSP(int, WS_LIST); S.kN = 2; S.flags = kf; S.bar = F.ctl + CW_BAR;
                S.A = (const char*)XNp; S.Bt = (const char*)WSP(bf16, WT_GU); S.estride = (size_t)512 * D * 2; S.lda = D * 2; S.K = D; S.nN = 2; S.gather = true; S.mode = 0;
                fresh_tid(F);
                pg8::gemm_phase<pg8::EpiAct, pg8::MoeOrderX, true>(F.lds, F.tid, pg8::Gemm{(unsigned)D * 2u, D}, S, pg8::EpiAct{WSP(bf16, WS_A2), WSP(float, WS_TOKW), kf});
                S.A = (const char*)WSP(bf16, WS_A2); S.Bt = (const char*)WSP(bf16, WT_DN); S.estride = (size_t)D * DE * 2; S.lda = DE * 2; S.K = DE; S.nN = 4; S.gather = false; S.mode = 1;
                fresh_tid(F);
                pg8::gemm_phase<pg8::EpiY8, pg8::MoeOrderX, false>(F.lds, F.tid, pg8::Gemm{(unsigned)DE * 2u, DE}, S, pg8::EpiY8{WSP(unsigned char, WS_Y)});
            }
        }
        if (step_ + 1 < args.hi) for (int rep_ = 0; rep_ < REP_BAR; ++rep_) xcd_barrier(bar);
    }
}

extern "C" void kernel_launch(void* const* d_in, const int* in_sizes, int n_in, void* d_out, int out_size, void* d_ws, size_t ws_size, hipStream_t stream) {
    static int grid = 0;
    if (grid == 0) {
        if (n_in != 26 || in_sizes[0] != T * D || out_size != T * D || ws_size < WS_END) {
            fprintf(stderr, "kernel_launch: unexpected shapes: n_in %d in0 %d out %d ws %zu (need >= %zu)\n", n_in, n_in > 0 ? in_sizes[0] : -1, out_size, ws_size, (size_t)WS_END); grid = -1; return; }
        int dev = 0, cus = 0;
        if (hipGetDevice(&dev) != hipSuccess || hipDeviceGetAttribute(&cus, hipDeviceAttributeMultiprocessorCount, dev) != hipSuccess) { grid = -1; return; }
        if (hipFuncSetAttribute((const void*)mk_fwd, hipFuncAttributeMaxDynamicSharedMemorySize, LDS_BYTES) != hipSuccess) { fprintf(stderr, "kernel_launch: hipFuncSetAttribute failed\n"); grid = -1; return; }
        int per_cu = 0;
        if (hipOccupancyMaxActiveBlocksPerMultiprocessor(&per_cu, (const void*)mk_fwd, NTHREADS, LDS_BYTES) != hipSuccess || per_cu < 1)
            fprintf(stderr, "kernel_launch: note: occupancy query reports %d blocks/CU\n", per_cu);
        (void)hipGetLastError();
        grid = cus;
    }
    if (grid < 0) return;
    if (hipMemsetAsync((char*)d_ws + WS_CTL, 0, CTL_ZERO_BYTES, stream) != hipSuccess) { fprintf(stderr, "kernel_launch: memset failed\n"); return; }
    Args a{};
    for (int i = 0; i < 26; ++i) a.in[i] = (const GAS void*)d_in[i];
    a.out = (GAS float*)d_out; a.ws = (GAS unsigned char*)d_ws;
#if MK_SPLIT
    for (int s = 0; s < NSTEPS; ++s) { a.lo = s; a.hi = s + 1; hipLaunchKernelGGL(mk_fwd, dim3(grid), dim3(NTHREADS), LDS_BYTES, stream, a); }
#else
    a.lo = 0; a.hi = NSTEPS;
    hipLaunchKernelGGL(mk_fwd, dim3(grid), dim3(NTHREADS), LDS_BYTES, stream, a);
#endif
    const hipError_t le = hipPeekAtLastError();
    if (le != hipSuccess) fprintf(stderr, "kernel_launch: launch failed: %s\n", hipGetErrorName(le));
}
```

```cpp
#include <hip/hip_runtime.h>
#include <cstdio>
#include <cstdint>

#ifndef FAST_GEMM
#define FAST_GEMM 1
#endif
#ifndef FAST_B
#define FAST_B FAST_GEMM
#endif
#ifndef FAST_D
#define FAST_D FAST_GEMM
#endif
#ifndef FAST_G
#define FAST_G FAST_GEMM
#endif
#ifndef FAST_H
#define FAST_H FAST_GEMM
#endif
#ifndef FAST_I
#define FAST_I FAST_GEMM
#endif
#ifndef FAST_K
#define FAST_K FAST_GEMM
#endif
#ifndef FAST_L
#define FAST_L FAST_GEMM
#endif
#define FAST_ANY (FAST_B || FAST_D || FAST_G || FAST_H || FAST_I || FAST_K || FAST_L)
#ifndef USE_OLD_J
#define USE_OLD_J 0
#endif
#ifndef DBG_SHFL
#define DBG_SHFL 1
#endif
#ifndef FAST_ATTN
#define FAST_ATTN 1
#endif
#ifndef REP_F
#define REP_F 1
#endif
#ifndef REP_CVT
#define REP_CVT 1
#endif
#ifndef REP_B
#define REP_B 1
#endif
#ifndef REP_C
#define REP_C 1
#endif
#ifndef REP_D
#define REP_D 1
#endif
#ifndef REP_E
#define REP_E 1
#endif
#ifndef REP_K
#define REP_K 1
#endif
#ifndef REP_L
#define REP_L 1
#endif
#ifndef REP_J
#define REP_J 1
#endif
#ifndef REP_A0
#define REP_A0 1
#endif
#ifndef REP_P0
#define REP_P0 1
#endif
#ifndef REP_BAR
#define REP_BAR 1
#endif
#ifndef ATTN_W64
#define ATTN_W64 1
#endif
#ifndef MK_SPLIT
#define MK_SPLIT 0
#endif

#define GAS __attribute__((address_space(1)))
#define LAS __attribute__((address_space(3)))
typedef unsigned short bf16;
typedef unsigned v4u __attribute__((ext_vector_type(4)));
typedef unsigned v2u __attribute__((ext_vector_type(2)));
typedef float f32x4 __attribute__((ext_vector_type(4)));
typedef float f32x2 __attribute__((ext_vector_type(2)));
typedef unsigned short bf16x8 __attribute__((ext_vector_type(8)));
typedef unsigned short bf16x4 __attribute__((ext_vector_type(4)));
typedef GAS unsigned gu32;

constexpr int NB = 2, S = 8192, T = NB * S, D = 1024, H = 8, DQK = 96, DV = 64;
constexpr int NIN = 4000, CW = 512, QL = 256, KVL = 128, NE = 16, DE = 256, NEX = NE + 1;
constexpr float EPS = 1e-6f;
constexpr float QSCALE = 0.10206207261596577f * 1.4426950408889634f;
constexpr int NWAVES = 8, NTHREADS = 512;

constexpr size_t MiB = 1u << 20, KiB = 1u << 10;
constexpr size_t WS_CTL = 0, CTL_ZERO_BYTES = 64 * KiB;
constexpr size_t WS_MOD = 1 * MiB;
constexpr size_t WS_TOKS = WS_MOD + 128 * KiB;
constexpr size_t WS_TOKW = WS_TOKS + 128 * KiB;
constexpr size_t WS_RS = WS_TOKW + 128 * KiB;
constexpr size_t WS_ROPE = 2 * MiB;
constexpr size_t WS_LIST = 4 * MiB;
constexpr size_t WS_WT = 5 * MiB;
constexpr size_t WS_XN = 45 * MiB;
constexpr size_t WS_R1 = 109 * MiB;
constexpr size_t WS_R2 = 157 * MiB;
constexpr size_t WS_GA = 173 * MiB;
constexpr size_t WS_X16 = 77 * MiB;
#define GBP(F_) ((bf16*)((unsigned char*)(F_).out + 32 * MiB))
constexpr size_t WS_U = 205 * MiB;
constexpr size_t WS_K = WS_XN;
constexpr size_t WS_V = 245 * MiB;
constexpr size_t WS_END = 261 * MiB;
constexpr size_t WS_KVRAW = WS_XN, WS_CONV = WS_R1, WS_QRAW = 221 * MiB  , WS_Q = WS_R1 + 24 * MiB, WS_SMALL = WS_R2, WS_O = WS_R2;
constexpr size_t WS_A2 = WS_R1;
constexpr size_t WS_Y = WS_R1 + 26 * MiB;
constexpr int SLOTS_MAX = 3 * T + NE * 256;
static_assert(WS_Y + (size_t)SLOTS_MAX * 2048 <= WS_END, "MoE overlay");
constexpr int CW_CNT = 8192, CNT_LS = 2048, CNT_ES = 64;
static_assert((CW_CNT + 2 * CNT_LS) * 4 <= (int)CTL_ZERO_BYTES && (4096 + 3456) * 4 <= (int)CTL_ZERO_BYTES, "control words (barrier region at word 4096, 3456 words; counters) inside the per-call memset");
constexpr int CW_BASE = 192;
constexpr int CW_BAR = 4096;
constexpr int CW_KF = 12288;
static_assert((CW_KF + 2 * 256) * 4 <= (int)CTL_ZERO_BYTES && CW_KF >= CW_CNT + 2 * CNT_LS, "slot-tile flags inside the per-call memset");

#define RLX_AGENT __ATOMIC_RELAXED, __HIP_MEMORY_SCOPE_AGENT
__device__ __forceinline__ unsigned f2bf(float f) { unsigned u = __builtin_bit_cast(unsigned, f); return (u + 0x7fffu + ((u >> 16) & 1u)) >> 16; }
typedef __bf16 hwbf16x2 __attribute__((ext_vector_type(2)));
__device__ __forceinline__ unsigned pk2(float lo, float hi) { f32x2 v = {lo, hi}; hwbf16x2 b = __builtin_convertvector(v, hwbf16x2); return __builtin_bit_cast(unsigned, b); }
__device__ __forceinline__ float bf2f(unsigned short b) { return __builtin_bit_cast(float, (unsigned)b << 16); }
template <int CTRL> __device__ __forceinline__ float dpp_mov(float v) { return __builtin_bit_cast(float, __builtin_amdgcn_update_dpp(0, __builtin_bit_cast(int, v), CTRL, 0xF, 0xF, false)); }
template <int K> __device__ __forceinline__ float xor_lane(float v) {
    if constexpr (K == 1) return dpp_mov<0xB1>(v);
    else if constexpr (K == 2) return dpp_mov<0x4E>(v);
    else return __builtin_bit_cast(float, __builtin_amdgcn_ds_swizzle(__builtin_bit_cast(int, v), (K << 10) | 0x1f)); }
__device__ __forceinline__ float row16_sum_dpp(float v) { v += dpp_mov<0x121>(v); v += dpp_mov<0x122>(v); v += dpp_mov<0x124>(v); v += dpp_mov<0x128>(v); return v; }
__device__ __forceinline__ float add_xor32(float v) {
    auto r = __builtin_amdgcn_permlane32_swap(__builtin_bit_cast(unsigned, v), __builtin_bit_cast(unsigned, v), false, false);
    return __builtin_bit_cast(float, r[0]) + __builtin_bit_cast(float, r[1]); }
__device__ __forceinline__ float bperm_xor(float v, int lane, int k) { return __builtin_bit_cast(float, __builtin_amdgcn_ds_bpermute((lane ^ k) << 2, __builtin_bit_cast(int, v))); }
__device__ __forceinline__ float wave_sum(float v, int lane) {
    v = row16_sum_dpp(v);
    const float r0 = __builtin_bit_cast(float, __builtin_amdgcn_readlane(__builtin_bit_cast(int, v), 0)), r1 = __builtin_bit_cast(float, __builtin_amdgcn_readlane(__builtin_bit_cast(int, v), 16));
    const float r2 = __builtin_bit_cast(float, __builtin_amdgcn_readlane(__builtin_bit_cast(int, v), 32)), r3 = __builtin_bit_cast(float, __builtin_amdgcn_readlane(__builtin_bit_cast(int, v), 48));
    return (r0 + r1) + (r2 + r3);
}
__device__ __forceinline__ float sigmoidf_(float x) { return 1.f / (1.f + __expf(-x)); }

#define XB_TMO      128
#define XB_XCNT(j)  (256  + 64 * (j))
#define XB_XSUB(j)  (1280 + 64 * (j))
#define XB_XGEN(j)  (2304 + 64 * (j))
#define XB_TOP      3328
#define XB_TOPGEN   3392
#define XCD_BAR_WORDS 3456
#define XB_SPIN_CAP (1u << 22)
__device__ __forceinline__ unsigned xb_ld(unsigned* p)              { return __hip_atomic_load(p, __ATOMIC_RELAXED, __HIP_MEMORY_SCOPE_AGENT); }
__device__ __forceinline__ unsigned xb_add(unsigned* p, unsigned v) { return __hip_atomic_fetch_add(p, v, __ATOMIC_RELAXED, __HIP_MEMORY_SCOPE_AGENT); }
__device__ __forceinline__ unsigned xb_xcc_id() { return (unsigned)__builtin_amdgcn_s_getreg((3 << 11) | 20) & 0xFu; }
#define XB_SPIN(cond, bar) do { unsigned _sp = 0; while (cond) { __builtin_amdgcn_s_sleep(1); \
    if ((++_sp & 255u) == 0u) { if (xb_ld(&(bar)[XB_TMO])) break; if (_sp > XB_SPIN_CAP) { atomicAdd(&(bar)[XB_TMO], 1u); break; } } } } while (0)
struct XcdBarrier { unsigned* bar; unsigned x; volatile LAS unsigned* st; };
__device__ __forceinline__ XcdBarrier xcd_barrier_post(unsigned* bar, volatile LAS unsigned* st) {
    XcdBarrier b; b.bar = bar; b.x = xb_xcc_id(); b.st = st;
    if (threadIdx.x == 0) (void)xb_add(&bar[XB_XCNT(b.x)], 1u);
    return b;
}
__device__ __forceinline__ void xcd_barrier_complete(unsigned* bar, unsigned x, unsigned& nloc, unsigned& nx) {
    const unsigned G = gridDim.x * gridDim.y * gridDim.z;
    unsigned sum, cnt, mine, sp = 0u;
    for (;;) {
        sum = 0u; cnt = 0u; mine = 0u;
#pragma unroll
        for (unsigned j = 0; j < 16; ++j) { const unsigned c = xb_ld(&bar[XB_XCNT(j)]); sum += c; cnt += (c > 0u) ? 1u : 0u; mine = (j == x) ? c : mine; }
        if (sum == G) break;
        __builtin_amdgcn_s_sleep(1);
        if ((++sp & 255u) == 0u) { if (xb_ld(&bar[XB_TMO])) break; if (sp > XB_SPIN_CAP) { atomicAdd(&bar[XB_TMO], 1u); break; } }
    }
    nloc = mine > 0u ? mine : 1u; nx = cnt > 0u ? cnt : 1u;
}
__device__ __forceinline__ void xcd_barrier(const XcdBarrier& b) {
    asm volatile("s_waitcnt vmcnt(0)" ::: "memory");
    __syncthreads();
    if (threadIdx.x == 0) {
        unsigned* bar = b.bar;
        __builtin_amdgcn_s_waitcnt(0);
        unsigned nloc = b.st[0], nx = b.st[1];
        if (nloc == 0u) { xcd_barrier_complete(bar, b.x, nloc, nx); b.st[0] = nloc; b.st[1] = nx; }
        const unsigned old = xb_add(&bar[XB_XSUB(b.x)], 1u);
        const unsigned gen = old / nloc;
        if (old + 1u == (gen + 1u) * nloc) {
            __builtin_amdgcn_fence(__ATOMIC_RELEASE, "agent");
            asm volatile("s_waitcnt vmcnt(0)" ::: "memory");
            const unsigned og = xb_add(&bar[XB_TOP], 1u);
            const unsigned tg = og / nx;
            if (og + 1u == (tg + 1u) * nx) xb_add(&bar[XB_TOPGEN], 1u);
            else XB_SPIN(xb_ld(&bar[XB_TOPGEN]) == tg, bar);
            __builtin_amdgcn_fence(__ATOMIC_ACQUIRE, "agent");
            xb_add(&bar[XB_XGEN(b.x)], 1u);
            asm volatile("s_waitcnt vmcnt(0)" ::: "memory");
        } else {
            XB_SPIN(xb_ld(&bar[XB_XGEN(b.x)]) == gen, bar);
            __builtin_amdgcn_fence(__ATOMIC_ACQUIRE, "agent");
            asm volatile("s_waitcnt vmcnt(0)" ::: "memory");
        }
    }
    __syncthreads();
}

constexpr int LDS_BYTES = 155648;
constexpr int MISC_OFF = 131072 + 320;
struct Frame {
    LAS unsigned char* lds; volatile LAS unsigned* MISC; unsigned* ctl;
    int tid, lane, wave, bid, G;
    const GAS void* const* in;
    float* out; GAS unsigned char* ws;
};
#define WSP(T_, off) ((T_*)(GAS T_*)(F.ws + (off)))
__device__ __forceinline__ void fresh_tid(Frame& F) { unsigned z_ = 0u; asm volatile("" : "+v"(z_)); const int l_ = (int)__builtin_amdgcn_mbcnt_hi(~0u, __builtin_amdgcn_mbcnt_lo(~0u, z_)); F.lane = l_; F.tid = F.wave * 64 + l_; }

__constant__ double INVF[16] = {1.0, 0.5623413251903491, 0.31622776601683794, 0.1778279410038923, 0.1, 0.05623413251903491, 0.03162277660168379, 0.01778279410038923,
                                0.01, 0.005623413251903491, 0.0031622776601683794, 0.001778279410038923, 0.001, 0.0005623413251903491, 0.00031622776601683794, 0.0001778279410038923};

constexpr size_t WS_MODP = WS_XN;
__device__ __forceinline__ void step_p0(Frame& F) {
    fresh_tid(F);
    const int gw = F.bid * NWAVES + F.wave, NGW = F.G * NWAVES;
    float* MODP = WSP(float, WS_MODP);
    const float* cin = (const float*)F.in[1];
    for (int it = gw; it < 2 * 96 * 16; it += NGW) {
        const int kc = it & 15, nc = (it >> 4) % 96, l = (it >> 4) / 96, n = nc * 64 + F.lane;
        const float* w = ((const float*)(const GAS float*)F.in[3]) + ((size_t)l * D + kc * 64) * (6 * D) + n;
        float a0 = 0.f, a1 = 0.f;
#pragma unroll
        for (int kh = 0; kh < 2; ++kh) {
            float wv[32];
#pragma unroll
            for (int k = 0; k < 32; ++k) wv[k] = w[(size_t)(kh * 32 + k) * (6 * D)];
#pragma unroll
            for (int k = 0; k < 32; ++k) {
                const float c0 = cin[kc * 64 + kh * 32 + k], c1 = cin[D + kc * 64 + kh * 32 + k];
                const float s0 = c0 / (1.f + __expf(-c0)), s1 = c1 / (1.f + __expf(-c1));
                a0 += s0 * wv[k]; a1 += s1 * wv[k];
            }
        }
        MODP[((size_t)(kc * 2 + l) * 2 + 0) * 6 * D + n] = a0; MODP[((size_t)(kc * 2 + l) * 2 + 1) * 6 * D + n] = a1;
    }
    f32x2* ROPE = WSP(f32x2, WS_ROPE);
    for (int idx = F.bid * NTHREADS + F.tid; idx < T * 16; idx += F.G * NTHREADS) {
        const int t = idx >> 4, i = idx & 15;
        const double a = (double)((const int*)(const GAS int*)F.in[2])[t] * INVF[i];
        const double n = __builtin_rint(a * 0.15915494309189535);
        double r = __builtin_fma(-n, 6.283185307179586, a); r = __builtin_fma(-n, 2.4492935982947064e-16, r);
        const float rf = (float)r;
        f32x2 cs; cs.x = __cosf(rf); cs.y = __sinf(rf);
        ROPE[idx] = cs;
    }
}
__device__ __forceinline__ void step_p0_reduce(Frame& F) {
    fresh_tid(F);
    const float* MODP = WSP(float, WS_MODP); float* MOD = WSP(float, WS_MOD);
    for (int idx = F.bid * NTHREADS + F.tid; idx < 2 * 2 * 6 * D; idx += F.G * NTHREADS) {
        const int n = idx % (6 * D), l = idx / (2 * 6 * D);
        float a = ((const float*)(const GAS float*)F.in[4])[l * 6 * D + n];
#pragma unroll
        for (int kc = 0; kc < 16; ++kc) a += MODP[(size_t)kc * (2 * 2 * 6 * D) + idx];
        MOD[idx] = a;
    }
}

__device__ __forceinline__ void step_a(Frame& F, int l) {
    fresh_tid(F);
    const int gw = F.bid * NWAVES + F.wave, NGW = F.G * NWAVES;
    const float* MOD = WSP(float, WS_MOD);
    const unsigned char* Y = WSP(unsigned char, WS_Y);
    const int* TOKS = WSP(int, WS_TOKS);
    bf16* XN = WSP(bf16, WS_XN); bf16* X16 = WSP(bf16, WS_X16);
    for (int row0 = gw; row0 < T; row0 += 2 * NGW) {
        const bool has1 = row0 + NGW < T;
        int rr[2]; rr[0] = row0; rr[1] = has1 ? row0 + NGW : row0;
        f32x4 v[2][4];
        if (l == 0) {
#pragma unroll
            for (int k = 0; k < 2; ++k)
#pragma unroll
                for (int j = 0; j < 4; ++j) v[k][j] = *(const f32x4*)(((const float*)(const GAS float*)F.in[0]) + (size_t)rr[k] * D + 4 * F.lane + 256 * j);
        } else {
            const unsigned* base = F.ctl + CW_BASE + 32 * (l - 1);
            int tk[2][2];
#pragma unroll
            for (int k = 0; k < 2; ++k) { tk[k][0] = TOKS[2 * rr[k]]; tk[k][1] = TOKS[2 * rr[k] + 1]; }
            size_t sl[2][3];
#pragma unroll
            for (int k = 0; k < 2; ++k) { sl[k][0] = base[tk[k][0] >> 16] + (tk[k][0] & 0xffff); sl[k][1] = base[tk[k][1] >> 16] + (tk[k][1] & 0xffff); sl[k][2] = base[16] + rr[k]; }
            f32x4 xo[2][4], gg[2][4]; unsigned ya[2][4], yb[2][4], yc[2][4];
#pragma unroll
            for (int k = 0; k < 2; ++k) { const float* gt2 = MOD + ((l - 1) * 2 + rr[k] / S) * 6 * D + 5 * D;
#pragma unroll
                for (int j = 0; j < 4; ++j) { const int col = 4 * F.lane + 256 * j;
                    { const bf16x4 t = *(const bf16x4*)(X16 + (size_t)rr[k] * D + col); xo[k][j] = (f32x4){bf2f(t[0]), bf2f(t[1]), bf2f(t[2]), bf2f(t[3])}; } gg[k][j] = *(const f32x4*)(gt2 + col);
                    ya[k][j] = *(const unsigned*)(Y + sl[k][0] * D + col); yb[k][j] = *(const unsigned*)(Y + sl[k][1] * D + col); yc[k][j] = *(const unsigned*)(Y + sl[k][2] * D + col); } }
#pragma unroll
            for (int k = 0; k < 2; ++k)
#pragma unroll
                for (int j = 0; j < 4; ++j) { f32x4 r;
                    const f32x2 a0 = __builtin_amdgcn_cvt_pk_f32_fp8((int)ya[k][j], false), a1 = __builtin_amdgcn_cvt_pk_f32_fp8((int)ya[k][j], true);
                    const f32x2 b0 = __builtin_amdgcn_cvt_pk_f32_fp8((int)yb[k][j], false), b1 = __builtin_amdgcn_cvt_pk_f32_fp8((int)yb[k][j], true);
                    const f32x2 c0 = __builtin_amdgcn_cvt_pk_f32_fp8((int)yc[k][j], false), c1 = __builtin_amdgcn_cvt_pk_f32_fp8((int)yc[k][j], true);
                    const f32x4 ys = (f32x4){a0.x + b0.x + c0.x, a0.y + b0.y + c0.y, a1.x + b1.x + c1.x, a1.y + b1.y + c1.y};
#pragma unroll
                    for (int e = 0; e < 4; ++e) r[e] = xo[k][j][e] + gg[k][j][e] * ys[e];
                    v[k][j] = r;
                    if (k == 0 || has1) { if (l == 2) *(f32x4*)(F.out + (size_t)rr[k] * D + 4 * F.lane + 256 * j) = r;
                        else { v2u o_; o_.x = pk2(r[0], r[1]); o_.y = pk2(r[2], r[3]); *(v2u*)(X16 + (size_t)rr[k] * D + 4 * F.lane + 256 * j) = o_; } } }
        }
        if (l < 2) {
            f32x4 g[4], sc[2][4], sh[2][4];
#pragma unroll
            for (int j = 0; j < 4; ++j) g[j] = *(const f32x4*)(((const float*)(const GAS float*)F.in[5]) + l * D + 4 * F.lane + 256 * j);
#pragma unroll
            for (int k = 0; k < 2; ++k) { const float* m = MOD + (l * 2 + rr[k] / S) * 6 * D;
#pragma unroll
                for (int j = 0; j < 4; ++j) { sc[k][j] = *(const f32x4*)(m + D + 4 * F.lane + 256 * j); sh[k][j] = *(const f32x4*)(m + 4 * F.lane + 256 * j); } }
            float ss[2];
#pragma unroll
            for (int k = 0; k < 2; ++k) { float a = 0.f;
#pragma unroll
                for (int j = 0; j < 4; ++j) a += (v[k][j].x * v[k][j].x + v[k][j].y * v[k][j].y) + (v[k][j].z * v[k][j].z + v[k][j].w * v[k][j].w);
                ss[k] = a; }
            const float rs0 = 1.0f / sqrtf(wave_sum(ss[0], F.lane) * (1.f / D) + EPS), rs1 = 1.0f / sqrtf(wave_sum(ss[1], F.lane) * (1.f / D) + EPS);
#pragma unroll
            for (int k = 0; k < 2; ++k) { const float rs = k ? rs1 : rs0;
#pragma unroll
                for (int j = 0; j < 4; ++j) { f32x4 h;
#pragma unroll
                    for (int e = 0; e < 4; ++e) h[e] = v[k][j][e] * rs * g[j][e] * (1.f + sc[k][j][e]) + sh[k][j][e];
                    v2u o; o.x = pk2(h[0], h[1]); o.y = pk2(h[2], h[3]);
                    if (k == 0 || has1) *(v2u*)(XN + (size_t)rr[k] * D + 4 * F.lane + 256 * j) = o; } }
        }
    }
}

template <int RPT, bool DUAL, class RowF, class Epi>
__device__ __forceinline__ void ngemm(Frame& F, int M, int N, int K, RowF rowf, const float* W, const float* W2, int ldw, const float* ksc, Epi epi) {
    fresh_tid(F);
    const int gw = F.bid * NWAVES + F.wave, NGW = F.G * NWAVES;
    const int nrb = (M + RPT - 1) / RPT, ncc = (N + 255) / 256;
    for (int it = gw; it < nrb * ncc; it += NGW) {
        const int cc = it / nrb, rb = it % nrb;
        const int n4 = cc * 256 + F.lane * 4;
        const bool nv = n4 < N;
        const int n4c = nv ? n4 : 0;
        const bf16* rp[RPT];
#pragma unroll
        for (int r = 0; r < RPT; ++r) { int m = rb * RPT + r; if (m >= M) m = M - 1; rp[r] = rowf(m); }
        f32x4 acc[RPT], acc2[RPT];
#pragma unroll
        for (int r = 0; r < RPT; ++r) { acc[r] = (f32x4){0.f, 0.f, 0.f, 0.f}; acc2[r] = (f32x4){0.f, 0.f, 0.f, 0.f}; }
        for (int k0 = 0; k0 < K; k0 += 8) {
            bf16x8 a[RPT];
#pragma unroll
            for (int r = 0; r < RPT; ++r) a[r] = *(const bf16x8*)(rp[r] + k0);
#pragma unroll
            for (int j = 0; j < 8; ++j) {
                f32x4 w = *(const f32x4*)(W + (size_t)(k0 + j) * ldw + n4c);
                f32x4 w2 = (f32x4){0.f, 0.f, 0.f, 0.f};
                if (DUAL) w2 = *(const f32x4*)(W2 + (size_t)(k0 + j) * ldw + n4c);
                if (ksc) { const float s = ksc[k0 + j]; w = w * s; }
#pragma unroll
                for (int r = 0; r < RPT; ++r) { const float av = bf2f(a[r][j]); acc[r] += av * w; if (DUAL) acc2[r] += av * w2; }
            }
        }
        if (nv) {
#pragma unroll
            for (int r = 0; r < RPT; ++r) { const int m = rb * RPT + r; if (m < M) epi(m, n4, acc[r], acc2[r]); }
        }
    }
}
struct RowLin { const bf16* p; int ld; __device__ __forceinline__ const bf16* operator()(int m) const { return p + (size_t)m * ld; } };
struct RowGather { const bf16* p; int ld; const int* list; __device__ __forceinline__ const bf16* operator()(int m) const { return p + (size_t)(list[m] >> 1) * ld; } };
__device__ __forceinline__ void st_bf4(bf16* p, f32x4 v) { v2u o; o.x = pk2(v[0], v[1]); o.y = pk2(v[2], v[3]); *(v2u*)p = o; }

struct EpiProj { bf16 *conv, *small, *ga, *gb;
    __device__ __forceinline__ void operator()(int m, int n, f32x4 a, f32x4) const {
        bf16* p;
        if (n < 1536) p = conv + (size_t)m * 1536 + n;
        else if (n < 1952) p = small + (size_t)m * 512 + (n - 1536);
        else if (n < 2976) p = ga + (size_t)m * 1024 + (n - 1952);
        else p = gb + (size_t)m * 1024 + (n - 2976);
        st_bf4(p, a);
    } };
struct EpiStore { bf16* o; int ld; __device__ __forceinline__ void operator()(int m, int n, f32x4 a, f32x4) const { st_bf4(o + (size_t)m * ld + n, a); } };
struct EpiGate1 { bf16* ga; __device__ __forceinline__ void operator()(int m, int n, f32x4 a, f32x4) const {
        bf16* p = ga + (size_t)m * D + n; const bf16x4 g = *(const bf16x4*)p; f32x4 r;
#pragma unroll
        for (int e = 0; e < 4; ++e) r[e] = sigmoidf_(bf2f(g[e])) * a[e];
        st_bf4(p, r); } };
struct EpiGate2 { bf16* t1; const bf16* gb; __device__ __forceinline__ void operator()(int m, int n, f32x4 a, f32x4) const {
        bf16* p = t1 + (size_t)m * D + n; const bf16x4 t = *(const bf16x4*)p; const bf16x4 g = *(const bf16x4*)(gb + (size_t)m * D + n); f32x4 r;
#pragma unroll
        for (int e = 0; e < 4; ++e) r[e] = bf2f(t[e]) + sigmoidf_(bf2f(g[e])) * a[e];
        st_bf4(p, r); } };
struct EpiRes { const float* xin; float* out; const float* gt; __device__ __forceinline__ void operator()(int m, int n, f32x4 a, f32x4) const {
        const f32x4 xv = *(const f32x4*)(xin + (size_t)m * D + n); const f32x4 g = *(const f32x4*)(gt + (m / S) * 6 * D + n);
        *(f32x4*)(out + (size_t)m * D + n) = xv + g * a; } };
struct EpiAct { bf16* a2; size_t slot0; const int* list; const float* tokw; __device__ __forceinline__ void operator()(int m, int n, f32x4 g, f32x4 u) const {
        const float w = list ? tokw[list[m]] : 1.f; f32x4 r;
#pragma unroll
        for (int e = 0; e < 4; ++e) r[e] = g[e] / (1.f + __expf(-g[e])) * u[e] * w;
        st_bf4(a2 + (slot0 + m) * DE + n, r); } };

__device__ __forceinline__ void step_c(Frame& F, int l) {
    fresh_tid(F);
    const bf16* CONV = WSP(bf16, WS_CONV); bf16* U = WSP(bf16, WS_U);
    const int gt = F.bid * NTHREADS + F.tid, NT = F.G * NTHREADS;
    for (int idx = gt; idx < T * 64; idx += NT) {
        const int t = idx >> 6, c8 = (idx & 63) * 8, s = t % S;
        const bf16* r0 = CONV + (size_t)t * 1024;
        const bf16x8 cb = *(const bf16x8*)(r0 + c8), p0v = *(const bf16x8*)(r0 + 512 + c8);
        bf16x8 pmv = (bf16x8){0, 0, 0, 0, 0, 0, 0, 0}, ppv = pmv;
        if (s > 0) pmv = *(const bf16x8*)(r0 - 1024 + 512 + c8);
        if (s < S - 1) ppv = *(const bf16x8*)(r0 + 1024 + 512 + c8);
        const float* cw = ((const float*)(const GAS float*)F.in[8]) + l * 3 * CW + c8;
        float o[8];
#pragma unroll
        for (int e = 0; e < 8; ++e) o[e] = bf2f(cb[e]) * (cw[e] * bf2f(pmv[e]) + cw[CW + e] * bf2f(p0v[e]) + cw[2 * CW + e] * bf2f(ppv[e]));
        v4u w; w.x = pk2(o[0], o[1]); w.y = pk2(o[2], o[3]); w.z = pk2(o[4], o[5]); w.w = pk2(o[6], o[7]);
        *(v4u*)(U + (size_t)t * CW + c8) = w;
    }
}

__device__ __forceinline__ float row16_sum(float v) { return row16_sum_dpp(v); }
__device__ __forceinline__ void step_e(Frame& F, int l) {
    fresh_tid(F);
    const bf16* QRAW = WSP(bf16, WS_QRAW); const bf16* SMALL = WSP(bf16, WS_SMALL);
    const f32x2* ROPE = WSP(f32x2, WS_ROPE);
    bf16* Q = WSP(bf16, WS_Q);
    const int gw = F.bid * NWAVES + F.wave, NGW = F.G * NWAVES;
    const int j = F.lane & 15, hh = F.lane >> 4; const bool act = j < 12, isrope = j >= 8 && act;
    const int jc = act ? j : 0;
    const float* gqp = ((const float*)(const GAS float*)F.in[13]) + l * DQK + 8 * jc;
    const f32x4 gq0 = *(const f32x4*)gqp, gq1 = *(const f32x4*)(gqp + 4);
    const float sgn = (j >= 10) ? 1.f : -1.f;
    for (int t = gw; t < T; t += NGW) {
        const int b = t / S, s = t % S;
        const bf16x8 xs = *(const bf16x8*)(SMALL + (size_t)t * 512 + 8 * (F.lane & 31));
        const f32x4* rp = (const f32x4*)(ROPE + (size_t)t * 16 + 8 * (j & 1));
        const f32x4 r0 = rp[0], r1 = rp[1], r2 = rp[2], r3 = rp[3];
        bf16x8 xq[2];
#pragma unroll
        for (int pass = 0; pass < 2; ++pass) xq[pass] = *(const bf16x8*)(QRAW + (size_t)t * 768 + (pass * 4 + hh) * 96 + 8 * jc);
        float sq = 0.f;
#pragma unroll
        for (int e = 0; e < 8; ++e) { const float f = bf2f(xs[e]); sq += f * f; }
        const float rsq = 1.0f / sqrtf(wave_sum(F.lane < 32 ? sq : 0.f, F.lane) * (1.f / 256.f) + EPS);
        float cs[8], sn[8];
        cs[0] = r0.x; sn[0] = r0.y; cs[1] = r0.z; sn[1] = r0.w; cs[2] = r1.x; sn[2] = r1.y; cs[3] = r1.z; sn[3] = r1.w;
        cs[4] = r2.x; sn[4] = r2.y; cs[5] = r2.z; sn[5] = r2.w; cs[6] = r3.x; sn[6] = r3.y; cs[7] = r3.z; sn[7] = r3.w;
#pragma unroll
        for (int pass = 0; pass < 2; ++pass) {
            const int h = pass * 4 + hh;
            const size_t orow = ((size_t)(b * H + h) * S + s);
            const bf16x8 x = xq[pass];
            float v[8]; float ss = 0.f;
#pragma unroll
            for (int e = 0; e < 8; ++e) { v[e] = act ? bf2f(x[e]) * rsq : 0.f; ss += v[e] * v[e]; }
            const float r = 1.0f / sqrtf(row16_sum(ss) * (1.f / 96.f) + EPS);
#pragma unroll
            for (int e = 0; e < 8; ++e) v[e] = v[e] * r * (e < 4 ? gq0[e & 3] : gq1[e & 3]);
#pragma unroll
            for (int e = 0; e < 8; ++e) { const float p = xor_lane<2>(v[e]); if (isrope) v[e] = v[e] * cs[e] + sgn * p * sn[e]; }
            if (act) { v4u w; w.x = pk2(v[0] * QSCALE, v[1] * QSCALE); w.y = pk2(v[2] * QSCALE, v[3] * QSCALE); w.z = pk2(v[4] * QSCALE, v[5] * QSCALE); w.w = pk2(v[6] * QSCALE, v[7] * QSCALE);
                *(v4u*)(Q + orow * 96 + 8 * j) = w; }
        }
    }
}

__device__ __forceinline__ void step_f(Frame& F) {
    fresh_tid(F);
    const bf16* Q = WSP(bf16, WS_Q); const bf16* K = WSP(bf16, WS_K); const bf16* V = WSP(bf16, WS_V); bf16* O = WSP(bf16, WS_O);
    const int gw = F.bid * NWAVES + F.wave, NGW = F.G * NWAVES;
    for (int it = gw; it < NB * H * (S / 64) * 2; it += NGW) {
        const int half = it & 1, it2 = it >> 1;
        const int bh = it2 / (S / 64), qi = (it2 % (S / 64)) * 64 + F.lane;
        bf16x8 q[12]; float o[32];
#pragma unroll
        for (int c = 0; c < 12; ++c) q[c] = *(const bf16x8*)(Q + ((size_t)bh * S + qi) * 96 + c * 8);
#pragma unroll
        for (int d = 0; d < 32; ++d) o[d] = 0.f;
        float m = -1e30f, lsum = 0.f;
        const bf16* kb = K + (size_t)bh * S * 96; const bf16* vb = V + (size_t)bh * S * 64 + half * 32;
#pragma unroll 1
        for (int j = 0; j < S; j += 2) {
            float sc[2];
#pragma unroll
            for (int i = 0; i < 2; ++i) { float a = 0.f;
#pragma unroll
                for (int c = 0; c < 12; ++c) { const bf16x8 kk = *(const bf16x8*)(kb + (size_t)(j + i) * 96 + c * 8);
#pragma unroll
                    for (int e = 0; e < 8; ++e) a += bf2f(q[c][e]) * bf2f(kk[e]); }
                sc[i] = a; asm volatile("" ::: "memory"); }
            const float mn = fmaxf(m, fmaxf(sc[0], sc[1]));
            const float alpha = exp2f(m - mn), p0 = exp2f(sc[0] - mn), p1 = exp2f(sc[1] - mn);
            lsum = lsum * alpha + (p0 + p1); m = mn;
#pragma unroll
            for (int c = 0; c < 4; ++c) {
                const bf16x8 v0 = *(const bf16x8*)(vb + (size_t)(j + 0) * 64 + c * 8), v1 = *(const bf16x8*)(vb + (size_t)(j + 1) * 64 + c * 8);
#pragma unroll
                for (int e = 0; e < 8; ++e) o[c * 8 + e] = o[c * 8 + e] * alpha + (p0 * bf2f(v0[e]) + p1 * bf2f(v1[e]));
                asm volatile("" ::: "memory");
            }
        }
        const float inv = 1.f / lsum; const int b = bh / H, h = bh % H;
        bf16* op = O + ((size_t)(b * S + qi)) * 512 + h * 64 + half * 32;
#pragma unroll
        for (int c = 0; c < 4; ++c) { v4u w; w.x = pk2(o[c * 8] * inv, o[c * 8 + 1] * inv); w.y = pk2(o[c * 8 + 2] * inv, o[c * 8 + 3] * inv); w.z = pk2(o[c * 8 + 4] * inv, o[c * 8 + 5] * inv);
            w.w = pk2(o[c * 8 + 6] * inv, o[c * 8 + 7] * inv); *(v4u*)(op + c * 8) = w; }
    }
}

__device__ __forceinline__ void route16(float myscore, float mybiased, int& e1, int& e2, float& w1, float& w2) {
    float scv[16], bi[16];
#pragma unroll
    for (int e = 0; e < 16; ++e) { scv[e] = __builtin_bit_cast(float, __builtin_amdgcn_readlane(__builtin_bit_cast(int, myscore), e)); bi[e] = __builtin_bit_cast(float, __builtin_amdgcn_readlane(__builtin_bit_cast(int, mybiased), e)); }
    float gs[4];
#pragma unroll
    for (int g = 0; g < 4; ++g) { const float a0 = bi[4 * g], a1 = bi[4 * g + 1], a2 = bi[4 * g + 2], a3 = bi[4 * g + 3];
        const float h1 = fmaxf(a0, a1), l1 = fminf(a0, a1), h2 = fmaxf(a2, a3), l2 = fminf(a2, a3);
        gs[g] = fmaxf(h1, h2) + fmaxf(fminf(h1, h2), fmaxf(l1, l2)); }
    int sg = 0; float bg = gs[0];
#pragma unroll
    for (int g = 1; g < 4; ++g) if (gs[g] > bg) { bg = gs[g]; sg = g; }
    float b0 = bi[0], b1 = bi[1], b2 = bi[2], b3 = bi[3], s0 = scv[0], s1 = scv[1], s2 = scv[2], s3 = scv[3];
#pragma unroll
    for (int g = 1; g < 4; ++g) if (sg == g) { b0 = bi[4 * g]; b1 = bi[4 * g + 1]; b2 = bi[4 * g + 2]; b3 = bi[4 * g + 3]; s0 = scv[4 * g]; s1 = scv[4 * g + 1]; s2 = scv[4 * g + 2]; s3 = scv[4 * g + 3]; }
    int i1 = 0; float m1 = b0, q1 = s0;
    if (b1 > m1) { m1 = b1; i1 = 1; q1 = s1; } if (b2 > m1) { m1 = b2; i1 = 2; q1 = s2; } if (b3 > m1) { m1 = b3; i1 = 3; q1 = s3; }
    int i2 = -1; float m2 = -1e30f, q2 = 0.f;
    if (i1 != 0 && (i2 < 0 || b0 > m2)) { m2 = b0; i2 = 0; q2 = s0; }
    if (i1 != 1 && (i2 < 0 || b1 > m2)) { m2 = b1; i2 = 1; q2 = s1; }
    if (i1 != 2 && (i2 < 0 || b2 > m2)) { m2 = b2; i2 = 2; q2 = s2; }
    if (i1 != 3 && (i2 < 0 || b3 > m2)) { m2 = b3; i2 = 3; q2 = s3; }
    const float inv = 1.f / (q1 + q2);
    e1 = 4 * sg + i1; e2 = 4 * sg + i2; w1 = q1 * inv; w2 = q2 * inv;
}
__device__ __forceinline__ void step_j(Frame& F, int l, bool dry = false) {
    fresh_tid(F);
    const bf16* X16 = WSP(bf16, WS_X16);
    const int gw = F.bid * NWAVES + F.wave, NGW = F.G * NWAVES;
    const float* MOD = WSP(float, WS_MOD); bf16* XN = WSP(bf16, WS_XN);
    int* TOKS = WSP(int, WS_TOKS); float* TOKW = WSP(float, WS_TOKW); int* LIST = WSP(int, WS_LIST);
    unsigned* cnt = F.ctl + CW_CNT + CNT_LS * l;
    LAS unsigned* lcnt = (LAS unsigned*)(F.lds + 65536); LAS unsigned* gbase = lcnt + 16; LAS unsigned* rinfo = (LAS unsigned*)(F.lds + 65536 + 256) + F.wave * 512;
    if (F.tid < 16) lcnt[F.tid] = 0u;
    __syncthreads();
    int ri = 0;
    LAS float* hrow = (LAS float*)(F.lds + F.wave * 8192);
    const int re = F.lane & 15, rq = F.lane >> 4;
    const float* wr = ((const float*)(const GAS float*)F.in[18]) + (size_t)(rq * 256) * NE + re;
    const float brt = ((const float*)(const GAS float*)F.in[19])[re];
    for (int row0 = gw; row0 < T; row0 += 2 * NGW) {
        const bool has1 = row0 + NGW < T;
        int rr[2]; rr[0] = row0; rr[1] = has1 ? row0 + NGW : row0;
        f32x4 v[2][4], g[4], sc[2][4], sh[2][4];
#pragma unroll
        for (int k = 0; k < 2; ++k)
#pragma unroll
            for (int j = 0; j < 4; ++j) { const bf16x4 t = *(const bf16x4*)(X16 + (size_t)rr[k] * D + 4 * F.lane + 256 * j); v[k][j] = (f32x4){bf2f(t[0]), bf2f(t[1]), bf2f(t[2]), bf2f(t[3])}; }
#pragma unroll
        for (int j = 0; j < 4; ++j) g[j] = *(const f32x4*)(((const float*)(const GAS float*)F.in[6]) + l * D + 4 * F.lane + 256 * j);
#pragma unroll
        for (int k = 0; k < 2; ++k) { const float* m = MOD + (l * 2 + rr[k] / S) * 6 * D;
#pragma unroll
            for (int j = 0; j < 4; ++j) { sc[k][j] = *(const f32x4*)(m + 4 * D + 4 * F.lane + 256 * j); sh[k][j] = *(const f32x4*)(m + 3 * D + 4 * F.lane + 256 * j); } }
        float ss[2];
#pragma unroll
        for (int k = 0; k < 2; ++k) { float a = 0.f;
#pragma unroll
            for (int j = 0; j < 4; ++j) a += (v[k][j].x * v[k][j].x + v[k][j].y * v[k][j].y) + (v[k][j].z * v[k][j].z + v[k][j].w * v[k][j].w);
            ss[k] = a; }
        const float rs0 = 1.0f / sqrtf(wave_sum(ss[0], F.lane) * (1.f / D) + EPS), rs1 = 1.0f / sqrtf(wave_sum(ss[1], F.lane) * (1.f / D) + EPS);
#pragma unroll
        for (int k = 0; k < 2; ++k) { const float rs = k ? rs1 : rs0;
#pragma unroll
            for (int j = 0; j < 4; ++j) { const int col = 4 * F.lane + 256 * j; f32x4 hh;
#pragma unroll
                for (int e = 0; e < 4; ++e) hh[e] = v[k][j][e] * rs * g[j][e] * (1.f + sc[k][j][e]) + sh[k][j][e];
                v2u o; o.x = pk2(hh[0], hh[1]); o.y = pk2(hh[2], hh[3]);
                if (k == 0 || has1) *(v2u*)(XN + (size_t)rr[k] * D + col) = o;
                *(LAS f32x4*)(hrow + k * 1024 + col) = hh; } }
        asm volatile("s_waitcnt lgkmcnt(0)" ::: "memory");
        float a0 = 0.f, a1 = 0.f, a2 = 0.f, a3 = 0.f, c0 = 0.f, c1 = 0.f, c2 = 0.f, c3 = 0.f;
#pragma unroll 4
        for (int c = 0; c < 256; c += 4) {
            const f32x4 h0 = *(const LAS f32x4*)(hrow + rq * 256 + c), h1 = *(const LAS f32x4*)(hrow + 1024 + rq * 256 + c);
            const float w0 = wr[(size_t)(c + 0) * NE], w1 = wr[(size_t)(c + 1) * NE], w2 = wr[(size_t)(c + 2) * NE], w3 = wr[(size_t)(c + 3) * NE];
            a0 += h0.x * w0; a1 += h0.y * w1; a2 += h0.z * w2; a3 += h0.w * w3;
            c0 += h1.x * w0; c1 += h1.y * w1; c2 += h1.z * w2; c3 += h1.w * w3;
        }
        float z0 = (a0 + a1) + (a2 + a3), z1 = (c0 + c1) + (c2 + c3);
        z0 += bperm_xor(z0, F.lane, 16); z0 += bperm_xor(z0, F.lane, 32);
        z1 += bperm_xor(z1, F.lane, 16); z1 += bperm_xor(z1, F.lane, 32);
        asm volatile("s_waitcnt lgkmcnt(0)" ::: "memory");
#pragma unroll
        for (int k = 0; k < 2; ++k) {
            const float z = k ? z1 : z0;
            const float myscore = 1.f / (1.f + expf(-z)), mybiased = myscore + brt;
            int e1, e2; float w1, w2;
            route16(myscore, mybiased, e1, e2, w1, w2);
            if (F.lane == 0 && !dry && (k == 0 || has1)) {
                const unsigned p1 = __hip_atomic_fetch_add(lcnt + e1, 1u, __ATOMIC_RELAXED, __HIP_MEMORY_SCOPE_WORKGROUP), p2 = __hip_atomic_fetch_add(lcnt + e2, 1u, __ATOMIC_RELAXED, __HIP_MEMORY_SCOPE_WORKGROUP);
                LAS unsigned* r = rinfo + ri * 8;
                r[0] = (unsigned)rr[k]; r[1] = (unsigned)e1; r[2] = p1; r[3] = (unsigned)e2; r[4] = p2; r[5] = __builtin_bit_cast(unsigned, w1); r[6] = __builtin_bit_cast(unsigned, w2);
            }
            if (k == 0 || has1) ++ri;
        }
    }
    if (dry) return;
    __syncthreads();
    if (F.tid < 16) { const unsigned c = lcnt[F.tid]; gbase[F.tid] = c ? __hip_atomic_fetch_add(cnt + CNT_ES * F.tid, c, RLX_AGENT) : 0u; }
    __syncthreads();
    if (F.lane < ri) {
        const LAS unsigned* r = rinfo + F.lane * 8;
        const int row = (int)r[0], e1 = (int)r[1], e2 = (int)r[3]; const unsigned p1 = gbase[e1] + r[2], p2 = gbase[e2] + r[4];
        LIST[(size_t)e1 * T + p1] = 2 * row; LIST[(size_t)e2 * T + p2] = 2 * row + 1;
        TOKS[2 * row] = (e1 << 16) | (int)p1; TOKS[2 * row + 1] = (e2 << 16) | (int)p2;
        TOKW[2 * row] = __builtin_bit_cast(float, r[5]); TOKW[2 * row + 1] = __builtin_bit_cast(float, r[6]);
    }
}

__device__ __forceinline__ void step_j_old(Frame& F, int l, bool dry = false) {
    fresh_tid(F);
    const int gw = F.bid * NWAVES + F.wave, NGW = F.G * NWAVES;
    const float* MOD = WSP(float, WS_MOD); bf16* XN = WSP(bf16, WS_XN);
    int* TOKS = WSP(int, WS_TOKS); float* TOKW = WSP(float, WS_TOKW); int* LIST = WSP(int, WS_LIST);
    unsigned* cnt = F.ctl + CW_CNT + CNT_LS * l;
    for (int row = gw; row < T; row += NGW) {
        const int b = row / S;
        float ss = 0.f;
#pragma unroll
        for (int j = 0; j < 4; ++j) { const f32x4 vv = *(const f32x4*)(F.out + (size_t)row * D + 4 * F.lane + 256 * j); ss += (vv.x * vv.x + vv.y * vv.y) + (vv.z * vv.z + vv.w * vv.w); }
        const float rs = 1.0f / sqrtf(wave_sum(ss, F.lane) * (1.f / D) + EPS);
        const float* m = MOD + (l * 2 + b) * 6 * D;
        float lg[16];
#pragma unroll
        for (int e = 0; e < 16; ++e) lg[e] = 0.f;
#pragma unroll 1
        for (int j = 0; j < 4; ++j) {
            const int col = 4 * F.lane + 256 * j;
            const f32x4 vj = *(const f32x4*)(F.out + (size_t)row * D + col);
            const f32x4 g = *(const f32x4*)(((const float*)(const GAS float*)F.in[6]) + l * D + col), sc = *(const f32x4*)(m + 4 * D + col), sh = *(const f32x4*)(m + 3 * D + col);
            f32x4 hh;
#pragma unroll
            for (int e = 0; e < 4; ++e) hh[e] = vj[e] * rs * g[e] * (1.f + sc[e]) + sh[e];
            v2u o; o.x = pk2(hh[0], hh[1]); o.y = pk2(hh[2], hh[3]);
            *(v2u*)(XN + (size_t)row * D + col) = o;
#pragma unroll
            for (int i = 0; i < 4; ++i) {
                const float* wr = ((const float*)(const GAS float*)F.in[18]) + (size_t)(col + i) * NE;
                const f32x4 w0 = *(const f32x4*)(wr), w1 = *(const f32x4*)(wr + 4), w2 = *(const f32x4*)(wr + 8), w3 = *(const f32x4*)(wr + 12);
#pragma unroll
                for (int e = 0; e < 4; ++e) { lg[e] += hh[i] * w0[e]; lg[4 + e] += hh[i] * w1[e]; lg[8 + e] += hh[i] * w2[e]; lg[12 + e] += hh[i] * w3[e]; }
            }
        }
        float scv[16], bi[16];
#pragma unroll
        for (int e = 0; e < 16; ++e) { const float z = wave_sum(lg[e], F.lane); scv[e] = 1.f / (1.f + expf(-z)); bi[e] = scv[e] + ((const float*)(const GAS float*)F.in[19])[e]; }
        float gs[4];
#pragma unroll
        for (int g = 0; g < 4; ++g) { const float a0 = bi[4 * g], a1 = bi[4 * g + 1], a2 = bi[4 * g + 2], a3 = bi[4 * g + 3];
            const float h1 = fmaxf(a0, a1), l1 = fminf(a0, a1), h2 = fmaxf(a2, a3), l2 = fminf(a2, a3);
            gs[g] = fmaxf(h1, h2) + fmaxf(fminf(h1, h2), fmaxf(l1, l2)); }
        int sg = 0; float bg = gs[0];
#pragma unroll
        for (int g = 1; g < 4; ++g) if (gs[g] > bg) { bg = gs[g]; sg = g; }
        float b0 = bi[0], b1 = bi[1], b2 = bi[2], b3 = bi[3], s0 = scv[0], s1 = scv[1], s2 = scv[2], s3 = scv[3];
#pragma unroll
        for (int g = 1; g < 4; ++g) if (sg == g) { b0 = bi[4 * g]; b1 = bi[4 * g + 1]; b2 = bi[4 * g + 2]; b3 = bi[4 * g + 3]; s0 = scv[4 * g]; s1 = scv[4 * g + 1]; s2 = scv[4 * g + 2]; s3 = scv[4 * g + 3]; }
        int i1 = 0; float m1 = b0, q1 = s0;
        if (b1 > m1) { m1 = b1; i1 = 1; q1 = s1; } if (b2 > m1) { m1 = b2; i1 = 2; q1 = s2; } if (b3 > m1) { m1 = b3; i1 = 3; q1 = s3; }
        int i2 = -1; float m2 = -1e30f, q2 = 0.f;
        if (i1 != 0 && (i2 < 0 || b0 > m2)) { m2 = b0; i2 = 0; q2 = s0; }
        if (i1 != 1 && (i2 < 0 || b1 > m2)) { m2 = b1; i2 = 1; q2 = s1; }
        if (i1 != 2 && (i2 < 0 || b2 > m2)) { m2 = b2; i2 = 2; q2 = s2; }
        if (i1 != 3 && (i2 < 0 || b3 > m2)) { m2 = b3; i2 = 3; q2 = s3; }
        if (F.lane == 0 && !dry) {
            const int e1 = 4 * sg + i1, e2 = 4 * sg + i2; const float inv = 1.f / (q1 + q2);
            const unsigned p1 = __hip_atomic_fetch_add(cnt + CNT_ES * e1, 1u, RLX_AGENT), p2 = __hip_atomic_fetch_add(cnt + CNT_ES * e2, 1u, RLX_AGENT);
            LIST[(size_t)e1 * T + p1] = 2 * row; LIST[(size_t)e2 * T + p2] = 2 * row + 1;
            TOKS[2 * row] = (e1 << 16) | (int)p1; TOKS[2 * row + 1] = (e2 << 16) | (int)p2;
            TOKW[2 * row] = q1 * inv; TOKW[2 * row + 1] = q2 * inv;
        }
    }
}


namespace att {
typedef short sbf16x8 __attribute__((ext_vector_type(8)));
typedef short s16x4 __attribute__((ext_vector_type(4)));
typedef float f32x16 __attribute__((ext_vector_type(16)));
constexpr int NW = 8, QBLK = 32, KVBLK = 64;
constexpr int SHM_K = KVBLK * 256, SHM_V = KVBLK * 256;
constexpr int OFF_V = 0, OFF_K = 2 * SHM_V, OFF_WS = 2 * SHM_V + 2 * SHM_K, OFF_OST = OFF_WS + NW * 64 * 4, LDS_NEED = OFF_OST + NW * 4096;
static_assert(LDS_NEED <= 131072, "attention LDS");
constexpr float THR2 = 11.f;
#define ATT_KSWZ(row, colB) ((row) * 256 + ((colB) ^ (((row) & 15) << 4)))
#define ATT_SBAR() __builtin_amdgcn_sched_barrier(0)
__device__ __forceinline__ int crow(int r, int hi) { return (r & 3) + 8 * (r >> 2) + 4 * hi; }
__device__ __forceinline__ void partialSM(f32x16& p0, f32x16& p1) {
#pragma unroll
    for (int r = 0; r < 16; ++r) p0[r] = __builtin_amdgcn_exp2f(p0[r]);
}
__device__ __forceinline__ void finishSM(f32x16& p0, f32x16& p1, float& l_reg, sbf16x8& pa0, sbf16x8& pa1, sbf16x8& pa2, sbf16x8& pa3) {
#pragma unroll
    for (int r = 0; r < 16; ++r) p1[r] = __builtin_amdgcn_exp2f(p1[r]);
    float ps0 = 0.f, ps1 = 0.f;
#pragma unroll
    for (int r = 0; r < 16; ++r) { ps0 += p0[r]; ps1 += p1[r]; }
    l_reg += ps0 + ps1;
#define ATT_PK4(P, BASE, OUT) do { unsigned a0 = pk2(P[BASE + 0], P[BASE + 1]), a1 = pk2(P[BASE + 2], P[BASE + 3]);   \
    unsigned b0 = pk2(P[BASE + 4], P[BASE + 5]), b1 = pk2(P[BASE + 6], P[BASE + 7]);                              \
    auto r0 = __builtin_amdgcn_permlane32_swap(a0, b0, false, false); auto r1 = __builtin_amdgcn_permlane32_swap(a1, b1, false, false); \
    v4u w = {r0[0], r1[0], r0[1], r1[1]}; OUT = __builtin_bit_cast(sbf16x8, w); } while (0)
    ATT_PK4(p0, 0, pa0); ATT_PK4(p0, 8, pa1); ATT_PK4(p1, 0, pa2); ATT_PK4(p1, 8, pa3);
#undef ATT_PK4
}
__device__ __forceinline__ void qkt(f32x16& p0, f32x16& p1, const LAS char* Ks, const sbf16x8* qr, int r32, int hi) {
    asm volatile("" : "+v"(r32));
    p0 = f32x16{}; p1 = f32x16{};
    sbf16x8 c0 = *(const LAS sbf16x8*)(Ks + ATT_KSWZ(r32, (hi * 8) * 2)), c1 = *(const LAS sbf16x8*)(Ks + ATT_KSWZ(32 + r32, (hi * 8) * 2));
#pragma unroll
    for (int d0 = 0; d0 < 6; ++d0) {
        sbf16x8 n0 = c0, n1 = c1;
        if (d0 < 5) { const int cb = ((d0 + 1) * 16 + hi * 8) * 2; n0 = *(const LAS sbf16x8*)(Ks + ATT_KSWZ(r32, cb)); n1 = *(const LAS sbf16x8*)(Ks + ATT_KSWZ(32 + r32, cb)); }
        p0 = __builtin_amdgcn_mfma_f32_32x32x16_bf16(c0, qr[d0], p0, 0, 0, 0);
        p1 = __builtin_amdgcn_mfma_f32_32x32x16_bf16(c1, qr[d0], p1, 0, 0, 0);
        c0 = n0; c1 = n1;
    }
}
__device__ __forceinline__ int v_st(int k, int c) { const int kk = (k & ~0xC) | ((k & 4) << 1) | ((k & 8) >> 1); return ((kk >> 3) * 4 + (c >> 5)) * 512 + ((kk & 7) * 32 + (c & 31)) * 2; }
__device__ __forceinline__ int v_rd_base(int lane) { return ((lane & 3) << 3) | (((lane >> 2) & 3) << 6) | (((lane >> 4) & 1) << 5) | (((lane >> 5) & 1) << 8); }
constexpr int v_rd_off(int d0, int ks, int half) { return d0 * 512 + ks * 4096 + half * 2048; }
template <int OFF> __device__ __forceinline__ s16x4 tr_read(int vb) { s16x4 r; asm volatile("ds_read_b64_tr_b16 %0, %1 offset:%2" : "=&v"(r) : "v"(vb), "i"(OFF) : "memory"); return r; }
template <int D0> __device__ __forceinline__ void pv_one(f32x16& od, int vb, sbf16x8 pa0, sbf16x8 pa1, sbf16x8 pa2, sbf16x8 pa3) {
    const s16x4 l0 = tr_read<v_rd_off(D0, 0, 0)>(vb), h0 = tr_read<v_rd_off(D0, 0, 1)>(vb), l1 = tr_read<v_rd_off(D0, 1, 0)>(vb), h1 = tr_read<v_rd_off(D0, 1, 1)>(vb);
    const s16x4 l2 = tr_read<v_rd_off(D0, 2, 0)>(vb), h2 = tr_read<v_rd_off(D0, 2, 1)>(vb), l3 = tr_read<v_rd_off(D0, 3, 0)>(vb), h3 = tr_read<v_rd_off(D0, 3, 1)>(vb);
    asm volatile("s_waitcnt lgkmcnt(0)" ::: "memory"); ATT_SBAR();
#define ATT_PK(L, H) (sbf16x8){L[0], L[1], L[2], L[3], H[0], H[1], H[2], H[3]}
    od = __builtin_amdgcn_mfma_f32_32x32x16_bf16(pa0, ATT_PK(l0, h0), od, 0, 0, 0);
    od = __builtin_amdgcn_mfma_f32_32x32x16_bf16(pa1, ATT_PK(l1, h1), od, 0, 0, 0);
    od = __builtin_amdgcn_mfma_f32_32x32x16_bf16(pa2, ATT_PK(l2, h2), od, 0, 0, 0);
    od = __builtin_amdgcn_mfma_f32_32x32x16_bf16(pa3, ATT_PK(l3, h3), od, 0, 0, 0);
#undef ATT_PK
}
__device__ __forceinline__ void pv2(f32x16* o, int vb, sbf16x8 pa0, sbf16x8 pa1, sbf16x8 pa2, sbf16x8 pa3) { pv_one<0>(o[0], vb, pa0, pa1, pa2, pa3); pv_one<1>(o[1], vb, pa0, pa1, pa2, pa3); }

__device__ __forceinline__ void attn_unit(const bf16* Qb, const bf16* Kh, const bf16* Vh, bf16* Ob, int seq, LAS char* lds, int tid) {
    const int wid = __builtin_amdgcn_readfirstlane(tid >> 6), lane = tid & 63, r32 = lane & 31, hi = lane >> 5; int lane2;
    LAS char* V_lds = lds + OFF_V; LAS char* K_lds = lds + OFF_K;
    LAS float* ws = (LAS float*)(lds + OFF_WS) + wid * 64; LAS float* li_l = ws;
    float l_reg = 0.f; f32x16 o[2]; o[0] = f32x16{}; o[1] = f32x16{}; sbf16x8 qr[6];
    const bf16* Qw = Qb + (size_t)(wid * QBLK + r32) * 96 + hi * 8;
#pragma unroll
    for (int d0 = 0; d0 < 6; ++d0) qr[d0] = *(const GAS sbf16x8*)((const GAS bf16*)Qw + d0 * 16);
    const int kc1 = 512 + (tid & 255), kr0 = tid / 12, kq0 = (tid % 12) * 8, kr1 = kc1 / 12, kq1 = (kc1 % 12) * 8;
    const int ksto0 = ATT_KSWZ(kr0, kq0 * 2), ksto1 = ATT_KSWZ(kr1, kq1 * 2);
    const int vr = tid >> 3, vq = (tid & 7) * 8, vsto = v_st(vr, vq);
    const int vb0 = (int)(unsigned)(size_t)V_lds + v_rd_base(lane);
    const unsigned ko0 = (unsigned)(kr0 * 96 + kq0) * 2u, ko1 = (unsigned)(kr1 * 96 + kq1) * 2u, vo = (unsigned)(vr * 64 + vq) * 2u;
    sbf16x8 sk0[2], sk1[2], sv[2];
    const GAS char* Kg = (const GAS char*)Kh; const GAS char* Vg = (const GAS char*)Vh;
#define ATT_SLOAD(i, k0) do { sk0[i] = *(const GAS sbf16x8*)(Kg + (ko0 + (unsigned)(k0) * 192u)); sk1[i] = *(const GAS sbf16x8*)(Kg + (ko1 + (unsigned)(k0) * 192u)); sv[i] = *(const GAS sbf16x8*)(Vg + (vo + (unsigned)(k0) * 128u)); } while (0)
#define ATT_SWRITE(b, i) do { *(LAS sbf16x8*)(K_lds + (b) * SHM_K + ksto0) = sk0[i]; *(LAS sbf16x8*)(K_lds + (b) * SHM_K + ksto1) = sk1[i]; *(LAS sbf16x8*)(V_lds + (b) * SHM_V + vsto) = sv[i]; } while (0)
#define ATT_SWAIT() asm volatile("s_waitcnt vmcnt(3)" ::: "memory")
    f32x16 pA0, pA1, pB0, pB1; sbf16x8 pa0, pa1, pa2, pa3; const int NT = seq / KVBLK;
    ATT_SLOAD(0, 0); asm volatile("s_waitcnt vmcnt(0)" ::: "memory"); ATT_SWRITE(0, 0); __syncthreads();
    qkt(pA0, pA1, K_lds, qr, r32, hi); partialSM(pA0, pA1);
    ATT_SLOAD(1, KVBLK); if (2 < NT) ATT_SLOAD(0, 2 * KVBLK);
    ATT_SWAIT(); ATT_SWRITE(1, 1); __syncthreads();
#pragma unroll 1
    for (int j = 1; j + 1 < NT; j += 2) {
        ATT_SBAR(); qkt(pB0, pB1, K_lds + SHM_K, qr, r32, hi);
        finishSM(pA0, pA1, l_reg, pa0, pa1, pa2, pa3); ATT_SBAR();
        ATT_SLOAD(1, (j + 2) * KVBLK); ATT_SBAR();
        pv2(o, vb0, pa0, pa1, pa2, pa3); partialSM(pB0, pB1);
        __syncthreads(); ATT_SWAIT(); ATT_SWRITE(0, 0);
        __syncthreads();
        ATT_SBAR(); qkt(pA0, pA1, K_lds, qr, r32, hi);
        finishSM(pB0, pB1, l_reg, pa0, pa1, pa2, pa3); ATT_SBAR();
        if (j + 3 < NT) ATT_SLOAD(0, (j + 3) * KVBLK); ATT_SBAR();
        pv2(o, vb0 + SHM_V, pa0, pa1, pa2, pa3); partialSM(pA0, pA1);
        __syncthreads(); ATT_SWAIT(); ATT_SWRITE(1, 1);
        __syncthreads();
    }
    ATT_SBAR(); qkt(pB0, pB1, K_lds + SHM_K, qr, r32, hi);
    finishSM(pA0, pA1, l_reg, pa0, pa1, pa2, pa3); ATT_SBAR();
    pv2(o, vb0, pa0, pa1, pa2, pa3); partialSM(pB0, pB1);
    __syncthreads();
    finishSM(pB0, pB1, l_reg, pa0, pa1, pa2, pa3); ATT_SBAR();
    pv2(o, vb0 + SHM_V, pa0, pa1, pa2, pa3);
    { auto rr = __builtin_amdgcn_permlane32_swap(__float_as_uint(l_reg), __float_as_uint(l_reg), false, false); l_reg = __uint_as_float(rr[0]) + __uint_as_float(rr[1]); }
    { unsigned z_ = 0u; asm volatile("" : "+v"(z_)); lane2 = (int)__builtin_amdgcn_mbcnt_hi(~0u, __builtin_amdgcn_mbcnt_lo(~0u, z_)); }
    const int r32e = lane2 & 31, hie = lane2 >> 5;
    if (hie == 0) li_l[r32e] = l_reg; asm volatile("s_waitcnt lgkmcnt(0)" ::: "memory");
    float rli[16];
#pragma unroll
    for (int r = 0; r < 16; ++r) rli[r] = __builtin_amdgcn_rcpf(li_l[crow(r, hie)]);
    LAS bf16* stg = (LAS bf16*)(lds + OFF_OST) + wid * 2048;
#pragma unroll
    for (int r = 0; r < 16; ++r) { const int orow = crow(r, hie);
#pragma unroll
        for (int d0 = 0; d0 < 2; ++d0) stg[orow * 64 + d0 * 32 + r32e] = (bf16)(pk2(o[d0][r] * rli[r], 0.f) & 0xffffu); }
    asm volatile("s_waitcnt lgkmcnt(0)" ::: "memory");
    bf16* Ow = Ob + (size_t)(wid * QBLK) * 512;
#pragma unroll
    for (int i = 0; i < 4; ++i) { const int row = i * 8 + (lane2 >> 3), ch = lane2 & 7; const v4u v = *(const LAS v4u*)(stg + row * 64 + ch * 8); *(GAS v4u*)((GAS bf16*)Ow + (size_t)row * 512 + ch * 8) = v; }
    asm volatile("s_waitcnt lgkmcnt(0)" ::: "memory");
#undef ATT_SLOAD
#undef ATT_SWRITE
#undef ATT_SWAIT
}
__device__ __forceinline__ void softmax_pack(f32x16& p0, f32x16& p1, float& l_reg, sbf16x8& pa0, sbf16x8& pa1, sbf16x8& pa2, sbf16x8& pa3) {
#pragma unroll
    for (int r = 0; r < 16; ++r) p0[r] = __builtin_amdgcn_exp2f(p0[r]);
#pragma unroll
    for (int r = 0; r < 16; ++r) p1[r] = __builtin_amdgcn_exp2f(p1[r]);
    float ps0 = 0.f, ps1 = 0.f;
#pragma unroll
    for (int r = 0; r < 16; ++r) { ps0 += p0[r]; ps1 += p1[r]; }
    l_reg += ps0 + ps1;
#define ATT_PK4(P, BASE, OUT) do { unsigned a0 = pk2(P[BASE + 0], P[BASE + 1]), a1 = pk2(P[BASE + 2], P[BASE + 3]);   \
    unsigned b0 = pk2(P[BASE + 4], P[BASE + 5]), b1 = pk2(P[BASE + 6], P[BASE + 7]);                              \
    auto r0 = __builtin_amdgcn_permlane32_swap(a0, b0, false, false); auto r1 = __builtin_amdgcn_permlane32_swap(a1, b1, false, false); \
    v4u w = {r0[0], r1[0], r0[1], r1[1]}; OUT = __builtin_bit_cast(sbf16x8, w); } while (0)
    ATT_PK4(p0, 0, pa0); ATT_PK4(p0, 8, pa1); ATT_PK4(p1, 0, pa2); ATT_PK4(p1, 8, pa3);
#undef ATT_PK4
}
__device__ __forceinline__ void qkt2(f32x16& x0, f32x16& x1, f32x16& y0, f32x16& y1, const LAS char* Ks, const sbf16x8* qx, const sbf16x8* qy, int r32, int hi) {
    asm volatile("" : "+v"(r32));
    x0 = f32x16{}; x1 = f32x16{}; y0 = f32x16{}; y1 = f32x16{};
    sbf16x8 c0 = *(const LAS sbf16x8*)(Ks + ATT_KSWZ(r32, (hi * 8) * 2)), c1 = *(const LAS sbf16x8*)(Ks + ATT_KSWZ(32 + r32, (hi * 8) * 2));
#pragma unroll
    for (int d0 = 0; d0 < 6; ++d0) {
        sbf16x8 n0 = c0, n1 = c1;
        if (d0 < 5) { const int cb = ((d0 + 1) * 16 + hi * 8) * 2; n0 = *(const LAS sbf16x8*)(Ks + ATT_KSWZ(r32, cb)); n1 = *(const LAS sbf16x8*)(Ks + ATT_KSWZ(32 + r32, cb)); }
        x0 = __builtin_amdgcn_mfma_f32_32x32x16_bf16(c0, qx[d0], x0, 0, 0, 0);
        x1 = __builtin_amdgcn_mfma_f32_32x32x16_bf16(c1, qx[d0], x1, 0, 0, 0);
        y0 = __builtin_amdgcn_mfma_f32_32x32x16_bf16(c0, qy[d0], y0, 0, 0, 0);
        y1 = __builtin_amdgcn_mfma_f32_32x32x16_bf16(c1, qy[d0], y1, 0, 0, 0);
        c0 = n0; c1 = n1;
    }
}
template <int D0> __device__ __forceinline__ void pv_one2(f32x16& ox, f32x16& oy, int vb, const sbf16x8 (&px)[4], const sbf16x8 (&py)[4]) {
    const s16x4 l0 = tr_read<v_rd_off(D0, 0, 0)>(vb), h0 = tr_read<v_rd_off(D0, 0, 1)>(vb), l1 = tr_read<v_rd_off(D0, 1, 0)>(vb), h1 = tr_read<v_rd_off(D0, 1, 1)>(vb);
    const s16x4 l2 = tr_read<v_rd_off(D0, 2, 0)>(vb), h2 = tr_read<v_rd_off(D0, 2, 1)>(vb), l3 = tr_read<v_rd_off(D0, 3, 0)>(vb), h3 = tr_read<v_rd_off(D0, 3, 1)>(vb);
    asm volatile("s_waitcnt lgkmcnt(0)" ::: "memory"); ATT_SBAR();
#define ATT_PK(L, H) (sbf16x8){L[0], L[1], L[2], L[3], H[0], H[1], H[2], H[3]}
    ox = __builtin_amdgcn_mfma_f32_32x32x16_bf16(px[0], ATT_PK(l0, h0), ox, 0, 0, 0);
    oy = __builtin_amdgcn_mfma_f32_32x32x16_bf16(py[0], ATT_PK(l0, h0), oy, 0, 0, 0);
    ox = __builtin_amdgcn_mfma_f32_32x32x16_bf16(px[1], ATT_PK(l1, h1), ox, 0, 0, 0);
    oy = __builtin_amdgcn_mfma_f32_32x32x16_bf16(py[1], ATT_PK(l1, h1), oy, 0, 0, 0);
    ox = __builtin_amdgcn_mfma_f32_32x32x16_bf16(px[2], ATT_PK(l2, h2), ox, 0, 0, 0);
    oy = __builtin_amdgcn_mfma_f32_32x32x16_bf16(py[2], ATT_PK(l2, h2), oy, 0, 0, 0);
    ox = __builtin_amdgcn_mfma_f32_32x32x16_bf16(px[3], ATT_PK(l3, h3), ox, 0, 0, 0);
    oy = __builtin_amdgcn_mfma_f32_32x32x16_bf16(py[3], ATT_PK(l3, h3), oy, 0, 0, 0);
#undef ATT_PK
}
__device__ __forceinline__ void softmax_half(f32x16& p, float& l_reg, sbf16x8& pa, sbf16x8& pb) {
#pragma unroll
    for (int r = 0; r < 16; ++r) p[r] = __builtin_amdgcn_exp2f(p[r]);
    float ps0 = 0.f, ps1 = 0.f;
#pragma unroll
    for (int r = 0; r < 8; ++r) { ps0 += p[r]; ps1 += p[8 + r]; }
    l_reg += ps0 + ps1;
    { v4u w; w.x = pk2(p[0], p[1]); w.y = pk2(p[2], p[3]); w.z = pk2(p[4], p[5]); w.w = pk2(p[6], p[7]); pa = __builtin_bit_cast(sbf16x8, w); }
    { v4u w; w.x = pk2(p[8], p[9]); w.y = pk2(p[10], p[11]); w.z = pk2(p[12], p[13]); w.w = pk2(p[14], p[15]); pb = __builtin_bit_cast(sbf16x8, w); }
}
template <int ROW0> __device__ __forceinline__ void qk_half(f32x16& x, f32x16& y, const LAS char* Ks, const sbf16x8* qx, const sbf16x8* qy, int r32, int hi) {
    asm volatile("" : "+v"(r32));
    x = f32x16{}; y = f32x16{};
    sbf16x8 c = *(const LAS sbf16x8*)(Ks + ATT_KSWZ(ROW0 + r32, (hi * 8) * 2));
#pragma unroll
    for (int d0 = 0; d0 < 6; ++d0) {
        sbf16x8 n = c;
        if (d0 < 5) n = *(const LAS sbf16x8*)(Ks + ATT_KSWZ(ROW0 + r32, ((d0 + 1) * 16 + hi * 8) * 2));
        x = __builtin_amdgcn_mfma_f32_32x32x16_bf16(c, qx[d0], x, 0, 0, 0);
        y = __builtin_amdgcn_mfma_f32_32x32x16_bf16(c, qy[d0], y, 0, 0, 0);
        c = n;
    }
}
template <int KS0> __device__ __forceinline__ void pv_half(f32x16* ox, f32x16* oy, int vb, sbf16x8 pxa, sbf16x8 pxb, sbf16x8 pya, sbf16x8 pyb) {
    const s16x4 l00 = tr_read<v_rd_off(0, KS0, 0)>(vb), h00 = tr_read<v_rd_off(0, KS0, 1)>(vb), l01 = tr_read<v_rd_off(0, KS0 + 1, 0)>(vb), h01 = tr_read<v_rd_off(0, KS0 + 1, 1)>(vb);
    const s16x4 l10 = tr_read<v_rd_off(1, KS0, 0)>(vb), h10 = tr_read<v_rd_off(1, KS0, 1)>(vb), l11 = tr_read<v_rd_off(1, KS0 + 1, 0)>(vb), h11 = tr_read<v_rd_off(1, KS0 + 1, 1)>(vb);
    asm volatile("s_waitcnt lgkmcnt(0)" ::: "memory"); ATT_SBAR();
#define ATT_PK(L, H) (sbf16x8){L[0], L[1], L[2], L[3], H[0], H[1], H[2], H[3]}
    ox[0] = __builtin_amdgcn_mfma_f32_32x32x16_bf16(ATT_PK(l00, h00), pxa, ox[0], 0, 0, 0);
    oy[0] = __builtin_amdgcn_mfma_f32_32x32x16_bf16(ATT_PK(l00, h00), pya, oy[0], 0, 0, 0);
    ox[1] = __builtin_amdgcn_mfma_f32_32x32x16_bf16(ATT_PK(l10, h10), pxa, ox[1], 0, 0, 0);
    oy[1] = __builtin_amdgcn_mfma_f32_32x32x16_bf16(ATT_PK(l10, h10), pya, oy[1], 0, 0, 0);
    ox[0] = __builtin_amdgcn_mfma_f32_32x32x16_bf16(ATT_PK(l01, h01), pxb, ox[0], 0, 0, 0);
    oy[0] = __builtin_amdgcn_mfma_f32_32x32x16_bf16(ATT_PK(l01, h01), pyb, oy[0], 0, 0, 0);
    ox[1] = __builtin_amdgcn_mfma_f32_32x32x16_bf16(ATT_PK(l11, h11), pxb, ox[1], 0, 0, 0);
    oy[1] = __builtin_amdgcn_mfma_f32_32x32x16_bf16(ATT_PK(l11, h11), pyb, oy[1], 0, 0, 0);
#undef ATT_PK
}
constexpr int OFF2_V = 0, OFF2_K = 2 * SHM_V, OFF2_WS = 2 * SHM_V + 2 * SHM_K;
__device__ __forceinline__ void attn_unit2(const bf16* Qb, const bf16* Kh, const bf16* Vh, bf16* Ob, int seq, LAS char* lds, int tid) {
    const int wid = __builtin_amdgcn_readfirstlane(tid >> 6), lane = tid & 63, r32 = lane & 31, hi = lane >> 5; int lane2;
    LAS char* V_lds = lds + OFF2_V; LAS char* K_lds = lds + OFF2_K;
    LAS float* ws = (LAS float*)(lds + OFF2_WS) + wid * 64;
    float lx = 0.f, ly = 0.f; f32x16 ox[2], oy[2]; ox[0] = f32x16{}; ox[1] = f32x16{}; oy[0] = f32x16{}; oy[1] = f32x16{}; sbf16x8 qx[6], qy[6];
    { const GAS bf16* Qw = (const GAS bf16*)Qb + (size_t)(wid * 64 + r32) * 96 + hi * 8;
#pragma unroll
      for (int d0 = 0; d0 < 6; ++d0) { qx[d0] = *(const GAS sbf16x8*)(Qw + d0 * 16); qy[d0] = *(const GAS sbf16x8*)(Qw + 32 * 96 + d0 * 16); } }
    const int kc1 = 512 + (tid & 255), kr0 = tid / 12, kq0 = (tid % 12) * 8, kr1 = kc1 / 12, kq1 = (kc1 % 12) * 8;
    const int ksto0 = ATT_KSWZ(kr0, kq0 * 2), ksto1 = ATT_KSWZ(kr1, kq1 * 2);
    const int vr = tid >> 3, vq = (tid & 7) * 8, vsto = v_st(vr, vq);
    const int vb0 = (int)(unsigned)(size_t)V_lds + v_rd_base(lane);
    const unsigned ko0 = (unsigned)(kr0 * 96 + kq0) * 2u, ko1 = (unsigned)(kr1 * 96 + kq1) * 2u, vo = (unsigned)(vr * 64 + vq) * 2u;
    const GAS char* Kg = (const GAS char*)Kh; const GAS char* Vg = (const GAS char*)Vh;
    sbf16x8 sk0, sk1, sv;
#define ATT2_SLOAD(k0) do { sk0 = *(const GAS sbf16x8*)(Kg + (ko0 + (unsigned)(k0) * 192u)); sk1 = *(const GAS sbf16x8*)(Kg + (ko1 + (unsigned)(k0) * 192u)); sv = *(const GAS sbf16x8*)(Vg + (vo + (unsigned)(k0) * 128u)); } while (0)
#define ATT2_SWRITE(b) do { *(LAS sbf16x8*)(K_lds + (b) * SHM_K + ksto0) = sk0; *(LAS sbf16x8*)(K_lds + (b) * SHM_K + ksto1) = sk1; *(LAS sbf16x8*)(V_lds + (b) * SHM_V + vsto) = sv; } while (0)
    const int NT = seq / KVBLK;
    ATT2_SLOAD(0); ATT2_SWRITE(0); __syncthreads();
    f32x16 x0, x1, y0, y1; sbf16x8 px[4], py[4];
#pragma unroll 1
    for (int j = 0; j < NT; ++j) {
        const int b = j & 1;
        if (j + 1 < NT) ATT2_SLOAD((j + 1) * KVBLK);
        ATT_SBAR();
        qk_half<0>(x0, y0, K_lds + b * SHM_K, qx, qy, r32, hi);
        ATT_SBAR();
        qk_half<32>(x1, y1, K_lds + b * SHM_K, qx, qy, r32, hi);
        softmax_half(x0, lx, px[0], px[1]); softmax_half(y0, ly, py[0], py[1]);
        ATT_SBAR();
        pv_half<0>(ox, oy, vb0 + b * SHM_V, px[0], px[1], py[0], py[1]);
        softmax_half(x1, lx, px[2], px[3]); softmax_half(y1, ly, py[2], py[3]);
        ATT_SBAR();
        pv_half<2>(ox, oy, vb0 + b * SHM_V, px[2], px[3], py[2], py[3]);
        ATT_SBAR();
        if (j + 1 < NT) ATT2_SWRITE(b ^ 1);
        __syncthreads();
    }
#undef ATT2_SLOAD
#undef ATT2_SWRITE
    { auto rr = __builtin_amdgcn_permlane32_swap(__float_as_uint(lx), __float_as_uint(lx), false, false); lx = __uint_as_float(rr[0]) + __uint_as_float(rr[1]); }
    { auto rr = __builtin_amdgcn_permlane32_swap(__float_as_uint(ly), __float_as_uint(ly), false, false); ly = __uint_as_float(rr[0]) + __uint_as_float(rr[1]); }
    { unsigned z_ = 0u; asm volatile("" : "+v"(z_)); lane2 = (int)__builtin_amdgcn_mbcnt_hi(~0u, __builtin_amdgcn_mbcnt_lo(~0u, z_)); }
    const int r32e = lane2 & 31, hie = lane2 >> 5;
    if (hie == 0) { ws[r32e] = lx; ws[32 + r32e] = ly; }
    asm volatile("s_waitcnt lgkmcnt(0)" ::: "memory");
    LAS bf16* stg = (LAS bf16*)(lds + wid * 8192);
#pragma unroll
    for (int r = 0; r < 16; ++r) { const int orow = crow(r, hie); const float rlx = __builtin_amdgcn_rcpf(ws[orow]), rly = __builtin_amdgcn_rcpf(ws[32 + orow]);
#pragma unroll
        for (int d0 = 0; d0 < 2; ++d0) { stg[orow * 64 + d0 * 32 + r32e] = (bf16)(pk2(ox[d0][r] * rlx, 0.f) & 0xffffu); stg[(32 + orow) * 64 + d0 * 32 + r32e] = (bf16)(pk2(oy[d0][r] * rly, 0.f) & 0xffffu); } }
    asm volatile("s_waitcnt lgkmcnt(0)" ::: "memory");
    GAS bf16* Ow = (GAS bf16*)Ob + (size_t)(wid * 64) * 512;
#pragma unroll
    for (int i = 0; i < 8; ++i) { const int row = i * 8 + (lane2 >> 3), ch = lane2 & 7; const v4u v = *(const LAS v4u*)(stg + row * 64 + ch * 8); *(GAS v4u*)(Ow + (size_t)row * 512 + ch * 8) = v; }
    asm volatile("s_waitcnt lgkmcnt(0)" ::: "memory");
}
constexpr int OFF4_K = 0, OFF4_V = 3 * SHM_K, OFF4_WS = 3 * SHM_K + 3 * SHM_V;
static_assert(OFF4_WS + NW * 64 * 4 <= 131072, "attention LDS");
__device__ __forceinline__ void attn_unit4(const bf16* Qb, const bf16* Kh, const bf16* Vh, bf16* Ob, int seq, LAS char* lds, int tid) {
    const int wid = __builtin_amdgcn_readfirstlane(tid >> 6), lane = tid & 63, r32 = lane & 31, hi = lane >> 5; int lane2;
    LAS char* K_lds = lds + OFF4_K; LAS char* V_lds = lds + OFF4_V;
    LAS float* ws = (LAS float*)(lds + OFF4_WS) + wid * 64;
    float lx = 0.f, ly = 0.f; f32x16 ox[2], oy[2]; ox[0] = f32x16{}; ox[1] = f32x16{}; oy[0] = f32x16{}; oy[1] = f32x16{}; sbf16x8 qx[6], qy[6];
    { const GAS bf16* Qw = (const GAS bf16*)Qb + (size_t)(wid * 64 + r32) * 96 + hi * 8;
#pragma unroll
      for (int d0 = 0; d0 < 6; ++d0) { qx[d0] = *(const GAS sbf16x8*)(Qw + d0 * 16); qy[d0] = *(const GAS sbf16x8*)(Qw + 32 * 96 + d0 * 16); } }
    const int rowA = 4 * wid + (lane >> 4), chA = (lane & 15) ^ (rowA & 15);
    const unsigned kofA = (unsigned)(rowA * 96 + (chA < 12 ? chA * 8 : 0)) * 2u, kofB = kofA + 32u * 192u;
    const int kkv = wid * 8 + ((lane & 31) >> 2), kv = kkv;
    const unsigned vof = (unsigned)(kv * 64 + (lane >> 5) * 32 + (lane & 3) * 8) * 2u;
    const GAS char* Kg = (const GAS char*)Kh; const GAS char* Vg = (const GAS char*)Vh;
    const int vb0 = (int)(unsigned)(size_t)V_lds + v_rd_base(lane);
#define ATT4_DMA(t, slot) do { \
    __builtin_amdgcn_global_load_lds((const GAS unsigned*)(Kg + (kofA + (unsigned)(t) * (64u * 192u))), (LAS unsigned*)(K_lds + (slot) * SHM_K + wid * 1024), 16, 0, 0); \
    __builtin_amdgcn_global_load_lds((const GAS unsigned*)(Kg + (kofB + (unsigned)(t) * (64u * 192u))), (LAS unsigned*)(K_lds + (slot) * SHM_K + (wid + 8) * 1024), 16, 0, 0); \
    __builtin_amdgcn_global_load_lds((const GAS unsigned*)(Vg + (vof + (unsigned)(t) * (64u * 128u))), (LAS unsigned*)(V_lds + (slot) * SHM_V + wid * 2048), 16, 0, 0); } while (0)
    const int NT = seq / KVBLK;
    ATT4_DMA(0, 0);
    asm volatile("s_waitcnt vmcnt(0)" ::: "memory"); __syncthreads();
    f32x16 x0, x1, y0, y1; sbf16x8 px[4], py[4];
    x1 = f32x16{}; y1 = f32x16{};
#pragma unroll
    for (int i = 0; i < 4; ++i) { px[i] = sbf16x8{}; py[i] = sbf16x8{}; }
    int s_prev = 2, s_cur = 0, s_next = 1;
#pragma unroll 1
    for (int j = 0; j < NT; ++j) {
        if (j + 1 < NT) ATT4_DMA(j + 1, s_next);
        ATT_SBAR();
        qk_half<0>(x0, y0, K_lds + s_cur * SHM_K, qx, qy, r32, hi);
        qk_half<32>(x1, y1, K_lds + s_cur * SHM_K, qx, qy, r32, hi);
        softmax_half(x0, lx, px[0], px[1]); softmax_half(y0, ly, py[0], py[1]);
        pv_half<0>(ox, oy, vb0 + s_cur * SHM_V, px[0], px[1], py[0], py[1]);
        softmax_half(x1, lx, px[2], px[3]); softmax_half(y1, ly, py[2], py[3]);
        pv_half<2>(ox, oy, vb0 + s_cur * SHM_V, px[2], px[3], py[2], py[3]);
        asm volatile("s_waitcnt vmcnt(0)" ::: "memory");
        __syncthreads();
        { const int t_ = s_prev; s_prev = s_cur; s_cur = s_next; s_next = t_; }
    }
#undef ATT4_DMA
    { auto rr = __builtin_amdgcn_permlane32_swap(__float_as_uint(lx), __float_as_uint(lx), false, false); lx = __uint_as_float(rr[0]) + __uint_as_float(rr[1]); }
    { auto rr = __builtin_amdgcn_permlane32_swap(__float_as_uint(ly), __float_as_uint(ly), false, false); ly = __uint_as_float(rr[0]) + __uint_as_float(rr[1]); }
    { unsigned z_ = 0u; asm volatile("" : "+v"(z_)); lane2 = (int)__builtin_amdgcn_mbcnt_hi(~0u, __builtin_amdgcn_mbcnt_lo(~0u, z_)); }
    const int r32e = lane2 & 31, hie = lane2 >> 5;
    const float rlx = __builtin_amdgcn_rcpf(lx), rly = __builtin_amdgcn_rcpf(ly);
    LAS bf16* stg = (LAS bf16*)(lds + wid * 8192);
#pragma unroll
    for (int d0 = 0; d0 < 2; ++d0)
#pragma unroll
        for (int g = 0; g < 4; ++g) {
            v2u wx, wy; wx.x = pk2(ox[d0][4 * g] * rlx, ox[d0][4 * g + 1] * rlx); wx.y = pk2(ox[d0][4 * g + 2] * rlx, ox[d0][4 * g + 3] * rlx);
            wy.x = pk2(oy[d0][4 * g] * rly, oy[d0][4 * g + 1] * rly); wy.y = pk2(oy[d0][4 * g + 2] * rly, oy[d0][4 * g + 3] * rly);
            *(LAS v2u*)(stg + r32e * 64 + d0 * 32 + 8 * g + 4 * hie) = wx; *(LAS v2u*)(stg + (32 + r32e) * 64 + d0 * 32 + 8 * g + 4 * hie) = wy; }
    asm volatile("s_waitcnt lgkmcnt(0)" ::: "memory");
    GAS bf16* Ow = (GAS bf16*)Ob + (size_t)(wid * 64) * 512;
#pragma unroll
    for (int i = 0; i < 8; ++i) { const int row = i * 8 + (lane2 >> 3), ch = lane2 & 7; const v4u v = *(const LAS v4u*)(stg + row * 64 + ch * 8); *(GAS v4u*)(Ow + (size_t)row * 512 + ch * 8) = v; }
    asm volatile("s_waitcnt lgkmcnt(0)" ::: "memory");
}
}

__device__ __forceinline__ bool attn_static_ok(Frame& F, int l) {
    const float* gq = ((const float*)(const GAS float*)F.in[13]) + l * DQK; const float* gk = ((const float*)(const GAS float*)F.in[14]) + l * DQK; float mq = 0.f, mk = 0.f;
    for (int d = 0; d < DQK; ++d) { mq = fmaxf(mq, fabsf(gq[d])); mk = fmaxf(mk, fabsf(gk[d])); }
    return 96.f * mq * mk * QSCALE <= 60.f;
}
__device__ __forceinline__ void step_f_fast(Frame& F) {
    fresh_tid(F);
    const bf16* Q = WSP(bf16, WS_Q); const bf16* K = WSP(bf16, WS_K); const bf16* V = WSP(bf16, WS_V); bf16* O = WSP(bf16, WS_O);
    const int vcu = (F.G % 8 == 0) ? (F.bid % 8) * (F.G / 8) + F.bid / 8 : F.bid;
#if ATTN_W64
    for (int u = vcu; u < NB * H * (S / 512); u += F.G) {
        const int qb = u % 16, bh = (u / 16), b = bh / H, h = bh % H;
        fresh_tid(F);
        att::attn_unit4(Q + ((size_t)bh * S + qb * 512) * 96, K + (size_t)bh * S * 96, V + (size_t)bh * S * 64, O + ((size_t)(b * S + qb * 512)) * 512 + h * 64, S, (LAS char*)F.lds, F.tid);
        __syncthreads();
    }
#else
    for (int u = vcu; u < NB * H * (S / 256); u += F.G) {
        const int qb = u % 32, bh = (u / 32), b = bh / H, h = bh % H;
        fresh_tid(F);
        att::attn_unit(Q + ((size_t)bh * S + qb * 256) * 96, K + (size_t)bh * S * 96, V + (size_t)bh * S * 64, O + ((size_t)(b * S + qb * 256)) * 512 + h * 64, S, (LAS char*)F.lds, F.tid);
        __syncthreads();
    }
#endif
}
constexpr size_t WT_IN = WS_WT, WT_UQ = WS_WT + 8 * MiB, WT_UKV = WT_UQ + 384 * KiB, WT_CO = WS_WT + 9 * MiB, WT_AO = WS_WT + 10 * MiB, WT_O = WS_WT + 11 * MiB,
                 WT_GU = WS_WT + 13 * MiB, WT_DN = WS_WT + 30 * MiB;
constexpr int NPROJ = 4096;
static_assert(WT_DN + (size_t)NEX * 1024 * 256 * 2 <= WS_WT + 40 * MiB, "weight region");
__device__ __forceinline__ void cvt_item(const float* W, int K, int N, bf16* WT, int drow0, const float* ksc, LAS float* scr, int k0, int n0, int lane) {
    float wv[32];
#pragma unroll
    for (int i = 0; i < 32; ++i) wv[i] = W[(size_t)(k0 + 2 * i + (lane >> 5)) * N + n0 + (lane & 31)];
#pragma unroll
    for (int i = 0; i < 32; ++i) { const int kk = 2 * i + (lane >> 5); float v = wv[i]; if (ksc) v *= ksc[k0 + kk]; scr[kk * 33 + (lane & 31)] = v; }
    asm volatile("s_waitcnt lgkmcnt(0)" ::: "memory");
    const int c = lane & 7;
#pragma unroll
    for (int j = 0; j < 4; ++j) { const int n = (lane >> 3) + 8 * j; const LAS float* s = scr + (8 * c) * 33 + n;
        v4u o; o.x = pk2(s[0 * 33], s[1 * 33]); o.y = pk2(s[2 * 33], s[3 * 33]); o.z = pk2(s[4 * 33], s[5 * 33]); o.w = pk2(s[6 * 33], s[7 * 33]);
        *(v4u*)(WT + (size_t)(drow0 + n) * K + k0 + 8 * c) = o; }
    asm volatile("s_waitcnt lgkmcnt(0)" ::: "memory");
}
__device__ __forceinline__ int proj_dest(int n0) {
    if (n0 < 512) return n0;
    if (n0 < 1024) return 512 + ((n0 - 512) >> 7) * 256 + ((n0 - 512) & 127);
    if (n0 < 1536) return 512 + ((n0 - 1024) >> 7) * 256 + 128 + ((n0 - 1024) & 127);
    if (n0 < 1952) return n0;
    return n0 + 96;
}
__device__ __forceinline__ int ukv_dest(int n0) { const int h = n0 >> 7, j0 = n0 & 127, kind = j0 >> 6, d0 = j0 & 63; return (kind * 2 + (h >> 2)) * 256 + (d0 >> 5) * 128 + (h & 3) * 32; }
__device__ __forceinline__ void convert_weights(Frame& F, int l) {
    fresh_tid(F);
    LAS float* scr = (LAS float*)(F.lds + F.wave * 16384);
    const int gw = F.bid * NWAVES + F.wave, NGW = F.G * NWAVES;
    constexpr int I_IN = 16 * 125, I_UQ = 4 * 24, I_UKV = 2 * 32, I_CO = 8 * 32, I_O = 16 * 32, I_GU = NEX * 16 * 8, I_DN = NEX * 4 * 32;
    constexpr int NITEMS = I_IN + I_UQ + I_UKV + 2 * I_CO + I_O + 2 * I_GU + I_DN;
    for (int it = gw; it < NITEMS; it += NGW) {
        int r = it;
        if (r < I_IN) { const int kb = r / 125, nb = r % 125, n0 = 32 * nb; cvt_item(((const float*)(const GAS float*)F.in[7]) + (size_t)l * D * NIN, D, NIN, WSP(bf16, WT_IN), proj_dest(n0), nullptr, scr, 64 * kb, n0, F.lane); continue; } r -= I_IN;
        if (r < I_UQ) { const int kb = r / 24, nb = r % 24; cvt_item(((const float*)(const GAS float*)F.in[10]) + (size_t)l * QL * 768, QL, 768, WSP(bf16, WT_UQ), 32 * nb, ((const float*)(const GAS float*)F.in[9]) + l * QL, scr, 64 * kb, 32 * nb, F.lane); continue; } r -= I_UQ;
        if (r < I_UKV) { const int kb = r / 32, nb = r % 32; cvt_item(((const float*)(const GAS float*)F.in[12]) + (size_t)l * KVL * 1024, KVL, 1024, WSP(bf16, WT_UKV), ukv_dest(32 * nb), ((const float*)(const GAS float*)F.in[11]) + l * KVL, scr, 64 * kb, 32 * nb, F.lane); continue; } r -= I_UKV;
        if (r < I_CO) { const int kb = r / 32, nb = r % 32; cvt_item(((const float*)(const GAS float*)F.in[15]) + (size_t)l * CW * D, CW, D, WSP(bf16, WT_CO), 32 * nb, nullptr, scr, 64 * kb, 32 * nb, F.lane); continue; } r -= I_CO;
        if (r < I_CO) { const int kb = r / 32, nb = r % 32; cvt_item(((const float*)(const GAS float*)F.in[16]) + (size_t)l * 512 * D, 512, D, WSP(bf16, WT_AO), 32 * nb, nullptr, scr, 64 * kb, 32 * nb, F.lane); continue; } r -= I_CO;
        if (r < I_O) { const int kb = r / 32, nb = r % 32; cvt_item(((const float*)(const GAS float*)F.in[17]) + (size_t)l * D * D, D, D, WSP(bf16, WT_O), 32 * nb, nullptr, scr, 64 * kb, 32 * nb, F.lane); continue; } r -= I_O;
        if (r < 2 * I_GU) { const int up = r >= I_GU ? 1 : 0; r -= up * I_GU; const int e = r / 128, q = r % 128, kb = q / 8, nb = q % 8, n0 = 32 * nb;
            const float* W = e < NE ? ((const float*)(const GAS float*)F.in[20 + up]) + ((size_t)l * NE + e) * D * DE : ((const float*)(const GAS float*)F.in[23 + up]) + (size_t)l * D * DE;
            cvt_item(W, D, DE, WSP(bf16, WT_GU) + (size_t)e * 512 * D, (n0 >> 7) * 256 + up * 128 + (n0 & 127), nullptr, scr, 64 * kb, n0, F.lane); continue; } r -= 2 * I_GU;
        { const int e = r / 128, q = r % 128, kb = q / 32, nb = q % 32;
            const float* W = e < NE ? ((const float*)(const GAS float*)F.in[22]) + ((size_t)l * NE + e) * DE * D : ((const float*)(const GAS float*)F.in[25]) + (size_t)l * DE * D;
            cvt_item(W, DE, D, WSP(bf16, WT_DN) + (size_t)e * D * DE, 32 * nb, nullptr, scr, 64 * kb, 32 * nb, F.lane); }
    }
    v4u* z = (v4u*)(WSP(bf16, WT_IN) + (size_t)1952 * D);
    unsigned z0 = 0u; asm volatile("" : "+v"(z0));
    for (int i = F.bid * NTHREADS + F.tid; i < 96 * D * 2 / 16; i += F.G * NTHREADS) z[i] = (v4u){z0, z0, z0, z0};
}

namespace pg8 {
typedef short sbf16x8 __attribute__((ext_vector_type(8)));
constexpr int BM = 256, BK = 64, HALF = 128, HTB = HALF * BK * 2, STAGE_BYTES = 8 * HTB, NXCD = 8, WGM = 8;
__device__ __forceinline__ int lds_byte(int r, int c) { const int st = (r >> 4) * 2 + (c >> 5), rr = r & 15, cc = c & 31, ob = rr * 64 + cc * 2; return st * 1024 + (ob ^ (((ob >> 9) & 1) << 5)); }
__device__ __forceinline__ void stage_rc(int b, int& R, int& C) { const int st = b / 1024, sb = b % 1024, swz = sb ^ (((sb >> 9) & 1) << 5); R = (st >> 1) * 16 + swz / 64; C = (st & 1) * 32 + (swz % 64) / 2; }
__device__ __forceinline__ int perm32(int rho) { const int n = rho >> 4, i = rho & 15; return 8 * (i >> 2) + 4 * n + (i & 3); }
__device__ __forceinline__ int xcd_remap(int L, int nwg) { const int q = nwg / NXCD, r = nwg % NXCD, xcd = L % NXCD, off = L / NXCD; return (xcd < r ? xcd * (q + 1) : r * (q + 1) + (xcd - r) * q) + off; }

struct Unit { int pm, pn; const char* a; const char* b; const int* list; int rows, tok0, e; };
struct Gemm { unsigned lda; int K; };

struct StaticOrder {
    const char* A; const char* Bt; unsigned lda; int K, nM, nN, nwg, G, c;
    static constexpr bool WAITS = false;
    __device__ __forceinline__ bool next(int i, Unit& u, int) const {
        const long L = (long)i * G + c; if (L >= nwg) return false;
        const int wgid = xcd_remap((int)L, nwg);
        const int nig = WGM * nN, gid = wgid / nig, fm = gid * WGM, gsz = (nM - fm) < WGM ? (nM - fm) : WGM;
        u.pm = fm + ((wgid % nig) % gsz); u.pn = (wgid % nig) / gsz;
        u.a = A + (size_t)u.pm * BM * lda; u.b = Bt + (size_t)u.pn * BM * K * 2; u.list = nullptr; u.rows = BM; u.tok0 = u.pm * BM; u.e = 0; return true;
    }
};
struct MoeOrder {
    const char* A; const char* Bt; size_t estride; unsigned lda; int K, nN, MT, G, c; const LAS unsigned* tb; const LAS unsigned* cnt; const int* LIST; bool gather;
    static constexpr bool WAITS = false;
    __device__ __forceinline__ bool next(int i, Unit& u, int) const {
        const int nwg = MT * nN; const long L = (long)i * G + c; if (L >= nwg) return false;
        const int wgid = xcd_remap((int)L, nwg);
        const int mt = wgid / nN, pn = wgid % nN; int e = 0;
#pragma unroll 1
        for (int j = 1; j <= NE; ++j) if ((unsigned)mt >= (unsigned)__builtin_amdgcn_readfirstlane(tb[j])) e = j;
        const int lt = mt - (int)__builtin_amdgcn_readfirstlane(tb[e]);
        u.pm = mt; u.pn = pn; u.e = e; u.tok0 = lt * BM;
        if (e < NE) { const int left = (int)__builtin_amdgcn_readfirstlane(cnt[e]) - lt * BM; u.rows = left < BM ? left : BM; u.list = LIST + (size_t)e * T + lt * BM; } else { u.rows = BM; u.list = nullptr; }
        u.a = gather ? A : A + (size_t)mt * BM * lda; u.b = Bt + (size_t)e * estride + (size_t)pn * BM * K * 2; return true;
    }
};

#ifndef KL_R
#define KL_R 3
#endif
struct MoeOrderX {
    static constexpr bool WAITS = true;
    const char* A; const char* Bt; size_t estride; unsigned lda; int K, nN, MT, G, c; const LAS unsigned* tb; const LAS unsigned* cnt; const LAS unsigned* te; const int* LIST; bool gather;
    int mode, kN; unsigned* flags; unsigned* bar;
    __device__ __forceinline__ bool next(int i, Unit& u, int wid) const {
        const int NX = (G % NXCD == 0) ? NXCD : 1, x = c % NX, cl = c / NX, GX = G / NX;
        const int qm = MT / NX, rm = MT % NX, sz = qm + (x < rm ? 1 : 0), m0 = x * qm + (x < rm ? x : rm);
        if (sz == 0) return false;
        int off;
        if (mode == 0) off = cl + i * GX;
        else {
            const int ku = kN * sz, kmax = (ku + GX - 1) / GX, hx = ku - (kmax - 1) * GX, nl = GX - hx;
            if (cl >= hx && i < KL_R) off = (cl - hx) + i * nl;
            else { const int p = cl + (cl >= hx ? i - KL_R : i) * GX; off = KL_R * nl + (p < GX ? (p >= hx ? p - hx : nl + p) : p); }
        }
        const int sl = off / nN, pn = off % nN; if (sl >= sz) return false;
        const int mt = m0 + sl; const unsigned pe = (unsigned)__builtin_amdgcn_readfirstlane(te[mt]); const int e = (int)(pe & 255u), lt = (int)(pe >> 8);
        u.pm = mt; u.pn = pn; u.e = e; u.tok0 = lt * BM;
        if (e < NE) { const int left = (int)__builtin_amdgcn_readfirstlane(cnt[e]) - lt * BM; u.rows = left < BM ? left : BM; u.list = LIST + (size_t)e * T + lt * BM; } else { u.rows = BM; u.list = nullptr; }
        u.a = gather ? A : A + (size_t)mt * BM * lda; u.b = Bt + (size_t)e * estride + (size_t)pn * BM * K * 2;
        if (mode == 1 && wid == 0) {
            XB_SPIN(xb_ld(flags + mt) < (unsigned)kN, bar);
            __builtin_amdgcn_fence(__ATOMIC_ACQUIRE, "agent");
        }
        return true;
    }
};

__device__ __forceinline__ v4u pack8(f32x4 v0, f32x4 v1) { v4u w; w.x = pk2(v0[0], v0[1]); w.y = pk2(v0[2], v0[3]); w.z = pk2(v1[0], v1[1]); w.w = pk2(v1[2], v1[3]); return w; }
struct EpiBf16 {
    static constexpr bool PERM = true; static constexpr bool SIGNAL = false; static constexpr bool PRE = false;
    bf16* O; int ldc; int split; bf16* gbp;
    __device__ __forceinline__ void operator()(const f32x4 (&acc)[2][2][4][2], const Unit& u, int wr, int wc, int fr, int fq) const {
        bf16* base = O; int ld = ldc, c0 = u.pn * BM;
        if (split) { const int pn = u.pn; unsigned char* w = (unsigned char*)O;
            if (pn >= 2 && pn < 6) {
                bf16* pb = (bf16*)(w + WS_CONV) + 512 + (pn - 2) * 128 + wc * 32 + 8 * fq; const int row0 = u.pm * BM + wr * 64 + fr;
#pragma unroll
                for (int ai = 0; ai < 2; ++ai)
#pragma unroll
                    for (int m = 0; m < 4; ++m) { *(v4u*)(pb + (size_t)(row0 + ai * HALF + m * 16) * 1024) = pack8(acc[ai][0][m][0] * acc[ai][1][m][0], acc[ai][0][m][1] * acc[ai][1][m][1]);
                        asm volatile("" ::: "memory"); }
                return; }
            if (pn < 2) { base = (bf16*)(w + WS_CONV); ld = 1024; c0 = pn * 256; }
            else if (pn < 8) { base = (bf16*)(w + WS_SMALL); ld = 512; c0 = (pn - 6) * 256; }
            else if (pn < 12) { base = (bf16*)(w + WS_GA); ld = 1024; c0 = (pn - 8) * 256; }
            else { base = gbp; ld = 1024; c0 = (pn - 12) * 256; } }
        const int row0 = u.pm * BM + wr * 64 + fr, col0 = c0 + wc * 32 + 8 * fq;
#pragma unroll
        for (int ai = 0; ai < 2; ++ai)
#pragma unroll
            for (int m = 0; m < 4; ++m) { bf16* rowp = base + (size_t)(row0 + ai * HALF + m * 16) * ld + col0;
#pragma unroll
                for (int bj = 0; bj < 2; ++bj) *(v4u*)(rowp + bj * HALF) = pack8(acc[ai][bj][m][0], acc[ai][bj][m][1]);
                asm volatile("" ::: "memory"); }
    }
};
__device__ __forceinline__ unsigned pk4_fp8(f32x4 v) {
#pragma unroll
    for (int e = 0; e < 4; ++e) v[e] = __builtin_fminf(__builtin_fmaxf(v[e], -448.f), 448.f);
    int w = __builtin_amdgcn_cvt_pk_fp8_f32(v[0], v[1], 0, false); w = __builtin_amdgcn_cvt_pk_fp8_f32(v[2], v[3], w, true); return (unsigned)w;
}
struct EpiY8 {
    static constexpr bool PERM = true; static constexpr bool SIGNAL = false; static constexpr bool PRE = false;
    unsigned char* Y8;
    __device__ __forceinline__ void operator()(const f32x4 (&acc)[2][2][4][2], const Unit& u, int wr, int wc, int fr, int fq) const {
        const int row0 = u.pm * BM + wr * 64 + fr, col0 = u.pn * BM + wc * 32 + 8 * fq;
#pragma unroll
        for (int ai = 0; ai < 2; ++ai)
#pragma unroll
            for (int m = 0; m < 4; ++m) { unsigned char* rowp = Y8 + (size_t)(row0 + ai * HALF + m * 16) * D + col0;
#pragma unroll
                for (int bj = 0; bj < 2; ++bj) { v2u w; w.x = pk4_fp8(acc[ai][bj][m][0]); w.y = pk4_fp8(acc[ai][bj][m][1]); *(v2u*)(rowp + bj * HALF) = w; }
                asm volatile("" ::: "memory"); }
    }
};
constexpr int KVE_RSK = 131072 + 2048, KVE_RP = KVE_RSK + 2048, KVE_GN = KVE_RP + 16384, KVE_END = KVE_GN + 256;
__device__ __forceinline__ float add_xor16(float v) {
    auto r = __builtin_amdgcn_permlane16_swap(__builtin_bit_cast(unsigned, v), __builtin_bit_cast(unsigned, v), false, false);
    return __builtin_bit_cast(float, r[0]) + __builtin_bit_cast(float, r[1]); }
struct EpiKV {
    static constexpr bool PERM = true; static constexpr bool SIGNAL = false; static constexpr bool PRE = true;
    bf16* Kb; bf16* Vb; const bf16* small; const f32x2* rope; const float* gk; LAS unsigned char* lds;
    __device__ __forceinline__ void pre(const Unit& u, int wid) const {
        unsigned z_ = 0u; asm volatile("" : "+v"(z_)); const int lane = (int)__builtin_amdgcn_mbcnt_hi(~0u, __builtin_amdgcn_mbcnt_lo(~0u, z_)), tid = wid * 64 + lane;
        const bool isK = u.pn < 2; const int q = lane & 3, i0 = 8 * (q & 1);
        if (isK && tid < 16) *(LAS f32x4*)(lds + KVE_GN + tid * 16) = *(const f32x4*)(gk + 4 * tid);
        f32x4 g1[2], g2[2];
#pragma unroll
        for (int n = 0; n < 2; ++n) { g1[n] = *(const f32x4*)(gk + 64 + i0 + 4 * n); g2[n] = *(const f32x4*)(gk + 80 + i0 + 4 * n); }
#pragma unroll 1
        for (int it = 0; it < 2; ++it) {
            const int rl = it * HALF + (tid >> 2), t = u.pm * BM + rl;
            const bf16* sm = small + (size_t)t * 512;
            float ss = 0.f;
#pragma unroll
            for (int c = 0; c < 4; ++c) { const bf16x8 x = *(const bf16x8*)(sm + 256 + 32 * q + 8 * c);
#pragma unroll
                for (int e = 0; e < 8; ++e) { const float f = bf2f(x[e]); ss += f * f; } }
            ss += xor_lane<1>(ss); ss += xor_lane<2>(ss);
            float sk = 0.f;
            if (isK) {
                const bf16x8 x1v = *(const bf16x8*)(sm + 384 + i0), x2v = *(const bf16x8*)(sm + 384 + 16 + i0);
                const f32x4* rp = (const f32x4*)(rope + (size_t)t * 16 + i0);
                const f32x4 rp0 = rp[0], rp1 = rp[1], rp2 = rp[2], rp3 = rp[3];
#pragma unroll
                for (int e = 0; e < 8; ++e) { const float f = bf2f(q < 2 ? x1v[e] : x2v[e]); sk += f * f; }
                sk += xor_lane<1>(sk); sk += xor_lane<2>(sk);
                f32x4 o0, o1;
#pragma unroll
                for (int e = 0; e < 8; ++e) {
                    const float a = bf2f(x1v[e]) * (e < 4 ? g1[0][e & 3] : g1[1][e & 3]), bb = bf2f(x2v[e]) * (e < 4 ? g2[0][e & 3] : g2[1][e & 3]);
                    const f32x4 cq = e < 2 ? rp0 : e < 4 ? rp1 : e < 6 ? rp2 : rp3; const float cs = (e & 1) ? cq.z : cq.x, sn_ = (e & 1) ? cq.w : cq.y;
                    const float o = q < 2 ? a * cs - bb * sn_ : bb * cs + a * sn_;
                    if (e < 4) o0[e & 3] = o; else o1[e & 3] = o; }
                *(LAS v4u*)(lds + KVE_RP + rl * 64 + q * 16) = pack8(o0, o1);
            }
            if (q == 0) { f32x2 w; w.x = 1.0f / sqrtf(ss * (1.f / 128.f) + EPS); w.y = sk; *(LAS f32x2*)(lds + KVE_RSK + rl * 8) = w; }
        }
    }
    __device__ __forceinline__ void operator()(const f32x4 (&acc)[2][2][4][2], const Unit& u, int wr, int wc, int fr, int fq) const {
        const bool isK = u.pn < 2; const int h = (u.pn & 1) * 4 + wc;
#pragma unroll
        for (int ai = 0; ai < 2; ++ai)
#pragma unroll
            for (int m = 0; m < 4; ++m) {
                const int rl = ai * HALF + wr * 64 + m * 16 + fr, t = u.pm * BM + rl, b = t / S, sq = t % S;
                const size_t orow = (size_t)(b * H + h) * S + sq;
                const f32x2 rsk = *(const LAS f32x2*)(lds + KVE_RSK + rl * 8);
                const float rs = rsk.x;
                if (isK) {
                    const v4u rpv = *(const LAS v4u*)(lds + KVE_RP + rl * 64 + fq * 16);
                    f32x4 gn[2][2];
#pragma unroll
                    for (int bj = 0; bj < 2; ++bj)
#pragma unroll
                        for (int n = 0; n < 2; ++n) gn[bj][n] = *(const LAS f32x4*)(lds + KVE_GN + (32 * bj + 8 * fq + 4 * n) * 4);
                    float sn = 0.f; f32x4 v[2][2];
#pragma unroll
                    for (int bj = 0; bj < 2; ++bj)
#pragma unroll
                        for (int n = 0; n < 2; ++n) { v[bj][n] = acc[ai][bj][m][n] * rs;
#pragma unroll
                            for (int e = 0; e < 4; ++e) sn += v[bj][n][e] * v[bj][n][e]; }
                    sn = add_xor16(sn); sn = add_xor32(sn);
                    const float r = 1.0f / sqrtf((sn + rsk.y) * (1.f / 96.f) + EPS);
#pragma unroll
                    for (int bj = 0; bj < 2; ++bj) *(v4u*)(Kb + orow * 96 + 32 * bj + 8 * fq) = pack8(v[bj][0] * r * gn[bj][0], v[bj][1] * r * gn[bj][1]);
                    f32x4 o0, o1;
                    o0[0] = bf2f((unsigned short)(rpv.x & 0xffffu)) * r; o0[1] = bf2f((unsigned short)(rpv.x >> 16)) * r; o0[2] = bf2f((unsigned short)(rpv.y & 0xffffu)) * r; o0[3] = bf2f((unsigned short)(rpv.y >> 16)) * r;
                    o1[0] = bf2f((unsigned short)(rpv.z & 0xffffu)) * r; o1[1] = bf2f((unsigned short)(rpv.z >> 16)) * r; o1[2] = bf2f((unsigned short)(rpv.w & 0xffffu)) * r; o1[3] = bf2f((unsigned short)(rpv.w >> 16)) * r;
                    *(v4u*)(Kb + orow * 96 + 64 + 8 * fq) = pack8(o0, o1);
                } else {
#pragma unroll
                    for (int bj = 0; bj < 2; ++bj) *(v4u*)(Vb + orow * 64 + 32 * bj + 8 * fq) = pack8(acc[ai][bj][m][0] * rs, acc[ai][bj][m][1] * rs);
                }
                asm volatile("" ::: "memory");
            }
    }
};
template <int MODE> struct EpiGate {
    static constexpr bool PERM = true; static constexpr bool SIGNAL = false; static constexpr bool PRE = false;
    bf16* ga; const bf16* gb;
    __device__ __forceinline__ void operator()(const f32x4 (&acc)[2][2][4][2], const Unit& u, int wr, int wc, int fr, int fq) const {
        const int row0 = u.pm * BM + wr * 64 + fr, col0 = u.pn * BM + wc * 32 + 8 * fq;
#pragma unroll
        for (int ai = 0; ai < 2; ++ai) {
            bf16x8 g[4][2], t[4][2];
#pragma unroll
            for (int m = 0; m < 4; ++m) { const size_t off = (size_t)(row0 + ai * HALF + m * 16) * D + col0;
#pragma unroll
                for (int bj = 0; bj < 2; ++bj) { g[m][bj] = *(const bf16x8*)((MODE == 1 ? ga : gb) + off + bj * HALF);
                    t[m][bj] = (bf16x8){0, 0, 0, 0, 0, 0, 0, 0}; if (MODE == 2) t[m][bj] = *(const bf16x8*)(ga + off + bj * HALF); } }
#pragma unroll
            for (int m = 0; m < 4; ++m) { const size_t off = (size_t)(row0 + ai * HALF + m * 16) * D + col0;
#pragma unroll
                for (int bj = 0; bj < 2; ++bj) {
                    f32x4 v0 = acc[ai][bj][m][0], v1 = acc[ai][bj][m][1];
#pragma unroll
                    for (int e = 0; e < 4; ++e) { v0[e] = sigmoidf_(bf2f(g[m][bj][e])) * v0[e]; v1[e] = sigmoidf_(bf2f(g[m][bj][4 + e])) * v1[e];
                        if (MODE == 2) { v0[e] += bf2f(t[m][bj][e]); v1[e] += bf2f(t[m][bj][4 + e]); } }
                    *(v4u*)(ga + off + bj * HALF) = pack8(v0, v1); } }
            asm volatile("" ::: "memory");
        }
    }
};
struct EpiRes {
    static constexpr bool PERM = false; static constexpr bool SIGNAL = false; static constexpr bool PRE = false;
    const float* xin; float* out; const float* gt;
    __device__ __forceinline__ void operator()(const f32x4 (&acc)[2][2][4][2], const Unit& u, int wr, int wc, int fr, int fq) const {
        const int col0 = u.pn * BM + wc * 32 + 4 * fq;
        const float* g = gt + ((u.pm * BM) / S) * 6 * D;
        f32x4 gv[2][2];
#pragma unroll
        for (int bj = 0; bj < 2; ++bj)
#pragma unroll
            for (int n = 0; n < 2; ++n) gv[bj][n] = *(const f32x4*)(g + col0 + bj * HALF + n * 16);
#pragma unroll
        for (int ai = 0; ai < 2; ++ai)
#pragma unroll
            for (int mp = 0; mp < 2; ++mp) {
                f32x4 xv[2][2][2];
#pragma unroll
                for (int mm = 0; mm < 2; ++mm) { const size_t off = (size_t)(u.pm * BM + ai * HALF + wr * 64 + (2 * mp + mm) * 16 + fr) * D + col0;
#pragma unroll
                    for (int bj = 0; bj < 2; ++bj)
#pragma unroll
                        for (int n = 0; n < 2; ++n) xv[mm][bj][n] = *(const f32x4*)(xin + off + bj * HALF + n * 16); }
#pragma unroll
                for (int mm = 0; mm < 2; ++mm) { const int m = 2 * mp + mm; const size_t off = (size_t)(u.pm * BM + ai * HALF + wr * 64 + m * 16 + fr) * D + col0;
#pragma unroll
                    for (int bj = 0; bj < 2; ++bj)
#pragma unroll
                        for (int n = 0; n < 2; ++n) *(f32x4*)(out + off + bj * HALF + n * 16) = xv[mm][bj][n] + gv[bj][n] * acc[ai][bj][m][n]; }
                asm volatile("" ::: "memory");
            }
    }
};
struct EpiRes16 {
    static constexpr bool PERM = true; static constexpr bool SIGNAL = false; static constexpr bool PRE = false;
    const float* xin32; bf16* x16; const float* gt;
    __device__ __forceinline__ void operator()(const f32x4 (&acc)[2][2][4][2], const Unit& u, int wr, int wc, int fr, int fq) const {
        const int row0 = u.pm * BM + wr * 64 + fr, col0 = u.pn * BM + wc * 32 + 8 * fq;
        const float* g = gt + ((u.pm * BM) / S) * 6 * D;
        f32x4 gv[2][2];
#pragma unroll
        for (int bj = 0; bj < 2; ++bj)
#pragma unroll
            for (int n = 0; n < 2; ++n) gv[bj][n] = *(const f32x4*)(g + col0 + bj * HALF + n * 4);
#pragma unroll
        for (int ai = 0; ai < 2; ++ai)
#pragma unroll
            for (int mp = 0; mp < 2; ++mp) {
                f32x4 xv[2][2][2];
#pragma unroll
                for (int mm = 0; mm < 2; ++mm) { const size_t off = (size_t)(row0 + ai * HALF + (2 * mp + mm) * 16) * D + col0;
#pragma unroll
                    for (int bj = 0; bj < 2; ++bj) {
                        if (xin32) { xv[mm][bj][0] = *(const f32x4*)(xin32 + off + bj * HALF); xv[mm][bj][1] = *(const f32x4*)(xin32 + off + bj * HALF + 4); }
                        else { const bf16x8 t = *(const bf16x8*)(x16 + off + bj * HALF);
#pragma unroll
                            for (int e = 0; e < 4; ++e) { xv[mm][bj][0][e] = bf2f(t[e]); xv[mm][bj][1][e] = bf2f(t[4 + e]); } } } }
#pragma unroll
                for (int mm = 0; mm < 2; ++mm) { const int m = 2 * mp + mm; const size_t off = (size_t)(row0 + ai * HALF + m * 16) * D + col0;
#pragma unroll
                    for (int bj = 0; bj < 2; ++bj) *(v4u*)(x16 + off + bj * HALF) = pack8(xv[mm][bj][0] + gv[bj][0] * acc[ai][bj][m][0], xv[mm][bj][1] + gv[bj][1] * acc[ai][bj][m][1]); }
                asm volatile("" ::: "memory");
            }
    }
};
struct EpiAct {
    static constexpr bool PERM = true; static constexpr bool SIGNAL = true; static constexpr bool PRE = false;
    bf16* a2; const float* tokw; unsigned* flags;
    __device__ __forceinline__ void operator()(const f32x4 (&acc)[2][2][4][2], const Unit& u, int wr, int wc, int fr, int fq) const {
        const int col0 = u.pn * HALF + wc * 32 + 8 * fq;
        const __amdgpu_buffer_rsrc_t rsrc = __builtin_amdgcn_make_buffer_rsrc((void*)a2, 0, SLOTS_MAX * DE * 2, 0x00020000);
        float wv[2][4];
        if (u.list) { int tk[2][4];
#pragma unroll
            for (int ai = 0; ai < 2; ++ai)
#pragma unroll
                for (int m = 0; m < 4; ++m) { const int rl = ai * HALF + wr * 64 + m * 16 + fr; tk[ai][m] = rl < u.rows ? u.list[rl] : -1; }
#pragma unroll
            for (int ai = 0; ai < 2; ++ai)
#pragma unroll
                for (int m = 0; m < 4; ++m) wv[ai][m] = tk[ai][m] >= 0 ? tokw[tk[ai][m]] : 0.f;
        } else {
#pragma unroll
            for (int ai = 0; ai < 2; ++ai)
#pragma unroll
                for (int m = 0; m < 4; ++m) wv[ai][m] = 1.f; }
#pragma unroll
        for (int ai = 0; ai < 2; ++ai)
#pragma unroll
            for (int m = 0; m < 4; ++m) { const int rl = ai * HALF + wr * 64 + m * 16 + fr;
                const float w = wv[ai][m];
                f32x4 v0, v1;
#pragma unroll
                for (int e = 0; e < 4; ++e) { const float g0 = acc[ai][0][m][0][e], g1 = acc[ai][0][m][1][e];
                    v0[e] = g0 / (1.f + __expf(-g0)) * acc[ai][1][m][0][e] * w; v1[e] = g1 / (1.f + __expf(-g1)) * acc[ai][1][m][1][e] * w; }
                __builtin_amdgcn_raw_buffer_store_b128(pack8(v0, v1), rsrc, ((u.pm * BM + rl) * DE + col0) * 2, 0,   16);
                asm volatile("" ::: "memory"); }
    }
    __device__ __forceinline__ void signal(const Unit& u, bool leader) const { if (leader) (void)xb_add(flags + u.pm, 1u); }
};

template <class Epi, class Sched, bool GATHER>
__device__ __forceinline__ void gemm_phase(LAS unsigned char* lds, const int tid, const Gemm g, const Sched& S, const Epi& E) {
    const int wid = __builtin_amdgcn_readfirstlane(tid >> 6), lane = tid & 63, wr = wid >> 2, wc = wid & 3, fr = lane & 15, fq = lane >> 4;
    const int K = g.K, nt = K / BK; const unsigned lda = g.lda;
    unsigned voffA[2], voffB[2]; int RA[2], CA2[2];
#pragma unroll
    for (int i = 0; i < 2; ++i) { int R, C; stage_rc(tid * 16 + i * 8192, R, C); const int Rb = Epi::PERM ? ((R & ~31) + perm32(R & 31)) : R;
        voffA[i] = (unsigned)R * lda + (unsigned)C * 2u; voffB[i] = (unsigned)(Rb * K + C) * 2u; RA[i] = R; CA2[i] = C * 2; }
    const size_t kstep = (size_t)(BK * 2);
    const size_t hstepA = (size_t)HALF * lda, hstepB = (size_t)HALF * K * 2;
    const unsigned ldsw = (unsigned)wid * 1024u;
    const int aoff = lds_byte(wr * 64 + fr, fq * 8), boff = lds_byte(wc * 32 + fr, fq * 8);
    unsigned offC[2][2], offN[2][2];
#define PG8_GOFF(dst, U) do { _Pragma("unroll") for (int h_ = 0; h_ < 2; ++h_) _Pragma("unroll") for (int i_ = 0; i_ < 2; ++i_) { const int rl_ = h_ * HALF + RA[i_]; \
        int tok_; if ((U).list) tok_ = rl_ < (U).rows ? ((U).list[rl_] >> 1) : 0; else tok_ = (U).tok0 + rl_; dst[h_][i_] = (unsigned)tok_ * lda + (unsigned)CA2[i_]; } } while (0)
#define PG8_SA(b, h) (((b) * 2 + (h)) * HTB)
#define PG8_SB(b, h) ((4 + (b) * 2 + (h)) * HTB)
#define PG8_GLDS(gp, bufoff, i_) __builtin_amdgcn_global_load_lds((const unsigned*)(gp), (LAS unsigned*)(lds + (bufoff) + ldsw + (i_) * 8192), 16, 0, 0)
#define PG8_STAGE_B(bufoff, gbase) do { _Pragma("unroll") for (int _i = 0; _i < 2; ++_i) PG8_GLDS((const char*)(gbase) + voffB[_i], bufoff, _i); } while (0)
#define PG8_STAGE_A(bufoff, ub, NX, h, koff) do { if constexpr (GATHER) { _Pragma("unroll") for (int _i = 0; _i < 2; ++_i) { const unsigned o_ = (NX) ? offN[h][_i] : offC[h][_i]; PG8_GLDS((ub) + (koff) + o_, bufoff, _i); } } \
        else { _Pragma("unroll") for (int _i = 0; _i < 2; ++_i) PG8_GLDS((ub) + (size_t)(h) * hstepA + (koff) + voffA[_i], bufoff, _i); } } while (0)
#define PG8_LDA(dst, b, h) do { _Pragma("unroll") for (int m = 0; m < 4; ++m) _Pragma("unroll") for (int k = 0; k < 2; ++k) dst[m][k] = *(const LAS sbf16x8*)(lds + PG8_SA(b, h) + aoff + m * 2048 + k * 1024); } while (0)
#define PG8_LDB(dst, b, h) do { _Pragma("unroll") for (int n = 0; n < 2; ++n) _Pragma("unroll") for (int k = 0; k < 2; ++k) dst[n][k] = *(const LAS sbf16x8*)(lds + PG8_SB(b, h) + boff + n * 2048 + k * 1024); } while (0)
#define PG8_MMA(ai, bj, At, Bt) do { __builtin_amdgcn_s_setprio(1); _Pragma("unroll") for (int m = 0; m < 4; ++m) _Pragma("unroll") for (int n = 0; n < 2; ++n) _Pragma("unroll") for (int k = 0; k < 2; ++k) \
        acc[ai][bj][m][n] = __builtin_amdgcn_mfma_f32_16x16x32_bf16(Bt[n][k], At[m][k], acc[ai][bj][m][n], 0, 0, 0); __builtin_amdgcn_s_setprio(0); } while (0)
#define PG8_WAIT_V(n) asm volatile("s_waitcnt vmcnt(" #n ")" ::: "memory")
#define PG8_WAIT_L(n) asm volatile("s_waitcnt lgkmcnt(" #n ")" ::: "memory")
#define PG8_BAR __builtin_amdgcn_s_barrier()
#define PG8_SCHED __builtin_amdgcn_sched_barrier(0)
    Unit cur, nxt; int ui = 0;
    if (!S.next(0, cur, wid)) return;
    if constexpr (Sched::WAITS) PG8_BAR;
    f32x4 acc[2][2][4][2];
#define PG8_ZERO_ACC() do { float z_ = 0.f; asm volatile("" : "+v"(z_)); _Pragma("unroll") for (int a = 0; a < 2; ++a) _Pragma("unroll") for (int b = 0; b < 2; ++b) _Pragma("unroll") for (int m = 0; m < 4; ++m) \
        _Pragma("unroll") for (int n = 0; n < 2; ++n) acc[a][b][m][n] = (f32x4){z_, z_, z_, z_}; } while (0)
    PG8_ZERO_ACC();
    sbf16x8 At[4][2], B0[2][2], B1[2][2];
    const char* cA = cur.a; const char* cB = cur.b;
    if constexpr (GATHER) { PG8_GOFF(offC, cur); PG8_WAIT_V(0); }
    PG8_STAGE_B(PG8_SB(0, 0), cB); PG8_STAGE_B(PG8_SB(0, 1), cB + hstepB); PG8_STAGE_A(PG8_SA(0, 0), cA, false, 0, 0); PG8_STAGE_A(PG8_SA(0, 1), cA, false, 1, 0);
    if constexpr (Epi::PRE) E.pre(cur, wid);
    if (wr == 1) PG8_BAR;
    PG8_WAIT_V(2); PG8_BAR;
    PG8_STAGE_B(PG8_SB(1, 0), cB + kstep); PG8_STAGE_A(PG8_SA(1, 0), cA, false, 0, kstep); PG8_STAGE_B(PG8_SB(1, 1), cB + hstepB + kstep);
    PG8_WAIT_V(6); PG8_BAR;
    for (;;) {
        const bool has_next = S.next(ui + 1, nxt, wid);
        if constexpr (GATHER) { if (has_next) { PG8_GOFF(offN, nxt); PG8_WAIT_V(0); } else {
#pragma unroll
            for (int h_ = 0; h_ < 2; ++h_)
#pragma unroll
                for (int i_ = 0; i_ < 2; ++i_) offN[h_][i_] = offC[h_][i_]; } }
        const char* nA = has_next ? nxt.a : cA; const char* nB = has_next ? nxt.b : cB;
#pragma unroll 1
        for (int t = 0; t < nt; t += 2) {
            const bool last = (t == nt - 2);
            const size_t k1 = (size_t)(t + 1) * kstep;
            const char* a2 = last ? nA : cA; const char* b2 = last ? nB : cB + (size_t)(t + 2) * kstep;
            const size_t k2 = last ? 0 : (size_t)(t + 2) * kstep;
            const char* b3 = b2 + kstep;
            PG8_LDB(B0, 0, 0); PG8_LDB(B1, 0, 1); PG8_SCHED; PG8_LDA(At, 0, 0); PG8_STAGE_A(PG8_SA(1, 1), cA, false, 1, k1);
            PG8_WAIT_V(8); PG8_WAIT_L(0); PG8_BAR; PG8_MMA(0, 0, At, B0); PG8_MMA(0, 1, At, B1); PG8_BAR; PG8_SCHED;
            PG8_LDA(At, 0, 1); PG8_STAGE_B(PG8_SB(0, 0), b2); PG8_STAGE_B(PG8_SB(0, 1), b2 + hstepB); PG8_STAGE_A(PG8_SA(0, 0), a2, last, 0, k2);
            PG8_WAIT_V(8); PG8_WAIT_L(0); PG8_BAR; PG8_MMA(1, 0, At, B0); PG8_MMA(1, 1, At, B1); PG8_BAR; PG8_SCHED;
            PG8_LDB(B0, 1, 0); PG8_LDB(B1, 1, 1); PG8_SCHED; PG8_LDA(At, 1, 0); PG8_STAGE_A(PG8_SA(0, 1), a2, last, 1, k2);
            PG8_WAIT_V(8); PG8_WAIT_L(0); PG8_BAR; PG8_MMA(0, 0, At, B0); PG8_MMA(0, 1, At, B1); PG8_BAR; PG8_SCHED;
            PG8_LDA(At, 1, 1); PG8_STAGE_B(PG8_SB(1, 0), b3); PG8_STAGE_B(PG8_SB(1, 1), b3 + hstepB); PG8_STAGE_A(PG8_SA(1, 0), a2, last, 0, k2 + kstep);
            PG8_WAIT_V(8); PG8_WAIT_L(0); PG8_BAR; PG8_MMA(1, 0, At, B0); PG8_MMA(1, 1, At, B1); PG8_BAR; PG8_SCHED;
        }
        if (wr == 0) PG8_BAR;
        { unsigned z_ = 0u; asm volatile("" : "+v"(z_)); const int l2_ = (int)__builtin_amdgcn_mbcnt_hi(~0u, __builtin_amdgcn_mbcnt_lo(~0u, z_));
          E(acc, cur, wr, wc, l2_ & 15, l2_ >> 4);
          if constexpr (Epi::SIGNAL) { PG8_WAIT_V(0); PG8_BAR; E.signal(cur, wid == 0 && l2_ == 0); } }
        if (!has_next) break;
        PG8_ZERO_ACC();
        cur = nxt; cA = nA; cB = nB; ++ui;
        if constexpr (GATHER) {
#pragma unroll
            for (int h_ = 0; h_ < 2; ++h_)
#pragma unroll
                for (int i_ = 0; i_ < 2; ++i_) offC[h_][i_] = offN[h_][i_]; }
        if constexpr (Epi::PRE) { PG8_BAR; E.pre(cur, wid); }
        if (wr == 1) PG8_BAR;
    }
    PG8_WAIT_V(0);
    PG8_BAR;
#undef PG8_GOFF
#undef PG8_ZERO_ACC
#undef PG8_SA
#undef PG8_SB
#undef PG8_GLDS
#undef PG8_STAGE_A
#undef PG8_STAGE_B
#undef PG8_LDA
#undef PG8_LDB
#undef PG8_MMA
#undef PG8_WAIT_V
#undef PG8_WAIT_L
#undef PG8_BAR
#undef PG8_SCHED
}
}

template <class Epi>
__device__ __forceinline__ void run_dense(Frame& F, const bf16* A, int lda_elems, const bf16* Bt, int M, int N, int K, const Epi& E) {
    pg8::StaticOrder S; S.A = (const char*)A; S.Bt = (const char*)Bt; S.lda = (unsigned)lda_elems * 2u; S.K = K; S.nM = M / 256; S.nN = N / 256; S.nwg = S.nM * S.nN; S.G = F.G; S.c = F.bid;
    pg8::Gemm g{(unsigned)lda_elems * 2u, K};
    fresh_tid(F);
    pg8::gemm_phase<Epi, pg8::StaticOrder, false>(F.lds, F.tid, g, S, E);
}

constexpr int TB_OFF = 131072;
static_assert(pg8::KVE_END <= LDS_BYTES && TB_OFF + 2048 <= pg8::KVE_RSK, "LDS side tables");
constexpr int TE_OFF = TB_OFF + 1024;
__device__ __forceinline__ void compute_bases(Frame& F, int l) {
    fresh_tid(F);
    LAS unsigned* tb = (LAS unsigned*)(F.lds + TB_OFF); LAS unsigned* lc = tb + 32;
    if (F.tid == 0) { const unsigned* cnt = F.ctl + CW_CNT + CNT_LS * l; unsigned acc = 0;
        for (int e = 0; e < NE; ++e) { const unsigned c = cnt[CNT_ES * e]; lc[e] = c; tb[e] = acc; acc += (c + 255u) >> 8; }
        tb[16] = acc; tb[17] = acc + T / 256;
        if (F.bid == 0) { unsigned* base = F.ctl + CW_BASE + 32 * l; for (int e = 0; e < 18; ++e) base[e] = tb[e] * 256u; } }
    __syncthreads();
    if (F.tid < 256) { LAS unsigned* te = (LAS unsigned*)(F.lds + TE_OFF); unsigned e = 0;
        for (int j = 1; j <= NE; ++j) if ((unsigned)F.tid >= tb[j]) e = (unsigned)j;
        te[F.tid] = e | (((unsigned)F.tid - tb[e]) << 8); }
    __syncthreads();
}

struct Args { const GAS void* in[26]; GAS float* out; GAS unsigned char* ws; int lo, hi; };
constexpr int NSTEPS = 21;

__global__ void __launch_bounds__(NTHREADS, 2) mk_fwd(Args args) {
    extern __shared__ __attribute__((aligned(16))) unsigned char lds_raw[];
    Frame F;
    F.lds = (LAS unsigned char*)lds_raw; F.MISC = (volatile LAS unsigned*)(F.lds + MISC_OFF);
    F.tid = threadIdx.x; F.lane = F.tid & 63; F.wave = __builtin_amdgcn_readfirstlane(F.tid >> 6); F.bid = blockIdx.x; F.G = gridDim.x;
    F.ws = args.ws; F.ctl = (unsigned*)(GAS unsigned*)(args.ws + WS_CTL); F.out = (float*)args.out;
    F.in = args.in; const int wave0 = F.wave;
    if (F.tid < 32) F.MISC[F.tid] = 0u;
    __syncthreads();
    XcdBarrier bar; bar.bar = F.ctl + CW_BAR; bar.x = 0; bar.st = nullptr;
    if (!MK_SPLIT) bar = xcd_barrier_post(F.ctl + CW_BAR, F.MISC + 8);

    for (int step_ = args.lo; step_ < args.hi; ++step_) {
        int step = step_; asm volatile("" : "+s"(step));
        { GAS unsigned char* w_ = args.ws; asm volatile("" : "+s"(w_)); F.ws = w_; F.ctl = (unsigned*)(GAS unsigned*)(w_ + WS_CTL);
          int b_ = blockIdx.x, g_ = gridDim.x, wv_ = wave0; GAS float* o_ = args.out; asm volatile("" : "+s"(b_), "+s"(g_), "+s"(wv_), "+s"(o_)); F.bid = b_; F.G = g_; F.wave = wv_; F.out = (float*)o_;
          F.tid = 0; F.lane = 0; }
#ifdef ONLY_PH
#define PHON(p) ((p) == ONLY_PH)
#else
#define PHON(p) true
#endif
        if (step == 0) { step_p0(F); if (FAST_ANY) convert_weights(F, 0); }
        else if (step == 1) step_p0_reduce(F);
        else if (step == NSTEPS - 1) { if (PHON(0)) step_a(F, 2); }
        else {
            const int l = (step - 2) / 9, ph = (step - 2) % 9, phx = ph == 2 ? 23 : ph;
            bf16* const XNp = WSP(bf16, WS_XN); const float* const MODp = WSP(float, WS_MOD);
            if (!PHON(ph)) {} else
            if (ph == 0) { if (FAST_ANY && l > 0) convert_weights(F, l); if (l == 0) for (int rep_ = 1; rep_ < REP_A0; ++rep_) step_a(F, 0); step_a(F, l); }
            else if (ph == 1) {
#if FAST_B
                for (int rep_ = 0; rep_ < REP_B; ++rep_) run_dense(F, XNp, D, WSP(bf16, WT_IN), T, NPROJ, D, pg8::EpiBf16{(bf16*)F.ws, 0, 1, GBP(F)});
#else
                EpiProj E{WSP(bf16, WS_CONV), WSP(bf16, WS_SMALL), WSP(bf16, WS_GA), GBP(F)};
                ngemm<8, false>(F, T, NIN, D, RowLin{XNp, D}, ((const float*)(const GAS float*)F.in[7]) + (size_t)l * D * NIN, nullptr, NIN, nullptr, E);
#endif
            } else if (phx == 23) { for (int rep_ = 0; rep_ < REP_C; ++rep_) step_c(F, l);
#if FAST_D
                for (int rep_ = 0; rep_ < REP_D; ++rep_) {
                run_dense(F, WSP(bf16, WS_SMALL), 512, WSP(bf16, WT_UQ), T, 768, QL, pg8::EpiBf16{WSP(bf16, WS_QRAW), 768, 0, nullptr});
                run_dense(F, WSP(bf16, WS_SMALL) + 256, 512, WSP(bf16, WT_UKV), T, 1024, KVL, pg8::EpiKV{WSP(bf16, WS_K), WSP(bf16, WS_V), WSP(bf16, WS_SMALL), WSP(f32x2, WS_ROPE), ((const float*)(const GAS float*)F.in[14]) + l * DQK, F.lds}); }
#else
                ngemm<8, false>(F, T, 768, QL, RowLin{WSP(bf16, WS_SMALL), 512}, ((const float*)(const GAS float*)F.in[10]) + (size_t)l * QL * 768, nullptr, 768, ((const float*)(const GAS float*)F.in[9]) + l * QL, EpiStore{WSP(bf16, WS_QRAW), 768});
                ngemm<8, false>(F, T, 1024, KVL, RowLin{WSP(bf16, WS_SMALL) + 256, 512}, ((const float*)(const GAS float*)F.in[12]) + (size_t)l * KVL * 1024, nullptr, 1024, ((const float*)(const GAS float*)F.in[11]) + l * KVL, EpiStore{WSP(bf16, WS_KVRAW), 1024});
#endif
            } else if (ph == 3) {
                for (int rep_ = 0; rep_ < REP_E; ++rep_) step_e(F, l);
#if FAST_G
                run_dense(F, WSP(bf16, WS_U), CW, WSP(bf16, WT_CO), T, D, CW, pg8::EpiGate<1>{WSP(bf16, WS_GA), nullptr});
#else
                ngemm<8, false>(F, T, D, CW, RowLin{WSP(bf16, WS_U), CW}, ((const float*)(const GAS float*)F.in[15]) + (size_t)l * CW * D, nullptr, D, nullptr, EpiGate1{WSP(bf16, WS_GA)});
#endif
            } else if (ph == 4) { for (int rep_ = 0; rep_ < REP_F; ++rep_) { if (FAST_ATTN && attn_static_ok(F, l)) step_f_fast(F); else step_f(F); }
            } else if (ph == 5) {
#if FAST_H
                run_dense(F, WSP(bf16, WS_O), 512, WSP(bf16, WT_AO), T, D, 512, pg8::EpiGate<2>{WSP(bf16, WS_GA), GBP(F)});
#else
                ngemm<8, false>(F, T, D, 512, RowLin{WSP(bf16, WS_O), 512}, ((const float*)(const GAS float*)F.in[16]) + (size_t)l * 512 * D, nullptr, D, nullptr, EpiGate2{WSP(bf16, WS_GA), GBP(F)});
#endif
            } else if (ph == 6) {
#if FAST_I
                run_dense(F, WSP(bf16, WS_GA), D, WSP(bf16, WT_O), T, D, D, pg8::EpiRes16{l == 0 ? ((const float*)(const GAS float*)F.in[0]) : nullptr, WSP(bf16, WS_X16), MODp + (size_t)l * 2 * 6 * D + 2 * D});
#else
                ngemm<8, false>(F, T, D, D, RowLin{WSP(bf16, WS_GA), D}, ((const float*)(const GAS float*)F.in[17]) + (size_t)l * D * D, nullptr, D, nullptr,
                                EpiRes{l == 0 ? ((const float*)(const GAS float*)F.in[0]) : F.out, F.out, MODp + (size_t)l * 2 * 6 * D + 2 * D});
#endif
            } else if (ph == 7) { for (int rep_ = 1; rep_ < REP_J; ++rep_) step_j(F, l, true); if (USE_OLD_J) step_j_old(F, l); else step_j(F, l);
            } else {
                compute_bases(F, l);
                const LAS unsigned* tb = (const LAS unsigned*)(F.lds + TB_OFF); const LAS unsigned* cnt = tb + 32;
                unsigned* kf = F.ctl + CW_KF + 256 * l;
                pg8::MoeOrderX S; S.MT = (int)__builtin_amdgcn_readfirstlane(tb[17]); S.G = F.G; S.c = F.bid; S.tb = tb; S.cnt = cnt; S.te = (const LAS unsigned*)(F.lds + TE_OFF); S.LIST = WSP(int, WS_LIST); S.kN = 2; S.flags = kf; S.bar = F.ctl + CW_BAR;
                S.A = (const char*)XNp; S.Bt = (const char*)WSP(bf16, WT_GU); S.estride = (size_t)512 * D * 2; S.lda = D * 2; S.K = D; S.nN = 2; S.gather = true; S.mode = 0;
                fresh_tid(F);
                pg8::gemm_phase<pg8::EpiAct, pg8::MoeOrderX, true>(F.lds, F.tid, pg8::Gemm{(unsigned)D * 2u, D}, S, pg8::EpiAct{WSP(bf16, WS_A2), WSP(float, WS_TOKW), kf});
                S.A = (const char*)WSP(bf16, WS_A2); S.Bt = (const char*)WSP(bf16, WT_DN); S.estride = (size_t)D * DE * 2; S.lda = DE * 2; S.K = DE; S.nN = 4; S.gather = false; S.mode = 1;
                fresh_tid(F);
                pg8::gemm_phase<pg8::EpiY8, pg8::MoeOrderX, false>(F.lds, F.tid, pg8::Gemm{(unsigned)DE * 2u, DE}, S, pg8::EpiY8{WSP(unsigned char, WS_Y)});
            }
        }
        if (step_ + 1 < args.hi) for (int rep_ = 0; rep_ < REP_BAR; ++rep_) xcd_barrier(bar);
    }
}

extern "C" void kernel_launch(void* const* d_in, const int* in_sizes, int n_in, void* d_out, int out_size, void* d_ws, size_t ws_size, hipStream_t stream) {
    static int grid = 0;
    if (grid == 0) {
        if (n_in != 26 || in_sizes[0] != T * D || out_size != T * D || ws_size < WS_END) {
            fprintf(stderr, "kernel_launch: unexpected shapes: n_in %d in0 %d out %d ws %zu (need >= %zu)\n", n_in, n_in > 0 ? in_sizes[0] : -1, out_size, ws_size, (size_t)WS_END); grid = -1; return; }
        int dev = 0, cus = 0;
        if (hipGetDevice(&dev) != hipSuccess || hipDeviceGetAttribute(&cus, hipDeviceAttributeMultiprocessorCount, dev) != hipSuccess) { grid = -1; return; }
        if (hipFuncSetAttribute((const void*)mk_fwd, hipFuncAttributeMaxDynamicSharedMemorySize, LDS_BYTES) != hipSuccess) { fprintf(stderr, "kernel_launch: hipFuncSetAttribute failed\n"); grid = -1; return; }
        int per_cu = 0;
        if (hipOccupancyMaxActiveBlocksPerMultiprocessor(&per_cu, (const void*)mk_fwd, NTHREADS, LDS_BYTES) != hipSuccess || per_cu < 1)
            fprintf(stderr, "kernel_launch: note: occupancy query reports %d blocks/CU\n", per_cu);
        (void)hipGetLastError();
        grid = cus;
    }
    if (grid < 0) return;
    if (hipMemsetAsync((char*)d_ws + WS_CTL, 0, CTL_ZERO_BYTES, stream) != hipSuccess) { fprintf(stderr, "kernel_launch: memset failed\n"); return; }
    Args a{};
    for (int i = 0; i < 26; ++i) a.in[i] = (const GAS void*)d_in[i];
    a.out = (GAS float*)d_out; a.ws = (GAS unsigned char*)d_ws;
#if MK_SPLIT
    for (int s = 0; s < NSTEPS; ++s) { a.lo = s; a.hi = s + 1; hipLaunchKernelGGL(mk_fwd, dim3(grid), dim3(NTHREADS), LDS_BYTES, stream, a); }
#else
    a.lo = 0; a.hi = NSTEPS;
    hipLaunchKernelGGL(mk_fwd, dim3(grid), dim3(NTHREADS), LDS_BYTES, stream, a);
#endif
    const hipError_t le = hipPeekAtLastError();
    if (le != hipSuccess) fprintf(stderr, "kernel_launch: launch failed: %s\n", hipGetErrorName(le));
}
```

```cpp
#include <hip/hip_runtime.h>
#include <cstdio>
#include <cstdint>

#ifndef FAST_GEMM
#define FAST_GEMM 1
#endif
#ifndef FAST_B
#define FAST_B FAST_GEMM
#endif
#ifndef FAST_D
#define FAST_D FAST_GEMM
#endif
#ifndef FAST_G
#define FAST_G FAST_GEMM
#endif
#ifndef FAST_H
#define FAST_H FAST_GEMM
#endif
#ifndef FAST_I
#define FAST_I FAST_GEMM
#endif
#ifndef FAST_K
#define FAST_K FAST_GEMM
#endif
#ifndef FAST_L
#define FAST_L FAST_GEMM
#endif
#define FAST_ANY (FAST_B || FAST_D || FAST_G || FAST_H || FAST_I || FAST_K || FAST_L)
#ifndef USE_OLD_J
#define USE_OLD_J 0
#endif
#ifndef DBG_SHFL
#define DBG_SHFL 1
#endif
#ifndef FAST_ATTN
#define FAST_ATTN 1
#endif
#ifndef REP_F
#define REP_F 1
#endif
#ifndef REP_CVT
#define REP_CVT 1
#endif
#ifndef REP_B
#define REP_B 1
#endif
#ifndef REP_C
#define REP_C 1
#endif
#ifndef REP_D
#define REP_D 1
#endif
#ifndef REP_E
#define REP_E 1
#endif
#ifndef REP_K
#define REP_K 1
#endif
#ifndef REP_L
#define REP_L 1
#endif
#ifndef REP_J
#define REP_J 1
#endif
#ifndef REP_A0
#define REP_A0 1
#endif
#ifndef REP_P0
#define REP_P0 1
#endif
#ifndef REP_BAR
#define REP_BAR 1
#endif
#ifndef ATTN_W64
#define ATTN_W64 1
#endif
#ifndef MK_SPLIT
#define MK_SPLIT 0
#endif

#define GAS __attribute__((address_space(1)))
#define LAS __attribute__((address_space(3)))
typedef unsigned short bf16;
typedef unsigned v4u __attribute__((ext_vector_type(4)));
typedef unsigned v2u __attribute__((ext_vector_type(2)));
typedef float f32x4 __attribute__((ext_vector_type(4)));
typedef float f32x2 __attribute__((ext_vector_type(2)));
typedef unsigned short bf16x8 __attribute__((ext_vector_type(8)));
typedef unsigned short bf16x4 __attribute__((ext_vector_type(4)));
typedef GAS unsigned gu32;

constexpr int NB = 2, S = 8192, T = NB * S, D = 1024, H = 8, DQK = 96, DV = 64;
constexpr int NIN = 4000, CW = 512, QL = 256, KVL = 128, NE = 16, DE = 256, NEX = NE + 1;
constexpr float EPS = 1e-6f;
constexpr float QSCALE = 0.10206207261596577f * 1.4426950408889634f;
constexpr int NWAVES = 8, NTHREADS = 512;

constexpr size_t MiB = 1u << 20, KiB = 1u << 10;
constexpr size_t WS_CTL = 0, CTL_ZERO_BYTES = 64 * KiB;
constexpr size_t WS_MOD = 1 * MiB;
constexpr size_t WS_TOKS = WS_MOD + 128 * KiB;
constexpr size_t WS_TOKW = WS_TOKS + 128 * KiB;
constexpr size_t WS_RS = WS_TOKW + 128 * KiB;
constexpr size_t WS_ROPE = 2 * MiB;
constexpr size_t WS_LIST = 4 * MiB;
constexpr size_t WS_WT = 5 * MiB;
constexpr size_t WS_XN = 45 * MiB;
constexpr size_t WS_R1 = 109 * MiB;
constexpr size_t WS_R2 = 157 * MiB;
constexpr size_t WS_GA = 173 * MiB;
constexpr size_t WS_X16 = 77 * MiB;
#define G8P(F_) ((unsigned char*)(F_).out)
#define GBP(F_) ((bf16*)((unsigned char*)(F_).out + 32 * MiB))
constexpr size_t WS_U = 205 * MiB;
constexpr size_t WS_K = WS_XN;
constexpr size_t WS_V = 245 * MiB;
constexpr size_t WS_END = 261 * MiB;
constexpr size_t WS_KVRAW = WS_XN, WS_CONV = WS_R1, WS_QRAW = 221 * MiB  , WS_Q = WS_R1 + 24 * MiB, WS_SMALL = WS_R2, WS_O = WS_R2;
constexpr size_t WS_A2 = WS_R1;
constexpr size_t WS_Y = WS_R1 + 26 * MiB;
constexpr int SLOTS_MAX = 3 * T + NE * 256;
static_assert(WS_Y + (size_t)SLOTS_MAX * 2048 <= WS_END, "MoE overlay");
constexpr int CW_CNT = 8192, CNT_LS = 2048, CNT_ES = 64;
static_assert((CW_CNT + 2 * CNT_LS) * 4 <= (int)CTL_ZERO_BYTES && (4096 + 3456) * 4 <= (int)CTL_ZERO_BYTES, "control words (barrier region at word 4096, 3456 words; counters) inside the per-call memset");
constexpr int CW_BASE = 192;
constexpr int CW_BAR = 4096;
constexpr int CW_KF = 12288;
static_assert((CW_KF + 2 * 256) * 4 <= (int)CTL_ZERO_BYTES && CW_KF >= CW_CNT + 2 * CNT_LS, "slot-tile flags inside the per-call memset");

#define RLX_AGENT __ATOMIC_RELAXED, __HIP_MEMORY_SCOPE_AGENT
__device__ __forceinline__ unsigned f2bf(float f) { unsigned u = __builtin_bit_cast(unsigned, f); return (u + 0x7fffu + ((u >> 16) & 1u)) >> 16; }
typedef __bf16 hwbf16x2 __attribute__((ext_vector_type(2)));
__device__ __forceinline__ unsigned pk2(float lo, float hi) { f32x2 v = {lo, hi}; hwbf16x2 b = __builtin_convertvector(v, hwbf16x2); return __builtin_bit_cast(unsigned, b); }
__device__ __forceinline__ float bf2f(unsigned short b) { return __builtin_bit_cast(float, (unsigned)b << 16); }
template <int CTRL> __device__ __forceinline__ float dpp_mov(float v) { return __builtin_bit_cast(float, __builtin_amdgcn_update_dpp(0, __builtin_bit_cast(int, v), CTRL, 0xF, 0xF, false)); }
template <int K> __device__ __forceinline__ float xor_lane(float v) {
    if constexpr (K == 1) return dpp_mov<0xB1>(v);
    else if constexpr (K == 2) return dpp_mov<0x4E>(v);
    else return __builtin_bit_cast(float, __builtin_amdgcn_ds_swizzle(__builtin_bit_cast(int, v), (K << 10) | 0x1f)); }
__device__ __forceinline__ float row16_sum_dpp(float v) { v += dpp_mov<0x121>(v); v += dpp_mov<0x122>(v); v += dpp_mov<0x124>(v); v += dpp_mov<0x128>(v); return v; }
__device__ __forceinline__ float add_xor32(float v) {
    auto r = __builtin_amdgcn_permlane32_swap(__builtin_bit_cast(unsigned, v), __builtin_bit_cast(unsigned, v), false, false);
    return __builtin_bit_cast(float, r[0]) + __builtin_bit_cast(float, r[1]); }
__device__ __forceinline__ float bperm_xor(float v, int lane, int k) { return __builtin_bit_cast(float, __builtin_amdgcn_ds_bpermute((lane ^ k) << 2, __builtin_bit_cast(int, v))); }
__device__ __forceinline__ float wave_sum(float v, int lane) {
    v = row16_sum_dpp(v);
    const float r0 = __builtin_bit_cast(float, __builtin_amdgcn_readlane(__builtin_bit_cast(int, v), 0)), r1 = __builtin_bit_cast(float, __builtin_amdgcn_readlane(__builtin_bit_cast(int, v), 16));
    const float r2 = __builtin_bit_cast(float, __builtin_amdgcn_readlane(__builtin_bit_cast(int, v), 32)), r3 = __builtin_bit_cast(float, __builtin_amdgcn_readlane(__builtin_bit_cast(int, v), 48));
    return (r0 + r1) + (r2 + r3);
}
__device__ __forceinline__ float sigmoidf_(float x) { return 1.f / (1.f + __expf(-x)); }

#define XB_TMO      128
#define XB_XCNT(j)  (256  + 64 * (j))
#define XB_XSUB(j)  (1280 + 64 * (j))
#define XB_XGEN(j)  (2304 + 64 * (j))
#define XB_TOP      3328
#define XB_TOPGEN   3392
#define XCD_BAR_WORDS 3456
#define XB_SPIN_CAP (1u << 22)
__device__ __forceinline__ unsigned xb_ld(unsigned* p)              { return __hip_atomic_load(p, __ATOMIC_RELAXED, __HIP_MEMORY_SCOPE_AGENT); }
__device__ __forceinline__ unsigned xb_add(unsigned* p, unsigned v) { return __hip_atomic_fetch_add(p, v, __ATOMIC_RELAXED, __HIP_MEMORY_SCOPE_AGENT); }
__device__ __forceinline__ unsigned xb_xcc_id() { return (unsigned)__builtin_amdgcn_s_getreg((3 << 11) | 20) & 0xFu; }
#define XB_SPIN(cond, bar) do { unsigned _sp = 0; while (cond) { __builtin_amdgcn_s_sleep(1); \
    if ((++_sp & 255u) == 0u) { if (xb_ld(&(bar)[XB_TMO])) break; if (_sp > XB_SPIN_CAP) { atomicAdd(&(bar)[XB_TMO], 1u); break; } } } } while (0)
struct XcdBarrier { unsigned* bar; unsigned x; volatile LAS unsigned* st; };
__device__ __forceinline__ XcdBarrier xcd_barrier_post(unsigned* bar, volatile LAS unsigned* st) {
    XcdBarrier b; b.bar = bar; b.x = xb_xcc_id(); b.st = st;
    if (threadIdx.x == 0) (void)xb_add(&bar[XB_XCNT(b.x)], 1u);
    return b;
}
__device__ __forceinline__ void xcd_barrier_complete(unsigned* bar, unsigned x, unsigned& nloc, unsigned& nx) {
    const unsigned G = gridDim.x * gridDim.y * gridDim.z;
    unsigned sum, cnt, mine, sp = 0u;
    for (;;) {
        sum = 0u; cnt = 0u; mine = 0u;
#pragma unroll
        for (unsigned j = 0; j < 16; ++j) { const unsigned c = xb_ld(&bar[XB_XCNT(j)]); sum += c; cnt += (c > 0u) ? 1u : 0u; mine = (j == x) ? c : mine; }
        if (sum == G) break;
        __builtin_amdgcn_s_sleep(1);
        if ((++sp & 255u) == 0u) { if (xb_ld(&bar[XB_TMO])) break; if (sp > XB_SPIN_CAP) { atomicAdd(&bar[XB_TMO], 1u); break; } }
    }
    nloc = mine > 0u ? mine : 1u; nx = cnt > 0u ? cnt : 1u;
}
__device__ __forceinline__ void xcd_barrier(const XcdBarrier& b) {
    asm volatile("s_waitcnt vmcnt(0)" ::: "memory");
    __syncthreads();
    if (threadIdx.x == 0) {
        unsigned* bar = b.bar;
        __builtin_amdgcn_s_waitcnt(0);
        unsigned nloc = b.st[0], nx = b.st[1];
        if (nloc == 0u) { xcd_barrier_complete(bar, b.x, nloc, nx); b.st[0] = nloc; b.st[1] = nx; }
        const unsigned old = xb_add(&bar[XB_XSUB(b.x)], 1u);
        const unsigned gen = old / nloc;
        if (old + 1u == (gen + 1u) * nloc) {
            __builtin_amdgcn_fence(__ATOMIC_RELEASE, "agent");
            asm volatile("s_waitcnt vmcnt(0)" ::: "memory");
            const unsigned og = xb_add(&bar[XB_TOP], 1u);
            const unsigned tg = og / nx;
            if (og + 1u == (tg + 1u) * nx) xb_add(&bar[XB_TOPGEN], 1u);
            else XB_SPIN(xb_ld(&bar[XB_TOPGEN]) == tg, bar);
            __builtin_amdgcn_fence(__ATOMIC_ACQUIRE, "agent");
            xb_add(&bar[XB_XGEN(b.x)], 1u);
            asm volatile("s_waitcnt vmcnt(0)" ::: "memory");
        } else {
            XB_SPIN(xb_ld(&bar[XB_XGEN(b.x)]) == gen, bar);
            __builtin_amdgcn_fence(__ATOMIC_ACQUIRE, "agent");
            asm volatile("s_waitcnt vmcnt(0)" ::: "memory");
        }
    }
    __syncthreads();
}

constexpr int LDS_BYTES = 155648;
constexpr int MISC_OFF = 131072 + 320;
struct Frame {
    LAS unsigned char* lds; volatile LAS unsigned* MISC; unsigned* ctl;
    int tid, lane, wave, bid, G;
    const GAS void* const* in;
    float* out; GAS unsigned char* ws;
};
#define WSP(T_, off) ((T_*)(GAS T_*)(F.ws + (off)))
__device__ __forceinline__ void fresh_tid(Frame& F) { unsigned z_ = 0u; asm volatile("" : "+v"(z_)); const int l_ = (int)__builtin_amdgcn_mbcnt_hi(~0u, __builtin_amdgcn_mbcnt_lo(~0u, z_)); F.lane = l_; F.tid = F.wave * 64 + l_; }

__constant__ double INVF[16] = {1.0, 0.5623413251903491, 0.31622776601683794, 0.1778279410038923, 0.1, 0.05623413251903491, 0.03162277660168379, 0.01778279410038923,
                                0.01, 0.005623413251903491, 0.0031622776601683794, 0.001778279410038923, 0.001, 0.0005623413251903491, 0.00031622776601683794, 0.0001778279410038923};

constexpr size_t WS_MODP = WS_XN;
__device__ __forceinline__ void step_p0(Frame& F) {
    fresh_tid(F);
    const int gw = F.bid * NWAVES + F.wave, NGW = F.G * NWAVES;
    float* MODP = WSP(float, WS_MODP);
    const float* cin = (const float*)F.in[1];
    for (int it = gw; it < 2 * 96 * 16; it += NGW) {
        const int kc = it & 15, nc = (it >> 4) % 96, l = (it >> 4) / 96, n = nc * 64 + F.lane;
        const float* w = ((const float*)(const GAS float*)F.in[3]) + ((size_t)l * D + kc * 64) * (6 * D) + n;
        float a0 = 0.f, a1 = 0.f;
#pragma unroll
        for (int kh = 0; kh < 2; ++kh) {
            float wv[32];
#pragma unroll
            for (int k = 0; k < 32; ++k) wv[k] = w[(size_t)(kh * 32 + k) * (6 * D)];
#pragma unroll
            for (int k = 0; k < 32; ++k) {
                const float c0 = cin[kc * 64 + kh * 32 + k], c1 = cin[D + kc * 64 + kh * 32 + k];
                const float s0 = c0 / (1.f + __expf(-c0)), s1 = c1 / (1.f + __expf(-c1));
                a0 += s0 * wv[k]; a1 += s1 * wv[k];
            }
        }
        MODP[((size_t)(kc * 2 + l) * 2 + 0) * 6 * D + n] = a0; MODP[((size_t)(kc * 2 + l) * 2 + 1) * 6 * D + n] = a1;
    }
    f32x2* ROPE = WSP(f32x2, WS_ROPE);
    for (int idx = F.bid * NTHREADS + F.tid; idx < T * 16; idx += F.G * NTHREADS) {
        const int t = idx >> 4, i = idx & 15;
        const double a = (double)((const int*)(const GAS int*)F.in[2])[t] * INVF[i];
        const double n = __builtin_rint(a * 0.15915494309189535);
        double r = __builtin_fma(-n, 6.283185307179586, a); r = __builtin_fma(-n, 2.4492935982947064e-16, r);
        const float rf = (float)r;
        f32x2 cs; cs.x = __cosf(rf); cs.y = __sinf(rf);
        ROPE[idx] = cs;
    }
}
__device__ __forceinline__ void step_p0_reduce(Frame& F) {
    fresh_tid(F);
    const float* MODP = WSP(float, WS_MODP); float* MOD = WSP(float, WS_MOD);
    for (int idx = F.bid * NTHREADS + F.tid; idx < 2 * 2 * 6 * D; idx += F.G * NTHREADS) {
        const int n = idx % (6 * D), l = idx / (2 * 6 * D);
        float a = ((const float*)(const GAS float*)F.in[4])[l * 6 * D + n];
#pragma unroll
        for (int kc = 0; kc < 16; ++kc) a += MODP[(size_t)kc * (2 * 2 * 6 * D) + idx];
        MOD[idx] = a;
    }
}

__device__ __forceinline__ void step_a(Frame& F, int l) {
    fresh_tid(F);
    const int gw = F.bid * NWAVES + F.wave, NGW = F.G * NWAVES;
    const float* MOD = WSP(float, WS_MOD);
    const unsigned char* Y = WSP(unsigned char, WS_Y);
    const int* TOKS = WSP(int, WS_TOKS);
    bf16* XN = WSP(bf16, WS_XN); bf16* X16 = WSP(bf16, WS_X16);
    for (int row0 = gw; row0 < T; row0 += 2 * NGW) {
        const bool has1 = row0 + NGW < T;
        int rr[2]; rr[0] = row0; rr[1] = has1 ? row0 + NGW : row0;
        f32x4 v[2][4];
        if (l == 0) {
#pragma unroll
            for (int k = 0; k < 2; ++k)
#pragma unroll
                for (int j = 0; j < 4; ++j) v[k][j] = *(const f32x4*)(((const float*)(const GAS float*)F.in[0]) + (size_t)rr[k] * D + 4 * F.lane + 256 * j);
        } else {
            const unsigned* base = F.ctl + CW_BASE + 32 * (l - 1);
            int tk[2][2];
#pragma unroll
            for (int k = 0; k < 2; ++k) { tk[k][0] = TOKS[2 * rr[k]]; tk[k][1] = TOKS[2 * rr[k] + 1]; }
            size_t sl[2][3];
#pragma unroll
            for (int k = 0; k < 2; ++k) { sl[k][0] = base[tk[k][0] >> 16] + (tk[k][0] & 0xffff); sl[k][1] = base[tk[k][1] >> 16] + (tk[k][1] & 0xffff); sl[k][2] = base[16] + rr[k]; }
            f32x4 xo[2][4], gg[2][4]; unsigned ya[2][4], yb[2][4], yc[2][4];
#pragma unroll
            for (int k = 0; k < 2; ++k) { const float* gt2 = MOD + ((l - 1) * 2 + rr[k] / S) * 6 * D + 5 * D;
#pragma unroll
                for (int j = 0; j < 4; ++j) { const int col = 4 * F.lane + 256 * j;
                    { const bf16x4 t = *(const bf16x4*)(X16 + (size_t)rr[k] * D + col); xo[k][j] = (f32x4){bf2f(t[0]), bf2f(t[1]), bf2f(t[2]), bf2f(t[3])}; } gg[k][j] = *(const f32x4*)(gt2 + col);
                    ya[k][j] = *(const unsigned*)(Y + sl[k][0] * D + col); yb[k][j] = *(const unsigned*)(Y + sl[k][1] * D + col); yc[k][j] = *(const unsigned*)(Y + sl[k][2] * D + col); } }
#pragma unroll
            for (int k = 0; k < 2; ++k)
#pragma unroll
                for (int j = 0; j < 4; ++j) { f32x4 r;
                    const f32x2 a0 = __builtin_amdgcn_cvt_pk_f32_fp8((int)ya[k][j], false), a1 = __builtin_amdgcn_cvt_pk_f32_fp8((int)ya[k][j], true);
                    const f32x2 b0 = __builtin_amdgcn_cvt_pk_f32_fp8((int)yb[k][j], false), b1 = __builtin_amdgcn_cvt_pk_f32_fp8((int)yb[k][j], true);
                    const f32x2 c0 = __builtin_amdgcn_cvt_pk_f32_fp8((int)yc[k][j], false), c1 = __builtin_amdgcn_cvt_pk_f32_fp8((int)yc[k][j], true);
                    const f32x4 ys = (f32x4){a0.x + b0.x + c0.x, a0.y + b0.y + c0.y, a1.x + b1.x + c1.x, a1.y + b1.y + c1.y};
#pragma unroll
                    for (int e = 0; e < 4; ++e) r[e] = xo[k][j][e] + gg[k][j][e] * ys[e];
                    v[k][j] = r;
                    if (k == 0 || has1) { if (l == 2) *(f32x4*)(F.out + (size_t)rr[k] * D + 4 * F.lane + 256 * j) = r;
                        else { v2u o_; o_.x = pk2(r[0], r[1]); o_.y = pk2(r[2], r[3]); *(v2u*)(X16 + (size_t)rr[k] * D + 4 * F.lane + 256 * j) = o_; } } }
        }
        if (l < 2) {
            f32x4 g[4], sc[2][4], sh[2][4];
#pragma unroll
            for (int j = 0; j < 4; ++j) g[j] = *(const f32x4*)(((const float*)(const GAS float*)F.in[5]) + l * D + 4 * F.lane + 256 * j);
#pragma unroll
            for (int k = 0; k < 2; ++k) { const float* m = MOD + (l * 2 + rr[k] / S) * 6 * D;
#pragma unroll
                for (int j = 0; j < 4; ++j) { sc[k][j] = *(const f32x4*)(m + D + 4 * F.lane + 256 * j); sh[k][j] = *(const f32x4*)(m + 4 * F.lane + 256 * j); } }
            float ss[2];
#pragma unroll
            for (int k = 0; k < 2; ++k) { float a = 0.f;
#pragma unroll
                for (int j = 0; j < 4; ++j) a += (v[k][j].x * v[k][j].x + v[k][j].y * v[k][j].y) + (v[k][j].z * v[k][j].z + v[k][j].w * v[k][j].w);
                ss[k] = a; }
            const float rs0 = 1.0f / sqrtf(wave_sum(ss[0], F.lane) * (1.f / D) + EPS), rs1 = 1.0f / sqrtf(wave_sum(ss[1], F.lane) * (1.f / D) + EPS);
#pragma unroll
            for (int k = 0; k < 2; ++k) { const float rs = k ? rs1 : rs0;
#pragma unroll
                for (int j = 0; j < 4; ++j) { f32x4 h;
#pragma unroll
                    for (int e = 0; e < 4; ++e) h[e] = v[k][j][e] * rs * g[j][e] * (1.f + sc[k][j][e]) + sh[k][j][e];
                    v2u o; o.x = pk2(h[0], h[1]); o.y = pk2(h[2], h[3]);
                    if (k == 0 || has1) *(v2u*)(XN + (size_t)rr[k] * D + 4 * F.lane + 256 * j) = o; } }
        }
    }
}

template <int RPT, bool DUAL, class RowF, class Epi>
__device__ __forceinline__ void ngemm(Frame& F, int M, int N, int K, RowF rowf, const float* W, const float* W2, int ldw, const float* ksc, Epi epi) {
    fresh_tid(F);
    const int gw = F.bid * NWAVES + F.wave, NGW = F.G * NWAVES;
    const int nrb = (M + RPT - 1) / RPT, ncc = (N + 255) / 256;
    for (int it = gw; it < nrb * ncc; it += NGW) {
        const int cc = it / nrb, rb = it % nrb;
        const int n4 = cc * 256 + F.lane * 4;
        const bool nv = n4 < N;
        const int n4c = nv ? n4 : 0;
        const bf16* rp[RPT];
#pragma unroll
        for (int r = 0; r < RPT; ++r) { int m = rb * RPT + r; if (m >= M) m = M - 1; rp[r] = rowf(m); }
        f32x4 acc[RPT], acc2[RPT];
#pragma unroll
        for (int r = 0; r < RPT; ++r) { acc[r] = (f32x4){0.f, 0.f, 0.f, 0.f}; acc2[r] = (f32x4){0.f, 0.f, 0.f, 0.f}; }
        for (int k0 = 0; k0 < K; k0 += 8) {
            bf16x8 a[RPT];
#pragma unroll
            for (int r = 0; r < RPT; ++r) a[r] = *(const bf16x8*)(rp[r] + k0);
#pragma unroll
            for (int j = 0; j < 8; ++j) {
                f32x4 w = *(const f32x4*)(W + (size_t)(k0 + j) * ldw + n4c);
                f32x4 w2 = (f32x4){0.f, 0.f, 0.f, 0.f};
                if (DUAL) w2 = *(const f32x4*)(W2 + (size_t)(k0 + j) * ldw + n4c);
                if (ksc) { const float s = ksc[k0 + j]; w = w * s; }
#pragma unroll
                for (int r = 0; r < RPT; ++r) { const float av = bf2f(a[r][j]); acc[r] += av * w; if (DUAL) acc2[r] += av * w2; }
            }
        }
        if (nv) {
#pragma unroll
            for (int r = 0; r < RPT; ++r) { const int m = rb * RPT + r; if (m < M) epi(m, n4, acc[r], acc2[r]); }
        }
    }
}
struct RowLin { const bf16* p; int ld; __device__ __forceinline__ const bf16* operator()(int m) const { return p + (size_t)m * ld; } };
struct RowGather { const bf16* p; int ld; const int* list; __device__ __forceinline__ const bf16* operator()(int m) const { return p + (size_t)(list[m] >> 1) * ld; } };
__device__ __forceinline__ void st_bf4(bf16* p, f32x4 v) { v2u o; o.x = pk2(v[0], v[1]); o.y = pk2(v[2], v[3]); *(v2u*)p = o; }

struct EpiProj { bf16 *conv, *small, *ga, *gb;
    __device__ __forceinline__ void operator()(int m, int n, f32x4 a, f32x4) const {
        bf16* p;
        if (n < 1536) p = conv + (size_t)m * 1536 + n;
        else if (n < 1952) p = small + (size_t)m * 512 + (n - 1536);
        else if (n < 2976) p = ga + (size_t)m * 1024 + (n - 1952);
        else p = gb + (size_t)m * 1024 + (n - 2976);
        st_bf4(p, a);
    } };
struct EpiStore { bf16* o; int ld; __device__ __forceinline__ void operator()(int m, int n, f32x4 a, f32x4) const { st_bf4(o + (size_t)m * ld + n, a); } };
struct EpiGate1 { bf16* ga; __device__ __forceinline__ void operator()(int m, int n, f32x4 a, f32x4) const {
        bf16* p = ga + (size_t)m * D + n; const bf16x4 g = *(const bf16x4*)p; f32x4 r;
#pragma unroll
        for (int e = 0; e < 4; ++e) r[e] = sigmoidf_(bf2f(g[e])) * a[e];
        st_bf4(p, r); } };
struct EpiGate2 { bf16* t1; const bf16* gb; __device__ __forceinline__ void operator()(int m, int n, f32x4 a, f32x4) const {
        bf16* p = t1 + (size_t)m * D + n; const bf16x4 t = *(const bf16x4*)p; const bf16x4 g = *(const bf16x4*)(gb + (size_t)m * D + n); f32x4 r;
#pragma unroll
        for (int e = 0; e < 4; ++e) r[e] = bf2f(t[e]) + sigmoidf_(bf2f(g[e])) * a[e];
        st_bf4(p, r); } };
struct EpiRes { const float* xin; float* out; const float* gt; __device__ __forceinline__ void operator()(int m, int n, f32x4 a, f32x4) const {
        const f32x4 xv = *(const f32x4*)(xin + (size_t)m * D + n); const f32x4 g = *(const f32x4*)(gt + (m / S) * 6 * D + n);
        *(f32x4*)(out + (size_t)m * D + n) = xv + g * a; } };
struct EpiAct { bf16* a2; size_t slot0; const int* list; const float* tokw; __device__ __forceinline__ void operator()(int m, int n, f32x4 g, f32x4 u) const {
        const float w = list ? tokw[list[m]] : 1.f; f32x4 r;
#pragma unroll
        for (int e = 0; e < 4; ++e) r[e] = g[e] / (1.f + __expf(-g[e])) * u[e] * w;
        st_bf4(a2 + (slot0 + m) * DE + n, r); } };

__device__ __forceinline__ void step_c(Frame& F, int l) {
    fresh_tid(F);
    const bf16* CONV = WSP(bf16, WS_CONV); bf16* U = WSP(bf16, WS_U);
    const int gt = F.bid * NTHREADS + F.tid, NT = F.G * NTHREADS;
    for (int idx = gt; idx < T * 64; idx += NT) {
        const int t = idx >> 6, c8 = (idx & 63) * 8, s = t % S;
        const bf16* r0 = CONV + (size_t)t * 1024;
        const bf16x8 cb = *(const bf16x8*)(r0 + c8), p0v = *(const bf16x8*)(r0 + 512 + c8);
        bf16x8 pmv = (bf16x8){0, 0, 0, 0, 0, 0, 0, 0}, ppv = pmv;
        if (s > 0) pmv = *(const bf16x8*)(r0 - 1024 + 512 + c8);
        if (s < S - 1) ppv = *(const bf16x8*)(r0 + 1024 + 512 + c8);
        const float* cw = ((const float*)(const GAS float*)F.in[8]) + l * 3 * CW + c8;
        float o[8];
#pragma unroll
        for (int e = 0; e < 8; ++e) o[e] = bf2f(cb[e]) * (cw[e] * bf2f(pmv[e]) + cw[CW + e] * bf2f(p0v[e]) + cw[2 * CW + e] * bf2f(ppv[e]));
        v4u w; w.x = pk2(o[0], o[1]); w.y = pk2(o[2], o[3]); w.z = pk2(o[4], o[5]); w.w = pk2(o[6], o[7]);
        *(v4u*)(U + (size_t)t * CW + c8) = w;
    }
}

__device__ __forceinline__ float row16_sum(float v) { return row16_sum_dpp(v); }
__device__ __forceinline__ void step_e(Frame& F, int l) {
    fresh_tid(F);
    const bf16* QRAW = WSP(bf16, WS_QRAW); const bf16* SMALL = WSP(bf16, WS_SMALL);
    const f32x2* ROPE = WSP(f32x2, WS_ROPE);
    bf16* Q = WSP(bf16, WS_Q);
    const int gw = F.bid * NWAVES + F.wave, NGW = F.G * NWAVES;
    const int j = F.lane & 15, hh = F.lane >> 4; const bool act = j < 12, isrope = j >= 8 && act;
    const int jc = act ? j : 0;
    const float* gqp = ((const float*)(const GAS float*)F.in[13]) + l * DQK + 8 * jc;
    const f32x4 gq0 = *(const f32x4*)gqp, gq1 = *(const f32x4*)(gqp + 4);
    const float sgn = (j >= 10) ? 1.f : -1.f;
    for (int t = gw; t < T; t += NGW) {
        const int b = t / S, s = t % S;
        const bf16x8 xs = *(const bf16x8*)(SMALL + (size_t)t * 512 + 8 * (F.lane & 31));
        const f32x4* rp = (const f32x4*)(ROPE + (size_t)t * 16 + 8 * (j & 1));
        const f32x4 r0 = rp[0], r1 = rp[1], r2 = rp[2], r3 = rp[3];
        bf16x8 xq[2];
#pragma unroll
        for (int pass = 0; pass < 2; ++pass) xq[pass] = *(const bf16x8*)(QRAW + (size_t)t * 768 + (pass * 4 + hh) * 96 + 8 * jc);
        float sq = 0.f;
#pragma unroll
        for (int e = 0; e < 8; ++e) { const float f = bf2f(xs[e]); sq += f * f; }
        const float rsq = 1.0f / sqrtf(wave_sum(F.lane < 32 ? sq : 0.f, F.lane) * (1.f / 256.f) + EPS);
        float cs[8], sn[8];
        cs[0] = r0.x; sn[0] = r0.y; cs[1] = r0.z; sn[1] = r0.w; cs[2] = r1.x; sn[2] = r1.y; cs[3] = r1.z; sn[3] = r1.w;
        cs[4] = r2.x; sn[4] = r2.y; cs[5] = r2.z; sn[5] = r2.w; cs[6] = r3.x; sn[6] = r3.y; cs[7] = r3.z; sn[7] = r3.w;
#pragma unroll
        for (int pass = 0; pass < 2; ++pass) {
            const int h = pass * 4 + hh;
            const size_t orow = ((size_t)(b * H + h) * S + s);
            const bf16x8 x = xq[pass];
            float v[8]; float ss = 0.f;
#pragma unroll
            for (int e = 0; e < 8; ++e) { v[e] = act ? bf2f(x[e]) * rsq : 0.f; ss += v[e] * v[e]; }
            const float r = 1.0f / sqrtf(row16_sum(ss) * (1.f / 96.f) + EPS);
#pragma unroll
            for (int e = 0; e < 8; ++e) v[e] = v[e] * r * (e < 4 ? gq0[e & 3] : gq1[e & 3]);
#pragma unroll
            for (int e = 0; e < 8; ++e) { const float p = xor_lane<2>(v[e]); if (isrope) v[e] = v[e] * cs[e] + sgn * p * sn[e]; }
            if (act) { v4u w; w.x = pk2(v[0] * QSCALE, v[1] * QSCALE); w.y = pk2(v[2] * QSCALE, v[3] * QSCALE); w.z = pk2(v[4] * QSCALE, v[5] * QSCALE); w.w = pk2(v[6] * QSCALE, v[7] * QSCALE);
                *(v4u*)(Q + orow * 96 + 8 * j) = w; }
        }
    }
}

__device__ __forceinline__ void step_f(Frame& F) {
    fresh_tid(F);
    const bf16* Q = WSP(bf16, WS_Q); const bf16* K = WSP(bf16, WS_K); const bf16* V = WSP(bf16, WS_V); bf16* O = WSP(bf16, WS_O);
    const int gw = F.bid * NWAVES + F.wave, NGW = F.G * NWAVES;
    for (int it = gw; it < NB * H * (S / 64) * 2; it += NGW) {
        const int half = it & 1, it2 = it >> 1;
        const int bh = it2 / (S / 64), qi = (it2 % (S / 64)) * 64 + F.lane;
        bf16x8 q[12]; float o[32];
#pragma unroll
        for (int c = 0; c < 12; ++c) q[c] = *(const bf16x8*)(Q + ((size_t)bh * S + qi) * 96 + c * 8);
#pragma unroll
        for (int d = 0; d < 32; ++d) o[d] = 0.f;
        float m = -1e30f, lsum = 0.f;
        const bf16* kb = K + (size_t)bh * S * 96; const bf16* vb = V + (size_t)bh * S * 64 + half * 32;
#pragma unroll 1
        for (int j = 0; j < S; j += 2) {
            float sc[2];
#pragma unroll
            for (int i = 0; i < 2; ++i) { float a = 0.f;
#pragma unroll
                for (int c = 0; c < 12; ++c) { const bf16x8 kk = *(const bf16x8*)(kb + (size_t)(j + i) * 96 + c * 8);
#pragma unroll
                    for (int e = 0; e < 8; ++e) a += bf2f(q[c][e]) * bf2f(kk[e]); }
                sc[i] = a; asm volatile("" ::: "memory"); }
            const float mn = fmaxf(m, fmaxf(sc[0], sc[1]));
            const float alpha = exp2f(m - mn), p0 = exp2f(sc[0] - mn), p1 = exp2f(sc[1] - mn);
            lsum = lsum * alpha + (p0 + p1); m = mn;
#pragma unroll
            for (int c = 0; c < 4; ++c) {
                const bf16x8 v0 = *(const bf16x8*)(vb + (size_t)(j + 0) * 64 + c * 8), v1 = *(const bf16x8*)(vb + (size_t)(j + 1) * 64 + c * 8);
#pragma unroll
                for (int e = 0; e < 8; ++e) o[c * 8 + e] = o[c * 8 + e] * alpha + (p0 * bf2f(v0[e]) + p1 * bf2f(v1[e]));
                asm volatile("" ::: "memory");
            }
        }
        const float inv = 1.f / lsum; const int b = bh / H, h = bh % H;
        bf16* op = O + ((size_t)(b * S + qi)) * 512 + h * 64 + half * 32;
#pragma unroll
        for (int c = 0; c < 4; ++c) { v4u w; w.x = pk2(o[c * 8] * inv, o[c * 8 + 1] * inv); w.y = pk2(o[c * 8 + 2] * inv, o[c * 8 + 3] * inv); w.z = pk2(o[c * 8 + 4] * inv, o[c * 8 + 5] * inv);
            w.w = pk2(o[c * 8 + 6] * inv, o[c * 8 + 7] * inv); *(v4u*)(op + c * 8) = w; }
    }
}

__device__ __forceinline__ void route16(float myscore, float mybiased, int& e1, int& e2, float& w1, float& w2) {
    float scv[16], bi[16];
#pragma unroll
    for (int e = 0; e < 16; ++e) { scv[e] = __builtin_bit_cast(float, __builtin_amdgcn_readlane(__builtin_bit_cast(int, myscore), e)); bi[e] = __builtin_bit_cast(float, __builtin_amdgcn_readlane(__builtin_bit_cast(int, mybiased), e)); }
    float gs[4];
#pragma unroll
    for (int g = 0; g < 4; ++g) { const float a0 = bi[4 * g], a1 = bi[4 * g + 1], a2 = bi[4 * g + 2], a3 = bi[4 * g + 3];
        const float h1 = fmaxf(a0, a1), l1 = fminf(a0, a1), h2 = fmaxf(a2, a3), l2 = fminf(a2, a3);
        gs[g] = fmaxf(h1, h2) + fmaxf(fminf(h1, h2), fmaxf(l1, l2)); }
    int sg = 0; float bg = gs[0];
#pragma unroll
    for (int g = 1; g < 4; ++g) if (gs[g] > bg) { bg = gs[g]; sg = g; }
    float b0 = bi[0], b1 = bi[1], b2 = bi[2], b3 = bi[3], s0 = scv[0], s1 = scv[1], s2 = scv[2], s3 = scv[3];
#pragma unroll
    for (int g = 1; g < 4; ++g) if (sg == g) { b0 = bi[4 * g]; b1 = bi[4 * g + 1]; b2 = bi[4 * g + 2]; b3 = bi[4 * g + 3]; s0 = scv[4 * g]; s1 = scv[4 * g + 1]; s2 = scv[4 * g + 2]; s3 = scv[4 * g + 3]; }
    int i1 = 0; float m1 = b0, q1 = s0;
    if (b1 > m1) { m1 = b1; i1 = 1; q1 = s1; } if (b2 > m1) { m1 = b2; i1 = 2; q1 = s2; } if (b3 > m1) { m1 = b3; i1 = 3; q1 = s3; }
    int i2 = -1; float m2 = -1e30f, q2 = 0.f;
    if (i1 != 0 && (i2 < 0 || b0 > m2)) { m2 = b0; i2 = 0; q2 = s0; }
    if (i1 != 1 && (i2 < 0 || b1 > m2)) { m2 = b1; i2 = 1; q2 = s1; }
    if (i1 != 2 && (i2 < 0 || b2 > m2)) { m2 = b2; i2 = 2; q2 = s2; }
    if (i1 != 3 && (i2 < 0 || b3 > m2)) { m2 = b3; i2 = 3; q2 = s3; }
    const float inv = 1.f / (q1 + q2);
    e1 = 4 * sg + i1; e2 = 4 * sg + i2; w1 = q1 * inv; w2 = q2 * inv;
}
__device__ __forceinline__ void step_j(Frame& F, int l, bool dry = false) {
    fresh_tid(F);
    const bf16* X16 = WSP(bf16, WS_X16);
    const int gw = F.bid * NWAVES + F.wave, NGW = F.G * NWAVES;
    const float* MOD = WSP(float, WS_MOD); bf16* XN = WSP(bf16, WS_XN);
    int* TOKS = WSP(int, WS_TOKS); float* TOKW = WSP(float, WS_TOKW); int* LIST = WSP(int, WS_LIST);
    unsigned* cnt = F.ctl + CW_CNT + CNT_LS * l;
    LAS unsigned* lcnt = (LAS unsigned*)(F.lds + 65536); LAS unsigned* gbase = lcnt + 16; LAS unsigned* rinfo = (LAS unsigned*)(F.lds + 65536 + 256) + F.wave * 512;
    if (F.tid < 16) lcnt[F.tid] = 0u;
    __syncthreads();
    int ri = 0;
    LAS float* hrow = (LAS float*)(F.lds + F.wave * 8192);
    const int re = F.lane & 15, rq = F.lane >> 4;
    const float* wr = ((const float*)(const GAS float*)F.in[18]) + (size_t)(rq * 256) * NE + re;
    const float brt = ((const float*)(const GAS float*)F.in[19])[re];
    for (int row0 = gw; row0 < T; row0 += 2 * NGW) {
        const bool has1 = row0 + NGW < T;
        int rr[2]; rr[0] = row0; rr[1] = has1 ? row0 + NGW : row0;
        f32x4 v[2][4], g[4], sc[2][4], sh[2][4];
#pragma unroll
        for (int k = 0; k < 2; ++k)
#pragma unroll
            for (int j = 0; j < 4; ++j) { const bf16x4 t = *(const bf16x4*)(X16 + (size_t)rr[k] * D + 4 * F.lane + 256 * j); v[k][j] = (f32x4){bf2f(t[0]), bf2f(t[1]), bf2f(t[2]), bf2f(t[3])}; }
#pragma unroll
        for (int j = 0; j < 4; ++j) g[j] = *(const f32x4*)(((const float*)(const GAS float*)F.in[6]) + l * D + 4 * F.lane + 256 * j);
#pragma unroll
        for (int k = 0; k < 2; ++k) { const float* m = MOD + (l * 2 + rr[k] / S) * 6 * D;
#pragma unroll
            for (int j = 0; j < 4; ++j) { sc[k][j] = *(const f32x4*)(m + 4 * D + 4 * F.lane + 256 * j); sh[k][j] = *(const f32x4*)(m + 3 * D + 4 * F.lane + 256 * j); } }
        float ss[2];
#pragma unroll
        for (int k = 0; k < 2; ++k) { float a = 0.f;
#pragma unroll
            for (int j = 0; j < 4; ++j) a += (v[k][j].x * v[k][j].x + v[k][j].y * v[k][j].y) + (v[k][j].z * v[k][j].z + v[k][j].w * v[k][j].w);
            ss[k] = a; }
        const float rs0 = 1.0f / sqrtf(wave_sum(ss[0], F.lane) * (1.f / D) + EPS), rs1 = 1.0f / sqrtf(wave_sum(ss[1], F.lane) * (1.f / D) + EPS);
#pragma unroll
        for (int k = 0; k < 2; ++k) { const float rs = k ? rs1 : rs0;
#pragma unroll
            for (int j = 0; j < 4; ++j) { const int col = 4 * F.lane + 256 * j; f32x4 hh;
#pragma unroll
                for (int e = 0; e < 4; ++e) hh[e] = v[k][j][e] * rs * g[j][e] * (1.f + sc[k][j][e]) + sh[k][j][e];
                v2u o; o.x = pk2(hh[0], hh[1]); o.y = pk2(hh[2], hh[3]);
                if (k == 0 || has1) *(v2u*)(XN + (size_t)rr[k] * D + col) = o;
                *(LAS f32x4*)(hrow + k * 1024 + col) = hh; } }
        asm volatile("s_waitcnt lgkmcnt(0)" ::: "memory");
        float a0 = 0.f, a1 = 0.f, a2 = 0.f, a3 = 0.f, c0 = 0.f, c1 = 0.f, c2 = 0.f, c3 = 0.f;
#pragma unroll 4
        for (int c = 0; c < 256; c += 4) {
            const f32x4 h0 = *(const LAS f32x4*)(hrow + rq * 256 + c), h1 = *(const LAS f32x4*)(hrow + 1024 + rq * 256 + c);
            const float w0 = wr[(size_t)(c + 0) * NE], w1 = wr[(size_t)(c + 1) * NE], w2 = wr[(size_t)(c + 2) * NE], w3 = wr[(size_t)(c + 3) * NE];
            a0 += h0.x * w0; a1 += h0.y * w1; a2 += h0.z * w2; a3 += h0.w * w3;
            c0 += h1.x * w0; c1 += h1.y * w1; c2 += h1.z * w2; c3 += h1.w * w3;
        }
        float z0 = (a0 + a1) + (a2 + a3), z1 = (c0 + c1) + (c2 + c3);
        z0 += bperm_xor(z0, F.lane, 16); z0 += bperm_xor(z0, F.lane, 32);
        z1 += bperm_xor(z1, F.lane, 16); z1 += bperm_xor(z1, F.lane, 32);
        asm volatile("s_waitcnt lgkmcnt(0)" ::: "memory");
#pragma unroll
        for (int k = 0; k < 2; ++k) {
            const float z = k ? z1 : z0;
            const float myscore = 1.f / (1.f + expf(-z)), mybiased = myscore + brt;
            int e1, e2; float w1, w2;
            route16(myscore, mybiased, e1, e2, w1, w2);
            if (F.lane == 0 && !dry && (k == 0 || has1)) {
                const unsigned p1 = __hip_atomic_fetch_add(lcnt + e1, 1u, __ATOMIC_RELAXED, __HIP_MEMORY_SCOPE_WORKGROUP), p2 = __hip_atomic_fetch_add(lcnt + e2, 1u, __ATOMIC_RELAXED, __HIP_MEMORY_SCOPE_WORKGROUP);
                LAS unsigned* r = rinfo + ri * 8;
                r[0] = (unsigned)rr[k]; r[1] = (unsigned)e1; r[2] = p1; r[3] = (unsigned)e2; r[4] = p2; r[5] = __builtin_bit_cast(unsigned, w1); r[6] = __builtin_bit_cast(unsigned, w2);
            }
            if (k == 0 || has1) ++ri;
        }
    }
    if (dry) return;
    __syncthreads();
    if (F.tid < 16) { const unsigned c = lcnt[F.tid]; gbase[F.tid] = c ? __hip_atomic_fetch_add(cnt + CNT_ES * F.tid, c, RLX_AGENT) : 0u; }
    __syncthreads();
    if (F.lane < ri) {
        const LAS unsigned* r = rinfo + F.lane * 8;
        const int row = (int)r[0], e1 = (int)r[1], e2 = (int)r[3]; const unsigned p1 = gbase[e1] + r[2], p2 = gbase[e2] + r[4];
        LIST[(size_t)e1 * T + p1] = 2 * row; LIST[(size_t)e2 * T + p2] = 2 * row + 1;
        TOKS[2 * row] = (e1 << 16) | (int)p1; TOKS[2 * row + 1] = (e2 << 16) | (int)p2;
        TOKW[2 * row] = __builtin_bit_cast(float, r[5]); TOKW[2 * row + 1] = __builtin_bit_cast(float, r[6]);
    }
}

__device__ __forceinline__ void step_j_old(Frame& F, int l, bool dry = false) {
    fresh_tid(F);
    const int gw = F.bid * NWAVES + F.wave, NGW = F.G * NWAVES;
    const float* MOD = WSP(float, WS_MOD); bf16* XN = WSP(bf16, WS_XN);
    int* TOKS = WSP(int, WS_TOKS); float* TOKW = WSP(float, WS_TOKW); int* LIST = WSP(int, WS_LIST);
    unsigned* cnt = F.ctl + CW_CNT + CNT_LS * l;
    for (int row = gw; row < T; row += NGW) {
        const int b = row / S;
        float ss = 0.f;
#pragma unroll
        for (int j = 0; j < 4; ++j) { const f32x4 vv = *(const f32x4*)(F.out + (size_t)row * D + 4 * F.lane + 256 * j); ss += (vv.x * vv.x + vv.y * vv.y) + (vv.z * vv.z + vv.w * vv.w); }
        const float rs = 1.0f / sqrtf(wave_sum(ss, F.lane) * (1.f / D) + EPS);
        const float* m = MOD + (l * 2 + b) * 6 * D;
        float lg[16];
#pragma unroll
        for (int e = 0; e < 16; ++e) lg[e] = 0.f;
#pragma unroll 1
        for (int j = 0; j < 4; ++j) {
            const int col = 4 * F.lane + 256 * j;
            const f32x4 vj = *(const f32x4*)(F.out + (size_t)row * D + col);
            const f32x4 g = *(const f32x4*)(((const float*)(const GAS float*)F.in[6]) + l * D + col), sc = *(const f32x4*)(m + 4 * D + col), sh = *(const f32x4*)(m + 3 * D + col);
            f32x4 hh;
#pragma unroll
            for (int e = 0; e < 4; ++e) hh[e] = vj[e] * rs * g[e] * (1.f + sc[e]) + sh[e];
            v2u o; o.x = pk2(hh[0], hh[1]); o.y = pk2(hh[2], hh[3]);
            *(v2u*)(XN + (size_t)row * D + col) = o;
#pragma unroll
            for (int i = 0; i < 4; ++i) {
                const float* wr = ((const float*)(const GAS float*)F.in[18]) + (size_t)(col + i) * NE;
                const f32x4 w0 = *(const f32x4*)(wr), w1 = *(const f32x4*)(wr + 4), w2 = *(const f32x4*)(wr + 8), w3 = *(const f32x4*)(wr + 12);
#pragma unroll
                for (int e = 0; e < 4; ++e) { lg[e] += hh[i] * w0[e]; lg[4 + e] += hh[i] * w1[e]; lg[8 + e] += hh[i] * w2[e]; lg[12 + e] += hh[i] * w3[e]; }
            }
        }
        float scv[16], bi[16];
#pragma unroll
        for (int e = 0; e < 16; ++e) { const float z = wave_sum(lg[e], F.lane); scv[e] = 1.f / (1.f + expf(-z)); bi[e] = scv[e] + ((const float*)(const GAS float*)F.in[19])[e]; }
        float gs[4];
#pragma unroll
        for (int g = 0; g < 4; ++g) { const float a0 = bi[4 * g], a1 = bi[4 * g + 1], a2 = bi[4 * g + 2], a3 = bi[4 * g + 3];
            const float h1 = fmaxf(a0, a1), l1 = fminf(a0, a1), h2 = fmaxf(a2, a3), l2 = fminf(a2, a3);
            gs[g] = fmaxf(h1, h2) + fmaxf(fminf(h1, h2), fmaxf(l1, l2)); }
        int sg = 0; float bg = gs[0];
#pragma unroll
        for (int g = 1; g < 4; ++g) if (gs[g] > bg) { bg = gs[g]; sg = g; }
        float b0 = bi[0], b1 = bi[1], b2 = bi[2], b3 = bi[3], s0 = scv[0], s1 = scv[1], s2 = scv[2], s3 = scv[3];
#pragma unroll
        for (int g = 1; g < 4; ++g) if (sg == g) { b0 = bi[4 * g]; b1 = bi[4 * g + 1]; b2 = bi[4 * g + 2]; b3 = bi[4 * g + 3]; s0 = scv[4 * g]; s1 = scv[4 * g + 1]; s2 = scv[4 * g + 2]; s3 = scv[4 * g + 3]; }
        int i1 = 0; float m1 = b0, q1 = s0;
        if (b1 > m1) { m1 = b1; i1 = 1; q1 = s1; } if (b2 > m1) { m1 = b2; i1 = 2; q1 = s2; } if (b3 > m1) { m1 = b3; i1 = 3; q1 = s3; }
        int i2 = -1; float m2 = -1e30f, q2 = 0.f;
        if (i1 != 0 && (i2 < 0 || b0 > m2)) { m2 = b0; i2 = 0; q2 = s0; }
        if (i1 != 1 && (i2 < 0 || b1 > m2)) { m2 = b1; i2 = 1; q2 = s1; }
        if (i1 != 2 && (i2 < 0 || b2 > m2)) { m2 = b2; i2 = 2; q2 = s2; }
        if (i1 != 3 && (i2 < 0 || b3 > m2)) { m2 = b3; i2 = 3; q2 = s3; }
        if (F.lane == 0 && !dry) {
            const int e1 = 4 * sg + i1, e2 = 4 * sg + i2; const float inv = 1.f / (q1 + q2);
            const unsigned p1 = __hip_atomic_fetch_add(cnt + CNT_ES * e1, 1u, RLX_AGENT), p2 = __hip_atomic_fetch_add(cnt + CNT_ES * e2, 1u, RLX_AGENT);
            LIST[(size_t)e1 * T + p1] = 2 * row; LIST[(size_t)e2 * T + p2] = 2 * row + 1;
            TOKS[2 * row] = (e1 << 16) | (int)p1; TOKS[2 * row + 1] = (e2 << 16) | (int)p2;
            TOKW[2 * row] = q1 * inv; TOKW[2 * row + 1] = q2 * inv;
        }
    }
}


namespace att {
typedef short sbf16x8 __attribute__((ext_vector_type(8)));
typedef short s16x4 __attribute__((ext_vector_type(4)));
typedef float f32x16 __attribute__((ext_vector_type(16)));
constexpr int NW = 8, QBLK = 32, KVBLK = 64;
constexpr int SHM_K = KVBLK * 256, SHM_V = KVBLK * 256;
constexpr int OFF_V = 0, OFF_K = 2 * SHM_V, OFF_WS = 2 * SHM_V + 2 * SHM_K, OFF_OST = OFF_WS + NW * 64 * 4, LDS_NEED = OFF_OST + NW * 4096;
static_assert(LDS_NEED <= 131072, "attention LDS");
constexpr float THR2 = 11.f;
#define ATT_KSWZ(row, colB) ((row) * 256 + ((colB) ^ (((row) & 15) << 4)))
#define ATT_SBAR() __builtin_amdgcn_sched_barrier(0)
__device__ __forceinline__ int crow(int r, int hi) { return (r & 3) + 8 * (r >> 2) + 4 * hi; }
__device__ __forceinline__ void partialSM(f32x16& p0, f32x16& p1) {
#pragma unroll
    for (int r = 0; r < 16; ++r) p0[r] = __builtin_amdgcn_exp2f(p0[r]);
}
__device__ __forceinline__ void finishSM(f32x16& p0, f32x16& p1, float& l_reg, sbf16x8& pa0, sbf16x8& pa1, sbf16x8& pa2, sbf16x8& pa3) {
#pragma unroll
    for (int r = 0; r < 16; ++r) p1[r] = __builtin_amdgcn_exp2f(p1[r]);
    float ps0 = 0.f, ps1 = 0.f;
#pragma unroll
    for (int r = 0; r < 16; ++r) { ps0 += p0[r]; ps1 += p1[r]; }
    l_reg += ps0 + ps1;
#define ATT_PK4(P, BASE, OUT) do { unsigned a0 = pk2(P[BASE + 0], P[BASE + 1]), a1 = pk2(P[BASE + 2], P[BASE + 3]);   \
    unsigned b0 = pk2(P[BASE + 4], P[BASE + 5]), b1 = pk2(P[BASE + 6], P[BASE + 7]);                              \
    auto r0 = __builtin_amdgcn_permlane32_swap(a0, b0, false, false); auto r1 = __builtin_amdgcn_permlane32_swap(a1, b1, false, false); \
    v4u w = {r0[0], r1[0], r0[1], r1[1]}; OUT = __builtin_bit_cast(sbf16x8, w); } while (0)
    ATT_PK4(p0, 0, pa0); ATT_PK4(p0, 8, pa1); ATT_PK4(p1, 0, pa2); ATT_PK4(p1, 8, pa3);
#undef ATT_PK4
}
__device__ __forceinline__ void qkt(f32x16& p0, f32x16& p1, const LAS char* Ks, const sbf16x8* qr, int r32, int hi) {
    asm volatile("" : "+v"(r32));
    p0 = f32x16{}; p1 = f32x16{};
    sbf16x8 c0 = *(const LAS sbf16x8*)(Ks + ATT_KSWZ(r32, (hi * 8) * 2)), c1 = *(const LAS sbf16x8*)(Ks + ATT_KSWZ(32 + r32, (hi * 8) * 2));
#pragma unroll
    for (int d0 = 0; d0 < 6; ++d0) {
        sbf16x8 n0 = c0, n1 = c1;
        if (d0 < 5) { const int cb = ((d0 + 1) * 16 + hi * 8) * 2; n0 = *(const LAS sbf16x8*)(Ks + ATT_KSWZ(r32, cb)); n1 = *(const LAS sbf16x8*)(Ks + ATT_KSWZ(32 + r32, cb)); }
        p0 = __builtin_amdgcn_mfma_f32_32x32x16_bf16(c0, qr[d0], p0, 0, 0, 0);
        p1 = __builtin_amdgcn_mfma_f32_32x32x16_bf16(c1, qr[d0], p1, 0, 0, 0);
        c0 = n0; c1 = n1;
    }
}
__device__ __forceinline__ int v_st(int k, int c) { const int kk = (k & ~0xC) | ((k & 4) << 1) | ((k & 8) >> 1); return ((kk >> 3) * 4 + (c >> 5)) * 512 + ((kk & 7) * 32 + (c & 31)) * 2; }
__device__ __forceinline__ int v_rd_base(int lane) { return ((lane & 3) << 3) | (((lane >> 2) & 3) << 6) | (((lane >> 4) & 1) << 5) | (((lane >> 5) & 1) << 8); }
constexpr int v_rd_off(int d0, int ks, int half) { return d0 * 512 + ks * 4096 + half * 2048; }
template <int OFF> __device__ __forceinline__ s16x4 tr_read(int vb) { s16x4 r; asm volatile("ds_read_b64_tr_b16 %0, %1 offset:%2" : "=&v"(r) : "v"(vb), "i"(OFF) : "memory"); return r; }
template <int D0> __device__ __forceinline__ void pv_one(f32x16& od, int vb, sbf16x8 pa0, sbf16x8 pa1, sbf16x8 pa2, sbf16x8 pa3) {
    const s16x4 l0 = tr_read<v_rd_off(D0, 0, 0)>(vb), h0 = tr_read<v_rd_off(D0, 0, 1)>(vb), l1 = tr_read<v_rd_off(D0, 1, 0)>(vb), h1 = tr_read<v_rd_off(D0, 1, 1)>(vb);
    const s16x4 l2 = tr_read<v_rd_off(D0, 2, 0)>(vb), h2 = tr_read<v_rd_off(D0, 2, 1)>(vb), l3 = tr_read<v_rd_off(D0, 3, 0)>(vb), h3 = tr_read<v_rd_off(D0, 3, 1)>(vb);
    asm volatile("s_waitcnt lgkmcnt(0)" ::: "memory"); ATT_SBAR();
#define ATT_PK(L, H) (sbf16x8){L[0], L[1], L[2], L[3], H[0], H[1], H[2], H[3]}
    od = __builtin_amdgcn_mfma_f32_32x32x16_bf16(pa0, ATT_PK(l0, h0), od, 0, 0, 0);
    od = __builtin_amdgcn_mfma_f32_32x32x16_bf16(pa1, ATT_PK(l1, h1), od, 0, 0, 0);
    od = __builtin_amdgcn_mfma_f32_32x32x16_bf16(pa2, ATT_PK(l2, h2), od, 0, 0, 0);
    od = __builtin_amdgcn_mfma_f32_32x32x16_bf16(pa3, ATT_PK(l3, h3), od, 0, 0, 0);
#undef ATT_PK
}
__device__ __forceinline__ void pv2(f32x16* o, int vb, sbf16x8 pa0, sbf16x8 pa1, sbf16x8 pa2, sbf16x8 pa3) { pv_one<0>(o[0], vb, pa0, pa1, pa2, pa3); pv_one<1>(o[1], vb, pa0, pa1, pa2, pa3); }

__device__ __forceinline__ void attn_unit(const bf16* Qb, const bf16* Kh, const bf16* Vh, bf16* Ob, int seq, LAS char* lds, int tid) {
    const int wid = __builtin_amdgcn_readfirstlane(tid >> 6), lane = tid & 63, r32 = lane & 31, hi = lane >> 5; int lane2;
    LAS char* V_lds = lds + OFF_V; LAS char* K_lds = lds + OFF_K;
    LAS float* ws = (LAS float*)(lds + OFF_WS) + wid * 64; LAS float* li_l = ws;
    float l_reg = 0.f; f32x16 o[2]; o[0] = f32x16{}; o[1] = f32x16{}; sbf16x8 qr[6];
    const bf16* Qw = Qb + (size_t)(wid * QBLK + r32) * 96 + hi * 8;
#pragma unroll
    for (int d0 = 0; d0 < 6; ++d0) qr[d0] = *(const GAS sbf16x8*)((const GAS bf16*)Qw + d0 * 16);
    const int kc1 = 512 + (tid & 255), kr0 = tid / 12, kq0 = (tid % 12) * 8, kr1 = kc1 / 12, kq1 = (kc1 % 12) * 8;
    const int ksto0 = ATT_KSWZ(kr0, kq0 * 2), ksto1 = ATT_KSWZ(kr1, kq1 * 2);
    const int vr = tid >> 3, vq = (tid & 7) * 8, vsto = v_st(vr, vq);
    const int vb0 = (int)(unsigned)(size_t)V_lds + v_rd_base(lane);
    const unsigned ko0 = (unsigned)(kr0 * 96 + kq0) * 2u, ko1 = (unsigned)(kr1 * 96 + kq1) * 2u, vo = (unsigned)(vr * 64 + vq) * 2u;
    sbf16x8 sk0[2], sk1[2], sv[2];
    const GAS char* Kg = (const GAS char*)Kh; const GAS char* Vg = (const GAS char*)Vh;
#define ATT_SLOAD(i, k0) do { sk0[i] = *(const GAS sbf16x8*)(Kg + (ko0 + (unsigned)(k0) * 192u)); sk1[i] = *(const GAS sbf16x8*)(Kg + (ko1 + (unsigned)(k0) * 192u)); sv[i] = *(const GAS sbf16x8*)(Vg + (vo + (unsigned)(k0) * 128u)); } while (0)
#define ATT_SWRITE(b, i) do { *(LAS sbf16x8*)(K_lds + (b) * SHM_K + ksto0) = sk0[i]; *(LAS sbf16x8*)(K_lds + (b) * SHM_K + ksto1) = sk1[i]; *(LAS sbf16x8*)(V_lds + (b) * SHM_V + vsto) = sv[i]; } while (0)
#define ATT_SWAIT() asm volatile("s_waitcnt vmcnt(3)" ::: "memory")
    f32x16 pA0, pA1, pB0, pB1; sbf16x8 pa0, pa1, pa2, pa3; const int NT = seq / KVBLK;
    ATT_SLOAD(0, 0); asm volatile("s_waitcnt vmcnt(0)" ::: "memory"); ATT_SWRITE(0, 0); __syncthreads();
    qkt(pA0, pA1, K_lds, qr, r32, hi); partialSM(pA0, pA1);
    ATT_SLOAD(1, KVBLK); if (2 < NT) ATT_SLOAD(0, 2 * KVBLK);
    ATT_SWAIT(); ATT_SWRITE(1, 1); __syncthreads();
#pragma unroll 1
    for (int j = 1; j + 1 < NT; j += 2) {
        ATT_SBAR(); qkt(pB0, pB1, K_lds + SHM_K, qr, r32, hi);
        finishSM(pA0, pA1, l_reg, pa0, pa1, pa2, pa3); ATT_SBAR();
        ATT_SLOAD(1, (j + 2) * KVBLK); ATT_SBAR();
        pv2(o, vb0, pa0, pa1, pa2, pa3); partialSM(pB0, pB1);
        __syncthreads(); ATT_SWAIT(); ATT_SWRITE(0, 0);
        __syncthreads();
        ATT_SBAR(); qkt(pA0, pA1, K_lds, qr, r32, hi);
        finishSM(pB0, pB1, l_reg, pa0, pa1, pa2, pa3); ATT_SBAR();
        if (j + 3 < NT) ATT_SLOAD(0, (j + 3) * KVBLK); ATT_SBAR();
        pv2(o, vb0 + SHM_V, pa0, pa1, pa2, pa3); partialSM(pA0, pA1);
        __syncthreads(); ATT_SWAIT(); ATT_SWRITE(1, 1);
        __syncthreads();
    }
    ATT_SBAR(); qkt(pB0, pB1, K_lds + SHM_K, qr, r32, hi);
    finishSM(pA0, pA1, l_reg, pa0, pa1, pa2, pa3); ATT_SBAR();
    pv2(o, vb0, pa0, pa1, pa2, pa3); partialSM(pB0, pB1);
    __syncthreads();
    finishSM(pB0, pB1, l_reg, pa0, pa1, pa2, pa3); ATT_SBAR();
    pv2(o, vb0 + SHM_V, pa0, pa1, pa2, pa3);
    { auto rr = __builtin_amdgcn_permlane32_swap(__float_as_uint(l_reg), __float_as_uint(l_reg), false, false); l_reg = __uint_as_float(rr[0]) + __uint_as_float(rr[1]); }
    { unsigned z_ = 0u; asm volatile("" : "+v"(z_)); lane2 = (int)__builtin_amdgcn_mbcnt_hi(~0u, __builtin_amdgcn_mbcnt_lo(~0u, z_)); }
    const int r32e = lane2 & 31, hie = lane2 >> 5;
    if (hie == 0) li_l[r32e] = l_reg; asm volatile("s_waitcnt lgkmcnt(0)" ::: "memory");
    float rli[16];
#pragma unroll
    for (int r = 0; r < 16; ++r) rli[r] = __builtin_amdgcn_rcpf(li_l[crow(r, hie)]);
    LAS bf16* stg = (LAS bf16*)(lds + OFF_OST) + wid * 2048;
#pragma unroll
    for (int r = 0; r < 16; ++r) { const int orow = crow(r, hie);
#pragma unroll
        for (int d0 = 0; d0 < 2; ++d0) stg[orow * 64 + d0 * 32 + r32e] = (bf16)(pk2(o[d0][r] * rli[r], 0.f) & 0xffffu); }
    asm volatile("s_waitcnt lgkmcnt(0)" ::: "memory");
    bf16* Ow = Ob + (size_t)(wid * QBLK) * 512;
#pragma unroll
    for (int i = 0; i < 4; ++i) { const int row = i * 8 + (lane2 >> 3), ch = lane2 & 7; const v4u v = *(const LAS v4u*)(stg + row * 64 + ch * 8); *(GAS v4u*)((GAS bf16*)Ow + (size_t)row * 512 + ch * 8) = v; }
    asm volatile("s_waitcnt lgkmcnt(0)" ::: "memory");
#undef ATT_SLOAD
#undef ATT_SWRITE
#undef ATT_SWAIT
}
__device__ __forceinline__ void softmax_pack(f32x16& p0, f32x16& p1, float& l_reg, sbf16x8& pa0, sbf16x8& pa1, sbf16x8& pa2, sbf16x8& pa3) {
#pragma unroll
    for (int r = 0; r < 16; ++r) p0[r] = __builtin_amdgcn_exp2f(p0[r]);
#pragma unroll
    for (int r = 0; r < 16; ++r) p1[r] = __builtin_amdgcn_exp2f(p1[r]);
    float ps0 = 0.f, ps1 = 0.f;
#pragma unroll
    for (int r = 0; r < 16; ++r) { ps0 += p0[r]; ps1 += p1[r]; }
    l_reg += ps0 + ps1;
#define ATT_PK4(P, BASE, OUT) do { unsigned a0 = pk2(P[BASE + 0], P[BASE + 1]), a1 = pk2(P[BASE + 2], P[BASE + 3]);   \
    unsigned b0 = pk2(P[BASE + 4], P[BASE + 5]), b1 = pk2(P[BASE + 6], P[BASE + 7]);                              \
    auto r0 = __builtin_amdgcn_permlane32_swap(a0, b0, false, false); auto r1 = __builtin_amdgcn_permlane32_swap(a1, b1, false, false); \
    v4u w = {r0[0], r1[0], r0[1], r1[1]}; OUT = __builtin_bit_cast(sbf16x8, w); } while (0)
    ATT_PK4(p0, 0, pa0); ATT_PK4(p0, 8, pa1); ATT_PK4(p1, 0, pa2); ATT_PK4(p1, 8, pa3);
#undef ATT_PK4
}
__device__ __forceinline__ void qkt2(f32x16& x0, f32x16& x1, f32x16& y0, f32x16& y1, const LAS char* Ks, const sbf16x8* qx, const sbf16x8* qy, int r32, int hi) {
    asm volatile("" : "+v"(r32));
    x0 = f32x16{}; x1 = f32x16{}; y0 = f32x16{}; y1 = f32x16{};
    sbf16x8 c0 = *(const LAS sbf16x8*)(Ks + ATT_KSWZ(r32, (hi * 8) * 2)), c1 = *(const LAS sbf16x8*)(Ks + ATT_KSWZ(32 + r32, (hi * 8) * 2));
#pragma unroll
    for (int d0 = 0; d0 < 6; ++d0) {
        sbf16x8 n0 = c0, n1 = c1;
        if (d0 < 5) { const int cb = ((d0 + 1) * 16 + hi * 8) * 2; n0 = *(const LAS sbf16x8*)(Ks + ATT_KSWZ(r32, cb)); n1 = *(const LAS sbf16x8*)(Ks + ATT_KSWZ(32 + r32, cb)); }
        x0 = __builtin_amdgcn_mfma_f32_32x32x16_bf16(c0, qx[d0], x0, 0, 0, 0);
        x1 = __builtin_amdgcn_mfma_f32_32x32x16_bf16(c1, qx[d0], x1, 0, 0, 0);
        y0 = __builtin_amdgcn_mfma_f32_32x32x16_bf16(c0, qy[d0], y0, 0, 0, 0);
        y1 = __builtin_amdgcn_mfma_f32_32x32x16_bf16(c1, qy[d0], y1, 0, 0, 0);
        c0 = n0; c1 = n1;
    }
}
template <int D0> __device__ __forceinline__ void pv_one2(f32x16& ox, f32x16& oy, int vb, const sbf16x8 (&px)[4], const sbf16x8 (&py)[4]) {
    const s16x4 l0 = tr_read<v_rd_off(D0, 0, 0)>(vb), h0 = tr_read<v_rd_off(D0, 0, 1)>(vb), l1 = tr_read<v_rd_off(D0, 1, 0)>(vb), h1 = tr_read<v_rd_off(D0, 1, 1)>(vb);
    const s16x4 l2 = tr_read<v_rd_off(D0, 2, 0)>(vb), h2 = tr_read<v_rd_off(D0, 2, 1)>(vb), l3 = tr_read<v_rd_off(D0, 3, 0)>(vb), h3 = tr_read<v_rd_off(D0, 3, 1)>(vb);
    asm volatile("s_waitcnt lgkmcnt(0)" ::: "memory"); ATT_SBAR();
#define ATT_PK(L, H) (sbf16x8){L[0], L[1], L[2], L[3], H[0], H[1], H[2], H[3]}
    ox = __builtin_amdgcn_mfma_f32_32x32x16_bf16(px[0], ATT_PK(l0, h0), ox, 0, 0, 0);
    oy = __builtin_amdgcn_mfma_f32_32x32x16_bf16(py[0], ATT_PK(l0, h0), oy, 0, 0, 0);
    ox = __builtin_amdgcn_mfma_f32_32x32x16_bf16(px[1], ATT_PK(l1, h1), ox, 0, 0, 0);
    oy = __builtin_amdgcn_mfma_f32_32x32x16_bf16(py[1], ATT_PK(l1, h1), oy, 0, 0, 0);
    ox = __builtin_amdgcn_mfma_f32_32x32x16_bf16(px[2], ATT_PK(l2, h2), ox, 0, 0, 0);
    oy = __builtin_amdgcn_mfma_f32_32x32x16_bf16(py[2], ATT_PK(l2, h2), oy, 0, 0, 0);
    ox = __builtin_amdgcn_mfma_f32_32x32x16_bf16(px[3], ATT_PK(l3, h3), ox, 0, 0, 0);
    oy = __builtin_amdgcn_mfma_f32_32x32x16_bf16(py[3], ATT_PK(l3, h3), oy, 0, 0, 0);
#undef ATT_PK
}
__device__ __forceinline__ void softmax_half(f32x16& p, float& l_reg, sbf16x8& pa, sbf16x8& pb) {
#pragma unroll
    for (int r = 0; r < 16; ++r) p[r] = __builtin_amdgcn_exp2f(p[r]);
    float ps0 = 0.f, ps1 = 0.f;
#pragma unroll
    for (int r = 0; r < 8; ++r) { ps0 += p[r]; ps1 += p[8 + r]; }
    l_reg += ps0 + ps1;
    { v4u w; w.x = pk2(p[0], p[1]); w.y = pk2(p[2], p[3]); w.z = pk2(p[4], p[5]); w.w = pk2(p[6], p[7]); pa = __builtin_bit_cast(sbf16x8, w); }
    { v4u w; w.x = pk2(p[8], p[9]); w.y = pk2(p[10], p[11]); w.z = pk2(p[12], p[13]); w.w = pk2(p[14], p[15]); pb = __builtin_bit_cast(sbf16x8, w); }
}
template <int ROW0> __device__ __forceinline__ void qk_half(f32x16& x, f32x16& y, const LAS char* Ks, const sbf16x8* qx, const sbf16x8* qy, int r32, int hi) {
    asm volatile("" : "+v"(r32));
    x = f32x16{}; y = f32x16{};
    sbf16x8 c = *(const LAS sbf16x8*)(Ks + ATT_KSWZ(ROW0 + r32, (hi * 8) * 2));
#pragma unroll
    for (int d0 = 0; d0 < 6; ++d0) {
        sbf16x8 n = c;
        if (d0 < 5) n = *(const LAS sbf16x8*)(Ks + ATT_KSWZ(ROW0 + r32, ((d0 + 1) * 16 + hi * 8) * 2));
        x = __builtin_amdgcn_mfma_f32_32x32x16_bf16(c, qx[d0], x, 0, 0, 0);
        y = __builtin_amdgcn_mfma_f32_32x32x16_bf16(c, qy[d0], y, 0, 0, 0);
        c = n;
    }
}
template <int KS0> __device__ __forceinline__ void pv_half(f32x16* ox, f32x16* oy, int vb, sbf16x8 pxa, sbf16x8 pxb, sbf16x8 pya, sbf16x8 pyb) {
    const s16x4 l00 = tr_read<v_rd_off(0, KS0, 0)>(vb), h00 = tr_read<v_rd_off(0, KS0, 1)>(vb), l01 = tr_read<v_rd_off(0, KS0 + 1, 0)>(vb), h01 = tr_read<v_rd_off(0, KS0 + 1, 1)>(vb);
    const s16x4 l10 = tr_read<v_rd_off(1, KS0, 0)>(vb), h10 = tr_read<v_rd_off(1, KS0, 1)>(vb), l11 = tr_read<v_rd_off(1, KS0 + 1, 0)>(vb), h11 = tr_read<v_rd_off(1, KS0 + 1, 1)>(vb);
    asm volatile("s_waitcnt lgkmcnt(0)" ::: "memory"); ATT_SBAR();
#define ATT_PK(L, H) (sbf16x8){L[0], L[1], L[2], L[3], H[0], H[1], H[2], H[3]}
    ox[0] = __builtin_amdgcn_mfma_f32_32x32x16_bf16(ATT_PK(l00, h00), pxa, ox[0], 0, 0, 0);
    oy[0] = __builtin_amdgcn_mfma_f32_32x32x16_bf16(ATT_PK(l00, h00), pya, oy[0], 0, 0, 0);
    ox[1] = __builtin_amdgcn_mfma_f32_32x32x16_bf16(ATT_PK(l10, h10), pxa, ox[1], 0, 0, 0);
    oy[1] = __builtin_amdgcn_mfma_f32_32x32x16_bf16(ATT_PK(l10, h10), pya, oy[1], 0, 0, 0);
    ox[0] = __builtin_amdgcn_mfma_f32_32x32x16_bf16(ATT_PK(l01, h01), pxb, ox[0], 0, 0, 0);
    oy[0] = __builtin_amdgcn_mfma_f32_32x32x16_bf16(ATT_PK(l01, h01), pyb, oy[0], 0, 0, 0);
    ox[1] = __builtin_amdgcn_mfma_f32_32x32x16_bf16(ATT_PK(l11, h11), pxb, ox[1], 0, 0, 0);
    oy[1] = __builtin_amdgcn_mfma_f32_32x32x16_bf16(ATT_PK(l11, h11), pyb, oy[1], 0, 0, 0);
#undef ATT_PK
}
constexpr int OFF2_V = 0, OFF2_K = 2 * SHM_V, OFF2_WS = 2 * SHM_V + 2 * SHM_K;
__device__ __forceinline__ void attn_unit2(const bf16* Qb, const bf16* Kh, const bf16* Vh, bf16* Ob, int seq, LAS char* lds, int tid) {
    const int wid = __builtin_amdgcn_readfirstlane(tid >> 6), lane = tid & 63, r32 = lane & 31, hi = lane >> 5; int lane2;
    LAS char* V_lds = lds + OFF2_V; LAS char* K_lds = lds + OFF2_K;
    LAS float* ws = (LAS float*)(lds + OFF2_WS) + wid * 64;
    float lx = 0.f, ly = 0.f; f32x16 ox[2], oy[2]; ox[0] = f32x16{}; ox[1] = f32x16{}; oy[0] = f32x16{}; oy[1] = f32x16{}; sbf16x8 qx[6], qy[6];
    { const GAS bf16* Qw = (const GAS bf16*)Qb + (size_t)(wid * 64 + r32) * 96 + hi * 8;
#pragma unroll
      for (int d0 = 0; d0 < 6; ++d0) { qx[d0] = *(const GAS sbf16x8*)(Qw + d0 * 16); qy[d0] = *(const GAS sbf16x8*)(Qw + 32 * 96 + d0 * 16); } }
    const int kc1 = 512 + (tid & 255), kr0 = tid / 12, kq0 = (tid % 12) * 8, kr1 = kc1 / 12, kq1 = (kc1 % 12) * 8;
    const int ksto0 = ATT_KSWZ(kr0, kq0 * 2), ksto1 = ATT_KSWZ(kr1, kq1 * 2);
    const int vr = tid >> 3, vq = (tid & 7) * 8, vsto = v_st(vr, vq);
    const int vb0 = (int)(unsigned)(size_t)V_lds + v_rd_base(lane);
    const unsigned ko0 = (unsigned)(kr0 * 96 + kq0) * 2u, ko1 = (unsigned)(kr1 * 96 + kq1) * 2u, vo = (unsigned)(vr * 64 + vq) * 2u;
    const GAS char* Kg = (const GAS char*)Kh; const GAS char* Vg = (const GAS char*)Vh;
    sbf16x8 sk0, sk1, sv;
#define ATT2_SLOAD(k0) do { sk0 = *(const GAS sbf16x8*)(Kg + (ko0 + (unsigned)(k0) * 192u)); sk1 = *(const GAS sbf16x8*)(Kg + (ko1 + (unsigned)(k0) * 192u)); sv = *(const GAS sbf16x8*)(Vg + (vo + (unsigned)(k0) * 128u)); } while (0)
#define ATT2_SWRITE(b) do { *(LAS sbf16x8*)(K_lds + (b) * SHM_K + ksto0) = sk0; *(LAS sbf16x8*)(K_lds + (b) * SHM_K + ksto1) = sk1; *(LAS sbf16x8*)(V_lds + (b) * SHM_V + vsto) = sv; } while (0)
    const int NT = seq / KVBLK;
    ATT2_SLOAD(0); ATT2_SWRITE(0); __syncthreads();
    f32x16 x0, x1, y0, y1; sbf16x8 px[4], py[4];
#pragma unroll 1
    for (int j = 0; j < NT; ++j) {
        const int b = j & 1;
        if (j + 1 < NT) ATT2_SLOAD((j + 1) * KVBLK);
        ATT_SBAR();
        qk_half<0>(x0, y0, K_lds + b * SHM_K, qx, qy, r32, hi);
        ATT_SBAR();
        qk_half<32>(x1, y1, K_lds + b * SHM_K, qx, qy, r32, hi);
        softmax_half(x0, lx, px[0], px[1]); softmax_half(y0, ly, py[0], py[1]);
        ATT_SBAR();
        pv_half<0>(ox, oy, vb0 + b * SHM_V, px[0], px[1], py[0], py[1]);
        softmax_half(x1, lx, px[2], px[3]); softmax_half(y1, ly, py[2], py[3]);
        ATT_SBAR();
        pv_half<2>(ox, oy, vb0 + b * SHM_V, px[2], px[3], py[2], py[3]);
        ATT_SBAR();
        if (j + 1 < NT) ATT2_SWRITE(b ^ 1);
        __syncthreads();
    }
#undef ATT2_SLOAD
#undef ATT2_SWRITE
    { auto rr = __builtin_amdgcn_permlane32_swap(__float_as_uint(lx), __float_as_uint(lx), false, false); lx = __uint_as_float(rr[0]) + __uint_as_float(rr[1]); }
    { auto rr = __builtin_amdgcn_permlane32_swap(__float_as_uint(ly), __float_as_uint(ly), false, false); ly = __uint_as_float(rr[0]) + __uint_as_float(rr[1]); }
    { unsigned z_ = 0u; asm volatile("" : "+v"(z_)); lane2 = (int)__builtin_amdgcn_mbcnt_hi(~0u, __builtin_amdgcn_mbcnt_lo(~0u, z_)); }
    const int r32e = lane2 & 31, hie = lane2 >> 5;
    if (hie == 0) { ws[r32e] = lx; ws[32 + r32e] = ly; }
    asm volatile("s_waitcnt lgkmcnt(0)" ::: "memory");
    LAS bf16* stg = (LAS bf16*)(lds + wid * 8192);
#pragma unroll
    for (int r = 0; r < 16; ++r) { const int orow = crow(r, hie); const float rlx = __builtin_amdgcn_rcpf(ws[orow]), rly = __builtin_amdgcn_rcpf(ws[32 + orow]);
#pragma unroll
        for (int d0 = 0; d0 < 2; ++d0) { stg[orow * 64 + d0 * 32 + r32e] = (bf16)(pk2(ox[d0][r] * rlx, 0.f) & 0xffffu); stg[(32 + orow) * 64 + d0 * 32 + r32e] = (bf16)(pk2(oy[d0][r] * rly, 0.f) & 0xffffu); } }
    asm volatile("s_waitcnt lgkmcnt(0)" ::: "memory");
    GAS bf16* Ow = (GAS bf16*)Ob + (size_t)(wid * 64) * 512;
#pragma unroll
    for (int i = 0; i < 8; ++i) { const int row = i * 8 + (lane2 >> 3), ch = lane2 & 7; const v4u v = *(const LAS v4u*)(stg + row * 64 + ch * 8); *(GAS v4u*)(Ow + (size_t)row * 512 + ch * 8) = v; }
    asm volatile("s_waitcnt lgkmcnt(0)" ::: "memory");
}
constexpr int OFF4_K = 0, OFF4_V = 3 * SHM_K, OFF4_WS = 3 * SHM_K + 3 * SHM_V;
static_assert(OFF4_WS + NW * 64 * 4 <= 131072, "attention LDS");
__device__ __forceinline__ void attn_unit4(const bf16* Qb, const bf16* Kh, const bf16* Vh, bf16* Ob, int seq, LAS char* lds, int tid) {
    const int wid = __builtin_amdgcn_readfirstlane(tid >> 6), lane = tid & 63, r32 = lane & 31, hi = lane >> 5; int lane2;
    LAS char* K_lds = lds + OFF4_K; LAS char* V_lds = lds + OFF4_V;
    LAS float* ws = (LAS float*)(lds + OFF4_WS) + wid * 64;
    float lx = 0.f, ly = 0.f; f32x16 ox[2], oy[2]; ox[0] = f32x16{}; ox[1] = f32x16{}; oy[0] = f32x16{}; oy[1] = f32x16{}; sbf16x8 qx[6], qy[6];
    { const GAS bf16* Qw = (const GAS bf16*)Qb + (size_t)(wid * 64 + r32) * 96 + hi * 8;
#pragma unroll
      for (int d0 = 0; d0 < 6; ++d0) { qx[d0] = *(const GAS sbf16x8*)(Qw + d0 * 16); qy[d0] = *(const GAS sbf16x8*)(Qw + 32 * 96 + d0 * 16); } }
    const int rowA = 4 * wid + (lane >> 4), chA = (lane & 15) ^ (rowA & 15);
    const unsigned kofA = (unsigned)(rowA * 96 + (chA < 12 ? chA * 8 : 0)) * 2u, kofB = kofA + 32u * 192u;
    const int kkv = wid * 8 + ((lane & 31) >> 2), kv = kkv;
    const unsigned vof = (unsigned)(kv * 64 + (lane >> 5) * 32 + (lane & 3) * 8) * 2u;
    const GAS char* Kg = (const GAS char*)Kh; const GAS char* Vg = (const GAS char*)Vh;
    const int vb0 = (int)(unsigned)(size_t)V_lds + v_rd_base(lane);
#define ATT4_DMA(t, slot) do { \
    __builtin_amdgcn_global_load_lds((const GAS unsigned*)(Kg + (kofA + (unsigned)(t) * (64u * 192u))), (LAS unsigned*)(K_lds + (slot) * SHM_K + wid * 1024), 16, 0, 0); \
    __builtin_amdgcn_global_load_lds((const GAS unsigned*)(Kg + (kofB + (unsigned)(t) * (64u * 192u))), (LAS unsigned*)(K_lds + (slot) * SHM_K + (wid + 8) * 1024), 16, 0, 0); \
    __builtin_amdgcn_global_load_lds((const GAS unsigned*)(Vg + (vof + (unsigned)(t) * (64u * 128u))), (LAS unsigned*)(V_lds + (slot) * SHM_V + wid * 2048), 16, 0, 0); } while (0)
    const int NT = seq / KVBLK;
    ATT4_DMA(0, 0);
    asm volatile("s_waitcnt vmcnt(0)" ::: "memory"); __syncthreads();
    f32x16 x0, x1, y0, y1; sbf16x8 px[4], py[4];
    x1 = f32x16{}; y1 = f32x16{};
#pragma unroll
    for (int i = 0; i < 4; ++i) { px[i] = sbf16x8{}; py[i] = sbf16x8{}; }
    int s_prev = 2, s_cur = 0, s_next = 1;
#pragma unroll 1
    for (int j = 0; j < NT; ++j) {
        if (j + 1 < NT) ATT4_DMA(j + 1, s_next);
        ATT_SBAR();
        qk_half<0>(x0, y0, K_lds + s_cur * SHM_K, qx, qy, r32, hi);
        qk_half<32>(x1, y1, K_lds + s_cur * SHM_K, qx, qy, r32, hi);
        softmax_half(x0, lx, px[0], px[1]); softmax_half(y0, ly, py[0], py[1]);
        pv_half<0>(ox, oy, vb0 + s_cur * SHM_V, px[0], px[1], py[0], py[1]);
        softmax_half(x1, lx, px[2], px[3]); softmax_half(y1, ly, py[2], py[3]);
        pv_half<2>(ox, oy, vb0 + s_cur * SHM_V, px[2], px[3], py[2], py[3]);
        asm volatile("s_waitcnt vmcnt(0)" ::: "memory");
        __syncthreads();
        { const int t_ = s_prev; s_prev = s_cur; s_cur = s_next; s_next = t_; }
    }
#undef ATT4_DMA
    { auto rr = __builtin_amdgcn_permlane32_swap(__float_as_uint(lx), __float_as_uint(lx), false, false); lx = __uint_as_float(rr[0]) + __uint_as_float(rr[1]); }
    { auto rr = __builtin_amdgcn_permlane32_swap(__float_as_uint(ly), __float_as_uint(ly), false, false); ly = __uint_as_float(rr[0]) + __uint_as_float(rr[1]); }
    { unsigned z_ = 0u; asm volatile("" : "+v"(z_)); lane2 = (int)__builtin_amdgcn_mbcnt_hi(~0u, __builtin_amdgcn_mbcnt_lo(~0u, z_)); }
    const int r32e = lane2 & 31, hie = lane2 >> 5;
    const float rlx = __builtin_amdgcn_rcpf(lx), rly = __builtin_amdgcn_rcpf(ly);
    LAS bf16* stg = (LAS bf16*)(lds + wid * 8192);
#pragma unroll
    for (int d0 = 0; d0 < 2; ++d0)
#pragma unroll
        for (int g = 0; g < 4; ++g) {
            v2u wx, wy; wx.x = pk2(ox[d0][4 * g] * rlx, ox[d0][4 * g + 1] * rlx); wx.y = pk2(ox[d0][4 * g + 2] * rlx, ox[d0][4 * g + 3] * rlx);
            wy.x = pk2(oy[d0][4 * g] * rly, oy[d0][4 * g + 1] * rly); wy.y = pk2(oy[d0][4 * g + 2] * rly, oy[d0][4 * g + 3] * rly);
            *(LAS v2u*)(stg + r32e * 64 + d0 * 32 + 8 * g + 4 * hie) = wx; *(LAS v2u*)(stg + (32 + r32e) * 64 + d0 * 32 + 8 * g + 4 * hie) = wy; }
    asm volatile("s_waitcnt lgkmcnt(0)" ::: "memory");
    GAS bf16* Ow = (GAS bf16*)Ob + (size_t)(wid * 64) * 512;
#pragma unroll
    for (int i = 0; i < 8; ++i) { const int row = i * 8 + (lane2 >> 3), ch = lane2 & 7; const v4u v = *(const LAS v4u*)(stg + row * 64 + ch * 8); *(GAS v4u*)(Ow + (size_t)row * 512 + ch * 8) = v; }
    asm volatile("s_waitcnt lgkmcnt(0)" ::: "memory");
}
}

__device__ __forceinline__ bool attn_static_ok(Frame& F, int l) {
    const float* gq = ((const float*)(const GAS float*)F.in[13]) + l * DQK; const float* gk = ((const float*)(const GAS float*)F.in[14]) + l * DQK; float mq = 0.f, mk = 0.f;
    for (int d = 0; d < DQK; ++d) { mq = fmaxf(mq, fabsf(gq[d])); mk = fmaxf(mk, fabsf(gk[d])); }
    return 96.f * mq * mk * QSCALE <= 60.f;
}
__device__ __forceinline__ void step_f_fast(Frame& F) {
    fresh_tid(F);
    const bf16* Q = WSP(bf16, WS_Q); const bf16* K = WSP(bf16, WS_K); const bf16* V = WSP(bf16, WS_V); bf16* O = WSP(bf16, WS_O);
    const int vcu = (F.G % 8 == 0) ? (F.bid % 8) * (F.G / 8) + F.bid / 8 : F.bid;
#if ATTN_W64
    for (int u = vcu; u < NB * H * (S / 512); u += F.G) {
        const int qb = u % 16, bh = (u / 16), b = bh / H, h = bh % H;
        fresh_tid(F);
        att::attn_unit4(Q + ((size_t)bh * S + qb * 512) * 96, K + (size_t)bh * S * 96, V + (size_t)bh * S * 64, O + ((size_t)(b * S + qb * 512)) * 512 + h * 64, S, (LAS char*)F.lds, F.tid);
        __syncthreads();
    }
#else
    for (int u = vcu; u < NB * H * (S / 256); u += F.G) {
        const int qb = u % 32, bh = (u / 32), b = bh / H, h = bh % H;
        fresh_tid(F);
        att::attn_unit(Q + ((size_t)bh * S + qb * 256) * 96, K + (size_t)bh * S * 96, V + (size_t)bh * S * 64, O + ((size_t)(b * S + qb * 256)) * 512 + h * 64, S, (LAS char*)F.lds, F.tid);
        __syncthreads();
    }
#endif
}
constexpr size_t WT_IN = WS_WT, WT_UQ = WS_WT + 8 * MiB, WT_UKV = WT_UQ + 384 * KiB, WT_CO = WS_WT + 9 * MiB, WT_AO = WS_WT + 10 * MiB, WT_O = WS_WT + 11 * MiB,
                 WT_GU = WS_WT + 13 * MiB, WT_DN = WS_WT + 30 * MiB;
constexpr int NPROJ = 4096;
static_assert(WT_DN + (size_t)NEX * 1024 * 256 * 2 <= WS_WT + 40 * MiB, "weight region");
__device__ __forceinline__ void cvt_item(const float* W, int K, int N, bf16* WT, int drow0, const float* ksc, LAS float* scr, int k0, int n0, int lane) {
    float wv[32];
#pragma unroll
    for (int i = 0; i < 32; ++i) wv[i] = W[(size_t)(k0 + 2 * i + (lane >> 5)) * N + n0 + (lane & 31)];
#pragma unroll
    for (int i = 0; i < 32; ++i) { const int kk = 2 * i + (lane >> 5); float v = wv[i]; if (ksc) v *= ksc[k0 + kk]; scr[kk * 33 + (lane & 31)] = v; }
    asm volatile("s_waitcnt lgkmcnt(0)" ::: "memory");
    const int c = lane & 7;
#pragma unroll
    for (int j = 0; j < 4; ++j) { const int n = (lane >> 3) + 8 * j; const LAS float* s = scr + (8 * c) * 33 + n;
        v4u o; o.x = pk2(s[0 * 33], s[1 * 33]); o.y = pk2(s[2 * 33], s[3 * 33]); o.z = pk2(s[4 * 33], s[5 * 33]); o.w = pk2(s[6 * 33], s[7 * 33]);
        *(v4u*)(WT + (size_t)(drow0 + n) * K + k0 + 8 * c) = o; }
    asm volatile("s_waitcnt lgkmcnt(0)" ::: "memory");
}
__device__ __forceinline__ int proj_dest(int n0) {
    if (n0 < 512) return n0;
    if (n0 < 1024) return 512 + ((n0 - 512) >> 7) * 256 + ((n0 - 512) & 127);
    if (n0 < 1536) return 512 + ((n0 - 1024) >> 7) * 256 + 128 + ((n0 - 1024) & 127);
    if (n0 < 1952) return n0;
    return n0 + 96;
}
__device__ __forceinline__ int ukv_dest(int n0) { const int h = n0 >> 7, j0 = n0 & 127, kind = j0 >> 6, d0 = j0 & 63; return (kind * 2 + (h >> 2)) * 256 + (d0 >> 5) * 128 + (h & 3) * 32; }
__device__ __forceinline__ void convert_weights(Frame& F, int l) {
    fresh_tid(F);
    LAS float* scr = (LAS float*)(F.lds + F.wave * 16384);
    const int gw = F.bid * NWAVES + F.wave, NGW = F.G * NWAVES;
    constexpr int I_IN = 16 * 125, I_UQ = 4 * 24, I_UKV = 2 * 32, I_CO = 8 * 32, I_O = 16 * 32, I_GU = NEX * 16 * 8, I_DN = NEX * 4 * 32;
    constexpr int NITEMS = I_IN + I_UQ + I_UKV + 2 * I_CO + I_O + 2 * I_GU + I_DN;
    for (int it = gw; it < NITEMS; it += NGW) {
        int r = it;
        if (r < I_IN) { const int kb = r / 125, nb = r % 125, n0 = 32 * nb; cvt_item(((const float*)(const GAS float*)F.in[7]) + (size_t)l * D * NIN, D, NIN, WSP(bf16, WT_IN), proj_dest(n0), nullptr, scr, 64 * kb, n0, F.lane); continue; } r -= I_IN;
        if (r < I_UQ) { const int kb = r / 24, nb = r % 24; cvt_item(((const float*)(const GAS float*)F.in[10]) + (size_t)l * QL * 768, QL, 768, WSP(bf16, WT_UQ), 32 * nb, ((const float*)(const GAS float*)F.in[9]) + l * QL, scr, 64 * kb, 32 * nb, F.lane); continue; } r -= I_UQ;
        if (r < I_UKV) { const int kb = r / 32, nb = r % 32; cvt_item(((const float*)(const GAS float*)F.in[12]) + (size_t)l * KVL * 1024, KVL, 1024, WSP(bf16, WT_UKV), ukv_dest(32 * nb), ((const float*)(const GAS float*)F.in[11]) + l * KVL, scr, 64 * kb, 32 * nb, F.lane); continue; } r -= I_UKV;
        if (r < I_CO) { const int kb = r / 32, nb = r % 32; cvt_item(((const float*)(const GAS float*)F.in[15]) + (size_t)l * CW * D, CW, D, WSP(bf16, WT_CO), 32 * nb, nullptr, scr, 64 * kb, 32 * nb, F.lane); continue; } r -= I_CO;
        if (r < I_CO) { const int kb = r / 32, nb = r % 32; cvt_item(((const float*)(const GAS float*)F.in[16]) + (size_t)l * 512 * D, 512, D, WSP(bf16, WT_AO), 32 * nb, nullptr, scr, 64 * kb, 32 * nb, F.lane); continue; } r -= I_CO;
        if (r < I_O) { const int kb = r / 32, nb = r % 32; cvt_item(((const float*)(const GAS float*)F.in[17]) + (size_t)l * D * D, D, D, WSP(bf16, WT_O), 32 * nb, nullptr, scr, 64 * kb, 32 * nb, F.lane); continue; } r -= I_O;
        if (r < 2 * I_GU) { const int up = r >= I_GU ? 1 : 0; r -= up * I_GU; const int e = r / 128, q = r % 128, kb = q / 8, nb = q % 8, n0 = 32 * nb;
            const float* W = e < NE ? ((const float*)(const GAS float*)F.in[20 + up]) + ((size_t)l * NE + e) * D * DE : ((const float*)(const GAS float*)F.in[23 + up]) + (size_t)l * D * DE;
            cvt_item(W, D, DE, WSP(bf16, WT_GU) + (size_t)e * 512 * D, (n0 >> 7) * 256 + up * 128 + (n0 & 127), nullptr, scr, 64 * kb, n0, F.lane); continue; } r -= 2 * I_GU;
        { const int e = r / 128, q = r % 128, kb = q / 32, nb = q % 32;
            const float* W = e < NE ? ((const float*)(const GAS float*)F.in[22]) + ((size_t)l * NE + e) * DE * D : ((const float*)(const GAS float*)F.in[25]) + (size_t)l * DE * D;
            cvt_item(W, DE, D, WSP(bf16, WT_DN) + (size_t)e * D * DE, 32 * nb, nullptr, scr, 64 * kb, 32 * nb, F.lane); }
    }
    v4u* z = (v4u*)(WSP(bf16, WT_IN) + (size_t)1952 * D);
    unsigned z0 = 0u; asm volatile("" : "+v"(z0));
    for (int i = F.bid * NTHREADS + F.tid; i < 96 * D * 2 / 16; i += F.G * NTHREADS) z[i] = (v4u){z0, z0, z0, z0};
}

namespace pg8 {
typedef short sbf16x8 __attribute__((ext_vector_type(8)));
constexpr int BM = 256, BK = 64, HALF = 128, HTB = HALF * BK * 2, STAGE_BYTES = 8 * HTB, NXCD = 8, WGM = 8;
__device__ __forceinline__ int lds_byte(int r, int c) { const int st = (r >> 4) * 2 + (c >> 5), rr = r & 15, cc = c & 31, ob = rr * 64 + cc * 2; return st * 1024 + (ob ^ (((ob >> 9) & 1) << 5)); }
__device__ __forceinline__ void stage_rc(int b, int& R, int& C) { const int st = b / 1024, sb = b % 1024, swz = sb ^ (((sb >> 9) & 1) << 5); R = (st >> 1) * 16 + swz / 64; C = (st & 1) * 32 + (swz % 64) / 2; }
__device__ __forceinline__ int perm32(int rho) { const int n = rho >> 4, i = rho & 15; return 8 * (i >> 2) + 4 * n + (i & 3); }
__device__ __forceinline__ int xcd_remap(int L, int nwg) { const int q = nwg / NXCD, r = nwg % NXCD, xcd = L % NXCD, off = L / NXCD; return (xcd < r ? xcd * (q + 1) : r * (q + 1) + (xcd - r) * q) + off; }

struct Unit { int pm, pn; const char* a; const char* b; const int* list; int rows, tok0, e; };
struct Gemm { unsigned lda; int K; };

struct StaticOrder {
    const char* A; const char* Bt; unsigned lda; int K, nM, nN, nwg, G, c;
    static constexpr bool WAITS = false;
    __device__ __forceinline__ bool next(int i, Unit& u, int) const {
        const long L = (long)i * G + c; if (L >= nwg) return false;
        const int wgid = xcd_remap((int)L, nwg);
        const int nig = WGM * nN, gid = wgid / nig, fm = gid * WGM, gsz = (nM - fm) < WGM ? (nM - fm) : WGM;
        u.pm = fm + ((wgid % nig) % gsz); u.pn = (wgid % nig) / gsz;
        u.a = A + (size_t)u.pm * BM * lda; u.b = Bt + (size_t)u.pn * BM * K * 2; u.list = nullptr; u.rows = BM; u.tok0 = u.pm * BM; u.e = 0; return true;
    }
};
struct MoeOrder {
    const char* A; const char* Bt; size_t estride; unsigned lda; int K, nN, MT, G, c; const LAS unsigned* tb; const LAS unsigned* cnt; const int* LIST; bool gather;
    static constexpr bool WAITS = false;
    __device__ __forceinline__ bool next(int i, Unit& u, int) const {
        const int nwg = MT * nN; const long L = (long)i * G + c; if (L >= nwg) return false;
        const int wgid = xcd_remap((int)L, nwg);
        const int mt = wgid / nN, pn = wgid % nN; int e = 0;
#pragma unroll 1
        for (int j = 1; j <= NE; ++j) if ((unsigned)mt >= (unsigned)__builtin_amdgcn_readfirstlane(tb[j])) e = j;
        const int lt = mt - (int)__builtin_amdgcn_readfirstlane(tb[e]);
        u.pm = mt; u.pn = pn; u.e = e; u.tok0 = lt * BM;
        if (e < NE) { const int left = (int)__builtin_amdgcn_readfirstlane(cnt[e]) - lt * BM; u.rows = left < BM ? left : BM; u.list = LIST + (size_t)e * T + lt * BM; } else { u.rows = BM; u.list = nullptr; }
        u.a = gather ? A : A + (size_t)mt * BM * lda; u.b = Bt + (size_t)e * estride + (size_t)pn * BM * K * 2; return true;
    }
};

#ifndef KL_R
#define KL_R 3
#endif
struct MoeOrderX {
    static constexpr bool WAITS = true;
    const char* A; const char* Bt; size_t estride; unsigned lda; int K, nN, MT, G, c; const LAS unsigned* tb; const LAS unsigned* cnt; const LAS unsigned* te; const int* LIST; bool gather;
    int mode, kN; unsigned* flags; unsigned* bar;
    __device__ __forceinline__ bool next(int i, Unit& u, int wid) const {
        const int NX = (G % NXCD == 0) ? NXCD : 1, x = c % NX, cl = c / NX, GX = G / NX;
        const int qm = MT / NX, rm = MT % NX, sz = qm + (x < rm ? 1 : 0), m0 = x * qm + (x < rm ? x : rm);
        if (sz == 0) return false;
        int off;
        if (mode == 0) off = cl + i * GX;
        else {
            const int ku = kN * sz, kmax = (ku + GX - 1) / GX, hx = ku - (kmax - 1) * GX, nl = GX - hx;
            if (cl >= hx && i < KL_R) off = (cl - hx) + i * nl;
            else { const int p = cl + (cl >= hx ? i - KL_R : i) * GX; off = KL_R * nl + (p < GX ? (p >= hx ? p - hx : nl + p) : p); }
        }
        const int sl = off / nN, pn = off % nN; if (sl >= sz) return false;
        const int mt = m0 + sl; const unsigned pe = (unsigned)__builtin_amdgcn_readfirstlane(te[mt]); const int e = (int)(pe & 255u), lt = (int)(pe >> 8);
        u.pm = mt; u.pn = pn; u.e = e; u.tok0 = lt * BM;
        if (e < NE) { const int left = (int)__builtin_amdgcn_readfirstlane(cnt[e]) - lt * BM; u.rows = left < BM ? left : BM; u.list = LIST + (size_t)e * T + lt * BM; } else { u.rows = BM; u.list = nullptr; }
        u.a = gather ? A : A + (size_t)mt * BM * lda; u.b = Bt + (size_t)e * estride + (size_t)pn * BM * K * 2;
        if (mode == 1 && wid == 0) {
            XB_SPIN(xb_ld(flags + mt) < (unsigned)kN, bar);
            __builtin_amdgcn_fence(__ATOMIC_ACQUIRE, "agent");
        }
        return true;
    }
};

__device__ __forceinline__ v4u pack8(f32x4 v0, f32x4 v1) { v4u w; w.x = pk2(v0[0], v0[1]); w.y = pk2(v0[2], v0[3]); w.z = pk2(v1[0], v1[1]); w.w = pk2(v1[2], v1[3]); return w; }
__device__ __forceinline__ unsigned pk4_fp8(f32x4 v) {
#pragma unroll
    for (int e = 0; e < 4; ++e) v[e] = __builtin_fminf(__builtin_fmaxf(v[e], -448.f), 448.f);
    int w = __builtin_amdgcn_cvt_pk_fp8_f32(v[0], v[1], 0, false); w = __builtin_amdgcn_cvt_pk_fp8_f32(v[2], v[3], w, true); return (unsigned)w;
}
struct EpiBf16 {
    static constexpr bool PERM = true; static constexpr bool SIGNAL = false; static constexpr bool PRE = false;
    bf16* O; int ldc; int split; unsigned char* g8;
    __device__ __forceinline__ void operator()(const f32x4 (&acc)[2][2][4][2], const Unit& u, int wr, int wc, int fr, int fq) const {
        bf16* base = O; int ld = ldc, c0 = u.pn * BM;
        if (split) { const int pn = u.pn; unsigned char* w = (unsigned char*)O;
            if (pn >= 2 && pn < 6) {
                bf16* pb = (bf16*)(w + WS_CONV) + 512 + (pn - 2) * 128 + wc * 32 + 8 * fq; const int row0 = u.pm * BM + wr * 64 + fr;
#pragma unroll
                for (int ai = 0; ai < 2; ++ai)
#pragma unroll
                    for (int m = 0; m < 4; ++m) { *(v4u*)(pb + (size_t)(row0 + ai * HALF + m * 16) * 1024) = pack8(acc[ai][0][m][0] * acc[ai][1][m][0], acc[ai][0][m][1] * acc[ai][1][m][1]);
                        asm volatile("" ::: "memory"); }
                return; }
            if (pn < 2) { base = (bf16*)(w + WS_CONV); ld = 1024; c0 = pn * 256; }
            else if (pn < 8) { base = (bf16*)(w + WS_SMALL); ld = 512; c0 = (pn - 6) * 256; }
            else {
                unsigned char* gb_ = g8 + (pn >= 12 ? (size_t)T * D : 0); const int cb_ = ((pn - 8) & 3) * 256 + wc * 32 + 8 * (fq & 2), r0_ = u.pm * BM + wr * 64 + fr + 16 * (fq & 1);
#pragma unroll
                for (int ai = 0; ai < 2; ++ai)
#pragma unroll
                    for (int mp = 0; mp < 2; ++mp) { unsigned char* rowp = gb_ + (size_t)(r0_ + ai * HALF + mp * 32) * D + cb_;
#pragma unroll
                        for (int bj = 0; bj < 2; ++bj) {
                            const auto s0 = __builtin_amdgcn_permlane16_swap(pk4_fp8(acc[ai][bj][2 * mp][0]), pk4_fp8(acc[ai][bj][2 * mp + 1][0]), false, false);
                            const auto s1 = __builtin_amdgcn_permlane16_swap(pk4_fp8(acc[ai][bj][2 * mp][1]), pk4_fp8(acc[ai][bj][2 * mp + 1][1]), false, false);
                            v4u w4; w4.x = s0[0]; w4.y = s1[0]; w4.z = s0[1]; w4.w = s1[1];
                            *(v4u*)(rowp + bj * HALF) = w4; }
                        asm volatile("" ::: "memory"); }
                return; } }
        const int row0 = u.pm * BM + wr * 64 + fr, col0 = c0 + wc * 32 + 8 * fq;
#pragma unroll
        for (int ai = 0; ai < 2; ++ai)
#pragma unroll
            for (int m = 0; m < 4; ++m) { bf16* rowp = base + (size_t)(row0 + ai * HALF + m * 16) * ld + col0;
#pragma unroll
                for (int bj = 0; bj < 2; ++bj) *(v4u*)(rowp + bj * HALF) = pack8(acc[ai][bj][m][0], acc[ai][bj][m][1]);
                asm volatile("" ::: "memory"); }
    }
};
struct EpiY8 {
    static constexpr bool PERM = true; static constexpr bool SIGNAL = false; static constexpr bool PRE = false;
    unsigned char* Y8;
    __device__ __forceinline__ void operator()(const f32x4 (&acc)[2][2][4][2], const Unit& u, int wr, int wc, int fr, int fq) const {
        const int row0 = u.pm * BM + wr * 64 + fr, col0 = u.pn * BM + wc * 32 + 8 * fq;
#pragma unroll
        for (int ai = 0; ai < 2; ++ai)
#pragma unroll
            for (int m = 0; m < 4; ++m) { unsigned char* rowp = Y8 + (size_t)(row0 + ai * HALF + m * 16) * D + col0;
#pragma unroll
                for (int bj = 0; bj < 2; ++bj) { v2u w; w.x = pk4_fp8(acc[ai][bj][m][0]); w.y = pk4_fp8(acc[ai][bj][m][1]); *(v2u*)(rowp + bj * HALF) = w; }
                asm volatile("" ::: "memory"); }
    }
};
constexpr int KVE_RSK = 131072 + 2048, KVE_RP = KVE_RSK + 2048, KVE_GN = KVE_RP + 16384, KVE_END = KVE_GN + 256;
__device__ __forceinline__ float add_xor16(float v) {
    auto r = __builtin_amdgcn_permlane16_swap(__builtin_bit_cast(unsigned, v), __builtin_bit_cast(unsigned, v), false, false);
    return __builtin_bit_cast(float, r[0]) + __builtin_bit_cast(float, r[1]); }
struct EpiKV {
    static constexpr bool PERM = true; static constexpr bool SIGNAL = false; static constexpr bool PRE = true;
    bf16* Kb; bf16* Vb; const bf16* small; const f32x2* rope; const float* gk; LAS unsigned char* lds;
    __device__ __forceinline__ void pre(const Unit& u, int wid) const {
        unsigned z_ = 0u; asm volatile("" : "+v"(z_)); const int lane = (int)__builtin_amdgcn_mbcnt_hi(~0u, __builtin_amdgcn_mbcnt_lo(~0u, z_)), tid = wid * 64 + lane;
        const bool isK = u.pn < 2; const int q = lane & 3, i0 = 8 * (q & 1);
        if (isK && tid < 16) *(LAS f32x4*)(lds + KVE_GN + tid * 16) = *(const f32x4*)(gk + 4 * tid);
        f32x4 g1[2], g2[2];
#pragma unroll
        for (int n = 0; n < 2; ++n) { g1[n] = *(const f32x4*)(gk + 64 + i0 + 4 * n); g2[n] = *(const f32x4*)(gk + 80 + i0 + 4 * n); }
#pragma unroll 1
        for (int it = 0; it < 2; ++it) {
            const int rl = it * HALF + (tid >> 2), t = u.pm * BM + rl;
            const bf16* sm = small + (size_t)t * 512;
            float ss = 0.f;
#pragma unroll
            for (int c = 0; c < 4; ++c) { const bf16x8 x = *(const bf16x8*)(sm + 256 + 32 * q + 8 * c);
#pragma unroll
                for (int e = 0; e < 8; ++e) { const float f = bf2f(x[e]); ss += f * f; } }
            ss += xor_lane<1>(ss); ss += xor_lane<2>(ss);
            float sk = 0.f;
            if (isK) {
                const bf16x8 x1v = *(const bf16x8*)(sm + 384 + i0), x2v = *(const bf16x8*)(sm + 384 + 16 + i0);
                const f32x4* rp = (const f32x4*)(rope + (size_t)t * 16 + i0);
                const f32x4 rp0 = rp[0], rp1 = rp[1], rp2 = rp[2], rp3 = rp[3];
#pragma unroll
                for (int e = 0; e < 8; ++e) { const float f = bf2f(q < 2 ? x1v[e] : x2v[e]); sk += f * f; }
                sk += xor_lane<1>(sk); sk += xor_lane<2>(sk);
                f32x4 o0, o1;
#pragma unroll
                for (int e = 0; e < 8; ++e) {
                    const float a = bf2f(x1v[e]) * (e < 4 ? g1[0][e & 3] : g1[1][e & 3]), bb = bf2f(x2v[e]) * (e < 4 ? g2[0][e & 3] : g2[1][e & 3]);
                    const f32x4 cq = e < 2 ? rp0 : e < 4 ? rp1 : e < 6 ? rp2 : rp3; const float cs = (e & 1) ? cq.z : cq.x, sn_ = (e & 1) ? cq.w : cq.y;
                    const float o = q < 2 ? a * cs - bb * sn_ : bb * cs + a * sn_;
                    if (e < 4) o0[e & 3] = o; else o1[e & 3] = o; }
                *(LAS v4u*)(lds + KVE_RP + rl * 64 + q * 16) = pack8(o0, o1);
            }
            if (q == 0) { f32x2 w; w.x = 1.0f / sqrtf(ss * (1.f / 128.f) + EPS); w.y = sk; *(LAS f32x2*)(lds + KVE_RSK + rl * 8) = w; }
        }
    }
    __device__ __forceinline__ void operator()(const f32x4 (&acc)[2][2][4][2], const Unit& u, int wr, int wc, int fr, int fq) const {
        const bool isK = u.pn < 2; const int h = (u.pn & 1) * 4 + wc;
#pragma unroll
        for (int ai = 0; ai < 2; ++ai)
#pragma unroll
            for (int m = 0; m < 4; ++m) {
                const int rl = ai * HALF + wr * 64 + m * 16 + fr, t = u.pm * BM + rl, b = t / S, sq = t % S;
                const size_t orow = (size_t)(b * H + h) * S + sq;
                const f32x2 rsk = *(const LAS f32x2*)(lds + KVE_RSK + rl * 8);
                const float rs = rsk.x;
                if (isK) {
                    const v4u rpv = *(const LAS v4u*)(lds + KVE_RP + rl * 64 + fq * 16);
                    f32x4 gn[2][2];
#pragma unroll
                    for (int bj = 0; bj < 2; ++bj)
#pragma unroll
                        for (int n = 0; n < 2; ++n) gn[bj][n] = *(const LAS f32x4*)(lds + KVE_GN + (32 * bj + 8 * fq + 4 * n) * 4);
                    float sn = 0.f; f32x4 v[2][2];
#pragma unroll
                    for (int bj = 0; bj < 2; ++bj)
#pragma unroll
                        for (int n = 0; n < 2; ++n) { v[bj][n] = acc[ai][bj][m][n] * rs;
#pragma unroll
                            for (int e = 0; e < 4; ++e) sn += v[bj][n][e] * v[bj][n][e]; }
                    sn = add_xor16(sn); sn = add_xor32(sn);
                    const float r = 1.0f / sqrtf((sn + rsk.y) * (1.f / 96.f) + EPS);
#pragma unroll
                    for (int bj = 0; bj < 2; ++bj) *(v4u*)(Kb + orow * 96 + 32 * bj + 8 * fq) = pack8(v[bj][0] * r * gn[bj][0], v[bj][1] * r * gn[bj][1]);
                    f32x4 o0, o1;
                    o0[0] = bf2f((unsigned short)(rpv.x & 0xffffu)) * r; o0[1] = bf2f((unsigned short)(rpv.x >> 16)) * r; o0[2] = bf2f((unsigned short)(rpv.y & 0xffffu)) * r; o0[3] = bf2f((unsigned short)(rpv.y >> 16)) * r;
                    o1[0] = bf2f((unsigned short)(rpv.z & 0xffffu)) * r; o1[1] = bf2f((unsigned short)(rpv.z >> 16)) * r; o1[2] = bf2f((unsigned short)(rpv.w & 0xffffu)) * r; o1[3] = bf2f((unsigned short)(rpv.w >> 16)) * r;
                    *(v4u*)(Kb + orow * 96 + 64 + 8 * fq) = pack8(o0, o1);
                } else {
#pragma unroll
                    for (int bj = 0; bj < 2; ++bj) *(v4u*)(Vb + orow * 64 + 32 * bj + 8 * fq) = pack8(acc[ai][bj][m][0] * rs, acc[ai][bj][m][1] * rs);
                }
                asm volatile("" ::: "memory");
            }
    }
};
template <int MODE> struct EpiGate {
    static constexpr bool PERM = true; static constexpr bool SIGNAL = false; static constexpr bool PRE = false;
    bf16* ga; const unsigned char* g8;
    __device__ __forceinline__ void operator()(const f32x4 (&acc)[2][2][4][2], const Unit& u, int wr, int wc, int fr, int fq) const {
        const int row0 = u.pm * BM + wr * 64 + fr, col0 = u.pn * BM + wc * 32 + 8 * fq;
#pragma unroll
        for (int ai = 0; ai < 2; ++ai) {
            v2u g[4][2]; bf16x8 t[4][2];
#pragma unroll
            for (int m = 0; m < 4; ++m) { const size_t off = (size_t)(row0 + ai * HALF + m * 16) * D + col0;
#pragma unroll
                for (int bj = 0; bj < 2; ++bj) { g[m][bj] = *(const v2u*)(g8 + off + bj * HALF);
                    t[m][bj] = (bf16x8){0, 0, 0, 0, 0, 0, 0, 0}; if (MODE == 2) t[m][bj] = *(const bf16x8*)(ga + off + bj * HALF); } }
#pragma unroll
            for (int m = 0; m < 4; ++m) { const size_t off = (size_t)(row0 + ai * HALF + m * 16) * D + col0;
#pragma unroll
                for (int bj = 0; bj < 2; ++bj) {
                    f32x4 v0 = acc[ai][bj][m][0], v1 = acc[ai][bj][m][1];
                    const f32x2 q0 = __builtin_amdgcn_cvt_pk_f32_fp8((int)g[m][bj].x, false), q1 = __builtin_amdgcn_cvt_pk_f32_fp8((int)g[m][bj].x, true);
                    const f32x2 q2 = __builtin_amdgcn_cvt_pk_f32_fp8((int)g[m][bj].y, false), q3 = __builtin_amdgcn_cvt_pk_f32_fp8((int)g[m][bj].y, true);
                    const f32x4 ga0 = {q0.x, q0.y, q1.x, q1.y}, ga1 = {q2.x, q2.y, q3.x, q3.y};
#pragma unroll
                    for (int e = 0; e < 4; ++e) { v0[e] = sigmoidf_(ga0[e]) * v0[e]; v1[e] = sigmoidf_(ga1[e]) * v1[e];
                        if (MODE == 2) { v0[e] += bf2f(t[m][bj][e]); v1[e] += bf2f(t[m][bj][4 + e]); } }
                    *(v4u*)(ga + off + bj * HALF) = pack8(v0, v1); } }
            asm volatile("" ::: "memory");
        }
    }
};
struct EpiRes {
    static constexpr bool PERM = false; static constexpr bool SIGNAL = false; static constexpr bool PRE = false;
    const float* xin; float* out; const float* gt;
    __device__ __forceinline__ void operator()(const f32x4 (&acc)[2][2][4][2], const Unit& u, int wr, int wc, int fr, int fq) const {
        const int col0 = u.pn * BM + wc * 32 + 4 * fq;
        const float* g = gt + ((u.pm * BM) / S) * 6 * D;
        f32x4 gv[2][2];
#pragma unroll
        for (int bj = 0; bj < 2; ++bj)
#pragma unroll
            for (int n = 0; n < 2; ++n) gv[bj][n] = *(const f32x4*)(g + col0 + bj * HALF + n * 16);
#pragma unroll
        for (int ai = 0; ai < 2; ++ai)
#pragma unroll
            for (int mp = 0; mp < 2; ++mp) {
                f32x4 xv[2][2][2];
#pragma unroll
                for (int mm = 0; mm < 2; ++mm) { const size_t off = (size_t)(u.pm * BM + ai * HALF + wr * 64 + (2 * mp + mm) * 16 + fr) * D + col0;
#pragma unroll
                    for (int bj = 0; bj < 2; ++bj)
#pragma unroll
                        for (int n = 0; n < 2; ++n) xv[mm][bj][n] = *(const f32x4*)(xin + off + bj * HALF + n * 16); }
#pragma unroll
                for (int mm = 0; mm < 2; ++mm) { const int m = 2 * mp + mm; const size_t off = (size_t)(u.pm * BM + ai * HALF + wr * 64 + m * 16 + fr) * D + col0;
#pragma unroll
                    for (int bj = 0; bj < 2; ++bj)
#pragma unroll
                        for (int n = 0; n < 2; ++n) *(f32x4*)(out + off + bj * HALF + n * 16) = xv[mm][bj][n] + gv[bj][n] * acc[ai][bj][m][n]; }
                asm volatile("" ::: "memory");
            }
    }
};
struct EpiRes16 {
    static constexpr bool PERM = true; static constexpr bool SIGNAL = false; static constexpr bool PRE = false;
    const float* xin32; bf16* x16; const float* gt;
    __device__ __forceinline__ void operator()(const f32x4 (&acc)[2][2][4][2], const Unit& u, int wr, int wc, int fr, int fq) const {
        const int row0 = u.pm * BM + wr * 64 + fr, col0 = u.pn * BM + wc * 32 + 8 * fq;
        const float* g = gt + ((u.pm * BM) / S) * 6 * D;
        f32x4 gv[2][2];
#pragma unroll
        for (int bj = 0; bj < 2; ++bj)
#pragma unroll
            for (int n = 0; n < 2; ++n) gv[bj][n] = *(const f32x4*)(g + col0 + bj * HALF + n * 4);
#pragma unroll
        for (int ai = 0; ai < 2; ++ai)
#pragma unroll
            for (int mp = 0; mp < 2; ++mp) {
                f32x4 xv[2][2][2];
#pragma unroll
                for (int mm = 0; mm < 2; ++mm) { const size_t off = (size_t)(row0 + ai * HALF + (2 * mp + mm) * 16) * D + col0;
#pragma unroll
                    for (int bj = 0; bj < 2; ++bj) {
                        if (xin32) { xv[mm][bj][0] = *(const f32x4*)(xin32 + off + bj * HALF); xv[mm][bj][1] = *(const f32x4*)(xin32 + off + bj * HALF + 4); }
                        else { const bf16x8 t = *(const bf16x8*)(x16 + off + bj * HALF);
#pragma unroll
                            for (int e = 0; e < 4; ++e) { xv[mm][bj][0][e] = bf2f(t[e]); xv[mm][bj][1][e] = bf2f(t[4 + e]); } } } }
#pragma unroll
                for (int mm = 0; mm < 2; ++mm) { const int m = 2 * mp + mm; const size_t off = (size_t)(row0 + ai * HALF + m * 16) * D + col0;
#pragma unroll
                    for (int bj = 0; bj < 2; ++bj) *(v4u*)(x16 + off + bj * HALF) = pack8(xv[mm][bj][0] + gv[bj][0] * acc[ai][bj][m][0], xv[mm][bj][1] + gv[bj][1] * acc[ai][bj][m][1]); }
                asm volatile("" ::: "memory");
            }
    }
};
struct EpiAct {
    static constexpr bool PERM = true; static constexpr bool SIGNAL = true; static constexpr bool PRE = false;
    bf16* a2; const float* tokw; unsigned* flags;
    __device__ __forceinline__ void operator()(const f32x4 (&acc)[2][2][4][2], const Unit& u, int wr, int wc, int fr, int fq) const {
        const int col0 = u.pn * HALF + wc * 32 + 8 * fq;
        const __amdgpu_buffer_rsrc_t rsrc = __builtin_amdgcn_make_buffer_rsrc((void*)a2, 0, SLOTS_MAX * DE * 2, 0x00020000);
        float wv[2][4];
        if (u.list) { int tk[2][4];
#pragma unroll
            for (int ai = 0; ai < 2; ++ai)
#pragma unroll
                for (int m = 0; m < 4; ++m) { const int rl = ai * HALF + wr * 64 + m * 16 + fr; tk[ai][m] = rl < u.rows ? u.list[rl] : -1; }
#pragma unroll
            for (int ai = 0; ai < 2; ++ai)
#pragma unroll
                for (int m = 0; m < 4; ++m) wv[ai][m] = tk[ai][m] >= 0 ? tokw[tk[ai][m]] : 0.f;
        } else {
#pragma unroll
            for (int ai = 0; ai < 2; ++ai)
#pragma unroll
                for (int m = 0; m < 4; ++m) wv[ai][m] = 1.f; }
#pragma unroll
        for (int ai = 0; ai < 2; ++ai)
#pragma unroll
            for (int m = 0; m < 4; ++m) { const int rl = ai * HALF + wr * 64 + m * 16 + fr;
                const float w = wv[ai][m];
                f32x4 v0, v1;
#pragma unroll
                for (int e = 0; e < 4; ++e) { const float g0 = acc[ai][0][m][0][e], g1 = acc[ai][0][m][1][e];
                    v0[e] = g0 / (1.f + __expf(-g0)) * acc[ai][1][m][0][e] * w; v1[e] = g1 / (1.f + __expf(-g1)) * acc[ai][1][m][1][e] * w; }
                __builtin_amdgcn_raw_buffer_store_b128(pack8(v0, v1), rsrc, ((u.pm * BM + rl) * DE + col0) * 2, 0,   16);
                asm volatile("" ::: "memory"); }
    }
    __device__ __forceinline__ void signal(const Unit& u, bool leader) const { if (leader) (void)xb_add(flags + u.pm, 1u); }
};

template <class Epi, class Sched, bool GATHER>
__device__ __forceinline__ void gemm_phase(LAS unsigned char* lds, const int tid, const Gemm g, const Sched& S, const Epi& E) {
    const int wid = __builtin_amdgcn_readfirstlane(tid >> 6), lane = tid & 63, wr = wid >> 2, wc = wid & 3, fr = lane & 15, fq = lane >> 4;
    const int K = g.K, nt = K / BK; const unsigned lda = g.lda;
    unsigned voffA[2], voffB[2]; int RA[2], CA2[2];
#pragma unroll
    for (int i = 0; i < 2; ++i) { int R, C; stage_rc(tid * 16 + i * 8192, R, C); const int Rb = Epi::PERM ? ((R & ~31) + perm32(R & 31)) : R;
        voffA[i] = (unsigned)R * lda + (unsigned)C * 2u; voffB[i] = (unsigned)(Rb * K + C) * 2u; RA[i] = R; CA2[i] = C * 2; }
    const size_t kstep = (size_t)(BK * 2);
    const size_t hstepA = (size_t)HALF * lda, hstepB = (size_t)HALF * K * 2;
    const unsigned ldsw = (unsigned)wid * 1024u;
    const int aoff = lds_byte(wr * 64 + fr, fq * 8), boff = lds_byte(wc * 32 + fr, fq * 8);
    unsigned offC[2][2], offN[2][2];
#define PG8_GOFF(dst, U) do { _Pragma("unroll") for (int h_ = 0; h_ < 2; ++h_) _Pragma("unroll") for (int i_ = 0; i_ < 2; ++i_) { const int rl_ = h_ * HALF + RA[i_]; \
        int tok_; if ((U).list) tok_ = rl_ < (U).rows ? ((U).list[rl_] >> 1) : 0; else tok_ = (U).tok0 + rl_; dst[h_][i_] = (unsigned)tok_ * lda + (unsigned)CA2[i_]; } } while (0)
#define PG8_SA(b, h) (((b) * 2 + (h)) * HTB)
#define PG8_SB(b, h) ((4 + (b) * 2 + (h)) * HTB)
#define PG8_GLDS(gp, bufoff, i_) __builtin_amdgcn_global_load_lds((const unsigned*)(gp), (LAS unsigned*)(lds + (bufoff) + ldsw + (i_) * 8192), 16, 0, 0)
#define PG8_STAGE_B(bufoff, gbase) do { _Pragma("unroll") for (int _i = 0; _i < 2; ++_i) PG8_GLDS((const char*)(gbase) + voffB[_i], bufoff, _i); } while (0)
#define PG8_STAGE_A(bufoff, ub, NX, h, koff) do { if constexpr (GATHER) { _Pragma("unroll") for (int _i = 0; _i < 2; ++_i) { const unsigned o_ = (NX) ? offN[h][_i] : offC[h][_i]; PG8_GLDS((ub) + (koff) + o_, bufoff, _i); } } \
        else { _Pragma("unroll") for (int _i = 0; _i < 2; ++_i) PG8_GLDS((ub) + (size_t)(h) * hstepA + (koff) + voffA[_i], bufoff, _i); } } while (0)
#define PG8_LDA(dst, b, h) do { _Pragma("unroll") for (int m = 0; m < 4; ++m) _Pragma("unroll") for (int k = 0; k < 2; ++k) dst[m][k] = *(const LAS sbf16x8*)(lds + PG8_SA(b, h) + aoff + m * 2048 + k * 1024); } while (0)
#define PG8_LDB(dst, b, h) do { _Pragma("unroll") for (int n = 0; n < 2; ++n) _Pragma("unroll") for (int k = 0; k < 2; ++k) dst[n][k] = *(const LAS sbf16x8*)(lds + PG8_SB(b, h) + boff + n * 2048 + k * 1024); } while (0)
#define PG8_MMA(ai, bj, At, Bt) do { __builtin_amdgcn_s_setprio(1); _Pragma("unroll") for (int m = 0; m < 4; ++m) _Pragma("unroll") for (int n = 0; n < 2; ++n) _Pragma("unroll") for (int k = 0; k < 2; ++k) \
        acc[ai][bj][m][n] = __builtin_amdgcn_mfma_f32_16x16x32_bf16(Bt[n][k], At[m][k], acc[ai][bj][m][n], 0, 0, 0); __builtin_amdgcn_s_setprio(0); } while (0)
#define PG8_WAIT_V(n) asm volatile("s_waitcnt vmcnt(" #n ")" ::: "memory")
#define PG8_WAIT_L(n) asm volatile("s_waitcnt lgkmcnt(" #n ")" ::: "memory")
#define PG8_BAR __builtin_amdgcn_s_barrier()
#define PG8_SCHED __builtin_amdgcn_sched_barrier(0)
    Unit cur, nxt; int ui = 0;
    if (!S.next(0, cur, wid)) return;
    if constexpr (Sched::WAITS) PG8_BAR;
    f32x4 acc[2][2][4][2];
#define PG8_ZERO_ACC() do { float z_ = 0.f; asm volatile("" : "+v"(z_)); _Pragma("unroll") for (int a = 0; a < 2; ++a) _Pragma("unroll") for (int b = 0; b < 2; ++b) _Pragma("unroll") for (int m = 0; m < 4; ++m) \
        _Pragma("unroll") for (int n = 0; n < 2; ++n) acc[a][b][m][n] = (f32x4){z_, z_, z_, z_}; } while (0)
    PG8_ZERO_ACC();
    sbf16x8 At[4][2], B0[2][2], B1[2][2];
    const char* cA = cur.a; const char* cB = cur.b;
    if constexpr (GATHER) { PG8_GOFF(offC, cur); PG8_WAIT_V(0); }
    PG8_STAGE_B(PG8_SB(0, 0), cB); PG8_STAGE_B(PG8_SB(0, 1), cB + hstepB); PG8_STAGE_A(PG8_SA(0, 0), cA, false, 0, 0); PG8_STAGE_A(PG8_SA(0, 1), cA, false, 1, 0);
    if constexpr (Epi::PRE) E.pre(cur, wid);
    if (wr == 1) PG8_BAR;
    PG8_WAIT_V(2); PG8_BAR;
    PG8_STAGE_B(PG8_SB(1, 0), cB + kstep); PG8_STAGE_A(PG8_SA(1, 0), cA, false, 0, kstep); PG8_STAGE_B(PG8_SB(1, 1), cB + hstepB + kstep);
    PG8_WAIT_V(6); PG8_BAR;
    for (;;) {
        const bool has_next = S.next(ui + 1, nxt, wid);
        if constexpr (GATHER) { if (has_next) { PG8_GOFF(offN, nxt); PG8_WAIT_V(0); } else {
#pragma unroll
            for (int h_ = 0; h_ < 2; ++h_)
#pragma unroll
                for (int i_ = 0; i_ < 2; ++i_) offN[h_][i_] = offC[h_][i_]; } }
        const char* nA = has_next ? nxt.a : cA; const char* nB = has_next ? nxt.b : cB;
#pragma unroll 1
        for (int t = 0; t < nt; t += 2) {
            const bool last = (t == nt - 2);
            const size_t k1 = (size_t)(t + 1) * kstep;
            const char* a2 = last ? nA : cA; const char* b2 = last ? nB : cB + (size_t)(t + 2) * kstep;
            const size_t k2 = last ? 0 : (size_t)(t + 2) * kstep;
            const char* b3 = b2 + kstep;
            PG8_LDB(B0, 0, 0); PG8_LDB(B1, 0, 1); PG8_SCHED; PG8_LDA(At, 0, 0); PG8_STAGE_A(PG8_SA(1, 1), cA, false, 1, k1);
            PG8_WAIT_V(8); PG8_WAIT_L(0); PG8_BAR; PG8_MMA(0, 0, At, B0); PG8_MMA(0, 1, At, B1); PG8_BAR; PG8_SCHED;
            PG8_LDA(At, 0, 1); PG8_STAGE_B(PG8_SB(0, 0), b2); PG8_STAGE_B(PG8_SB(0, 1), b2 + hstepB); PG8_STAGE_A(PG8_SA(0, 0), a2, last, 0, k2);
            PG8_WAIT_V(8); PG8_WAIT_L(0); PG8_BAR; PG8_MMA(1, 0, At, B0); PG8_MMA(1, 1, At, B1); PG8_BAR; PG8_SCHED;
            PG8_LDB(B0, 1, 0); PG8_LDB(B1, 1, 1); PG8_SCHED; PG8_LDA(At, 1, 0); PG8_STAGE_A(PG8_SA(0, 1), a2, last, 1, k2);
            PG8_WAIT_V(8); PG8_WAIT_L(0); PG8_BAR; PG8_MMA(0, 0, At, B0); PG8_MMA(0, 1, At, B1); PG8_BAR; PG8_SCHED;
            PG8_LDA(At, 1, 1); PG8_STAGE_B(PG8_SB(1, 0), b3); PG8_STAGE_B(PG8_SB(1, 1), b3 + hstepB); PG8_STAGE_A(PG8_SA(1, 0), a2, last, 0, k2 + kstep);
            PG8_WAIT_V(8); PG8_WAIT_L(0); PG8_BAR; PG8_MMA(1, 0, At, B0); PG8_MMA(1, 1, At, B1); PG8_BAR; PG8_SCHED;
        }
        if (wr == 0) PG8_BAR;
        { unsigned z_ = 0u; asm volatile("" : "+v"(z_)); const int l2_ = (int)__builtin_amdgcn_mbcnt_hi(~0u, __builtin_amdgcn_mbcnt_lo(~0u, z_));
          E(acc, cur, wr, wc, l2_ & 15, l2_ >> 4);
          if constexpr (Epi::SIGNAL) { PG8_WAIT_V(0); PG8_BAR; E.signal(cur, wid == 0 && l2_ == 0); } }
        if (!has_next) break;
        PG8_ZERO_ACC();
        cur = nxt; cA = nA; cB = nB; ++ui;
        if constexpr (GATHER) {
#pragma unroll
            for (int h_ = 0; h_ < 2; ++h_)
#pragma unroll
                for (int i_ = 0; i_ < 2; ++i_) offC[h_][i_] = offN[h_][i_]; }
        if constexpr (Epi::PRE) { PG8_BAR; E.pre(cur, wid); }
        if (wr == 1) PG8_BAR;
    }
    PG8_WAIT_V(0);
    PG8_BAR;
#undef PG8_GOFF
#undef PG8_ZERO_ACC
#undef PG8_SA
#undef PG8_SB
#undef PG8_GLDS
#undef PG8_STAGE_A
#undef PG8_STAGE_B
#undef PG8_LDA
#undef PG8_LDB
#undef PG8_MMA
#undef PG8_WAIT_V
#undef PG8_WAIT_L
#undef PG8_BAR
#undef PG8_SCHED
}
}

template <class Epi>
__device__ __forceinline__ void run_dense(Frame& F, const bf16* A, int lda_elems, const bf16* Bt, int M, int N, int K, const Epi& E) {
    pg8::StaticOrder S; S.A = (const char*)A; S.Bt = (const char*)Bt; S.lda = (unsigned)lda_elems * 2u; S.K = K; S.nM = M / 256; S.nN = N / 256; S.nwg = S.nM * S.nN; S.G = F.G; S.c = F.bid;
    pg8::Gemm g{(unsigned)lda_elems * 2u, K};
    fresh_tid(F);
    pg8::gemm_phase<Epi, pg8::StaticOrder, false>(F.lds, F.tid, g, S, E);
}

constexpr int TB_OFF = 131072;
static_assert(pg8::KVE_END <= LDS_BYTES && TB_OFF + 2048 <= pg8::KVE_RSK, "LDS side tables");
constexpr int TE_OFF = TB_OFF + 1024;
__device__ __forceinline__ void compute_bases(Frame& F, int l) {
    fresh_tid(F);
    LAS unsigned* tb = (LAS unsigned*)(F.lds + TB_OFF); LAS unsigned* lc = tb + 32;
    if (F.tid == 0) { const unsigned* cnt = F.ctl + CW_CNT + CNT_LS * l; unsigned acc = 0;
        for (int e = 0; e < NE; ++e) { const unsigned c = cnt[CNT_ES * e]; lc[e] = c; tb[e] = acc; acc += (c + 255u) >> 8; }
        tb[16] = acc; tb[17] = acc + T / 256;
        if (F.bid == 0) { unsigned* base = F.ctl + CW_BASE + 32 * l; for (int e = 0; e < 18; ++e) base[e] = tb[e] * 256u; } }
    __syncthreads();
    if (F.tid < 256) { LAS unsigned* te = (LAS unsigned*)(F.lds + TE_OFF); unsigned e = 0;
        for (int j = 1; j <= NE; ++j) if ((unsigned)F.tid >= tb[j]) e = (unsigned)j;
        te[F.tid] = e | (((unsigned)F.tid - tb[e]) << 8); }
    __syncthreads();
}

struct Args { const GAS void* in[26]; GAS float* out; GAS unsigned char* ws; int lo, hi; };
constexpr int NSTEPS = 21;

__global__ void __launch_bounds__(NTHREADS, 2) mk_fwd(Args args) {
    extern __shared__ __attribute__((aligned(16))) unsigned char lds_raw[];
    Frame F;
    F.lds = (LAS unsigned char*)lds_raw; F.MISC = (volatile LAS unsigned*)(F.lds + MISC_OFF);
    F.tid = threadIdx.x; F.lane = F.tid & 63; F.wave = __builtin_amdgcn_readfirstlane(F.tid >> 6); F.bid = blockIdx.x; F.G = gridDim.x;
    F.ws = args.ws; F.ctl = (unsigned*)(GAS unsigned*)(args.ws + WS_CTL); F.out = (float*)args.out;
    F.in = args.in; const int wave0 = F.wave;
    if (F.tid < 32) F.MISC[F.tid] = 0u;
    __syncthreads();
    XcdBarrier bar; bar.bar = F.ctl + CW_BAR; bar.x = 0; bar.st = nullptr;
    if (!MK_SPLIT) bar = xcd_barrier_post(F.ctl + CW_BAR, F.MISC + 8);

    for (int step_ = args.lo; step_ < args.hi; ++step_) {
        int step = step_; asm volatile("" : "+s"(step));
        { GAS unsigned char* w_ = args.ws; asm volatile("" : "+s"(w_)); F.ws = w_; F.ctl = (unsigned*)(GAS unsigned*)(w_ + WS_CTL);
          int b_ = blockIdx.x, g_ = gridDim.x, wv_ = wave0; GAS float* o_ = args.out; asm volatile("" : "+s"(b_), "+s"(g_), "+s"(wv_), "+s"(o_)); F.bid = b_; F.G = g_; F.wave = wv_; F.out = (float*)o_;
          F.tid = 0; F.lane = 0; }
#ifdef ONLY_PH
#define PHON(p) ((p) == ONLY_PH)
#else
#define PHON(p) true
#endif
        if (step == 0) { step_p0(F); if (FAST_ANY) convert_weights(F, 0); }
        else if (step == 1) step_p0_reduce(F);
        else if (step == NSTEPS - 1) { if (PHON(0)) step_a(F, 2); }
        else {
            const int l = (step - 2) / 9, ph = (step - 2) % 9, phx = ph == 2 ? 23 : ph;
            bf16* const XNp = WSP(bf16, WS_XN); const float* const MODp = WSP(float, WS_MOD);
            if (!PHON(ph)) {} else
            if (ph == 0) { if (FAST_ANY && l > 0) convert_weights(F, l); if (l == 0) for (int rep_ = 1; rep_ < REP_A0; ++rep_) step_a(F, 0); step_a(F, l); }
            else if (ph == 1) {
#if FAST_B
                for (int rep_ = 0; rep_ < REP_B; ++rep_) run_dense(F, XNp, D, WSP(bf16, WT_IN), T, NPROJ, D, pg8::EpiBf16{(bf16*)F.ws, 0, 1, G8P(F)});
#else
                EpiProj E{WSP(bf16, WS_CONV), WSP(bf16, WS_SMALL), WSP(bf16, WS_GA), GBP(F)};
                ngemm<8, false>(F, T, NIN, D, RowLin{XNp, D}, ((const float*)(const GAS float*)F.in[7]) + (size_t)l * D * NIN, nullptr, NIN, nullptr, E);
#endif
            } else if (phx == 23) { for (int rep_ = 0; rep_ < REP_C; ++rep_) step_c(F, l);
#if FAST_D
                for (int rep_ = 0; rep_ < REP_D; ++rep_) {
                run_dense(F, WSP(bf16, WS_SMALL), 512, WSP(bf16, WT_UQ), T, 768, QL, pg8::EpiBf16{WSP(bf16, WS_QRAW), 768, 0, nullptr});
                run_dense(F, WSP(bf16, WS_SMALL) + 256, 512, WSP(bf16, WT_UKV), T, 1024, KVL, pg8::EpiKV{WSP(bf16, WS_K), WSP(bf16, WS_V), WSP(bf16, WS_SMALL), WSP(f32x2, WS_ROPE), ((const float*)(const GAS float*)F.in[14]) + l * DQK, F.lds}); }
#else
                ngemm<8, false>(F, T, 768, QL, RowLin{WSP(bf16, WS_SMALL), 512}, ((const float*)(const GAS float*)F.in[10]) + (size_t)l * QL * 768, nullptr, 768, ((const float*)(const GAS float*)F.in[9]) + l * QL, EpiStore{WSP(bf16, WS_QRAW), 768});
                ngemm<8, false>(F, T, 1024, KVL, RowLin{WSP(bf16, WS_SMALL) + 256, 512}, ((const float*)(const GAS float*)F.in[12]) + (size_t)l * KVL * 1024, nullptr, 1024, ((const float*)(const GAS float*)F.in[11]) + l * KVL, EpiStore{WSP(bf16, WS_KVRAW), 1024});
#endif
            } else if (ph == 3) {
                for (int rep_ = 0; rep_ < REP_E; ++rep_) step_e(F, l);
#if FAST_G
                run_dense(F, WSP(bf16, WS_U), CW, WSP(bf16, WT_CO), T, D, CW, pg8::EpiGate<1>{WSP(bf16, WS_GA), G8P(F)});
#else
                ngemm<8, false>(F, T, D, CW, RowLin{WSP(bf16, WS_U), CW}, ((const float*)(const GAS float*)F.in[15]) + (size_t)l * CW * D, nullptr, D, nullptr, EpiGate1{WSP(bf16, WS_GA)});
#endif
            } else if (ph == 4) { for (int rep_ = 0; rep_ < REP_F; ++rep_) { if (FAST_ATTN && attn_static_ok(F, l)) step_f_fast(F); else step_f(F); }
            } else if (ph == 5) {
#if FAST_H
                run_dense(F, WSP(bf16, WS_O), 512, WSP(bf16, WT_AO), T, D, 512, pg8::EpiGate<2>{WSP(bf16, WS_GA), G8P(F) + (size_t)T * D});
#else
                ngemm<8, false>(F, T, D, 512, RowLin{WSP(bf16, WS_O), 512}, ((const float*)(const GAS float*)F.in[16]) + (size_t)l * 512 * D, nullptr, D, nullptr, EpiGate2{WSP(bf16, WS_GA), GBP(F)});
#endif
            } else if (ph == 6) {
#if FAST_I
                run_dense(F, WSP(bf16, WS_GA), D, WSP(bf16, WT_O), T, D, D, pg8::EpiRes16{l == 0 ? ((const float*)(const GAS float*)F.in[0]) : nullptr, WSP(bf16, WS_X16), MODp + (size_t)l * 2 * 6 * D + 2 * D});
#else
                ngemm<8, false>(F, T, D, D, RowLin{WSP(bf16, WS_GA), D}, ((const float*)(const GAS float*)F.in[17]) + (size_t)l * D * D, nullptr, D, nullptr,
                                EpiRes{l == 0 ? ((const float*)(const GAS float*)F.in[0]) : F.out, F.out, MODp + (size_t)l * 2 * 6 * D + 2 * D});
#endif
            } else if (ph == 7) { for (int rep_ = 1; rep_ < REP_J; ++rep_) step_j(F, l, true); if (USE_OLD_J) step_j_old(F, l); else step_j(F, l);
            } else {
                compute_bases(F, l);
                const LAS unsigned* tb = (const LAS unsigned*)(F.lds + TB_OFF); const LAS unsigned* cnt = tb + 32;
                unsigned* kf = F.ctl + CW_KF + 256 * l;
                pg8::MoeOrderX S; S.MT = (int)__builtin_amdgcn_readfirstlane(tb[17]); S.G = F.G; S.c = F.bid; S.tb = tb; S.cnt = cnt; S.te = (const LAS unsigned*)(F.lds + TE_OFF); S.LIST = WSP(int, WS_LIST); S.kN = 2; S.flags = kf; S.bar = F.ctl + CW_BAR;
                S.A = (const char*)XNp; S.Bt = (const char*)WSP(bf16, WT_GU); S.estride = (size_t)512 * D * 2; S.lda = D * 2; S.K = D; S.nN = 2; S.gather = true; S.mode = 0;
                fresh_tid(F);
                pg8::gemm_phase<pg8::EpiAct, pg8::MoeOrderX, true>(F.lds, F.tid, pg8::Gemm{(unsigned)D * 2u, D}, S, pg8::EpiAct{WSP(bf16, WS_A2), WSP(float, WS_TOKW), kf});
                S.A = (const char*)WSP(bf16, WS_A2); S.Bt = (const char*)WSP(bf16, WT_DN); S.estride = (size_t)D * DE * 2; S.lda = DE * 2; S.K = DE; S.nN = 4; S.gather = false; S.mode = 1;
                fresh_tid(F);
                pg8::gemm_phase<pg8::EpiY8, pg8::MoeOrderX, false>(F.lds, F.tid, pg8::Gemm{(unsigned)DE * 2u, DE}, S, pg8::EpiY8{WSP(unsigned char, WS_Y)});
            }
        }
        if (step_ + 1 < args.hi) for (int rep_ = 0; rep_ < REP_BAR; ++rep_) xcd_barrier(bar);
    }
}

extern "C" void kernel_launch(void* const* d_in, const int* in_sizes, int n_in, void* d_out, int out_size, void* d_ws, size_t ws_size, hipStream_t stream) {
    static int grid = 0;
    if (grid == 0) {
        if (n_in != 26 || in_sizes[0] != T * D || out_size != T * D || ws_size < WS_END) {
            fprintf(stderr, "kernel_launch: unexpected shapes: n_in %d in0 %d out %d ws %zu (need >= %zu)\n", n_in, n_in > 0 ? in_sizes[0] : -1, out_size, ws_size, (size_t)WS_END); grid = -1; return; }
        int dev = 0, cus = 0;
        if (hipGetDevice(&dev) != hipSuccess || hipDeviceGetAttribute(&cus, hipDeviceAttributeMultiprocessorCount, dev) != hipSuccess) { grid = -1; return; }
        if (hipFuncSetAttribute((const void*)mk_fwd, hipFuncAttributeMaxDynamicSharedMemorySize, LDS_BYTES) != hipSuccess) { fprintf(stderr, "kernel_launch: hipFuncSetAttribute failed\n"); grid = -1; return; }
        int per_cu = 0;
        if (hipOccupancyMaxActiveBlocksPerMultiprocessor(&per_cu, (const void*)mk_fwd, NTHREADS, LDS_BYTES) != hipSuccess || per_cu < 1)
            fprintf(stderr, "kernel_launch: note: occupancy query reports %d blocks/CU\n", per_cu);
        (void)hipGetLastError();
        grid = cus;
    }
    if (grid < 0) return;
    if (hipMemsetAsync((char*)d_ws + WS_CTL, 0, CTL_ZERO_BYTES, stream) != hipSuccess) { fprintf(stderr, "kernel_launch: memset failed\n"); return; }
    Args a{};
    for (int i = 0; i < 26; ++i) a.in[i] = (const GAS void*)d_in[i];
    a.out = (GAS float*)d_out; a.ws = (GAS unsigned char*)d_ws;
#if MK_SPLIT
    for (int s = 0; s < NSTEPS; ++s) { a.lo = s; a.hi = s + 1; hipLaunchKernelGGL(mk_fwd, dim3(grid), dim3(NTHREADS), LDS_BYTES, stream, a); }
#else
    a.lo = 0; a.hi = NSTEPS;
    hipLaunchKernelGGL(mk_fwd, dim3(grid), dim3(NTHREADS), LDS_BYTES, stream, a);
#endif
    const hipError_t le = hipPeekAtLastError();
    if (le != hipSuccess) fprintf(stderr, "kernel_launch: launch failed: %s\n", hipGetErrorName(le));
}
```

```cpp
#include <hip/hip_runtime.h>
#include <cstdio>
#include <cstdint>

#ifndef FAST_GEMM
#define FAST_GEMM 1
#endif
#ifndef FAST_B
#define FAST_B FAST_GEMM
#endif
#ifndef FAST_D
#define FAST_D FAST_GEMM
#endif
#ifndef FAST_G
#define FAST_G FAST_GEMM
#endif
#ifndef FAST_H
#define FAST_H FAST_GEMM
#endif
#ifndef FAST_I
#define FAST_I FAST_GEMM
#endif
#ifndef FAST_K
#define FAST_K FAST_GEMM
#endif
#ifndef FAST_L
#define FAST_L FAST_GEMM
#endif
#define FAST_ANY (FAST_B || FAST_D || FAST_G || FAST_H || FAST_I || FAST_K || FAST_L)
#ifndef USE_OLD_J
#define USE_OLD_J 0
#endif
#ifndef DBG_SHFL
#define DBG_SHFL 1
#endif
#ifndef FAST_ATTN
#define FAST_ATTN 1
#endif
#ifndef REP_F
#define REP_F 1
#endif
#ifndef REP_CVT
#define REP_CVT 1
#endif
#ifndef REP_B
#define REP_B 1
#endif
#ifndef REP_C
#define REP_C 1
#endif
#ifndef REP_D
#define REP_D 1
#endif
#ifndef REP_E
#define REP_E 1
#endif
#ifndef REP_K
#define REP_K 1
#endif
#ifndef REP_L
#define REP_L 1
#endif
#ifndef REP_J
#define REP_J 1
#endif
#ifndef REP_A0
#define REP_A0 1
#endif
#ifndef REP_P0
#define REP_P0 1
#endif
#ifndef REP_BAR
#define REP_BAR 1
#endif
#ifndef ATTN_W64
#define ATTN_W64 1
#endif
#ifndef MK_SPLIT
#define MK_SPLIT 0
#endif

#define GAS __attribute__((address_space(1)))
#define LAS __attribute__((address_space(3)))
typedef unsigned short bf16;
typedef unsigned v4u __attribute__((ext_vector_type(4)));
typedef unsigned v2u __attribute__((ext_vector_type(2)));
typedef float f32x4 __attribute__((ext_vector_type(4)));
typedef float f32x2 __attribute__((ext_vector_type(2)));
typedef unsigned short bf16x8 __attribute__((ext_vector_type(8)));
typedef unsigned short bf16x4 __attribute__((ext_vector_type(4)));
typedef GAS unsigned gu32;

constexpr int NB = 2, S = 8192, T = NB * S, D = 1024, H = 8, DQK = 96, DV = 64;
constexpr int NIN = 4000, CW = 512, QL = 256, KVL = 128, NE = 16, DE = 256, NEX = NE + 1;
constexpr float EPS = 1e-6f;
constexpr float QSCALE = 0.10206207261596577f * 1.4426950408889634f;
constexpr float Q8SC = QSCALE * 8.f;
constexpr int NWAVES = 8, NTHREADS = 512;

constexpr size_t MiB = 1u << 20, KiB = 1u << 10;
constexpr size_t WS_CTL = 0, CTL_ZERO_BYTES = 64 * KiB;
constexpr size_t WS_MOD = 1 * MiB;
constexpr size_t WS_TOKS = WS_MOD + 128 * KiB;
constexpr size_t WS_TOKW = WS_TOKS + 128 * KiB;
constexpr size_t WS_RS = WS_TOKW + 128 * KiB;
constexpr size_t WS_ROPE = 2 * MiB;
constexpr size_t WS_LIST = 4 * MiB;
constexpr size_t WS_WT = 5 * MiB;
constexpr size_t WS_XN = 45 * MiB;
constexpr size_t WS_R1 = 109 * MiB;
constexpr size_t WS_R2 = 157 * MiB;
constexpr size_t WS_GA = 173 * MiB;
constexpr size_t WS_X16 = 77 * MiB;
#define G8P(F_) ((unsigned char*)(F_).out)
#define GBP(F_) ((bf16*)((unsigned char*)(F_).out + 32 * MiB))
constexpr size_t WS_U = 205 * MiB;
constexpr size_t WS_K = WS_XN;
constexpr size_t WS_V = 245 * MiB;
constexpr size_t WS_END = 261 * MiB;
constexpr size_t WS_XN8 = 245 * MiB;
constexpr size_t WS_KVRAW = WS_XN, WS_CONV = WS_R1, WS_QRAW = 221 * MiB  , WS_Q = FAST_D ? 221 * MiB   : WS_R1 + 24 * MiB, WS_SMALL = WS_R2, WS_O = 205 * MiB  ;
constexpr size_t WS_A2 = WS_R1;
constexpr size_t WS_Y = WS_R1 + 26 * MiB;
constexpr int SLOTS_MAX = 3 * T + NE * 256;
static_assert(WS_Y + (size_t)SLOTS_MAX * 2048 <= WS_END, "MoE overlay");
constexpr int CW_CNT = 8192, CNT_LS = 2048, CNT_ES = 64;
static_assert((CW_CNT + 2 * CNT_LS) * 4 <= (int)CTL_ZERO_BYTES && (4096 + 3456) * 4 <= (int)CTL_ZERO_BYTES, "control words (barrier region at word 4096, 3456 words; counters) inside the per-call memset");
constexpr int CW_BASE = 192;
constexpr int CW_BAR = 4096;
constexpr int CW_KF = 12288;
static_assert((CW_KF + 2 * 256) * 4 <= (int)CTL_ZERO_BYTES && CW_KF >= CW_CNT + 2 * CNT_LS, "slot-tile flags inside the per-call memset");

#define RLX_AGENT __ATOMIC_RELAXED, __HIP_MEMORY_SCOPE_AGENT
__device__ __forceinline__ unsigned f2bf(float f) { unsigned u = __builtin_bit_cast(unsigned, f); return (u + 0x7fffu + ((u >> 16) & 1u)) >> 16; }
typedef __bf16 hwbf16x2 __attribute__((ext_vector_type(2)));
__device__ __forceinline__ unsigned pk2(float lo, float hi) { f32x2 v = {lo, hi}; hwbf16x2 b = __builtin_convertvector(v, hwbf16x2); return __builtin_bit_cast(unsigned, b); }
__device__ __forceinline__ float bf2f(unsigned short b) { return __builtin_bit_cast(float, (unsigned)b << 16); }
template <int CTRL> __device__ __forceinline__ float dpp_mov(float v) { return __builtin_bit_cast(float, __builtin_amdgcn_update_dpp(0, __builtin_bit_cast(int, v), CTRL, 0xF, 0xF, false)); }
template <int K> __device__ __forceinline__ float xor_lane(float v) {
    if constexpr (K == 1) return dpp_mov<0xB1>(v);
    else if constexpr (K == 2) return dpp_mov<0x4E>(v);
    else return __builtin_bit_cast(float, __builtin_amdgcn_ds_swizzle(__builtin_bit_cast(int, v), (K << 10) | 0x1f)); }
__device__ __forceinline__ float row16_sum_dpp(float v) { v += dpp_mov<0x121>(v); v += dpp_mov<0x122>(v); v += dpp_mov<0x124>(v); v += dpp_mov<0x128>(v); return v; }
__device__ __forceinline__ float add_xor32(float v) {
    auto r = __builtin_amdgcn_permlane32_swap(__builtin_bit_cast(unsigned, v), __builtin_bit_cast(unsigned, v), false, false);
    return __builtin_bit_cast(float, r[0]) + __builtin_bit_cast(float, r[1]); }
__device__ __forceinline__ float bperm_xor(float v, int lane, int k) { return __builtin_bit_cast(float, __builtin_amdgcn_ds_bpermute((lane ^ k) << 2, __builtin_bit_cast(int, v))); }
__device__ __forceinline__ float wave_sum(float v, int lane) {
    v = row16_sum_dpp(v);
    const float r0 = __builtin_bit_cast(float, __builtin_amdgcn_readlane(__builtin_bit_cast(int, v), 0)), r1 = __builtin_bit_cast(float, __builtin_amdgcn_readlane(__builtin_bit_cast(int, v), 16));
    const float r2 = __builtin_bit_cast(float, __builtin_amdgcn_readlane(__builtin_bit_cast(int, v), 32)), r3 = __builtin_bit_cast(float, __builtin_amdgcn_readlane(__builtin_bit_cast(int, v), 48));
    return (r0 + r1) + (r2 + r3);
}
__device__ __forceinline__ unsigned pk4f8(float a, float b, float c, float d) {
    a = __builtin_amdgcn_fmed3f(a, -448.f, 448.f); b = __builtin_amdgcn_fmed3f(b, -448.f, 448.f); c = __builtin_amdgcn_fmed3f(c, -448.f, 448.f); d = __builtin_amdgcn_fmed3f(d, -448.f, 448.f);
    int w = __builtin_amdgcn_cvt_pk_fp8_f32(a, b, 0, false); w = __builtin_amdgcn_cvt_pk_fp8_f32(c, d, w, true); return (unsigned)w; }
__device__ __forceinline__ int v8t_kpos(int kappa) { return 32 * ((kappa >> 2) & 1) + 16 * (kappa >> 5) + 4 * ((kappa >> 3) & 3) + (kappa & 3); }
__device__ __forceinline__ float sigmoidf_(float x) { return __builtin_amdgcn_rcpf(1.f + __expf(-x)); }

#define XB_TMO      128
#define XB_XCNT(j)  (256  + 64 * (j))
#define XB_XSUB(j)  (1280 + 64 * (j))
#define XB_XGEN(j)  (2304 + 64 * (j))
#define XB_TOP      3328
#define XB_TOPGEN   3392
#define XCD_BAR_WORDS 3456
#define XB_SPIN_CAP (1u << 22)
__device__ __forceinline__ unsigned xb_ld(unsigned* p)              { return __hip_atomic_load(p, __ATOMIC_RELAXED, __HIP_MEMORY_SCOPE_AGENT); }
__device__ __forceinline__ unsigned xb_add(unsigned* p, unsigned v) { return __hip_atomic_fetch_add(p, v, __ATOMIC_RELAXED, __HIP_MEMORY_SCOPE_AGENT); }
__device__ __forceinline__ unsigned xb_xcc_id() { return (unsigned)__builtin_amdgcn_s_getreg((3 << 11) | 20) & 0xFu; }
#define XB_SPIN(cond, bar) do { unsigned _sp = 0; while (cond) { __builtin_amdgcn_s_sleep(1); \
    if ((++_sp & 255u) == 0u) { if (xb_ld(&(bar)[XB_TMO])) break; if (_sp > XB_SPIN_CAP) { atomicAdd(&(bar)[XB_TMO], 1u); break; } } } } while (0)
struct XcdBarrier { unsigned* bar; unsigned x; volatile LAS unsigned* st; };
__device__ __forceinline__ XcdBarrier xcd_barrier_post(unsigned* bar, volatile LAS unsigned* st) {
    XcdBarrier b; b.bar = bar; b.x = xb_xcc_id(); b.st = st;
    if (threadIdx.x == 0) (void)xb_add(&bar[XB_XCNT(b.x)], 1u);
    return b;
}
__device__ __forceinline__ void xcd_barrier_complete(unsigned* bar, unsigned x, unsigned& nloc, unsigned& nx) {
    const unsigned G = gridDim.x * gridDim.y * gridDim.z;
    unsigned sum, cnt, mine, sp = 0u;
    for (;;) {
        sum = 0u; cnt = 0u; mine = 0u;
#pragma unroll
        for (unsigned j = 0; j < 16; ++j) { const unsigned c = xb_ld(&bar[XB_XCNT(j)]); sum += c; cnt += (c > 0u) ? 1u : 0u; mine = (j == x) ? c : mine; }
        if (sum == G) break;
        __builtin_amdgcn_s_sleep(1);
        if ((++sp & 255u) == 0u) { if (xb_ld(&bar[XB_TMO])) break; if (sp > XB_SPIN_CAP) { atomicAdd(&bar[XB_TMO], 1u); break; } }
    }
    nloc = mine > 0u ? mine : 1u; nx = cnt > 0u ? cnt : 1u;
}
__device__ __forceinline__ void xcd_barrier(const XcdBarrier& b) {
    asm volatile("s_waitcnt vmcnt(0)" ::: "memory");
    __syncthreads();
    if (threadIdx.x == 0) {
        unsigned* bar = b.bar;
        __builtin_amdgcn_s_waitcnt(0);
        unsigned nloc = b.st[0], nx = b.st[1];
        if (nloc == 0u) { xcd_barrier_complete(bar, b.x, nloc, nx); b.st[0] = nloc; b.st[1] = nx; }
        const unsigned old = xb_add(&bar[XB_XSUB(b.x)], 1u);
        const unsigned gen = old / nloc;
        if (old + 1u == (gen + 1u) * nloc) {
            __builtin_amdgcn_fence(__ATOMIC_RELEASE, "agent");
            asm volatile("s_waitcnt vmcnt(0)" ::: "memory");
            const unsigned og = xb_add(&bar[XB_TOP], 1u);
            const unsigned tg = og / nx;
            if (og + 1u == (tg + 1u) * nx) xb_add(&bar[XB_TOPGEN], 1u);
            else XB_SPIN(xb_ld(&bar[XB_TOPGEN]) == tg, bar);
            __builtin_amdgcn_fence(__ATOMIC_ACQUIRE, "agent");
            xb_add(&bar[XB_XGEN(b.x)], 1u);
            asm volatile("s_waitcnt vmcnt(0)" ::: "memory");
        } else {
            XB_SPIN(xb_ld(&bar[XB_XGEN(b.x)]) == gen, bar);
            __builtin_amdgcn_fence(__ATOMIC_ACQUIRE, "agent");
            asm volatile("s_waitcnt vmcnt(0)" ::: "memory");
        }
    }
    __syncthreads();
}

constexpr int LDS_BYTES = 155648;
constexpr int MISC_OFF = 131072 + 320;
struct Frame {
    LAS unsigned char* lds; volatile LAS unsigned* MISC; unsigned* ctl;
    int tid, lane, wave, bid, G;
    const GAS void* const* in;
    float* out; GAS unsigned char* ws;
};
#define WSP(T_, off) ((T_*)(GAS T_*)(F.ws + (off)))
__device__ __forceinline__ void fresh_tid(Frame& F) { unsigned z_ = 0u; asm volatile("" : "+v"(z_)); const int l_ = (int)__builtin_amdgcn_mbcnt_hi(~0u, __builtin_amdgcn_mbcnt_lo(~0u, z_)); F.lane = l_; F.tid = F.wave * 64 + l_; }

__constant__ double INVF[16] = {1.0, 0.5623413251903491, 0.31622776601683794, 0.1778279410038923, 0.1, 0.05623413251903491, 0.03162277660168379, 0.01778279410038923,
                                0.01, 0.005623413251903491, 0.0031622776601683794, 0.001778279410038923, 0.001, 0.0005623413251903491, 0.00031622776601683794, 0.0001778279410038923};

constexpr size_t WS_MODP = WS_XN;
__device__ __forceinline__ void step_p0(Frame& F) {
    fresh_tid(F);
    const int gw = F.bid * NWAVES + F.wave, NGW = F.G * NWAVES;
    float* MODP = WSP(float, WS_MODP);
    const float* cin = (const float*)F.in[1];
    LAS float* sct = (LAS float*)(F.lds + 131072 + 2048);
    for (int i = F.tid; i < 2 * D; i += NTHREADS) { const float c_ = cin[i]; sct[i] = c_ / (1.f + __expf(-c_)); }
    __syncthreads();
    for (int it = gw; it < 2 * 96 * 16; it += NGW) {
        const int kc = it & 15, nc = (it >> 4) % 96, l = (it >> 4) / 96, n = nc * 64 + F.lane;
        const float* w = ((const float*)(const GAS float*)F.in[3]) + ((size_t)l * D + kc * 64) * (6 * D) + n;
        float a0 = 0.f, a1 = 0.f;
#pragma unroll
        for (int kh = 0; kh < 2; ++kh) {
            float wv[32];
#pragma unroll
            for (int k = 0; k < 32; ++k) wv[k] = __builtin_nontemporal_load(&w[(size_t)(kh * 32 + k) * (6 * D)]);
#pragma unroll
            for (int k4 = 0; k4 < 8; ++k4) {
                const f32x4 s0 = *(const LAS f32x4*)(sct + kc * 64 + kh * 32 + 4 * k4), s1 = *(const LAS f32x4*)(sct + D + kc * 64 + kh * 32 + 4 * k4);
#pragma unroll
                for (int e = 0; e < 4; ++e) { a0 += s0[e] * wv[4 * k4 + e]; a1 += s1[e] * wv[4 * k4 + e]; }
            }
        }
        MODP[((size_t)(kc * 2 + l) * 2 + 0) * 6 * D + n] = a0; MODP[((size_t)(kc * 2 + l) * 2 + 1) * 6 * D + n] = a1;
    }
    f32x2* ROPE = WSP(f32x2, WS_ROPE);
    for (int idx = F.bid * NTHREADS + F.tid; idx < T * 16; idx += F.G * NTHREADS) {
        const int t = idx >> 4, i = idx & 15;
        const double a = (double)((const int*)(const GAS int*)F.in[2])[t] * INVF[i];
        const double n = __builtin_rint(a * 0.15915494309189535);
        double r = __builtin_fma(-n, 6.283185307179586, a); r = __builtin_fma(-n, 2.4492935982947064e-16, r);
        const float rf = (float)r;
        f32x2 cs; cs.x = __cosf(rf); cs.y = __sinf(rf);
        ROPE[idx] = cs;
    }
}
__device__ __forceinline__ void step_p0_reduce(Frame& F) {
    fresh_tid(F);
    const float* MODP = WSP(float, WS_MODP); float* MOD = WSP(float, WS_MOD);
    for (int idx = F.bid * NTHREADS + F.tid; idx < 2 * 2 * 6 * D; idx += F.G * NTHREADS) {
        const int n = idx % (6 * D), l = idx / (2 * 6 * D);
        float a = ((const float*)(const GAS float*)F.in[4])[l * 6 * D + n];
#pragma unroll
        for (int kc = 0; kc < 16; ++kc) a += MODP[(size_t)kc * (2 * 2 * 6 * D) + idx];
        MOD[idx] = a;
    }
}

__device__ __forceinline__ void step_a(Frame& F, int l) {
    fresh_tid(F);
    const int gw = F.bid * NWAVES + F.wave, NGW = F.G * NWAVES;
    const float* MOD = WSP(float, WS_MOD);
    const unsigned char* Y = WSP(unsigned char, WS_Y);
    const int* TOKS = WSP(int, WS_TOKS);
    bf16* XN = WSP(bf16, WS_XN); bf16* X16 = WSP(bf16, WS_X16); unsigned char* XN8 = WSP(unsigned char, WS_XN8);
    const int NP = T / 2, c0 = 4 * F.lane;
    const unsigned* base = F.ctl + CW_BASE + 32 * (l > 0 ? l - 1 : 0);
    f32x4 g[4], gg[4], sc[4], sh[4];
#pragma unroll
    for (int j = 0; j < 4; ++j) { g[j] = l < 2 ? *(const f32x4*)(((const float*)(const GAS float*)F.in[5]) + l * D + c0 + 256 * j) : (f32x4){0.f, 0.f, 0.f, 0.f}; gg[j] = sc[j] = sh[j] = (f32x4){0.f, 0.f, 0.f, 0.f}; }
    int bcur = -1;
    unsigned slc[2][3], sln[2][3];
#pragma unroll
    for (int k = 0; k < 2; ++k)
#pragma unroll
        for (int i = 0; i < 3; ++i) slc[k][i] = sln[k][i] = 0u;
#define A_IDX(P_, SL_) { const v4u tk_ = *(const v4u*)(TOKS + 4 * (P_)); const unsigned bs_ = base[16]; \
        SL_[0][0] = base[tk_.x >> 16] + (unsigned)(tk_.x & 0xffff); SL_[0][1] = base[tk_.y >> 16] + (unsigned)(tk_.y & 0xffff); SL_[0][2] = bs_ + 2u * (unsigned)(P_); \
        SL_[1][0] = base[tk_.z >> 16] + (unsigned)(tk_.z & 0xffff); SL_[1][1] = base[tk_.w >> 16] + (unsigned)(tk_.w & 0xffff); SL_[1][2] = bs_ + 2u * (unsigned)(P_) + 1u; }
    if (l > 0 && gw < NP) A_IDX(gw, slc)
    for (int p = gw; p < NP; p += NGW) {
        const int r0 = 2 * p, b = r0 / S;
        f32x4 v[2][4];
        v2u xo[2][4]; unsigned ya[2][4], yb[2][4], yc[2][4];
        if (l == 0) {
#pragma unroll
            for (int k = 0; k < 2; ++k)
#pragma unroll
                for (int j = 0; j < 4; ++j) v[k][j] = __builtin_nontemporal_load((const f32x4*)(((const float*)(const GAS float*)F.in[0]) + (size_t)(r0 + k) * D + c0 + 256 * j));
        } else {
#pragma unroll
            for (int k = 0; k < 2; ++k)
#pragma unroll
                for (int j = 0; j < 4; ++j) { const int col = c0 + 256 * j;
                    xo[k][j] = __builtin_nontemporal_load((const v2u*)(X16 + (size_t)(r0 + k) * D + col));
                    ya[k][j] = __builtin_nontemporal_load((const unsigned*)(Y + (size_t)slc[k][0] * D + col)); yb[k][j] = __builtin_nontemporal_load((const unsigned*)(Y + (size_t)slc[k][1] * D + col)); yc[k][j] = __builtin_nontemporal_load((const unsigned*)(Y + (size_t)slc[k][2] * D + col)); }
            if (p + NGW < NP) A_IDX(p + NGW, sln)
        }
        if (b != bcur) { bcur = b;
            const float* gt2 = MOD + ((l > 0 ? l - 1 : 0) * 2 + b) * 6 * D + 5 * D; const float* m = MOD + ((l < 2 ? l : 0) * 2 + b) * 6 * D;
#pragma unroll
            for (int j = 0; j < 4; ++j) { if (l > 0) gg[j] = *(const f32x4*)(gt2 + c0 + 256 * j); if (l < 2) { sc[j] = *(const f32x4*)(m + D + c0 + 256 * j); sh[j] = *(const f32x4*)(m + c0 + 256 * j); } } }
        if (l > 0) {
#pragma unroll
            for (int k = 0; k < 2; ++k)
#pragma unroll
                for (int j = 0; j < 4; ++j) { f32x4 r;
                    const f32x2 a0 = __builtin_amdgcn_cvt_pk_f32_fp8((int)ya[k][j], false), a1 = __builtin_amdgcn_cvt_pk_f32_fp8((int)ya[k][j], true);
                    const f32x2 b0 = __builtin_amdgcn_cvt_pk_f32_fp8((int)yb[k][j], false), b1 = __builtin_amdgcn_cvt_pk_f32_fp8((int)yb[k][j], true);
                    const f32x2 c0_ = __builtin_amdgcn_cvt_pk_f32_fp8((int)yc[k][j], false), c1_ = __builtin_amdgcn_cvt_pk_f32_fp8((int)yc[k][j], true);
                    const f32x4 ys = (f32x4){a0.x + b0.x + c0_.x, a0.y + b0.y + c0_.y, a1.x + b1.x + c1_.x, a1.y + b1.y + c1_.y};
                    const f32x4 xf = (f32x4){bf2f((unsigned short)(xo[k][j].x & 0xffffu)), bf2f((unsigned short)(xo[k][j].x >> 16)), bf2f((unsigned short)(xo[k][j].y & 0xffffu)), bf2f((unsigned short)(xo[k][j].y >> 16))};
#pragma unroll
                    for (int e = 0; e < 4; ++e) r[e] = xf[e] + gg[j][e] * ys[e];
                    v[k][j] = r;
                    if (l == 2) __builtin_nontemporal_store(r, (f32x4*)(F.out + (size_t)(r0 + k) * D + c0 + 256 * j));
                    else { v2u o_; o_.x = pk2(r[0], r[1]); o_.y = pk2(r[2], r[3]); __builtin_nontemporal_store(o_, (v2u*)(X16 + (size_t)(r0 + k) * D + c0 + 256 * j)); } }
        }
        if (l < 2) {
            float ss[2];
#pragma unroll
            for (int k = 0; k < 2; ++k) { float a = 0.f;
#pragma unroll
                for (int j = 0; j < 4; ++j) a += (v[k][j].x * v[k][j].x + v[k][j].y * v[k][j].y) + (v[k][j].z * v[k][j].z + v[k][j].w * v[k][j].w);
                ss[k] = a; }
            const float rs0 = 1.0f / sqrtf(wave_sum(ss[0], F.lane) * (1.f / D) + EPS), rs1 = 1.0f / sqrtf(wave_sum(ss[1], F.lane) * (1.f / D) + EPS);
#pragma unroll
            for (int k = 0; k < 2; ++k) { const float rs = k ? rs1 : rs0;
#pragma unroll
                for (int j = 0; j < 4; ++j) { f32x4 h;
#pragma unroll
                    for (int e = 0; e < 4; ++e) h[e] = v[k][j][e] * rs * g[j][e] * (1.f + sc[j][e]) + sh[j][e];
                    v2u o; o.x = pk2(h[0], h[1]); o.y = pk2(h[2], h[3]);
                    *(v2u*)(XN + (size_t)(r0 + k) * D + c0 + 256 * j) = o; *(unsigned*)(XN8 + (size_t)(r0 + k) * D + c0 + 256 * j) = pk4f8(h[0], h[1], h[2], h[3]); } }
        }
#pragma unroll
        for (int k = 0; k < 2; ++k)
#pragma unroll
            for (int i = 0; i < 3; ++i) slc[k][i] = sln[k][i];
    }
#undef A_IDX
}

template <int RPT, bool DUAL, class RowF, class Epi>
__device__ __forceinline__ void ngemm(Frame& F, int M, int N, int K, RowF rowf, const float* W, const float* W2, int ldw, const float* ksc, Epi epi) {
    fresh_tid(F);
    const int gw = F.bid * NWAVES + F.wave, NGW = F.G * NWAVES;
    const int nrb = (M + RPT - 1) / RPT, ncc = (N + 255) / 256;
    for (int it = gw; it < nrb * ncc; it += NGW) {
        const int cc = it / nrb, rb = it % nrb;
        const int n4 = cc * 256 + F.lane * 4;
        const bool nv = n4 < N;
        const int n4c = nv ? n4 : 0;
        const bf16* rp[RPT];
#pragma unroll
        for (int r = 0; r < RPT; ++r) { int m = rb * RPT + r; if (m >= M) m = M - 1; rp[r] = rowf(m); }
        f32x4 acc[RPT], acc2[RPT];
#pragma unroll
        for (int r = 0; r < RPT; ++r) { acc[r] = (f32x4){0.f, 0.f, 0.f, 0.f}; acc2[r] = (f32x4){0.f, 0.f, 0.f, 0.f}; }
        for (int k0 = 0; k0 < K; k0 += 8) {
            bf16x8 a[RPT];
#pragma unroll
            for (int r = 0; r < RPT; ++r) a[r] = *(const bf16x8*)(rp[r] + k0);
#pragma unroll
            for (int j = 0; j < 8; ++j) {
                f32x4 w = *(const f32x4*)(W + (size_t)(k0 + j) * ldw + n4c);
                f32x4 w2 = (f32x4){0.f, 0.f, 0.f, 0.f};
                if (DUAL) w2 = *(const f32x4*)(W2 + (size_t)(k0 + j) * ldw + n4c);
                if (ksc) { const float s = ksc[k0 + j]; w = w * s; }
#pragma unroll
                for (int r = 0; r < RPT; ++r) { const float av = bf2f(a[r][j]); acc[r] += av * w; if (DUAL) acc2[r] += av * w2; }
            }
        }
        if (nv) {
#pragma unroll
            for (int r = 0; r < RPT; ++r) { const int m = rb * RPT + r; if (m < M) epi(m, n4, acc[r], acc2[r]); }
        }
    }
}
struct RowLin { const bf16* p; int ld; __device__ __forceinline__ const bf16* operator()(int m) const { return p + (size_t)m * ld; } };
struct RowGather { const bf16* p; int ld; const int* list; __device__ __forceinline__ const bf16* operator()(int m) const { return p + (size_t)(list[m] >> 1) * ld; } };
__device__ __forceinline__ void st_bf4(bf16* p, f32x4 v) { v2u o; o.x = pk2(v[0], v[1]); o.y = pk2(v[2], v[3]); *(v2u*)p = o; }

struct EpiProj { bf16 *conv, *small, *ga, *gb;
    __device__ __forceinline__ void operator()(int m, int n, f32x4 a, f32x4) const {
        bf16* p;
        if (n < 1536) p = conv + (size_t)m * 1536 + n;
        else if (n < 1952) p = small + (size_t)m * 512 + (n - 1536);
        else if (n < 2976) p = ga + (size_t)m * 1024 + (n - 1952);
        else p = gb + (size_t)m * 1024 + (n - 2976);
        st_bf4(p, a);
    } };
struct EpiStore { bf16* o; int ld; __device__ __forceinline__ void operator()(int m, int n, f32x4 a, f32x4) const { st_bf4(o + (size_t)m * ld + n, a); } };
struct EpiGate1 { bf16* ga; __device__ __forceinline__ void operator()(int m, int n, f32x4 a, f32x4) const {
        bf16* p = ga + (size_t)m * D + n; const bf16x4 g = *(const bf16x4*)p; f32x4 r;
#pragma unroll
        for (int e = 0; e < 4; ++e) r[e] = sigmoidf_(bf2f(g[e])) * a[e];
        st_bf4(p, r); } };
struct EpiGate2 { bf16* t1; const bf16* gb; __device__ __forceinline__ void operator()(int m, int n, f32x4 a, f32x4) const {
        bf16* p = t1 + (size_t)m * D + n; const bf16x4 t = *(const bf16x4*)p; const bf16x4 g = *(const bf16x4*)(gb + (size_t)m * D + n); f32x4 r;
#pragma unroll
        for (int e = 0; e < 4; ++e) r[e] = bf2f(t[e]) + sigmoidf_(bf2f(g[e])) * a[e];
        st_bf4(p, r); } };
struct EpiRes { const float* xin; float* out; const float* gt; __device__ __forceinline__ void operator()(int m, int n, f32x4 a, f32x4) const {
        const f32x4 xv = *(const f32x4*)(xin + (size_t)m * D + n); const f32x4 g = *(const f32x4*)(gt + (m / S) * 6 * D + n);
        *(f32x4*)(out + (size_t)m * D + n) = xv + g * a; } };
struct EpiAct { bf16* a2; size_t slot0; const int* list; const float* tokw; __device__ __forceinline__ void operator()(int m, int n, f32x4 g, f32x4 u) const {
        const float w = list ? tokw[list[m]] : 1.f; f32x4 r;
#pragma unroll
        for (int e = 0; e < 4; ++e) r[e] = g[e] / (1.f + __expf(-g[e])) * u[e] * w;
        st_bf4(a2 + (slot0 + m) * DE + n, r); } };

__device__ __forceinline__ void step_c(Frame& F, int l) {
    fresh_tid(F);
    const bf16* CONV = WSP(bf16, WS_CONV); bf16* U = WSP(bf16, WS_U);
    const int gt = F.bid * NTHREADS + F.tid, NT = F.G * NTHREADS;
    for (int idx = gt; idx < T * 64; idx += NT) {
        const int t = idx >> 6, c8 = (idx & 63) * 8, s = t % S;
        const bf16* r0 = CONV + (size_t)t * 1024;
        const bf16x8 cb = __builtin_nontemporal_load((const bf16x8*)(r0 + c8)), p0v = *(const bf16x8*)(r0 + 512 + c8);
        bf16x8 pmv = (bf16x8){0, 0, 0, 0, 0, 0, 0, 0}, ppv = pmv;
        if (s > 0) pmv = *(const bf16x8*)(r0 - 1024 + 512 + c8);
        if (s < S - 1) ppv = *(const bf16x8*)(r0 + 1024 + 512 + c8);
        const float* cw = ((const float*)(const GAS float*)F.in[8]) + l * 3 * CW + c8;
        float o[8];
#pragma unroll
        for (int e = 0; e < 8; ++e) o[e] = bf2f(cb[e]) * (cw[e] * bf2f(pmv[e]) + cw[CW + e] * bf2f(p0v[e]) + cw[2 * CW + e] * bf2f(ppv[e]));
        v2u w; w.x = pk4f8(o[0], o[1], o[2], o[3]); w.y = pk4f8(o[4], o[5], o[6], o[7]);
        *(v2u*)((unsigned char*)U + (size_t)t * 1024 + 512 + c8) = w;
    }
}

__device__ __forceinline__ float row16_sum(float v) { return row16_sum_dpp(v); }
__device__ __forceinline__ void step_e(Frame& F, int l) {
    fresh_tid(F);
    const bf16* QRAW = WSP(bf16, WS_QRAW); const bf16* SMALL = WSP(bf16, WS_SMALL);
    const f32x2* ROPE = WSP(f32x2, WS_ROPE);
    unsigned char* Q8 = WSP(unsigned char, WS_Q);
    const int gw = F.bid * NWAVES + F.wave, NGW = F.G * NWAVES;
    const int j = F.lane & 15, hh = F.lane >> 4; const bool act = j < 12, isrope = j >= 8 && act;
    const int jc = act ? j : 0;
    const float* gqp = ((const float*)(const GAS float*)F.in[13]) + l * DQK + 8 * jc;
    const f32x4 gq0 = *(const f32x4*)gqp, gq1 = *(const f32x4*)(gqp + 4);
    const float sgn = (j >= 10) ? 1.f : -1.f;
    for (int t = gw; t < T; t += NGW) {
        const int b = t / S, s = t % S;
        const bf16x8 xs = *(const bf16x8*)(SMALL + (size_t)t * 512 + 8 * (F.lane & 31));
        const f32x4* rp = (const f32x4*)(ROPE + (size_t)t * 16 + 8 * (j & 1));
        const f32x4 r0 = rp[0], r1 = rp[1], r2 = rp[2], r3 = rp[3];
        bf16x8 xq[2];
#pragma unroll
        for (int pass = 0; pass < 2; ++pass) xq[pass] = *(const bf16x8*)(QRAW + (size_t)t * 768 + (pass * 4 + hh) * 96 + 8 * jc);
        float sq = 0.f;
#pragma unroll
        for (int e = 0; e < 8; ++e) { const float f = bf2f(xs[e]); sq += f * f; }
        const float rsq = 1.0f / sqrtf(wave_sum(F.lane < 32 ? sq : 0.f, F.lane) * (1.f / 256.f) + EPS);
        float cs[8], sn[8];
        cs[0] = r0.x; sn[0] = r0.y; cs[1] = r0.z; sn[1] = r0.w; cs[2] = r1.x; sn[2] = r1.y; cs[3] = r1.z; sn[3] = r1.w;
        cs[4] = r2.x; sn[4] = r2.y; cs[5] = r2.z; sn[5] = r2.w; cs[6] = r3.x; sn[6] = r3.y; cs[7] = r3.z; sn[7] = r3.w;
#pragma unroll
        for (int pass = 0; pass < 2; ++pass) {
            const int h = pass * 4 + hh;
            const size_t orow = ((size_t)(b * H + h) * S + s);
            const bf16x8 x = xq[pass];
            float v[8]; float ss = 0.f;
#pragma unroll
            for (int e = 0; e < 8; ++e) { v[e] = act ? bf2f(x[e]) * rsq : 0.f; ss += v[e] * v[e]; }
            const float r = 1.0f / sqrtf(row16_sum(ss) * (1.f / 96.f) + EPS);
#pragma unroll
            for (int e = 0; e < 8; ++e) v[e] = v[e] * r * (e < 4 ? gq0[e & 3] : gq1[e & 3]);
#pragma unroll
            for (int e = 0; e < 8; ++e) { const float p = xor_lane<2>(v[e]); if (isrope) v[e] = v[e] * cs[e] + sgn * p * sn[e]; }
            if (act) { v2u w; w.x = pk4f8(v[0] * Q8SC, v[1] * Q8SC, v[2] * Q8SC, v[3] * Q8SC); w.y = pk4f8(v[4] * Q8SC, v[5] * Q8SC, v[6] * Q8SC, v[7] * Q8SC);
                *(v2u*)(Q8 + orow * 96 + 8 * j) = w; }
        }
    }
}

__device__ __forceinline__ void step_f(Frame& F) {
    fresh_tid(F);
    const unsigned char* Q8 = WSP(unsigned char, WS_Q); const unsigned char* K8 = WSP(unsigned char, WS_K); const unsigned char* V8T = WSP(unsigned char, WS_V); bf16* O = WSP(bf16, WS_O);
    const int gw = F.bid * NWAVES + F.wave, NGW = F.G * NWAVES;
    for (int it = gw; it < NB * H * (S / 64) * 2; it += NGW) {
        const int half = it & 1, it2 = it >> 1;
        const int bh = it2 / (S / 64), qi = (it2 % (S / 64)) * 64 + F.lane;
        v4u q[6]; float o[32];
#pragma unroll
        for (int c = 0; c < 6; ++c) q[c] = *(const v4u*)(Q8 + ((size_t)bh * S + qi) * 96 + c * 16);
#pragma unroll
        for (int d = 0; d < 32; ++d) o[d] = 0.f;
        float m = -1e30f, lsum = 0.f;
        const unsigned char* kb = K8 + (size_t)bh * S * 96; const unsigned char* vtb = V8T + (size_t)bh * (S / 64) * 4096 + (size_t)(half * 32) * 64;
#pragma unroll 1
        for (int j = 0; j < S; j += 2) {
            float sc[2];
#pragma unroll
            for (int i = 0; i < 2; ++i) { float a = 0.f;
#pragma unroll
                for (int c = 0; c < 6; ++c) { const v4u kk = *(const v4u*)(kb + (size_t)(j + i) * 96 + c * 16);
#pragma unroll
                    for (int w = 0; w < 4; ++w) { const int qw = (int)(w == 0 ? q[c].x : w == 1 ? q[c].y : w == 2 ? q[c].z : q[c].w), kw = (int)(w == 0 ? kk.x : w == 1 ? kk.y : w == 2 ? kk.z : kk.w);
                        const f32x2 q0 = __builtin_amdgcn_cvt_pk_f32_fp8(qw, false), q1 = __builtin_amdgcn_cvt_pk_f32_fp8(qw, true), k0 = __builtin_amdgcn_cvt_pk_f32_fp8(kw, false), k1 = __builtin_amdgcn_cvt_pk_f32_fp8(kw, true);
                        a += (q0.x * k0.x + q0.y * k0.y) + (q1.x * k1.x + q1.y * k1.y); } }
                sc[i] = a * 0.125f; asm volatile("" ::: "memory"); }
            const float mn = fmaxf(m, fmaxf(sc[0], sc[1]));
            const float alpha = exp2f(m - mn), p0 = exp2f(sc[0] - mn), p1 = exp2f(sc[1] - mn);
            lsum = lsum * alpha + (p0 + p1); m = mn;
            const unsigned char* vt0 = vtb + (size_t)(j >> 6) * 4096 + v8t_kpos(j & 63); const unsigned char* vt1 = vtb + (size_t)((j + 1) >> 6) * 4096 + v8t_kpos((j + 1) & 63);
#pragma unroll
            for (int c = 0; c < 32; ++c) { const float v0 = __builtin_amdgcn_cvt_f32_fp8((int)vt0[c * 64], 0), v1 = __builtin_amdgcn_cvt_f32_fp8((int)vt1[c * 64], 0);
                o[c] = o[c] * alpha + (p0 * v0 + p1 * v1); if ((c & 7) == 7) asm volatile("" ::: "memory"); }
        }
        const float inv = 1.f / lsum; const int b = bh / H, h = bh % H;
        unsigned char* op = (unsigned char*)O + ((size_t)(b * S + qi)) * 1024 + h * 64 + half * 32;
        const float i64 = inv * 64.f;
#pragma unroll
        for (int c = 0; c < 2; ++c) { v4u w; w.x = pk4f8(o[c * 16] * i64, o[c * 16 + 1] * i64, o[c * 16 + 2] * i64, o[c * 16 + 3] * i64); w.y = pk4f8(o[c * 16 + 4] * i64, o[c * 16 + 5] * i64, o[c * 16 + 6] * i64, o[c * 16 + 7] * i64);
            w.z = pk4f8(o[c * 16 + 8] * i64, o[c * 16 + 9] * i64, o[c * 16 + 10] * i64, o[c * 16 + 11] * i64); w.w = pk4f8(o[c * 16 + 12] * i64, o[c * 16 + 13] * i64, o[c * 16 + 14] * i64, o[c * 16 + 15] * i64); *(v4u*)(op + c * 16) = w; }
    }
}

__device__ __forceinline__ void route16(float myscore, float mybiased, int& e1, int& e2, float& w1, float& w2) {
    float scv[16], bi[16];
#pragma unroll
    for (int e = 0; e < 16; ++e) { scv[e] = __builtin_bit_cast(float, __builtin_amdgcn_readlane(__builtin_bit_cast(int, myscore), e)); bi[e] = __builtin_bit_cast(float, __builtin_amdgcn_readlane(__builtin_bit_cast(int, mybiased), e)); }
    float gs[4];
#pragma unroll
    for (int g = 0; g < 4; ++g) { const float a0 = bi[4 * g], a1 = bi[4 * g + 1], a2 = bi[4 * g + 2], a3 = bi[4 * g + 3];
        const float h1 = fmaxf(a0, a1), l1 = fminf(a0, a1), h2 = fmaxf(a2, a3), l2 = fminf(a2, a3);
        gs[g] = fmaxf(h1, h2) + fmaxf(fminf(h1, h2), fmaxf(l1, l2)); }
    int sg = 0; float bg = gs[0];
#pragma unroll
    for (int g = 1; g < 4; ++g) if (gs[g] > bg) { bg = gs[g]; sg = g; }
    float b0 = bi[0], b1 = bi[1], b2 = bi[2], b3 = bi[3], s0 = scv[0], s1 = scv[1], s2 = scv[2], s3 = scv[3];
#pragma unroll
    for (int g = 1; g < 4; ++g) if (sg == g) { b0 = bi[4 * g]; b1 = bi[4 * g + 1]; b2 = bi[4 * g + 2]; b3 = bi[4 * g + 3]; s0 = scv[4 * g]; s1 = scv[4 * g + 1]; s2 = scv[4 * g + 2]; s3 = scv[4 * g + 3]; }
    int i1 = 0; float m1 = b0, q1 = s0;
    if (b1 > m1) { m1 = b1; i1 = 1; q1 = s1; } if (b2 > m1) { m1 = b2; i1 = 2; q1 = s2; } if (b3 > m1) { m1 = b3; i1 = 3; q1 = s3; }
    int i2 = -1; float m2 = -1e30f, q2 = 0.f;
    if (i1 != 0 && (i2 < 0 || b0 > m2)) { m2 = b0; i2 = 0; q2 = s0; }
    if (i1 != 1 && (i2 < 0 || b1 > m2)) { m2 = b1; i2 = 1; q2 = s1; }
    if (i1 != 2 && (i2 < 0 || b2 > m2)) { m2 = b2; i2 = 2; q2 = s2; }
    if (i1 != 3 && (i2 < 0 || b3 > m2)) { m2 = b3; i2 = 3; q2 = s3; }
    const float inv = 1.f / (q1 + q2);
    e1 = 4 * sg + i1; e2 = 4 * sg + i2; w1 = q1 * inv; w2 = q2 * inv;
}
__device__ __forceinline__ void step_j(Frame& F, int l, bool dry = false) {
    fresh_tid(F);
    const bf16* X16 = WSP(bf16, WS_X16);
    const int gw = F.bid * NWAVES + F.wave, NGW = F.G * NWAVES;
    const float* MOD = WSP(float, WS_MOD); bf16* XN = WSP(bf16, WS_XN);
    int* TOKS = WSP(int, WS_TOKS); float* TOKW = WSP(float, WS_TOKW); int* LIST = WSP(int, WS_LIST);
    unsigned* cnt = F.ctl + CW_CNT + CNT_LS * l;
    LAS unsigned* lcnt = (LAS unsigned*)(F.lds + 65536); LAS unsigned* gbase = lcnt + 16; LAS unsigned* rinfo = (LAS unsigned*)(F.lds + 65536 + 256) + F.wave * 512;
    if (F.tid < 16) lcnt[F.tid] = 0u;
    constexpr int JW1 = 65536 + 256 + NWAVES * 2048, JW2 = 131072 + 2048, JWS = 47, JWROW = 1040;
    static_assert(JW1 + JWS * JWROW <= 131072 && JW2 + (64 - JWS) * JWROW <= LDS_BYTES, "router stage layout");
    { const f32x4* wg = (const f32x4*)(const GAS f32x4*)F.in[18];
      f32x4 wv[8];
#pragma unroll
      for (int i = 0; i < 8; ++i) wv[i] = wg[F.tid + i * NTHREADS];
#pragma unroll
      for (int i = 0; i < 8; ++i) { const int f = F.tid + i * NTHREADS, col = f >> 2, e0 = 4 * (f & 3), q_ = col >> 8, c_ = col & 255;
#pragma unroll
          for (int k = 0; k < 4; ++k) { const int r_ = q_ * 16 + e0 + k; *(LAS float*)(F.lds + (r_ < JWS ? JW1 + r_ * JWROW : JW2 + (r_ - JWS) * JWROW) + 4 * c_) = wv[i][k]; } } }
    __syncthreads();
    int ri = 0;
    LAS float* hrow = (LAS float*)(F.lds + F.wave * 8192);
    const int re = F.lane & 15, rq = F.lane >> 4;
    const LAS float* wl = (const LAS float*)(F.lds + (F.lane < JWS ? JW1 + F.lane * JWROW : JW2 + (F.lane - JWS) * JWROW));
    const float brt = ((const float*)(const GAS float*)F.in[19])[re];
    for (int row0 = gw; row0 < T; row0 += 2 * NGW) {
        const bool has1 = row0 + NGW < T;
        int rr[2]; rr[0] = row0; rr[1] = has1 ? row0 + NGW : row0;
        f32x4 v[2][4], g[4], sc[2][4], sh[2][4];
#pragma unroll
        for (int k = 0; k < 2; ++k)
#pragma unroll
            for (int j = 0; j < 4; ++j) { const bf16x4 t = __builtin_nontemporal_load((const bf16x4*)(X16 + (size_t)rr[k] * D + 4 * F.lane + 256 * j)); v[k][j] = (f32x4){bf2f(t[0]), bf2f(t[1]), bf2f(t[2]), bf2f(t[3])}; }
#pragma unroll
        for (int j = 0; j < 4; ++j) g[j] = *(const f32x4*)(((const float*)(const GAS float*)F.in[6]) + l * D + 4 * F.lane + 256 * j);
#pragma unroll
        for (int k = 0; k < 2; ++k) { const float* m = MOD + (l * 2 + rr[k] / S) * 6 * D;
#pragma unroll
            for (int j = 0; j < 4; ++j) { sc[k][j] = *(const f32x4*)(m + 4 * D + 4 * F.lane + 256 * j); sh[k][j] = *(const f32x4*)(m + 3 * D + 4 * F.lane + 256 * j); } }
        float ss[2];
#pragma unroll
        for (int k = 0; k < 2; ++k) { float a = 0.f;
#pragma unroll
            for (int j = 0; j < 4; ++j) a += (v[k][j].x * v[k][j].x + v[k][j].y * v[k][j].y) + (v[k][j].z * v[k][j].z + v[k][j].w * v[k][j].w);
            ss[k] = a; }
        const float rs0 = 1.0f / sqrtf(wave_sum(ss[0], F.lane) * (1.f / D) + EPS), rs1 = 1.0f / sqrtf(wave_sum(ss[1], F.lane) * (1.f / D) + EPS);
#pragma unroll
        for (int k = 0; k < 2; ++k) { const float rs = k ? rs1 : rs0;
#pragma unroll
            for (int j = 0; j < 4; ++j) { const int col = 4 * F.lane + 256 * j; f32x4 hh;
#pragma unroll
                for (int e = 0; e < 4; ++e) hh[e] = v[k][j][e] * rs * g[j][e] * (1.f + sc[k][j][e]) + sh[k][j][e];
                if (k == 0 || has1) *(unsigned*)((unsigned char*)XN + (size_t)rr[k] * D + col) = pk4f8(hh[0], hh[1], hh[2], hh[3]);
                *(LAS f32x4*)(hrow + k * 1024 + col) = hh; } }
        asm volatile("s_waitcnt lgkmcnt(0)" ::: "memory");
        float a0 = 0.f, a1 = 0.f, a2 = 0.f, a3 = 0.f, c0 = 0.f, c1 = 0.f, c2 = 0.f, c3 = 0.f;
#pragma unroll 4
        for (int c = 0; c < 256; c += 4) {
            const f32x4 h0 = *(const LAS f32x4*)(hrow + rq * 256 + c), h1 = *(const LAS f32x4*)(hrow + 1024 + rq * 256 + c);
            const f32x4 w4 = *(const LAS f32x4*)(wl + c); const float w0 = w4.x, w1 = w4.y, w2 = w4.z, w3 = w4.w;
            a0 += h0.x * w0; a1 += h0.y * w1; a2 += h0.z * w2; a3 += h0.w * w3;
            c0 += h1.x * w0; c1 += h1.y * w1; c2 += h1.z * w2; c3 += h1.w * w3;
        }
        float z0 = (a0 + a1) + (a2 + a3), z1 = (c0 + c1) + (c2 + c3);
        z0 += bperm_xor(z0, F.lane, 16); z0 += bperm_xor(z0, F.lane, 32);
        z1 += bperm_xor(z1, F.lane, 16); z1 += bperm_xor(z1, F.lane, 32);
        asm volatile("s_waitcnt lgkmcnt(0)" ::: "memory");
#pragma unroll
        for (int k = 0; k < 2; ++k) {
            const float z = k ? z1 : z0;
            const float myscore = 1.f / (1.f + expf(-z)), mybiased = myscore + brt;
            int e1, e2; float w1, w2;
            route16(myscore, mybiased, e1, e2, w1, w2);
            if (F.lane == 0 && !dry && (k == 0 || has1)) {
                const unsigned p1 = __hip_atomic_fetch_add(lcnt + e1, 1u, __ATOMIC_RELAXED, __HIP_MEMORY_SCOPE_WORKGROUP), p2 = __hip_atomic_fetch_add(lcnt + e2, 1u, __ATOMIC_RELAXED, __HIP_MEMORY_SCOPE_WORKGROUP);
                LAS unsigned* r = rinfo + ri * 8;
                r[0] = (unsigned)rr[k]; r[1] = (unsigned)e1; r[2] = p1; r[3] = (unsigned)e2; r[4] = p2; r[5] = __builtin_bit_cast(unsigned, w1); r[6] = __builtin_bit_cast(unsigned, w2);
            }
            if (k == 0 || has1) ++ri;
        }
    }
    if (dry) return;
    __syncthreads();
    if (F.tid < 16) { const unsigned c = lcnt[F.tid]; gbase[F.tid] = c ? __hip_atomic_fetch_add(cnt + CNT_ES * F.tid, c, RLX_AGENT) : 0u; }
    __syncthreads();
    if (F.lane < ri) {
        const LAS unsigned* r = rinfo + F.lane * 8;
        const int row = (int)r[0], e1 = (int)r[1], e2 = (int)r[3]; const unsigned p1 = gbase[e1] + r[2], p2 = gbase[e2] + r[4];
        LIST[(size_t)e1 * T + p1] = 2 * row; LIST[(size_t)e2 * T + p2] = 2 * row + 1;
        TOKS[2 * row] = (e1 << 16) | (int)p1; TOKS[2 * row + 1] = (e2 << 16) | (int)p2;
        TOKW[2 * row] = __builtin_bit_cast(float, r[5]); TOKW[2 * row + 1] = __builtin_bit_cast(float, r[6]);
    }
}

__device__ __forceinline__ void step_j_old(Frame& F, int l, bool dry = false) {
    fresh_tid(F);
    const int gw = F.bid * NWAVES + F.wave, NGW = F.G * NWAVES;
    const float* MOD = WSP(float, WS_MOD); bf16* XN = WSP(bf16, WS_XN);
    int* TOKS = WSP(int, WS_TOKS); float* TOKW = WSP(float, WS_TOKW); int* LIST = WSP(int, WS_LIST);
    unsigned* cnt = F.ctl + CW_CNT + CNT_LS * l;
    for (int row = gw; row < T; row += NGW) {
        const int b = row / S;
        float ss = 0.f;
#pragma unroll
        for (int j = 0; j < 4; ++j) { const f32x4 vv = *(const f32x4*)(F.out + (size_t)row * D + 4 * F.lane + 256 * j); ss += (vv.x * vv.x + vv.y * vv.y) + (vv.z * vv.z + vv.w * vv.w); }
        const float rs = 1.0f / sqrtf(wave_sum(ss, F.lane) * (1.f / D) + EPS);
        const float* m = MOD + (l * 2 + b) * 6 * D;
        float lg[16];
#pragma unroll
        for (int e = 0; e < 16; ++e) lg[e] = 0.f;
#pragma unroll 1
        for (int j = 0; j < 4; ++j) {
            const int col = 4 * F.lane + 256 * j;
            const f32x4 vj = *(const f32x4*)(F.out + (size_t)row * D + col);
            const f32x4 g = *(const f32x4*)(((const float*)(const GAS float*)F.in[6]) + l * D + col), sc = *(const f32x4*)(m + 4 * D + col), sh = *(const f32x4*)(m + 3 * D + col);
            f32x4 hh;
#pragma unroll
            for (int e = 0; e < 4; ++e) hh[e] = vj[e] * rs * g[e] * (1.f + sc[e]) + sh[e];
            v2u o; o.x = pk2(hh[0], hh[1]); o.y = pk2(hh[2], hh[3]);
            *(v2u*)(XN + (size_t)row * D + col) = o;
#pragma unroll
            for (int i = 0; i < 4; ++i) {
                const float* wr = ((const float*)(const GAS float*)F.in[18]) + (size_t)(col + i) * NE;
                const f32x4 w0 = *(const f32x4*)(wr), w1 = *(const f32x4*)(wr + 4), w2 = *(const f32x4*)(wr + 8), w3 = *(const f32x4*)(wr + 12);
#pragma unroll
                for (int e = 0; e < 4; ++e) { lg[e] += hh[i] * w0[e]; lg[4 + e] += hh[i] * w1[e]; lg[8 + e] += hh[i] * w2[e]; lg[12 + e] += hh[i] * w3[e]; }
            }
        }
        float scv[16], bi[16];
#pragma unroll
        for (int e = 0; e < 16; ++e) { const float z = wave_sum(lg[e], F.lane); scv[e] = 1.f / (1.f + expf(-z)); bi[e] = scv[e] + ((const float*)(const GAS float*)F.in[19])[e]; }
        float gs[4];
#pragma unroll
        for (int g = 0; g < 4; ++g) { const float a0 = bi[4 * g], a1 = bi[4 * g + 1], a2 = bi[4 * g + 2], a3 = bi[4 * g + 3];
            const float h1 = fmaxf(a0, a1), l1 = fminf(a0, a1), h2 = fmaxf(a2, a3), l2 = fminf(a2, a3);
            gs[g] = fmaxf(h1, h2) + fmaxf(fminf(h1, h2), fmaxf(l1, l2)); }
        int sg = 0; float bg = gs[0];
#pragma unroll
        for (int g = 1; g < 4; ++g) if (gs[g] > bg) { bg = gs[g]; sg = g; }
        float b0 = bi[0], b1 = bi[1], b2 = bi[2], b3 = bi[3], s0 = scv[0], s1 = scv[1], s2 = scv[2], s3 = scv[3];
#pragma unroll
        for (int g = 1; g < 4; ++g) if (sg == g) { b0 = bi[4 * g]; b1 = bi[4 * g + 1]; b2 = bi[4 * g + 2]; b3 = bi[4 * g + 3]; s0 = scv[4 * g]; s1 = scv[4 * g + 1]; s2 = scv[4 * g + 2]; s3 = scv[4 * g + 3]; }
        int i1 = 0; float m1 = b0, q1 = s0;
        if (b1 > m1) { m1 = b1; i1 = 1; q1 = s1; } if (b2 > m1) { m1 = b2; i1 = 2; q1 = s2; } if (b3 > m1) { m1 = b3; i1 = 3; q1 = s3; }
        int i2 = -1; float m2 = -1e30f, q2 = 0.f;
        if (i1 != 0 && (i2 < 0 || b0 > m2)) { m2 = b0; i2 = 0; q2 = s0; }
        if (i1 != 1 && (i2 < 0 || b1 > m2)) { m2 = b1; i2 = 1; q2 = s1; }
        if (i1 != 2 && (i2 < 0 || b2 > m2)) { m2 = b2; i2 = 2; q2 = s2; }
        if (i1 != 3 && (i2 < 0 || b3 > m2)) { m2 = b3; i2 = 3; q2 = s3; }
        if (F.lane == 0 && !dry) {
            const int e1 = 4 * sg + i1, e2 = 4 * sg + i2; const float inv = 1.f / (q1 + q2);
            const unsigned p1 = __hip_atomic_fetch_add(cnt + CNT_ES * e1, 1u, RLX_AGENT), p2 = __hip_atomic_fetch_add(cnt + CNT_ES * e2, 1u, RLX_AGENT);
            LIST[(size_t)e1 * T + p1] = 2 * row; LIST[(size_t)e2 * T + p2] = 2 * row + 1;
            TOKS[2 * row] = (e1 << 16) | (int)p1; TOKS[2 * row + 1] = (e2 << 16) | (int)p2;
            TOKW[2 * row] = q1 * inv; TOKW[2 * row + 1] = q2 * inv;
        }
    }
}


namespace att {
typedef short sbf16x8 __attribute__((ext_vector_type(8)));
typedef short s16x4 __attribute__((ext_vector_type(4)));
typedef float f32x16 __attribute__((ext_vector_type(16)));
constexpr int NW = 8, QBLK = 32, KVBLK = 64;
constexpr int SHM_K = KVBLK * 256, SHM_V = KVBLK * 256;
constexpr int OFF_V = 0, OFF_K = 2 * SHM_V, OFF_WS = 2 * SHM_V + 2 * SHM_K, OFF_OST = OFF_WS + NW * 64 * 4, LDS_NEED = OFF_OST + NW * 4096;
static_assert(LDS_NEED <= 131072, "attention LDS");
constexpr float THR2 = 11.f;
#define ATT_KSWZ(row, colB) ((row) * 256 + ((colB) ^ (((row) & 15) << 4)))
#define ATT_SBAR() __builtin_amdgcn_sched_barrier(0)
__device__ __forceinline__ int crow(int r, int hi) { return (r & 3) + 8 * (r >> 2) + 4 * hi; }
__device__ __forceinline__ void partialSM(f32x16& p0, f32x16& p1) {
#pragma unroll
    for (int r = 0; r < 16; ++r) p0[r] = __builtin_amdgcn_exp2f(p0[r]);
}
__device__ __forceinline__ void finishSM(f32x16& p0, f32x16& p1, float& l_reg, sbf16x8& pa0, sbf16x8& pa1, sbf16x8& pa2, sbf16x8& pa3) {
#pragma unroll
    for (int r = 0; r < 16; ++r) p1[r] = __builtin_amdgcn_exp2f(p1[r]);
    float ps0 = 0.f, ps1 = 0.f;
#pragma unroll
    for (int r = 0; r < 16; ++r) { ps0 += p0[r]; ps1 += p1[r]; }
    l_reg += ps0 + ps1;
#define ATT_PK4(P, BASE, OUT) do { unsigned a0 = pk2(P[BASE + 0], P[BASE + 1]), a1 = pk2(P[BASE + 2], P[BASE + 3]);   \
    unsigned b0 = pk2(P[BASE + 4], P[BASE + 5]), b1 = pk2(P[BASE + 6], P[BASE + 7]);                              \
    auto r0 = __builtin_amdgcn_permlane32_swap(a0, b0, false, false); auto r1 = __builtin_amdgcn_permlane32_swap(a1, b1, false, false); \
    v4u w = {r0[0], r1[0], r0[1], r1[1]}; OUT = __builtin_bit_cast(sbf16x8, w); } while (0)
    ATT_PK4(p0, 0, pa0); ATT_PK4(p0, 8, pa1); ATT_PK4(p1, 0, pa2); ATT_PK4(p1, 8, pa3);
#undef ATT_PK4
}
__device__ __forceinline__ void qkt(f32x16& p0, f32x16& p1, const LAS char* Ks, const sbf16x8* qr, int r32, int hi) {
    asm volatile("" : "+v"(r32));
    p0 = f32x16{}; p1 = f32x16{};
    sbf16x8 c0 = *(const LAS sbf16x8*)(Ks + ATT_KSWZ(r32, (hi * 8) * 2)), c1 = *(const LAS sbf16x8*)(Ks + ATT_KSWZ(32 + r32, (hi * 8) * 2));
#pragma unroll
    for (int d0 = 0; d0 < 6; ++d0) {
        sbf16x8 n0 = c0, n1 = c1;
        if (d0 < 5) { const int cb = ((d0 + 1) * 16 + hi * 8) * 2; n0 = *(const LAS sbf16x8*)(Ks + ATT_KSWZ(r32, cb)); n1 = *(const LAS sbf16x8*)(Ks + ATT_KSWZ(32 + r32, cb)); }
        p0 = __builtin_amdgcn_mfma_f32_32x32x16_bf16(c0, qr[d0], p0, 0, 0, 0);
        p1 = __builtin_amdgcn_mfma_f32_32x32x16_bf16(c1, qr[d0], p1, 0, 0, 0);
        c0 = n0; c1 = n1;
    }
}
__device__ __forceinline__ int v_st(int k, int c) { const int kk = (k & ~0xC) | ((k & 4) << 1) | ((k & 8) >> 1); return ((kk >> 3) * 4 + (c >> 5)) * 512 + ((kk & 7) * 32 + (c & 31)) * 2; }
__device__ __forceinline__ int v_rd_base(int lane) { return ((lane & 3) << 3) | (((lane >> 2) & 3) << 6) | (((lane >> 4) & 1) << 5) | (((lane >> 5) & 1) << 8); }
constexpr int v_rd_off(int d0, int ks, int half) { return d0 * 512 + ks * 4096 + half * 2048; }
template <int OFF> __device__ __forceinline__ s16x4 tr_read(int vb) { s16x4 r; asm volatile("ds_read_b64_tr_b16 %0, %1 offset:%2" : "=&v"(r) : "v"(vb), "i"(OFF) : "memory"); return r; }
template <int D0> __device__ __forceinline__ void pv_one(f32x16& od, int vb, sbf16x8 pa0, sbf16x8 pa1, sbf16x8 pa2, sbf16x8 pa3) {
    const s16x4 l0 = tr_read<v_rd_off(D0, 0, 0)>(vb), h0 = tr_read<v_rd_off(D0, 0, 1)>(vb), l1 = tr_read<v_rd_off(D0, 1, 0)>(vb), h1 = tr_read<v_rd_off(D0, 1, 1)>(vb);
    const s16x4 l2 = tr_read<v_rd_off(D0, 2, 0)>(vb), h2 = tr_read<v_rd_off(D0, 2, 1)>(vb), l3 = tr_read<v_rd_off(D0, 3, 0)>(vb), h3 = tr_read<v_rd_off(D0, 3, 1)>(vb);
    asm volatile("s_waitcnt lgkmcnt(0)" ::: "memory"); ATT_SBAR();
#define ATT_PK(L, H) (sbf16x8){L[0], L[1], L[2], L[3], H[0], H[1], H[2], H[3]}
    od = __builtin_amdgcn_mfma_f32_32x32x16_bf16(pa0, ATT_PK(l0, h0), od, 0, 0, 0);
    od = __builtin_amdgcn_mfma_f32_32x32x16_bf16(pa1, ATT_PK(l1, h1), od, 0, 0, 0);
    od = __builtin_amdgcn_mfma_f32_32x32x16_bf16(pa2, ATT_PK(l2, h2), od, 0, 0, 0);
    od = __builtin_amdgcn_mfma_f32_32x32x16_bf16(pa3, ATT_PK(l3, h3), od, 0, 0, 0);
#undef ATT_PK
}
__device__ __forceinline__ void pv2(f32x16* o, int vb, sbf16x8 pa0, sbf16x8 pa1, sbf16x8 pa2, sbf16x8 pa3) { pv_one<0>(o[0], vb, pa0, pa1, pa2, pa3); pv_one<1>(o[1], vb, pa0, pa1, pa2, pa3); }

__device__ __forceinline__ void attn_unit(const bf16* Qb, const bf16* Kh, const bf16* Vh, bf16* Ob, int seq, LAS char* lds, int tid) {
    const int wid = __builtin_amdgcn_readfirstlane(tid >> 6), lane = tid & 63, r32 = lane & 31, hi = lane >> 5; int lane2;
    LAS char* V_lds = lds + OFF_V; LAS char* K_lds = lds + OFF_K;
    LAS float* ws = (LAS float*)(lds + OFF_WS) + wid * 64; LAS float* li_l = ws;
    float l_reg = 0.f; f32x16 o[2]; o[0] = f32x16{}; o[1] = f32x16{}; sbf16x8 qr[6];
    const bf16* Qw = Qb + (size_t)(wid * QBLK + r32) * 96 + hi * 8;
#pragma unroll
    for (int d0 = 0; d0 < 6; ++d0) qr[d0] = *(const GAS sbf16x8*)((const GAS bf16*)Qw + d0 * 16);
    const int kc1 = 512 + (tid & 255), kr0 = tid / 12, kq0 = (tid % 12) * 8, kr1 = kc1 / 12, kq1 = (kc1 % 12) * 8;
    const int ksto0 = ATT_KSWZ(kr0, kq0 * 2), ksto1 = ATT_KSWZ(kr1, kq1 * 2);
    const int vr = tid >> 3, vq = (tid & 7) * 8, vsto = v_st(vr, vq);
    const int vb0 = (int)(unsigned)(size_t)V_lds + v_rd_base(lane);
    const unsigned ko0 = (unsigned)(kr0 * 96 + kq0) * 2u, ko1 = (unsigned)(kr1 * 96 + kq1) * 2u, vo = (unsigned)(vr * 64 + vq) * 2u;
    sbf16x8 sk0[2], sk1[2], sv[2];
    const GAS char* Kg = (const GAS char*)Kh; const GAS char* Vg = (const GAS char*)Vh;
#define ATT_SLOAD(i, k0) do { sk0[i] = *(const GAS sbf16x8*)(Kg + (ko0 + (unsigned)(k0) * 192u)); sk1[i] = *(const GAS sbf16x8*)(Kg + (ko1 + (unsigned)(k0) * 192u)); sv[i] = *(const GAS sbf16x8*)(Vg + (vo + (unsigned)(k0) * 128u)); } while (0)
#define ATT_SWRITE(b, i) do { *(LAS sbf16x8*)(K_lds + (b) * SHM_K + ksto0) = sk0[i]; *(LAS sbf16x8*)(K_lds + (b) * SHM_K + ksto1) = sk1[i]; *(LAS sbf16x8*)(V_lds + (b) * SHM_V + vsto) = sv[i]; } while (0)
#define ATT_SWAIT() asm volatile("s_waitcnt vmcnt(3)" ::: "memory")
    f32x16 pA0, pA1, pB0, pB1; sbf16x8 pa0, pa1, pa2, pa3; const int NT = seq / KVBLK;
    ATT_SLOAD(0, 0); asm volatile("s_waitcnt vmcnt(0)" ::: "memory"); ATT_SWRITE(0, 0); __syncthreads();
    qkt(pA0, pA1, K_lds, qr, r32, hi); partialSM(pA0, pA1);
    ATT_SLOAD(1, KVBLK); if (2 < NT) ATT_SLOAD(0, 2 * KVBLK);
    ATT_SWAIT(); ATT_SWRITE(1, 1); __syncthreads();
#pragma unroll 1
    for (int j = 1; j + 1 < NT; j += 2) {
        ATT_SBAR(); qkt(pB0, pB1, K_lds + SHM_K, qr, r32, hi);
        finishSM(pA0, pA1, l_reg, pa0, pa1, pa2, pa3); ATT_SBAR();
        ATT_SLOAD(1, (j + 2) * KVBLK); ATT_SBAR();
        pv2(o, vb0, pa0, pa1, pa2, pa3); partialSM(pB0, pB1);
        __syncthreads(); ATT_SWAIT(); ATT_SWRITE(0, 0);
        __syncthreads();
        ATT_SBAR(); qkt(pA0, pA1, K_lds, qr, r32, hi);
        finishSM(pB0, pB1, l_reg, pa0, pa1, pa2, pa3); ATT_SBAR();
        if (j + 3 < NT) ATT_SLOAD(0, (j + 3) * KVBLK); ATT_SBAR();
        pv2(o, vb0 + SHM_V, pa0, pa1, pa2, pa3); partialSM(pA0, pA1);
        __syncthreads(); ATT_SWAIT(); ATT_SWRITE(1, 1);
        __syncthreads();
    }
    ATT_SBAR(); qkt(pB0, pB1, K_lds + SHM_K, qr, r32, hi);
    finishSM(pA0, pA1, l_reg, pa0, pa1, pa2, pa3); ATT_SBAR();
    pv2(o, vb0, pa0, pa1, pa2, pa3); partialSM(pB0, pB1);
    __syncthreads();
    finishSM(pB0, pB1, l_reg, pa0, pa1, pa2, pa3); ATT_SBAR();
    pv2(o, vb0 + SHM_V, pa0, pa1, pa2, pa3);
    { auto rr = __builtin_amdgcn_permlane32_swap(__float_as_uint(l_reg), __float_as_uint(l_reg), false, false); l_reg = __uint_as_float(rr[0]) + __uint_as_float(rr[1]); }
    { unsigned z_ = 0u; asm volatile("" : "+v"(z_)); lane2 = (int)__builtin_amdgcn_mbcnt_hi(~0u, __builtin_amdgcn_mbcnt_lo(~0u, z_)); }
    const int r32e = lane2 & 31, hie = lane2 >> 5;
    if (hie == 0) li_l[r32e] = l_reg; asm volatile("s_waitcnt lgkmcnt(0)" ::: "memory");
    float rli[16];
#pragma unroll
    for (int r = 0; r < 16; ++r) rli[r] = __builtin_amdgcn_rcpf(li_l[crow(r, hie)]);
    LAS bf16* stg = (LAS bf16*)(lds + OFF_OST) + wid * 2048;
#pragma unroll
    for (int r = 0; r < 16; ++r) { const int orow = crow(r, hie);
#pragma unroll
        for (int d0 = 0; d0 < 2; ++d0) stg[orow * 64 + d0 * 32 + r32e] = (bf16)(pk2(o[d0][r] * rli[r], 0.f) & 0xffffu); }
    asm volatile("s_waitcnt lgkmcnt(0)" ::: "memory");
    bf16* Ow = Ob + (size_t)(wid * QBLK) * 512;
#pragma unroll
    for (int i = 0; i < 4; ++i) { const int row = i * 8 + (lane2 >> 3), ch = lane2 & 7; const v4u v = *(const LAS v4u*)(stg + row * 64 + ch * 8); *(GAS v4u*)((GAS bf16*)Ow + (size_t)row * 512 + ch * 8) = v; }
    asm volatile("s_waitcnt lgkmcnt(0)" ::: "memory");
#undef ATT_SLOAD
#undef ATT_SWRITE
#undef ATT_SWAIT
}
__device__ __forceinline__ void softmax_pack(f32x16& p0, f32x16& p1, float& l_reg, sbf16x8& pa0, sbf16x8& pa1, sbf16x8& pa2, sbf16x8& pa3) {
#pragma unroll
    for (int r = 0; r < 16; ++r) p0[r] = __builtin_amdgcn_exp2f(p0[r]);
#pragma unroll
    for (int r = 0; r < 16; ++r) p1[r] = __builtin_amdgcn_exp2f(p1[r]);
    float ps0 = 0.f, ps1 = 0.f;
#pragma unroll
    for (int r = 0; r < 16; ++r) { ps0 += p0[r]; ps1 += p1[r]; }
    l_reg += ps0 + ps1;
#define ATT_PK4(P, BASE, OUT) do { unsigned a0 = pk2(P[BASE + 0], P[BASE + 1]), a1 = pk2(P[BASE + 2], P[BASE + 3]);   \
    unsigned b0 = pk2(P[BASE + 4], P[BASE + 5]), b1 = pk2(P[BASE + 6], P[BASE + 7]);                              \
    auto r0 = __builtin_amdgcn_permlane32_swap(a0, b0, false, false); auto r1 = __builtin_amdgcn_permlane32_swap(a1, b1, false, false); \
    v4u w = {r0[0], r1[0], r0[1], r1[1]}; OUT = __builtin_bit_cast(sbf16x8, w); } while (0)
    ATT_PK4(p0, 0, pa0); ATT_PK4(p0, 8, pa1); ATT_PK4(p1, 0, pa2); ATT_PK4(p1, 8, pa3);
#undef ATT_PK4
}
__device__ __forceinline__ void qkt2(f32x16& x0, f32x16& x1, f32x16& y0, f32x16& y1, const LAS char* Ks, const sbf16x8* qx, const sbf16x8* qy, int r32, int hi) {
    asm volatile("" : "+v"(r32));
    x0 = f32x16{}; x1 = f32x16{}; y0 = f32x16{}; y1 = f32x16{};
    sbf16x8 c0 = *(const LAS sbf16x8*)(Ks + ATT_KSWZ(r32, (hi * 8) * 2)), c1 = *(const LAS sbf16x8*)(Ks + ATT_KSWZ(32 + r32, (hi * 8) * 2));
#pragma unroll
    for (int d0 = 0; d0 < 6; ++d0) {
        sbf16x8 n0 = c0, n1 = c1;
        if (d0 < 5) { const int cb = ((d0 + 1) * 16 + hi * 8) * 2; n0 = *(const LAS sbf16x8*)(Ks + ATT_KSWZ(r32, cb)); n1 = *(const LAS sbf16x8*)(Ks + ATT_KSWZ(32 + r32, cb)); }
        x0 = __builtin_amdgcn_mfma_f32_32x32x16_bf16(c0, qx[d0], x0, 0, 0, 0);
        x1 = __builtin_amdgcn_mfma_f32_32x32x16_bf16(c1, qx[d0], x1, 0, 0, 0);
        y0 = __builtin_amdgcn_mfma_f32_32x32x16_bf16(c0, qy[d0], y0, 0, 0, 0);
        y1 = __builtin_amdgcn_mfma_f32_32x32x16_bf16(c1, qy[d0], y1, 0, 0, 0);
        c0 = n0; c1 = n1;
    }
}
template <int D0> __device__ __forceinline__ void pv_one2(f32x16& ox, f32x16& oy, int vb, const sbf16x8 (&px)[4], const sbf16x8 (&py)[4]) {
    const s16x4 l0 = tr_read<v_rd_off(D0, 0, 0)>(vb), h0 = tr_read<v_rd_off(D0, 0, 1)>(vb), l1 = tr_read<v_rd_off(D0, 1, 0)>(vb), h1 = tr_read<v_rd_off(D0, 1, 1)>(vb);
    const s16x4 l2 = tr_read<v_rd_off(D0, 2, 0)>(vb), h2 = tr_read<v_rd_off(D0, 2, 1)>(vb), l3 = tr_read<v_rd_off(D0, 3, 0)>(vb), h3 = tr_read<v_rd_off(D0, 3, 1)>(vb);
    asm volatile("s_waitcnt lgkmcnt(0)" ::: "memory"); ATT_SBAR();
#define ATT_PK(L, H) (sbf16x8){L[0], L[1], L[2], L[3], H[0], H[1], H[2], H[3]}
    ox = __builtin_amdgcn_mfma_f32_32x32x16_bf16(px[0], ATT_PK(l0, h0), ox, 0, 0, 0);
    oy = __builtin_amdgcn_mfma_f32_32x32x16_bf16(py[0], ATT_PK(l0, h0), oy, 0, 0, 0);
    ox = __builtin_amdgcn_mfma_f32_32x32x16_bf16(px[1], ATT_PK(l1, h1), ox, 0, 0, 0);
    oy = __builtin_amdgcn_mfma_f32_32x32x16_bf16(py[1], ATT_PK(l1, h1), oy, 0, 0, 0);
    ox = __builtin_amdgcn_mfma_f32_32x32x16_bf16(px[2], ATT_PK(l2, h2), ox, 0, 0, 0);
    oy = __builtin_amdgcn_mfma_f32_32x32x16_bf16(py[2], ATT_PK(l2, h2), oy, 0, 0, 0);
    ox = __builtin_amdgcn_mfma_f32_32x32x16_bf16(px[3], ATT_PK(l3, h3), ox, 0, 0, 0);
    oy = __builtin_amdgcn_mfma_f32_32x32x16_bf16(py[3], ATT_PK(l3, h3), oy, 0, 0, 0);
#undef ATT_PK
}
__device__ __forceinline__ void softmax_half(f32x16& p, float& l_reg, sbf16x8& pa, sbf16x8& pb) {
#pragma unroll
    for (int r = 0; r < 16; ++r) p[r] = __builtin_amdgcn_exp2f(p[r]);
    float ps0 = 0.f, ps1 = 0.f;
#pragma unroll
    for (int r = 0; r < 8; ++r) { ps0 += p[r]; ps1 += p[8 + r]; }
    l_reg += ps0 + ps1;
    { v4u w; w.x = pk2(p[0], p[1]); w.y = pk2(p[2], p[3]); w.z = pk2(p[4], p[5]); w.w = pk2(p[6], p[7]); pa = __builtin_bit_cast(sbf16x8, w); }
    { v4u w; w.x = pk2(p[8], p[9]); w.y = pk2(p[10], p[11]); w.z = pk2(p[12], p[13]); w.w = pk2(p[14], p[15]); pb = __builtin_bit_cast(sbf16x8, w); }
}
template <int ROW0> __device__ __forceinline__ void qk_half(f32x16& x, f32x16& y, const LAS char* Ks, const sbf16x8* qx, const sbf16x8* qy, int r32, int hi) {
    asm volatile("" : "+v"(r32));
    x = f32x16{}; y = f32x16{};
    sbf16x8 c = *(const LAS sbf16x8*)(Ks + ATT_KSWZ(ROW0 + r32, (hi * 8) * 2));
#pragma unroll
    for (int d0 = 0; d0 < 6; ++d0) {
        sbf16x8 n = c;
        if (d0 < 5) n = *(const LAS sbf16x8*)(Ks + ATT_KSWZ(ROW0 + r32, ((d0 + 1) * 16 + hi * 8) * 2));
        x = __builtin_amdgcn_mfma_f32_32x32x16_bf16(c, qx[d0], x, 0, 0, 0);
        y = __builtin_amdgcn_mfma_f32_32x32x16_bf16(c, qy[d0], y, 0, 0, 0);
        c = n;
    }
}
template <int KS0> __device__ __forceinline__ void pv_half(f32x16* ox, f32x16* oy, int vb, sbf16x8 pxa, sbf16x8 pxb, sbf16x8 pya, sbf16x8 pyb) {
    const s16x4 l00 = tr_read<v_rd_off(0, KS0, 0)>(vb), h00 = tr_read<v_rd_off(0, KS0, 1)>(vb), l01 = tr_read<v_rd_off(0, KS0 + 1, 0)>(vb), h01 = tr_read<v_rd_off(0, KS0 + 1, 1)>(vb);
    const s16x4 l10 = tr_read<v_rd_off(1, KS0, 0)>(vb), h10 = tr_read<v_rd_off(1, KS0, 1)>(vb), l11 = tr_read<v_rd_off(1, KS0 + 1, 0)>(vb), h11 = tr_read<v_rd_off(1, KS0 + 1, 1)>(vb);
    asm volatile("s_waitcnt lgkmcnt(0)" ::: "memory"); ATT_SBAR();
#define ATT_PK(L, H) (sbf16x8){L[0], L[1], L[2], L[3], H[0], H[1], H[2], H[3]}
    ox[0] = __builtin_amdgcn_mfma_f32_32x32x16_bf16(ATT_PK(l00, h00), pxa, ox[0], 0, 0, 0);
    oy[0] = __builtin_amdgcn_mfma_f32_32x32x16_bf16(ATT_PK(l00, h00), pya, oy[0], 0, 0, 0);
    ox[1] = __builtin_amdgcn_mfma_f32_32x32x16_bf16(ATT_PK(l10, h10), pxa, ox[1], 0, 0, 0);
    oy[1] = __builtin_amdgcn_mfma_f32_32x32x16_bf16(ATT_PK(l10, h10), pya, oy[1], 0, 0, 0);
    ox[0] = __builtin_amdgcn_mfma_f32_32x32x16_bf16(ATT_PK(l01, h01), pxb, ox[0], 0, 0, 0);
    oy[0] = __builtin_amdgcn_mfma_f32_32x32x16_bf16(ATT_PK(l01, h01), pyb, oy[0], 0, 0, 0);
    ox[1] = __builtin_amdgcn_mfma_f32_32x32x16_bf16(ATT_PK(l11, h11), pxb, ox[1], 0, 0, 0);
    oy[1] = __builtin_amdgcn_mfma_f32_32x32x16_bf16(ATT_PK(l11, h11), pyb, oy[1], 0, 0, 0);
#undef ATT_PK
}
constexpr int OFF2_V = 0, OFF2_K = 2 * SHM_V, OFF2_WS = 2 * SHM_V + 2 * SHM_K;
__device__ __forceinline__ void attn_unit2(const bf16* Qb, const bf16* Kh, const bf16* Vh, bf16* Ob, int seq, LAS char* lds, int tid) {
    const int wid = __builtin_amdgcn_readfirstlane(tid >> 6), lane = tid & 63, r32 = lane & 31, hi = lane >> 5; int lane2;
    LAS char* V_lds = lds + OFF2_V; LAS char* K_lds = lds + OFF2_K;
    LAS float* ws = (LAS float*)(lds + OFF2_WS) + wid * 64;
    float lx = 0.f, ly = 0.f; f32x16 ox[2], oy[2]; ox[0] = f32x16{}; ox[1] = f32x16{}; oy[0] = f32x16{}; oy[1] = f32x16{}; sbf16x8 qx[6], qy[6];
    { const GAS bf16* Qw = (const GAS bf16*)Qb + (size_t)(wid * 64 + r32) * 96 + hi * 8;
#pragma unroll
      for (int d0 = 0; d0 < 6; ++d0) { qx[d0] = *(const GAS sbf16x8*)(Qw + d0 * 16); qy[d0] = *(const GAS sbf16x8*)(Qw + 32 * 96 + d0 * 16); } }
    const int kc1 = 512 + (tid & 255), kr0 = tid / 12, kq0 = (tid % 12) * 8, kr1 = kc1 / 12, kq1 = (kc1 % 12) * 8;
    const int ksto0 = ATT_KSWZ(kr0, kq0 * 2), ksto1 = ATT_KSWZ(kr1, kq1 * 2);
    const int vr = tid >> 3, vq = (tid & 7) * 8, vsto = v_st(vr, vq);
    const int vb0 = (int)(unsigned)(size_t)V_lds + v_rd_base(lane);
    const unsigned ko0 = (unsigned)(kr0 * 96 + kq0) * 2u, ko1 = (unsigned)(kr1 * 96 + kq1) * 2u, vo = (unsigned)(vr * 64 + vq) * 2u;
    const GAS char* Kg = (const GAS char*)Kh; const GAS char* Vg = (const GAS char*)Vh;
    sbf16x8 sk0, sk1, sv;
#define ATT2_SLOAD(k0) do { sk0 = *(const GAS sbf16x8*)(Kg + (ko0 + (unsigned)(k0) * 192u)); sk1 = *(const GAS sbf16x8*)(Kg + (ko1 + (unsigned)(k0) * 192u)); sv = *(const GAS sbf16x8*)(Vg + (vo + (unsigned)(k0) * 128u)); } while (0)
#define ATT2_SWRITE(b) do { *(LAS sbf16x8*)(K_lds + (b) * SHM_K + ksto0) = sk0; *(LAS sbf16x8*)(K_lds + (b) * SHM_K + ksto1) = sk1; *(LAS sbf16x8*)(V_lds + (b) * SHM_V + vsto) = sv; } while (0)
    const int NT = seq / KVBLK;
    ATT2_SLOAD(0); ATT2_SWRITE(0); __syncthreads();
    f32x16 x0, x1, y0, y1; sbf16x8 px[4], py[4];
#pragma unroll 1
    for (int j = 0; j < NT; ++j) {
        const int b = j & 1;
        if (j + 1 < NT) ATT2_SLOAD((j + 1) * KVBLK);
        ATT_SBAR();
        qk_half<0>(x0, y0, K_lds + b * SHM_K, qx, qy, r32, hi);
        ATT_SBAR();
        qk_half<32>(x1, y1, K_lds + b * SHM_K, qx, qy, r32, hi);
        softmax_half(x0, lx, px[0], px[1]); softmax_half(y0, ly, py[0], py[1]);
        ATT_SBAR();
        pv_half<0>(ox, oy, vb0 + b * SHM_V, px[0], px[1], py[0], py[1]);
        softmax_half(x1, lx, px[2], px[3]); softmax_half(y1, ly, py[2], py[3]);
        ATT_SBAR();
        pv_half<2>(ox, oy, vb0 + b * SHM_V, px[2], px[3], py[2], py[3]);
        ATT_SBAR();
        if (j + 1 < NT) ATT2_SWRITE(b ^ 1);
        __syncthreads();
    }
#undef ATT2_SLOAD
#undef ATT2_SWRITE
    { auto rr = __builtin_amdgcn_permlane32_swap(__float_as_uint(lx), __float_as_uint(lx), false, false); lx = __uint_as_float(rr[0]) + __uint_as_float(rr[1]); }
    { auto rr = __builtin_amdgcn_permlane32_swap(__float_as_uint(ly), __float_as_uint(ly), false, false); ly = __uint_as_float(rr[0]) + __uint_as_float(rr[1]); }
    { unsigned z_ = 0u; asm volatile("" : "+v"(z_)); lane2 = (int)__builtin_amdgcn_mbcnt_hi(~0u, __builtin_amdgcn_mbcnt_lo(~0u, z_)); }
    const int r32e = lane2 & 31, hie = lane2 >> 5;
    if (hie == 0) { ws[r32e] = lx; ws[32 + r32e] = ly; }
    asm volatile("s_waitcnt lgkmcnt(0)" ::: "memory");
    LAS bf16* stg = (LAS bf16*)(lds + wid * 8192);
#pragma unroll
    for (int r = 0; r < 16; ++r) { const int orow = crow(r, hie); const float rlx = __builtin_amdgcn_rcpf(ws[orow]), rly = __builtin_amdgcn_rcpf(ws[32 + orow]);
#pragma unroll
        for (int d0 = 0; d0 < 2; ++d0) { stg[orow * 64 + d0 * 32 + r32e] = (bf16)(pk2(ox[d0][r] * rlx, 0.f) & 0xffffu); stg[(32 + orow) * 64 + d0 * 32 + r32e] = (bf16)(pk2(oy[d0][r] * rly, 0.f) & 0xffffu); } }
    asm volatile("s_waitcnt lgkmcnt(0)" ::: "memory");
    GAS bf16* Ow = (GAS bf16*)Ob + (size_t)(wid * 64) * 512;
#pragma unroll
    for (int i = 0; i < 8; ++i) { const int row = i * 8 + (lane2 >> 3), ch = lane2 & 7; const v4u v = *(const LAS v4u*)(stg + row * 64 + ch * 8); *(GAS v4u*)(Ow + (size_t)row * 512 + ch * 8) = v; }
    asm volatile("s_waitcnt lgkmcnt(0)" ::: "memory");
}
constexpr int OFF4_K = 0, OFF4_V = 3 * SHM_K, OFF4_WS = 3 * SHM_K + 3 * SHM_V;
static_assert(OFF4_WS + NW * 64 * 4 <= 131072, "attention LDS");
__device__ __forceinline__ void attn_unit4(const bf16* Qb, const bf16* Kh, const bf16* Vh, bf16* Ob, int seq, LAS char* lds, int tid) {
    const int wid = __builtin_amdgcn_readfirstlane(tid >> 6), lane = tid & 63, r32 = lane & 31, hi = lane >> 5; int lane2;
    LAS char* K_lds = lds + OFF4_K; LAS char* V_lds = lds + OFF4_V;
    LAS float* ws = (LAS float*)(lds + OFF4_WS) + wid * 64;
    float lx = 0.f, ly = 0.f; f32x16 ox[2], oy[2]; ox[0] = f32x16{}; ox[1] = f32x16{}; oy[0] = f32x16{}; oy[1] = f32x16{}; sbf16x8 qx[6], qy[6];
    { const GAS bf16* Qw = (const GAS bf16*)Qb + (size_t)(wid * 64 + r32) * 96 + hi * 8;
#pragma unroll
      for (int d0 = 0; d0 < 6; ++d0) { qx[d0] = *(const GAS sbf16x8*)(Qw + d0 * 16); qy[d0] = *(const GAS sbf16x8*)(Qw + 32 * 96 + d0 * 16); } }
    const int rowA = 4 * wid + (lane >> 4), chA = (lane & 15) ^ (rowA & 15);
    const unsigned kofA = (unsigned)(rowA * 96 + (chA < 12 ? chA * 8 : 0)) * 2u, kofB = kofA + 32u * 192u;
    const int kkv = wid * 8 + ((lane & 31) >> 2), kv = kkv;
    const unsigned vof = (unsigned)(kv * 64 + (lane >> 5) * 32 + (lane & 3) * 8) * 2u;
    const GAS char* Kg = (const GAS char*)Kh; const GAS char* Vg = (const GAS char*)Vh;
    const int vb0 = (int)(unsigned)(size_t)V_lds + v_rd_base(lane);
#define ATT4_DMA(t, slot) do { \
    __builtin_amdgcn_global_load_lds((const GAS unsigned*)(Kg + (kofA + (unsigned)(t) * (64u * 192u))), (LAS unsigned*)(K_lds + (slot) * SHM_K + wid * 1024), 16, 0, 0); \
    __builtin_amdgcn_global_load_lds((const GAS unsigned*)(Kg + (kofB + (unsigned)(t) * (64u * 192u))), (LAS unsigned*)(K_lds + (slot) * SHM_K + (wid + 8) * 1024), 16, 0, 0); \
    __builtin_amdgcn_global_load_lds((const GAS unsigned*)(Vg + (vof + (unsigned)(t) * (64u * 128u))), (LAS unsigned*)(V_lds + (slot) * SHM_V + wid * 2048), 16, 0, 0); } while (0)
    const int NT = seq / KVBLK;
    ATT4_DMA(0, 0);
    asm volatile("s_waitcnt vmcnt(0)" ::: "memory"); __syncthreads();
    f32x16 x0, x1, y0, y1; sbf16x8 px[4], py[4];
    x1 = f32x16{}; y1 = f32x16{};
#pragma unroll
    for (int i = 0; i < 4; ++i) { px[i] = sbf16x8{}; py[i] = sbf16x8{}; }
    int s_prev = 2, s_cur = 0, s_next = 1;
#pragma unroll 1
    for (int j = 0; j < NT; ++j) {
        if (j + 1 < NT) ATT4_DMA(j + 1, s_next);
        ATT_SBAR();
        qk_half<0>(x0, y0, K_lds + s_cur * SHM_K, qx, qy, r32, hi);
        qk_half<32>(x1, y1, K_lds + s_cur * SHM_K, qx, qy, r32, hi);
        softmax_half(x0, lx, px[0], px[1]); softmax_half(y0, ly, py[0], py[1]);
        pv_half<0>(ox, oy, vb0 + s_cur * SHM_V, px[0], px[1], py[0], py[1]);
        softmax_half(x1, lx, px[2], px[3]); softmax_half(y1, ly, py[2], py[3]);
        pv_half<2>(ox, oy, vb0 + s_cur * SHM_V, px[2], px[3], py[2], py[3]);
        asm volatile("s_waitcnt vmcnt(0)" ::: "memory");
        __syncthreads();
        { const int t_ = s_prev; s_prev = s_cur; s_cur = s_next; s_next = t_; }
    }
#undef ATT4_DMA
    { auto rr = __builtin_amdgcn_permlane32_swap(__float_as_uint(lx), __float_as_uint(lx), false, false); lx = __uint_as_float(rr[0]) + __uint_as_float(rr[1]); }
    { auto rr = __builtin_amdgcn_permlane32_swap(__float_as_uint(ly), __float_as_uint(ly), false, false); ly = __uint_as_float(rr[0]) + __uint_as_float(rr[1]); }
    { unsigned z_ = 0u; asm volatile("" : "+v"(z_)); lane2 = (int)__builtin_amdgcn_mbcnt_hi(~0u, __builtin_amdgcn_mbcnt_lo(~0u, z_)); }
    const int r32e = lane2 & 31, hie = lane2 >> 5;
    const float rlx = __builtin_amdgcn_rcpf(lx), rly = __builtin_amdgcn_rcpf(ly);
    LAS bf16* stg = (LAS bf16*)(lds + wid * 8192);
#pragma unroll
    for (int d0 = 0; d0 < 2; ++d0)
#pragma unroll
        for (int g = 0; g < 4; ++g) {
            v2u wx, wy; wx.x = pk2(ox[d0][4 * g] * rlx, ox[d0][4 * g + 1] * rlx); wx.y = pk2(ox[d0][4 * g + 2] * rlx, ox[d0][4 * g + 3] * rlx);
            wy.x = pk2(oy[d0][4 * g] * rly, oy[d0][4 * g + 1] * rly); wy.y = pk2(oy[d0][4 * g + 2] * rly, oy[d0][4 * g + 3] * rly);
            *(LAS v2u*)(stg + r32e * 64 + d0 * 32 + 8 * g + 4 * hie) = wx; *(LAS v2u*)(stg + (32 + r32e) * 64 + d0 * 32 + 8 * g + 4 * hie) = wy; }
    asm volatile("s_waitcnt lgkmcnt(0)" ::: "memory");
    GAS bf16* Ow = (GAS bf16*)Ob + (size_t)(wid * 64) * 512;
#pragma unroll
    for (int i = 0; i < 8; ++i) { const int row = i * 8 + (lane2 >> 3), ch = lane2 & 7; const v4u v = *(const LAS v4u*)(stg + row * 64 + ch * 8); *(GAS v4u*)(Ow + (size_t)row * 512 + ch * 8) = v; }
    asm volatile("s_waitcnt lgkmcnt(0)" ::: "memory");
}
typedef int v8i __attribute__((ext_vector_type(8)));
constexpr int SHM_K8 = KVBLK * 128;
constexpr int OFF6_K = 0, OFF6_V = 3 * SHM_K8, OFF6_WS = 3 * SHM_K8 + 3 * SHM_V;
static_assert(OFF6_WS + NW * 64 * 4 <= 131072, "attention LDS");
#define ATT8_MFMA(A_, B_, C_) __builtin_amdgcn_mfma_scale_f32_32x32x64_f8f6f4(A_, B_, C_, 0, 0, 0, 0x7f7f7f7f, 0, 0x7c7c7c7c)
template <int ROW0> __device__ __forceinline__ void qk8_half(f32x16& x, f32x16& y, const LAS char* Ks, const v8i (&qx)[2], const v8i (&qy)[2], int ko0, int ko2) {
    asm volatile("" : "+v"(ko0), "+v"(ko2)); const int ko1 = ko0 ^ 16, ko3 = ko2 ^ 16;
    const v4u a0 = *(const LAS v4u*)(Ks + ROW0 * 128 + ko0), a1 = *(const LAS v4u*)(Ks + ROW0 * 128 + ko1), b0 = *(const LAS v4u*)(Ks + ROW0 * 128 + ko2), b1 = *(const LAS v4u*)(Ks + ROW0 * 128 + ko3);
    const v8i c1 = {(int)a0.x, (int)a0.y, (int)a0.z, (int)a0.w, (int)a1.x, (int)a1.y, (int)a1.z, (int)a1.w}, c2 = {(int)b0.x, (int)b0.y, (int)b0.z, (int)b0.w, (int)b1.x, (int)b1.y, (int)b1.z, (int)b1.w};
    x = ATT8_MFMA(c1, qx[0], f32x16{}); y = ATT8_MFMA(c1, qy[0], f32x16{});
    x = ATT8_MFMA(c2, qx[1], x); y = ATT8_MFMA(c2, qy[1], y);
}
__device__ __forceinline__ void attn_unit6(const unsigned char* Qb8, const unsigned char* Kh8, const bf16* Vh, bf16* Ob, int seq, LAS char* lds, int tid) {
    const int wid = __builtin_amdgcn_readfirstlane(tid >> 6), lane = tid & 63, r32 = lane & 31, hi = lane >> 5; int lane2;
    LAS char* K_lds = lds + OFF6_K; LAS char* V_lds = lds + OFF6_V;
    float lx = 0.f, ly = 0.f; f32x16 ox[2], oy[2]; ox[0] = f32x16{}; ox[1] = f32x16{}; oy[0] = f32x16{}; oy[1] = f32x16{};
    v8i qx[2], qy[2];
    { const GAS unsigned char* Qw = (const GAS unsigned char*)Qb8 + (size_t)(wid * 64 + r32) * 96;
      const v4u x0 = *(const GAS v4u*)(Qw + 32 * hi), x1 = *(const GAS v4u*)(Qw + 32 * hi + 16), x2 = *(const GAS v4u*)(Qw + 64), x3 = *(const GAS v4u*)(Qw + 80);
      const v4u y0 = *(const GAS v4u*)(Qw + 32 * 96 + 32 * hi), y1 = *(const GAS v4u*)(Qw + 32 * 96 + 32 * hi + 16), y2 = *(const GAS v4u*)(Qw + 32 * 96 + 64), y3 = *(const GAS v4u*)(Qw + 32 * 96 + 80);
      const int mk = hi ? 0 : -1;
      qx[0] = (v8i){(int)x0.x, (int)x0.y, (int)x0.z, (int)x0.w, (int)x1.x, (int)x1.y, (int)x1.z, (int)x1.w};
      qx[1] = (v8i){(int)x2.x & mk, (int)x2.y & mk, (int)x2.z & mk, (int)x2.w & mk, (int)x3.x & mk, (int)x3.y & mk, (int)x3.z & mk, (int)x3.w & mk};
      qy[0] = (v8i){(int)y0.x, (int)y0.y, (int)y0.z, (int)y0.w, (int)y1.x, (int)y1.y, (int)y1.z, (int)y1.w};
      qy[1] = (v8i){(int)y2.x & mk, (int)y2.y & mk, (int)y2.z & mk, (int)y2.w & mk, (int)y3.x & mk, (int)y3.y & mk, (int)y3.z & mk, (int)y3.w & mk}; }
    const int ksw = (r32 >> 1) & 7;
    const int ko0 = r32 * 128 + (((2 * hi) ^ ksw) << 4), ko2 = r32 * 128 + ((4 ^ ksw) << 4);
    const int rowA = 8 * wid + (lane >> 3), lcA = (lane & 7) ^ ((rowA >> 1) & 7);
    const unsigned kofA = (unsigned)(rowA * 96 + (lcA < 6 ? lcA : 0) * 16);
    const int kv = wid * 8 + ((lane & 31) >> 2);
    const unsigned vof = (unsigned)(kv * 64 + (lane >> 5) * 32 + (lane & 3) * 8) * 2u;
    const GAS char* Kg = (const GAS char*)Kh8; const GAS char* Vg = (const GAS char*)Vh;
    const int vb0 = (int)(unsigned)(size_t)V_lds + v_rd_base(lane);
#define ATT6_DMA(t, slot) do { \
    __builtin_amdgcn_global_load_lds((const GAS unsigned*)(Kg + (kofA + (unsigned)(t) * (64u * 96u))), (LAS unsigned*)(K_lds + (slot) * SHM_K8 + wid * 1024), 16, 0, 0); \
    __builtin_amdgcn_global_load_lds((const GAS unsigned*)(Vg + (vof + (unsigned)(t) * (64u * 128u))), (LAS unsigned*)(V_lds + (slot) * SHM_V + wid * 2048), 16, 0, 0); } while (0)
    const int NT = seq / KVBLK;
    ATT6_DMA(0, 0);
    asm volatile("s_waitcnt vmcnt(0)" ::: "memory"); __syncthreads();
    f32x16 x0, x1, y0, y1; sbf16x8 px[4], py[4];
    int s_prev = 2, s_cur = 0, s_next = 1;
#pragma unroll 1
    for (int j = 0; j < NT; ++j) {
        if (j + 1 < NT) ATT6_DMA(j + 1, s_next);
        ATT_SBAR();
        qk8_half<0>(x0, y0, K_lds + s_cur * SHM_K8, qx, qy, ko0, ko2);
        qk8_half<32>(x1, y1, K_lds + s_cur * SHM_K8, qx, qy, ko0, ko2);
        softmax_half(x0, lx, px[0], px[1]); softmax_half(y0, ly, py[0], py[1]);
        pv_half<0>(ox, oy, vb0 + s_cur * SHM_V, px[0], px[1], py[0], py[1]);
        softmax_half(x1, lx, px[2], px[3]); softmax_half(y1, ly, py[2], py[3]);
        pv_half<2>(ox, oy, vb0 + s_cur * SHM_V, px[2], px[3], py[2], py[3]);
        asm volatile("s_waitcnt vmcnt(0)" ::: "memory");
        __syncthreads();
        { const int t_ = s_prev; s_prev = s_cur; s_cur = s_next; s_next = t_; }
    }
#undef ATT6_DMA
    { auto rr = __builtin_amdgcn_permlane32_swap(__float_as_uint(lx), __float_as_uint(lx), false, false); lx = __uint_as_float(rr[0]) + __uint_as_float(rr[1]); }
    { auto rr = __builtin_amdgcn_permlane32_swap(__float_as_uint(ly), __float_as_uint(ly), false, false); ly = __uint_as_float(rr[0]) + __uint_as_float(rr[1]); }
    { unsigned z_ = 0u; asm volatile("" : "+v"(z_)); lane2 = (int)__builtin_amdgcn_mbcnt_hi(~0u, __builtin_amdgcn_mbcnt_lo(~0u, z_)); }
    const int r32e = lane2 & 31, hie = lane2 >> 5;
    const float rlx = __builtin_amdgcn_rcpf(lx), rly = __builtin_amdgcn_rcpf(ly);
    LAS bf16* stg = (LAS bf16*)(lds + wid * 8192);
#pragma unroll
    for (int d0 = 0; d0 < 2; ++d0)
#pragma unroll
        for (int g = 0; g < 4; ++g) {
            v2u wx, wy; wx.x = pk2(ox[d0][4 * g] * rlx, ox[d0][4 * g + 1] * rlx); wx.y = pk2(ox[d0][4 * g + 2] * rlx, ox[d0][4 * g + 3] * rlx);
            wy.x = pk2(oy[d0][4 * g] * rly, oy[d0][4 * g + 1] * rly); wy.y = pk2(oy[d0][4 * g + 2] * rly, oy[d0][4 * g + 3] * rly);
            *(LAS v2u*)(stg + r32e * 64 + d0 * 32 + 8 * g + 4 * hie) = wx; *(LAS v2u*)(stg + (32 + r32e) * 64 + d0 * 32 + 8 * g + 4 * hie) = wy; }
    asm volatile("s_waitcnt lgkmcnt(0)" ::: "memory");
    GAS bf16* Ow = (GAS bf16*)Ob + (size_t)(wid * 64) * 512;
#pragma unroll
    for (int i = 0; i < 8; ++i) { const int row = i * 8 + (lane2 >> 3), ch = lane2 & 7; const v4u v = *(const LAS v4u*)(stg + row * 64 + ch * 8); *(GAS v4u*)(Ow + (size_t)row * 512 + ch * 8) = v; }
    asm volatile("s_waitcnt lgkmcnt(0)" ::: "memory");
}
constexpr int SHM_V8 = 64 * 64;
constexpr int OFF7_K = 0, OFF7_V = 3 * SHM_K8;
static_assert(OFF7_V + 3 * SHM_V8 <= 65536, "attention LDS (the O stage overlays the rings after the loop)");
#define ATT8_QK(A_, B_, C_) __builtin_amdgcn_mfma_scale_f32_32x32x64_f8f6f4(A_, B_, C_, 0, 0, 0, 0x7f7f7f7f, 0, 0x7c7c7c7c)
#define ATT8_PV(A_, B_, C_) __builtin_amdgcn_mfma_scale_f32_32x32x64_f8f6f4(A_, B_, C_, 0, 1, 0, 0x7f7f7f7f, 0, 0x7f7f7f7f)
typedef int v4i __attribute__((ext_vector_type(4)));
#define ATT8_CAT(lo_, hi_) __builtin_shufflevector(lo_, hi_, 0, 1, 2, 3, 4, 5, 6, 7)
template <int ROW0> __device__ __forceinline__ void qk8s_half(f32x16& x, f32x16& y, const LAS char* Ks, const v8i (&qx)[2], const v8i (&qy)[2], int ko0, int ko2) {
    asm volatile("" : "+v"(ko0), "+v"(ko2)); const int ko1 = ko0 ^ 16, ko3 = ko2 ^ 16;
    const v4i a0 = *(const LAS v4i*)(Ks + ROW0 * 128 + ko0), a1 = *(const LAS v4i*)(Ks + ROW0 * 128 + ko1), b0 = *(const LAS v4i*)(Ks + ROW0 * 128 + ko2), b1 = *(const LAS v4i*)(Ks + ROW0 * 128 + ko3);
    const v8i c1 = ATT8_CAT(a0, a1), c2 = ATT8_CAT(b0, b1);
    x = ATT8_QK(c1, qx[0], f32x16{}); y = ATT8_QK(c1, qy[0], f32x16{});
    x = ATT8_QK(c2, qx[1], x); y = ATT8_QK(c2, qy[1], y);
}
__device__ __forceinline__ v4i softmax8_half(f32x16& p, float& l_reg) {
#pragma unroll
    for (int r = 0; r < 16; ++r) p[r] = __builtin_amdgcn_exp2f(p[r]);
    float ps0 = 0.f, ps1 = 0.f;
#pragma unroll
    for (int r = 0; r < 8; ++r) { ps0 += p[r]; ps1 += p[8 + r]; }
    l_reg += ps0 + ps1;
    v4i w;
#pragma unroll
    for (int i = 0; i < 4; ++i) {
        int t_;
        asm("s_nop 0\n\tv_cvt_scalef32_pk_bf8_f32 %0, %1, %2, 4.0\n\tv_cvt_scalef32_pk_bf8_f32 %0, %3, %4, 4.0 op_sel:[0,0,0,1]" : "=&v"(t_) : "v"(p[4 * i]), "v"(p[4 * i + 1]), "v"(p[4 * i + 2]), "v"(p[4 * i + 3]));
        w[i] = t_; }
    return w;
}
__device__ __forceinline__ v4i softmax8n_half(f32x16& p) {
#pragma unroll
    for (int r = 0; r < 16; ++r) p[r] = __builtin_amdgcn_exp2f(p[r]);
    int w0, w1, w2, w3;
    asm("s_nop 0\n\t"
        "v_cvt_scalef32_pk_bf8_f32 %0, %4, %5, 4.0\n\tv_cvt_scalef32_pk_bf8_f32 %0, %6, %7, 4.0 op_sel:[0,0,0,1]\n\t"
        "v_cvt_scalef32_pk_bf8_f32 %1, %8, %9, 4.0\n\tv_cvt_scalef32_pk_bf8_f32 %1, %10, %11, 4.0 op_sel:[0,0,0,1]\n\t"
        "v_cvt_scalef32_pk_bf8_f32 %2, %12, %13, 4.0\n\tv_cvt_scalef32_pk_bf8_f32 %2, %14, %15, 4.0 op_sel:[0,0,0,1]\n\t"
        "v_cvt_scalef32_pk_bf8_f32 %3, %16, %17, 4.0\n\tv_cvt_scalef32_pk_bf8_f32 %3, %18, %19, 4.0 op_sel:[0,0,0,1]"
        : "=&v"(w0), "=&v"(w1), "=&v"(w2), "=&v"(w3)
        : "v"(p[0]), "v"(p[1]), "v"(p[2]), "v"(p[3]), "v"(p[4]), "v"(p[5]), "v"(p[6]), "v"(p[7]), "v"(p[8]), "v"(p[9]), "v"(p[10]), "v"(p[11]), "v"(p[12]), "v"(p[13]), "v"(p[14]), "v"(p[15]));
    return (v4i){w0, w1, w2, w3};
}
__device__ __forceinline__ void attn_unit7(const unsigned char* Qb8, const unsigned char* Kh8, const unsigned char* Vt8, bf16* Ob, int seq, LAS char* lds, int tid) {
    const int wid = __builtin_amdgcn_readfirstlane(tid >> 6), lane = tid & 63, r32 = lane & 31, hi = lane >> 5; int lane2;
    LAS char* K_lds = lds + OFF7_K; LAS char* V_lds = lds + OFF7_V;
    f32x16 lsum = f32x16{}; f32x16 ox[2], oy[2]; ox[0] = f32x16{}; ox[1] = f32x16{}; oy[0] = f32x16{}; oy[1] = f32x16{};
    v8i qx[2], qy[2];
    { const GAS unsigned char* Qw = (const GAS unsigned char*)Qb8 + (size_t)(wid * 64 + r32) * 96;
      const v4u x0 = *(const GAS v4u*)(Qw + 32 * hi), x1 = *(const GAS v4u*)(Qw + 32 * hi + 16), x2 = *(const GAS v4u*)(Qw + 64), x3 = *(const GAS v4u*)(Qw + 80);
      const v4u y0 = *(const GAS v4u*)(Qw + 32 * 96 + 32 * hi), y1 = *(const GAS v4u*)(Qw + 32 * 96 + 32 * hi + 16), y2 = *(const GAS v4u*)(Qw + 32 * 96 + 64), y3 = *(const GAS v4u*)(Qw + 32 * 96 + 80);
      const int mk = hi ? 0 : -1;
      qx[0] = (v8i){(int)x0.x, (int)x0.y, (int)x0.z, (int)x0.w, (int)x1.x, (int)x1.y, (int)x1.z, (int)x1.w};
      qx[1] = (v8i){(int)x2.x & mk, (int)x2.y & mk, (int)x2.z & mk, (int)x2.w & mk, (int)x3.x & mk, (int)x3.y & mk, (int)x3.z & mk, (int)x3.w & mk};
      qy[0] = (v8i){(int)y0.x, (int)y0.y, (int)y0.z, (int)y0.w, (int)y1.x, (int)y1.y, (int)y1.z, (int)y1.w};
      qy[1] = (v8i){(int)y2.x & mk, (int)y2.y & mk, (int)y2.z & mk, (int)y2.w & mk, (int)y3.x & mk, (int)y3.y & mk, (int)y3.z & mk, (int)y3.w & mk}; }
    const int on_x = r32 < 16 ? 0x38383838 : 0, on_y = r32 < 16 ? 0 : 0x38383838;
    const v8i ax1 = {on_x, on_x, on_x, on_x, on_x, on_x, on_x, on_x}, ay1 = {on_y, on_y, on_y, on_y, on_y, on_y, on_y, on_y};
    const int ksw = (r32 >> 1) & 7;
    const int ko0 = r32 * 128 + (((2 * hi) ^ ksw) << 4), ko2 = r32 * 128 + ((4 ^ ksw) << 4);
    const int vo0 = r32 * 64 + (((2 * hi) ^ ((r32 >> 2) & 3)) << 4);
    const int rowA = 8 * wid + (lane >> 3), lcA = (lane & 7) ^ ((rowA >> 1) & 7);
    const unsigned kofA = (unsigned)(rowA * 96 + (lcA < 6 ? lcA : 0) * 16);
    const int dvV = 16 * (wid & 3) + (lane >> 2);
    const unsigned vofV = (unsigned)(dvV * 64 + (((lane & 3) ^ ((dvV >> 2) & 3)) << 4));
    const GAS char* Kg = (const GAS char*)Kh8; const GAS char* Vg = (const GAS char*)Vt8;
#define ATT7_DMA(t, slot) do { \
    __builtin_amdgcn_global_load_lds((const GAS unsigned*)(Kg + (kofA + (unsigned)(t) * (64u * 96u))), (LAS unsigned*)(K_lds + (slot) * SHM_K8 + wid * 1024), 16, 0, 0); \
    if (wid < 4) __builtin_amdgcn_global_load_lds((const GAS unsigned*)(Vg + (vofV + (unsigned)(t) * 4096u)), (LAS unsigned*)(V_lds + (slot) * SHM_V8 + wid * 1024), 16, 0, 0); } while (0)
    const int NT = seq / KVBLK;
    ATT7_DMA(0, 0);
    asm volatile("s_waitcnt vmcnt(0)" ::: "memory"); __syncthreads();
    f32x16 x0, x1, y0, y1;
    int s_prev = 2, s_cur = 0, s_next = 1;
#pragma unroll 1
    for (int j = 0; j < NT; ++j) {
        if (j + 1 < NT) ATT7_DMA(j + 1, s_next);
        ATT_SBAR();
        const LAS char* Ks = K_lds + s_cur * SHM_K8; const LAS char* Vs = V_lds + s_cur * SHM_V8;
        qk8s_half<0>(x0, y0, Ks, qx, qy, ko0, ko2);
        qk8s_half<32>(x1, y1, Ks, qx, qy, ko0, ko2);
        const v4i px0 = softmax8n_half(x0), py0 = softmax8n_half(y0);
        const v4i px1 = softmax8n_half(x1);
        const v4i va0 = *(const LAS v4i*)(Vs + vo0), va1 = *(const LAS v4i*)(Vs + (vo0 ^ 16)), vb0_ = *(const LAS v4i*)(Vs + 2048 + vo0), vb1_ = *(const LAS v4i*)(Vs + 2048 + (vo0 ^ 16));
        const v8i vf0 = ATT8_CAT(va0, va1), vf1 = ATT8_CAT(vb0_, vb1_);
        const v8i pxv = ATT8_CAT(px0, px1);
        ox[0] = ATT8_PV(vf0, pxv, ox[0]); ox[1] = ATT8_PV(vf1, pxv, ox[1]); lsum = ATT8_PV(ax1, pxv, lsum);
        const v4i py1 = softmax8n_half(y1);
        const v8i pyv = ATT8_CAT(py0, py1);
        oy[0] = ATT8_PV(vf0, pyv, oy[0]); oy[1] = ATT8_PV(vf1, pyv, oy[1]); lsum = ATT8_PV(ay1, pyv, lsum);
        asm volatile("s_waitcnt vmcnt(0)" ::: "memory");
        __syncthreads();
        { const int t_ = s_prev; s_prev = s_cur; s_cur = s_next; s_next = t_; }
    }
#undef ATT7_DMA
    const float lx = __builtin_fmaxf(lsum[0], 1e-30f), ly = __builtin_fmaxf(lsum[8], 1e-30f);
    { unsigned z_ = 0u; asm volatile("" : "+v"(z_)); lane2 = (int)__builtin_amdgcn_mbcnt_hi(~0u, __builtin_amdgcn_mbcnt_lo(~0u, z_)); }
    const int r32e = lane2 & 31, hie = lane2 >> 5;
    const float rlx = __builtin_amdgcn_rcpf(lx), rly = __builtin_amdgcn_rcpf(ly);
    LAS unsigned char* stg = (LAS unsigned char*)(lds + wid * 4096);
    const float sx_ = rlx * 64.f, sy_ = rly * 64.f;
#pragma unroll
    for (int d0 = 0; d0 < 2; ++d0)
#pragma unroll
        for (int g = 0; g < 4; ++g) {
            *(LAS unsigned*)(stg + r32e * 64 + d0 * 32 + 8 * g + 4 * hie) = pk4f8(ox[d0][4 * g] * sx_, ox[d0][4 * g + 1] * sx_, ox[d0][4 * g + 2] * sx_, ox[d0][4 * g + 3] * sx_);
            *(LAS unsigned*)(stg + (32 + r32e) * 64 + d0 * 32 + 8 * g + 4 * hie) = pk4f8(oy[d0][4 * g] * sy_, oy[d0][4 * g + 1] * sy_, oy[d0][4 * g + 2] * sy_, oy[d0][4 * g + 3] * sy_); }
    asm volatile("s_waitcnt lgkmcnt(0)" ::: "memory");
    GAS unsigned char* Ow = (GAS unsigned char*)Ob + (size_t)(wid * 64) * 1024;
#pragma unroll
    for (int i = 0; i < 4; ++i) { const int row = i * 16 + (lane2 >> 2), ch = lane2 & 3; const v4u v = *(const LAS v4u*)(stg + row * 64 + ch * 16); *(GAS v4u*)(Ow + (size_t)row * 1024 + ch * 16) = v; }
    asm volatile("s_waitcnt lgkmcnt(0)" ::: "memory");
}
}

__device__ __forceinline__ bool attn_static_ok(Frame& F, int l) {
    const float* gq = ((const float*)(const GAS float*)F.in[13]) + l * DQK; const float* gk = ((const float*)(const GAS float*)F.in[14]) + l * DQK; float mq = 0.f, mk = 0.f;
    for (int d = 0; d < DQK; ++d) { mq = fmaxf(mq, fabsf(gq[d])); mk = fmaxf(mk, fabsf(gk[d])); }
    return 96.f * mq * mk * QSCALE <= 17.5f;
}
__device__ __forceinline__ void step_f_fast(Frame& F) {
    fresh_tid(F);
    const bf16* Q = WSP(bf16, WS_Q); const bf16* K = WSP(bf16, WS_K); const bf16* V = WSP(bf16, WS_V); bf16* O = WSP(bf16, WS_O);
    const int vcu = (F.G % 8 == 0) ? (F.bid % 8) * (F.G / 8) + F.bid / 8 : F.bid;
#if ATTN_W64
    for (int u = vcu; u < NB * H * (S / 512); u += F.G) {
        const int qb = u % 16, bh = (u / 16), b = bh / H, h = bh % H;
        fresh_tid(F);
        att::attn_unit7((const unsigned char*)Q + ((size_t)bh * S + qb * 512) * 96, (const unsigned char*)K + (size_t)bh * S * 96, (const unsigned char*)V + (size_t)bh * (S / 64) * 4096, (bf16*)((unsigned char*)O + ((size_t)(b * S + qb * 512)) * 1024 + h * 64), S, (LAS char*)F.lds, F.tid);
        __syncthreads();
    }
#else
    for (int u = vcu; u < NB * H * (S / 256); u += F.G) {
        const int qb = u % 32, bh = (u / 32), b = bh / H, h = bh % H;
        fresh_tid(F);
        att::attn_unit(Q + ((size_t)bh * S + qb * 256) * 96, K + (size_t)bh * S * 96, V + (size_t)bh * S * 64, O + ((size_t)(b * S + qb * 256)) * 512 + h * 64, S, (LAS char*)F.lds, F.tid);
        __syncthreads();
    }
#endif
}
constexpr size_t WT_IN = WS_WT, WT_UQ = WS_WT + 8 * MiB, WT_UKV = WT_UQ + 512 * KiB, WT_CO = WS_WT + 9 * MiB, WT_AO = WS_WT + 10 * MiB, WT_O = WS_WT + 11 * MiB,
                 WT_GU = WS_WT + 13 * MiB, WT_DN = WS_WT + 30 * MiB;
constexpr int NPROJ = 4096;
static_assert(WT_DN + (size_t)NEX * 1024 * 256 * 2 <= WS_WT + 40 * MiB, "weight region");
__device__ __forceinline__ void cvt_item(const float* W, int K, int N, bf16* WT, int drow0, const float* ksc, LAS float* scr, int k0, int n0, int lane, unsigned char* WT8 = nullptr) {
    float wv[32];
#pragma unroll
    for (int i = 0; i < 32; ++i) wv[i] = __builtin_nontemporal_load(&W[(size_t)(k0 + 2 * i + (lane >> 5)) * N + n0 + (lane & 31)]);
#pragma unroll
    for (int i = 0; i < 32; ++i) { const int kk = 2 * i + (lane >> 5); float v = wv[i]; if (ksc) v *= ksc[k0 + kk]; scr[kk * 33 + (lane & 31)] = v; }
    asm volatile("s_waitcnt lgkmcnt(0)" ::: "memory");
    const int c = lane & 7;
#pragma unroll
    for (int j = 0; j < 4; ++j) { const int n = (lane >> 3) + 8 * j; const LAS float* s = scr + (8 * c) * 33 + n;
        v4u o; o.x = pk2(s[0 * 33], s[1 * 33]); o.y = pk2(s[2 * 33], s[3 * 33]); o.z = pk2(s[4 * 33], s[5 * 33]); o.w = pk2(s[6 * 33], s[7 * 33]);
        if (WT8) { v2u o8; o8.x = pk4f8(s[0 * 33] * 32.f, s[1 * 33] * 32.f, s[2 * 33] * 32.f, s[3 * 33] * 32.f); o8.y = pk4f8(s[4 * 33] * 32.f, s[5 * 33] * 32.f, s[6 * 33] * 32.f, s[7 * 33] * 32.f);
            *(v2u*)(WT8 + (size_t)(drow0 + n) * K + k0 + 8 * c) = o8; }
        else *(v4u*)(WT + (size_t)(drow0 + n) * K + k0 + 8 * c) = o; }
    asm volatile("s_waitcnt lgkmcnt(0)" ::: "memory");
}
__device__ __forceinline__ int proj_dest(int n0) {
    if (n0 < 512) return n0;
    if (n0 < 1024) return 512 + ((n0 - 512) >> 7) * 256 + ((n0 - 512) & 127);
    if (n0 < 1536) return 512 + ((n0 - 1024) >> 7) * 256 + 128 + ((n0 - 1024) & 127);
    if (n0 < 1952) return n0;
    return n0 + 96;
}
__device__ __forceinline__ int uq_dest(int n0) { const int h = n0 / 96, d0 = n0 % 96; return (h >> 1) * 256 + (d0 < 64 ? (d0 >> 5) * 128 + (h & 1) * 32 : (2 + (h & 1)) * 32); }
__device__ __forceinline__ int ukv_dest(int n0) { const int h = n0 >> 7, j0 = n0 & 127, kind = j0 >> 6, d0 = j0 & 63; return (kind * 2 + (h >> 2)) * 256 + (d0 >> 5) * 128 + (h & 3) * 32; }
__device__ __forceinline__ void convert_weights(Frame& F, int l) {
    fresh_tid(F);
    LAS float* scr = (LAS float*)(F.lds + F.wave * 16384);
    const int gw = F.bid * NWAVES + F.wave, NGW = F.G * NWAVES;
    constexpr int I_IN = 16 * 125, I_UQ = 4 * 24, I_UKV = 2 * 32, I_CO = 8 * 32, I_O = 16 * 32, I_GU = NEX * 16 * 8, I_DN = NEX * 4 * 32;
    constexpr int NITEMS = I_IN + I_UQ + I_UKV + 2 * I_CO + I_O + 2 * I_GU + I_DN;
    for (int it = gw; it < NITEMS; it += NGW) {
        int r = it;
        if (r < I_IN) { const int kb = r / 125, nb = r % 125, n0 = 32 * nb; { const int dr = proj_dest(n0); const bool g8 = dr >= 2048;
            cvt_item(((const float*)(const GAS float*)F.in[7]) + (size_t)l * D * NIN, D, NIN, WSP(bf16, WT_IN), g8 ? dr - 2048 : dr, nullptr, scr, 64 * kb, n0, F.lane, g8 ? WSP(unsigned char, WT_IN) + 2048 * D * 2 : nullptr); } continue; } r -= I_IN;
        if (r < I_UQ) { const int kb = r / 24, nb = r % 24; cvt_item(((const float*)(const GAS float*)F.in[10]) + (size_t)l * QL * 768, QL, 768, WSP(bf16, WT_UQ), uq_dest(32 * nb), ((const float*)(const GAS float*)F.in[9]) + l * QL, scr, 64 * kb, 32 * nb, F.lane); continue; } r -= I_UQ;
        if (r < I_UKV) { const int kb = r / 32, nb = r % 32; cvt_item(((const float*)(const GAS float*)F.in[12]) + (size_t)l * KVL * 1024, KVL, 1024, WSP(bf16, WT_UKV), ukv_dest(32 * nb), ((const float*)(const GAS float*)F.in[11]) + l * KVL, scr, 64 * kb, 32 * nb, F.lane); continue; } r -= I_UKV;
        if (r < I_CO) { const int kb = r / 32, nb = r % 32; cvt_item(((const float*)(const GAS float*)F.in[15]) + (size_t)l * CW * D, 1024, D, nullptr, 32 * nb, nullptr, scr, 64 * kb, 32 * nb, F.lane, WSP(unsigned char, WT_CO) + 512); continue; } r -= I_CO;
        if (r < I_CO) { const int kb = r / 32, nb = r % 32; cvt_item(((const float*)(const GAS float*)F.in[16]) + (size_t)l * 512 * D, 1024, D, nullptr, 32 * nb, nullptr, scr, 64 * kb, 32 * nb, F.lane, WSP(unsigned char, WT_CO)); continue; } r -= I_CO;
        if (r < I_O) { const int kb = r / 32, nb = r % 32; cvt_item(((const float*)(const GAS float*)F.in[17]) + (size_t)l * D * D, D, D, nullptr, 32 * nb, nullptr, scr, 64 * kb, 32 * nb, F.lane, WSP(unsigned char, WT_O)); continue; } r -= I_O;
        if (r < 2 * I_GU) { const int up = r >= I_GU ? 1 : 0; r -= up * I_GU; const int e = r / 128, q = r % 128, kb = q / 8, nb = q % 8, n0 = 32 * nb;
            const float* W = e < NE ? ((const float*)(const GAS float*)F.in[20 + up]) + ((size_t)l * NE + e) * D * DE : ((const float*)(const GAS float*)F.in[23 + up]) + (size_t)l * D * DE;
            cvt_item(W, D, DE, nullptr, (n0 >> 7) * 256 + up * 128 + (n0 & 127), nullptr, scr, 64 * kb, n0, F.lane, WSP(unsigned char, WT_GU) + (size_t)e * 512 * D); continue; } r -= 2 * I_GU;
        { const int e = r / 128, q = r % 128, kb = q / 32, nb = q % 32;
            const float* W = e < NE ? ((const float*)(const GAS float*)F.in[22]) + ((size_t)l * NE + e) * DE * D : ((const float*)(const GAS float*)F.in[25]) + (size_t)l * DE * D;
            cvt_item(W, DE, D, nullptr, 32 * nb, nullptr, scr, 64 * kb, 32 * nb, F.lane, WSP(unsigned char, WT_DN) + (size_t)e * D * DE); }
    }
    v4u* z = (v4u*)(WSP(bf16, WT_IN) + (size_t)1952 * D);
    unsigned z0 = 0u; asm volatile("" : "+v"(z0));
    for (int i = F.bid * NTHREADS + F.tid; i < 96 * D * 2 / 16; i += F.G * NTHREADS) z[i] = (v4u){z0, z0, z0, z0};
}

namespace pg8 {
typedef short sbf16x8 __attribute__((ext_vector_type(8)));
typedef int v4i_ __attribute__((ext_vector_type(4)));
constexpr int BM = 256, BK = 64, HALF = 128, HTB = HALF * BK * 2, STAGE_BYTES = 8 * HTB, NXCD = 8, WGM = 8;
__device__ __forceinline__ int lds_byte(int r, int c) { const int st = (r >> 4) * 2 + (c >> 5), rr = r & 15, cc = c & 31, ob = rr * 64 + cc * 2; return st * 1024 + (ob ^ (((ob >> 9) & 1) << 5)); }
__device__ __forceinline__ void stage_rc(int b, int& R, int& C) { const int st = b / 1024, sb = b % 1024, swz = sb ^ (((sb >> 9) & 1) << 5); R = (st >> 1) * 16 + swz / 64; C = (st & 1) * 32 + (swz % 64) / 2; }
__device__ __forceinline__ int perm32(int rho) { const int n = rho >> 4, i = rho & 15; return 8 * (i >> 2) + 4 * n + (i & 3); }
__device__ __forceinline__ int xcd_remap(int L, int nwg) { const int q = nwg / NXCD, r = nwg % NXCD, xcd = L % NXCD, off = L / NXCD; return (xcd < r ? xcd * (q + 1) : r * (q + 1) + (xcd - r) * q) + off; }

struct Unit { int pm, pn; const char* a; const char* b; const int* list; int rows, tok0, e; };
struct Gemm { unsigned lda; int K; int sw = 0x7a7a7a7a, sx = 0x7f7f7f7f; };

struct StaticOrder {
    const char* A; const char* Bt; unsigned lda; int K, nM, nN, nwg, G, c;
    static constexpr bool WAITS = false; static constexpr bool SINGLE = false;
    __device__ __forceinline__ bool next(int i, Unit& u, int) const {
        const long L = (long)i * G + c; if (L >= nwg) return false;
        const int wgid = xcd_remap((int)L, nwg);
        const int nig = WGM * nN, gid = wgid / nig, fm = gid * WGM, gsz = (nM - fm) < WGM ? (nM - fm) : WGM;
        u.pm = fm + ((wgid % nig) % gsz); u.pn = (wgid % nig) / gsz;
        u.a = A + (size_t)u.pm * BM * lda; u.b = Bt + (size_t)u.pn * BM * K * 2; u.list = nullptr; u.rows = BM; u.tok0 = u.pm * BM; u.e = 0; return true;
    }
};
struct StaticOrder1 {
    const char* A; const char* Bt; unsigned lda; int K, nM, nN, nwg, G, c, base;
    static constexpr bool WAITS = false; static constexpr bool SINGLE = true;
    __device__ __forceinline__ bool next(int i, Unit& u, int) const {
        const long L = (long)base + c; if (i > 0 || L >= nwg) return false;
        const int wgid = xcd_remap((int)L, nwg);
        const int nig = WGM * nN, gid = wgid / nig, fm = gid * WGM, gsz = (nM - fm) < WGM ? (nM - fm) : WGM;
        u.pm = fm + ((wgid % nig) % gsz); u.pn = (wgid % nig) / gsz;
        u.a = A + (size_t)u.pm * BM * lda; u.b = Bt + (size_t)u.pn * BM * K * 2; u.list = nullptr; u.rows = BM; u.tok0 = u.pm * BM; u.e = 0; return true;
    }
};
struct MoeOrder {
    const char* A; const char* Bt; size_t estride; unsigned lda; int K, nN, MT, G, c; const LAS unsigned* tb; const LAS unsigned* cnt; const int* LIST; bool gather;
    static constexpr bool WAITS = false; static constexpr bool SINGLE = false;
    __device__ __forceinline__ bool next(int i, Unit& u, int) const {
        const int nwg = MT * nN; const long L = (long)i * G + c; if (L >= nwg) return false;
        const int wgid = xcd_remap((int)L, nwg);
        const int mt = wgid / nN, pn = wgid % nN; int e = 0;
#pragma unroll 1
        for (int j = 1; j <= NE; ++j) if ((unsigned)mt >= (unsigned)__builtin_amdgcn_readfirstlane(tb[j])) e = j;
        const int lt = mt - (int)__builtin_amdgcn_readfirstlane(tb[e]);
        u.pm = mt; u.pn = pn; u.e = e; u.tok0 = lt * BM;
        if (e < NE) { const int left = (int)__builtin_amdgcn_readfirstlane(cnt[e]) - lt * BM; u.rows = left < BM ? left : BM; u.list = LIST + (size_t)e * T + lt * BM; } else { u.rows = BM; u.list = nullptr; }
        u.a = gather ? A : A + (size_t)mt * BM * lda; u.b = Bt + (size_t)e * estride + (size_t)pn * BM * K * 2; return true;
    }
};

#ifndef KL_R
#define KL_R 3
#endif
struct MoeOrderX {
    static constexpr bool WAITS = true; static constexpr bool SINGLE = false;
    const char* A; const char* Bt; size_t estride; unsigned lda; int K, nN, MT, G, c; const LAS unsigned* tb; const LAS unsigned* cnt; const LAS unsigned* te; const int* LIST; bool gather;
    int mode, kN; unsigned* flags; unsigned* bar;
    __device__ __forceinline__ bool next(int i, Unit& u, int wid) const {
        const int NX = (G % NXCD == 0) ? NXCD : 1, x = c % NX, cl = c / NX, GX = G / NX;
        const int qm = MT / NX, rm = MT % NX, sz = qm + (x < rm ? 1 : 0), m0 = x * qm + (x < rm ? x : rm);
        if (sz == 0) return false;
        int off;
        if (mode == 0) off = cl + i * GX;
        else {
            const int ku = kN * sz, kmax = (ku + GX - 1) / GX, hx = ku - (kmax - 1) * GX, nl = GX - hx;
            if (cl >= hx && i < KL_R) off = (cl - hx) + i * nl;
            else { const int p = cl + (cl >= hx ? i - KL_R : i) * GX; off = KL_R * nl + (p < GX ? (p >= hx ? p - hx : nl + p) : p); }
        }
        const int sl = off / nN, pn = off % nN; if (sl >= sz) return false;
        const int mt = m0 + sl; const unsigned pe = (unsigned)__builtin_amdgcn_readfirstlane(te[mt]); const int e = (int)(pe & 255u), lt = (int)(pe >> 8);
        u.pm = mt; u.pn = pn; u.e = e; u.tok0 = lt * BM;
        if (e < NE) { const int left = (int)__builtin_amdgcn_readfirstlane(cnt[e]) - lt * BM; u.rows = left < BM ? left : BM; u.list = LIST + (size_t)e * T + lt * BM; } else { u.rows = BM; u.list = nullptr; }
        u.a = gather ? A : A + (size_t)mt * BM * lda; u.b = Bt + (size_t)e * estride + (size_t)pn * BM * K * 2;
        if (mode == 1 && wid == 0) {
            XB_SPIN(xb_ld(flags + mt) < (unsigned)kN, bar);
            __builtin_amdgcn_fence(__ATOMIC_ACQUIRE, "agent");
        }
        return true;
    }
};

struct MoeOrderX1 {
    static constexpr bool WAITS = false; static constexpr bool SINGLE = true;
    MoeOrderX S; int i0;
    __device__ __forceinline__ bool next(int i, Unit& u, int wid) const { return i == 0 && S.next(i0, u, wid); }
};
__device__ __forceinline__ v4u pack8(f32x4 v0, f32x4 v1) { v4u w; w.x = pk2(v0[0], v0[1]); w.y = pk2(v0[2], v0[3]); w.z = pk2(v1[0], v1[1]); w.w = pk2(v1[2], v1[3]); return w; }
__device__ __forceinline__ unsigned pk4_fp8(f32x4 v) {
#pragma unroll
    for (int e = 0; e < 4; ++e) v[e] = __builtin_amdgcn_fmed3f(v[e], -448.f, 448.f);
    int w = __builtin_amdgcn_cvt_pk_fp8_f32(v[0], v[1], 0, false); w = __builtin_amdgcn_cvt_pk_fp8_f32(v[2], v[3], w, true); return (unsigned)w;
}
__device__ __forceinline__ unsigned pk4_gate(f32x4 v) {
#pragma unroll
    for (int e = 0; e < 4; ++e) v[e] = __builtin_amdgcn_fmed3f(v[e] * -1.4426950408889634f, -43.28f, 43.28f);
    int w = __builtin_amdgcn_cvt_pk_fp8_f32(v[0], v[1], 0, false); w = __builtin_amdgcn_cvt_pk_fp8_f32(v[2], v[3], w, true); return (unsigned)w;
}
struct EpiBf16 {
    static constexpr bool PERM = true; static constexpr bool SIGNAL = false; static constexpr bool PRE = false; static constexpr int MIDK = 0;
    bf16* O; int ldc; int split; unsigned char* g8; int pn0 = 0;
    __device__ __forceinline__ void operator()(const f32x4 (&acc)[2][2][4][2], const Unit& u, int wr, int wc, int fr, int fq) const {
        bf16* base = O; int ld = ldc, c0 = u.pn * BM;
        if (split) { const int pn = u.pn + pn0; unsigned char* w = (unsigned char*)O;
            if (pn >= 2 && pn < 6) {
                bf16* pb = (bf16*)(w + WS_CONV) + 512 + (pn - 2) * 128 + wc * 32 + 8 * fq; const int row0 = u.pm * BM + wr * 64 + fr;
#pragma unroll
                for (int ai = 0; ai < 2; ++ai)
#pragma unroll
                    for (int m = 0; m < 4; ++m) { *(v4u*)(pb + (size_t)(row0 + ai * HALF + m * 16) * 1024) = pack8(acc[ai][0][m][0] * acc[ai][1][m][0], acc[ai][0][m][1] * acc[ai][1][m][1]);
                        asm volatile("" ::: "memory"); }
                return; }
            if (pn < 2) { base = (bf16*)(w + WS_CONV); ld = 1024; c0 = pn * 256; }
            else if (pn < 8) { base = (bf16*)(w + WS_SMALL); ld = 512; c0 = (pn - 6) * 256; }
            else {
                unsigned char* gb_ = g8 + (pn >= 12 ? (size_t)T * D : 0); const int cb_ = ((pn - 8) & 3) * 256 + wc * 32 + 8 * (fq & 2), r0_ = u.pm * BM + wr * 64 + fr + 16 * (fq & 1);
#pragma unroll
                for (int ai = 0; ai < 2; ++ai)
#pragma unroll
                    for (int mp = 0; mp < 2; ++mp) { unsigned char* rowp = gb_ + (size_t)(r0_ + ai * HALF + mp * 32) * D + cb_;
#pragma unroll
                        for (int bj = 0; bj < 2; ++bj) {
                            const auto s0 = __builtin_amdgcn_permlane16_swap(pk4_gate(acc[ai][bj][2 * mp][0]), pk4_gate(acc[ai][bj][2 * mp + 1][0]), false, false);
                            const auto s1 = __builtin_amdgcn_permlane16_swap(pk4_gate(acc[ai][bj][2 * mp][1]), pk4_gate(acc[ai][bj][2 * mp + 1][1]), false, false);
                            v4u w4; w4.x = s0[0]; w4.y = s1[0]; w4.z = s0[1]; w4.w = s1[1];
                            *(v4u*)(rowp + bj * HALF) = w4; }
                        asm volatile("" ::: "memory"); }
                return; } }
        const int row0 = u.pm * BM + wr * 64 + fr, col0 = c0 + wc * 32 + 8 * fq;
#pragma unroll
        for (int ai = 0; ai < 2; ++ai)
#pragma unroll
            for (int m = 0; m < 4; ++m) { bf16* rowp = base + (size_t)(row0 + ai * HALF + m * 16) * ld + col0;
#pragma unroll
                for (int bj = 0; bj < 2; ++bj) *(v4u*)(rowp + bj * HALF) = pack8(acc[ai][bj][m][0], acc[ai][bj][m][1]);
                asm volatile("" ::: "memory"); }
    }
};
struct EpiY8 {
    static constexpr bool PERM = true; static constexpr bool SIGNAL = false; static constexpr bool PRE = false; static constexpr int MIDK = 0;
    unsigned char* Y8;
    __device__ __forceinline__ void operator()(const f32x4 (&acc)[2][2][4][2], const Unit& u, int wr, int wc, int fr, int fq) const {
        const int row0 = u.pm * BM + wr * 64 + fr, col0 = u.pn * BM + wc * 32 + 8 * fq;
#pragma unroll
        for (int ai = 0; ai < 2; ++ai)
#pragma unroll
            for (int m = 0; m < 4; ++m) { unsigned char* rowp = Y8 + (size_t)(row0 + ai * HALF + m * 16) * D + col0;
#pragma unroll
                for (int bj = 0; bj < 2; ++bj) { v2u w; w.x = pk4_fp8(acc[ai][bj][m][0]); w.y = pk4_fp8(acc[ai][bj][m][1]); *(v2u*)(rowp + bj * HALF) = w; }
                asm volatile("" ::: "memory"); }
    }
};
constexpr int KVE_RSK = 131072 + 2048, KVE_RP = KVE_RSK + 2048, KVE_GN = KVE_RP + 16384, KVE_END = KVE_GN + 256;
__device__ __forceinline__ float add_xor16(float v) {
    auto r = __builtin_amdgcn_permlane16_swap(__builtin_bit_cast(unsigned, v), __builtin_bit_cast(unsigned, v), false, false);
    return __builtin_bit_cast(float, r[0]) + __builtin_bit_cast(float, r[1]); }
struct EpiKV {
    static constexpr bool PERM = true; static constexpr bool SIGNAL = false; static constexpr bool PRE = true; static constexpr int MIDK = 0;
    unsigned char* K8; unsigned char* V8T; const bf16* small; const f32x2* rope; const float* gk; LAS unsigned char* lds;
    __device__ __forceinline__ void pre(const Unit& u, int wid) const {
        unsigned z_ = 0u; asm volatile("" : "+v"(z_)); const int lane = (int)__builtin_amdgcn_mbcnt_hi(~0u, __builtin_amdgcn_mbcnt_lo(~0u, z_)), tid = wid * 64 + lane;
        const bool isK = u.pn < 2; const int q = lane & 3, i0 = 8 * (q & 1);
        if (isK && tid < 16) *(LAS f32x4*)(lds + KVE_GN + tid * 16) = *(const f32x4*)(gk + 4 * tid);
        bf16x8 xc[2][4], x1v[2], x2v[2]; f32x4 rpq[2][4], g1[2], g2[2];
#pragma unroll
        for (int it = 0; it < 2; ++it) { const int t = u.pm * BM + it * HALF + (tid >> 2); const bf16* sm = small + (size_t)t * 512;
#pragma unroll
            for (int c = 0; c < 4; ++c) xc[it][c] = *(const bf16x8*)(sm + 256 + 32 * q + 8 * c);
            if (isK) { x1v[it] = *(const bf16x8*)(sm + 384 + i0); x2v[it] = *(const bf16x8*)(sm + 384 + 16 + i0);
                const f32x4* rp = (const f32x4*)(rope + (size_t)t * 16 + i0);
#pragma unroll
                for (int c = 0; c < 4; ++c) rpq[it][c] = rp[c]; }
            else { x1v[it] = x2v[it] = xc[it][0];
#pragma unroll
                for (int c = 0; c < 4; ++c) rpq[it][c] = (f32x4){0.f, 0.f, 0.f, 0.f}; } }
#pragma unroll
        for (int n = 0; n < 2; ++n) { if (isK) { g1[n] = *(const f32x4*)(gk + 64 + i0 + 4 * n); g2[n] = *(const f32x4*)(gk + 80 + i0 + 4 * n); } else { g1[n] = g2[n] = (f32x4){0.f, 0.f, 0.f, 0.f}; } }
#pragma unroll
        for (int it = 0; it < 2; ++it) {
            const int rl = it * HALF + (tid >> 2);
            float ss = 0.f;
#pragma unroll
            for (int c = 0; c < 4; ++c)
#pragma unroll
                for (int e = 0; e < 8; ++e) { const float f = bf2f(xc[it][c][e]); ss += f * f; }
            ss += xor_lane<1>(ss); ss += xor_lane<2>(ss);
            float sk = 0.f;
            if (isK) {
#pragma unroll
                for (int e = 0; e < 8; ++e) { const float f = bf2f(q < 2 ? x1v[it][e] : x2v[it][e]); sk += f * f; }
                sk += xor_lane<1>(sk); sk += xor_lane<2>(sk);
                f32x4 o0, o1;
#pragma unroll
                for (int e = 0; e < 8; ++e) {
                    const float a = bf2f(x1v[it][e]) * (e < 4 ? g1[0][e & 3] : g1[1][e & 3]), bb = bf2f(x2v[it][e]) * (e < 4 ? g2[0][e & 3] : g2[1][e & 3]);
                    const f32x4 cq = rpq[it][e >> 1]; const float cs = (e & 1) ? cq.z : cq.x, sn_ = (e & 1) ? cq.w : cq.y;
                    const float o = q < 2 ? a * cs - bb * sn_ : bb * cs + a * sn_;
                    if (e < 4) o0[e & 3] = o; else o1[e & 3] = o; }
                *(LAS v4u*)(lds + KVE_RP + rl * 64 + q * 16) = pack8(o0, o1);
            }
            if (q == 0) { f32x2 w; w.x = 1.0f / sqrtf(ss * (1.f / 128.f) + EPS); w.y = sk; *(LAS f32x2*)(lds + KVE_RSK + rl * 8) = w; }
        }
    }
    __device__ __forceinline__ void operator()(const f32x4 (&acc)[2][2][4][2], const Unit& u, int wr, int wc, int fr, int fq) const {
        const bool isK = u.pn < 2; const int h = (u.pn & 1) * 4 + wc;
#pragma unroll
        for (int ai = 0; ai < 2; ++ai)
#pragma unroll
            for (int m = 0; m < 4; ++m) {
                const int rl = ai * HALF + wr * 64 + m * 16 + fr, t = u.pm * BM + rl, b = t / S, sq = t % S;
                const size_t orow = (size_t)(b * H + h) * S + sq;
                const f32x2 rsk = *(const LAS f32x2*)(lds + KVE_RSK + rl * 8);
                const float rs = rsk.x;
                if (isK) {
                    const v4u rpv = *(const LAS v4u*)(lds + KVE_RP + rl * 64 + fq * 16);
                    float sn = 0.f;
#pragma unroll
                    for (int bj = 0; bj < 2; ++bj)
#pragma unroll
                        for (int n = 0; n < 2; ++n) { const f32x4 t_ = acc[ai][bj][m][n] * rs;
#pragma unroll
                            for (int e = 0; e < 4; ++e) sn += t_[e] * t_[e]; }
                    sn = add_xor16(sn); sn = add_xor32(sn);
                    const float r = __builtin_amdgcn_rsqf((sn + rsk.y) * (1.f / 96.f) + EPS), rr_ = rs * r;
#pragma unroll
                    for (int bj = 0; bj < 2; ++bj) { const f32x4 g0_ = *(const LAS f32x4*)(lds + KVE_GN + (32 * bj + 8 * fq) * 4), g1_ = *(const LAS f32x4*)(lds + KVE_GN + (32 * bj + 8 * fq + 4) * 4);
                        const f32x4 k0 = acc[ai][bj][m][0] * rr_ * g0_, k1 = acc[ai][bj][m][1] * rr_ * g1_;
                        v2u w8; w8.x = pk4f8(k0[0], k0[1], k0[2], k0[3]); w8.y = pk4f8(k1[0], k1[1], k1[2], k1[3]); *(v2u*)(K8 + orow * 96 + 32 * bj + 8 * fq) = w8; }
                    f32x4 o0, o1;
                    o0[0] = bf2f((unsigned short)(rpv.x & 0xffffu)) * r; o0[1] = bf2f((unsigned short)(rpv.x >> 16)) * r; o0[2] = bf2f((unsigned short)(rpv.y & 0xffffu)) * r; o0[3] = bf2f((unsigned short)(rpv.y >> 16)) * r;
                    o1[0] = bf2f((unsigned short)(rpv.z & 0xffffu)) * r; o1[1] = bf2f((unsigned short)(rpv.z >> 16)) * r; o1[2] = bf2f((unsigned short)(rpv.w & 0xffffu)) * r; o1[3] = bf2f((unsigned short)(rpv.w >> 16)) * r;
                    { v2u w8; w8.x = pk4f8(o0[0], o0[1], o0[2], o0[3]); w8.y = pk4f8(o1[0], o1[1], o1[2], o1[3]); *(v2u*)(K8 + orow * 96 + 64 + 8 * fq) = w8; }
                } else {
                    unsigned char* vt = V8T + ((size_t)(b * H + h) * (S / 64) + (sq >> 6)) * 4096 + v8t_kpos(sq & 63);
#pragma unroll
                    for (int bj = 0; bj < 2; ++bj) { const f32x4 a0 = acc[ai][bj][m][0] * rs, a1 = acc[ai][bj][m][1] * rs;
                        const unsigned w0 = pk4f8(a0[0], a0[1], a0[2], a0[3]), w1 = pk4f8(a1[0], a1[1], a1[2], a1[3]);
#pragma unroll
                        for (int e = 0; e < 4; ++e) { vt[(32 * bj + 8 * fq + e) * 64] = (unsigned char)(w0 >> (8 * e)); vt[(32 * bj + 8 * fq + 4 + e) * 64] = (unsigned char)(w1 >> (8 * e)); } }
                }
                asm volatile("" ::: "memory");
            }
    }
};
struct EpiQ {
    static constexpr bool PERM = true; static constexpr bool SIGNAL = false; static constexpr bool PRE = true; static constexpr int MIDK = 0;
    unsigned char* Q8; const bf16* small; const f32x2* rope; const float* gq; LAS unsigned char* lds;
    __device__ __forceinline__ void pre(const Unit& u, int wid) const {
        unsigned z_ = 0u; asm volatile("" : "+v"(z_)); const int lane = (int)__builtin_amdgcn_mbcnt_hi(~0u, __builtin_amdgcn_mbcnt_lo(~0u, z_)), tid = wid * 64 + lane;
        const int q = lane & 3;
        bf16x8 x[2][8]; f32x4 cs4[4];
#pragma unroll
        for (int it = 0; it < 2; ++it) { const bf16* sm = small + (size_t)(u.pm * BM + it * HALF + (tid >> 2)) * 512 + 64 * q;
#pragma unroll
            for (int c = 0; c < 8; ++c) x[it][c] = *(const bf16x8*)(sm + 8 * c); }
        { const f32x4* p_ = (const f32x4*)(rope + (size_t)(u.pm * BM + (tid >> 1)) * 16 + 8 * (tid & 1));
#pragma unroll
          for (int c = 0; c < 4; ++c) cs4[c] = p_[c]; }
#pragma unroll
        for (int it = 0; it < 2; ++it) { const int rl = it * HALF + (tid >> 2);
            float ss = 0.f;
#pragma unroll
            for (int c = 0; c < 8; ++c)
#pragma unroll
                for (int e = 0; e < 8; ++e) { const float f = bf2f(x[it][c][e]); ss += f * f; }
            ss += xor_lane<1>(ss); ss += xor_lane<2>(ss);
            if (q == 0) { f32x2 w; w.x = 1.0f / sqrtf(ss * (1.f / 256.f) + EPS); w.y = 0.f; *(LAS f32x2*)(lds + KVE_RSK + rl * 8) = w; } }
        { v4u w0, w1;
          w0.x = pk2(cs4[0].x, cs4[0].y); w0.y = pk2(cs4[0].z, cs4[0].w); w0.z = pk2(cs4[1].x, cs4[1].y); w0.w = pk2(cs4[1].z, cs4[1].w);
          w1.x = pk2(cs4[2].x, cs4[2].y); w1.y = pk2(cs4[2].z, cs4[2].w); w1.z = pk2(cs4[3].x, cs4[3].y); w1.w = pk2(cs4[3].z, cs4[3].w);
          LAS unsigned char* d_ = lds + KVE_RP + (tid >> 1) * 64 + (tid & 1) * 32; *(LAS v4u*)d_ = w0; *(LAS v4u*)(d_ + 16) = w1; }
    }
    __device__ __forceinline__ void operator()(const f32x4 (&acc)[2][2][4][2], const Unit& u, int wr, int wc, int fr, int fq) const {
        LAS float* PS = (LAS float*)(lds + KVE_GN);
        f32x4 gn[2][2];
        if (wc < 2) {
#pragma unroll
            for (int bj = 0; bj < 2; ++bj) { gn[bj][0] = *(const f32x4*)(gq + 32 * bj + 8 * fq); gn[bj][1] = *(const f32x4*)(gq + 32 * bj + 8 * fq + 4); }
        } else { gn[0][0] = *(const f32x4*)(gq + 64 + 8 * fq); gn[0][1] = *(const f32x4*)(gq + 64 + 8 * fq + 4); gn[1][0] = gn[0][0]; gn[1][1] = gn[0][1]; }
        {
#pragma unroll
            for (int ai = 0; ai < 2; ++ai)
#pragma unroll
                for (int m = 0; m < 4; ++m) {
                    const int rl = ai * HALF + wr * 64 + m * 16 + fr;
                    const float rs = *(const LAS float*)(lds + KVE_RSK + rl * 8);
                    float sn[2];
#pragma unroll
                    for (int bj = 0; bj < 2; ++bj) { float a_ = 0.f;
#pragma unroll
                        for (int n = 0; n < 2; ++n) { const f32x4 t_ = acc[ai][bj][m][n] * rs;
#pragma unroll
                            for (int e = 0; e < 4; ++e) a_ += t_[e] * t_[e]; }
                        sn[bj] = a_; }
                    if (wc < 2) { float s_ = sn[0] + sn[1]; s_ = add_xor16(s_); s_ = add_xor32(s_); if (fq == 0) PS[rl * 4 + wc] = s_; }
                    else { float s0 = add_xor16(sn[0]); s0 = add_xor32(s0); if (fq == 0) PS[rl * 4 + wc] = s0; }
                }
        }
        asm volatile("s_waitcnt lgkmcnt(0)" ::: "memory"); __builtin_amdgcn_s_barrier();
        if (wc < 2) {
            const int h = 2 * u.pn + wc;
#pragma unroll
            for (int ai = 0; ai < 2; ++ai)
#pragma unroll
                for (int m = 0; m < 4; ++m) {
                    const int rl = ai * HALF + wr * 64 + m * 16 + fr, t = u.pm * BM + rl, b = t / S, sq = t % S;
                    const size_t orow = (size_t)(b * H + h) * S + sq;
                    const float rs = *(const LAS float*)(lds + KVE_RSK + rl * 8);
                    const float tot = PS[rl * 4 + wc] + PS[rl * 4 + 2 + wc];
                    const float rr_ = rs * __builtin_amdgcn_rsqf(tot * (1.f / 96.f) + EPS) * Q8SC;
#pragma unroll
                    for (int bj = 0; bj < 2; ++bj) { const f32x4 k0 = acc[ai][bj][m][0] * rr_ * gn[bj][0], k1 = acc[ai][bj][m][1] * rr_ * gn[bj][1];
                        v2u w8; w8.x = pk4f8(k0[0], k0[1], k0[2], k0[3]); w8.y = pk4f8(k1[0], k1[1], k1[2], k1[3]); *(v2u*)(Q8 + orow * 96 + 32 * bj + 8 * fq) = w8; }
                    asm volatile("" ::: "memory");
                }
        } else {
            const f32x4 gr0 = gn[0][0], gr1 = gn[0][1];
            const bool hi = fq >= 2; const float sgn = hi ? 1.f : -1.f;
#pragma unroll
            for (int ai = 0; ai < 2; ++ai)
#pragma unroll
                for (int mp = 0; mp < 2; ++mp) {
#pragma unroll
                    for (int mm = 0; mm < 2; ++mm) { const int m = 2 * mp + mm;
                        const int rl = ai * HALF + wr * 64 + m * 16 + fr, t = u.pm * BM + rl, b = t / S, sq = t % S;
                        const float rs = *(const LAS float*)(lds + KVE_RSK + rl * 8);
                        const f32x4 ps = *(const LAS f32x4*)(PS + rl * 4);
                        const v4u c0_ = *(const LAS v4u*)(lds + KVE_RP + rl * 64 + (fq & 1) * 32), c1_ = *(const LAS v4u*)(lds + KVE_RP + rl * 64 + (fq & 1) * 32 + 16);
                        { constexpr int bj = 0;
                            const size_t orow = (size_t)(b * H + 2 * u.pn + (wc - 2)) * S + sq;
                            const float tot = wc == 3 ? ps.y + ps.w : ps.x + ps.z;
                            const float rr_ = rs * __builtin_amdgcn_rsqf(tot * (1.f / 96.f) + EPS) * Q8SC;
                            const f32x4 v0 = acc[ai][bj][m][0] * rr_ * gr0, v1 = acc[ai][bj][m][1] * rr_ * gr1;
                            float o[8];
#pragma unroll
                            for (int i = 0; i < 8; ++i) { const float v = i < 4 ? v0[i & 3] : v1[i & 3];
                                auto sw = __builtin_amdgcn_permlane32_swap(__builtin_bit_cast(unsigned, v), __builtin_bit_cast(unsigned, v), false, false);
                                const float pr = __builtin_bit_cast(float, hi ? sw[0] : sw[1]);
                                const unsigned cw_ = i < 4 ? c0_[i & 3] : c1_[i & 3]; const float cs = __builtin_bit_cast(float, cw_ << 16), sn_ = __builtin_bit_cast(float, cw_ & 0xffff0000u);
                                o[i] = v * cs + sgn * pr * sn_; }
                            v2u w8; w8.x = pk4f8(o[0], o[1], o[2], o[3]); w8.y = pk4f8(o[4], o[5], o[6], o[7]); *(v2u*)(Q8 + orow * 96 + 64 + 8 * fq) = w8; }
                    }
                    asm volatile("" ::: "memory");
                }
        }
    }
};
template <int MODE> struct EpiGate {
    static constexpr bool PERM = true; static constexpr bool SIGNAL = false; static constexpr bool PRE = false; static constexpr int MIDK = 0;
    bf16* ga; const unsigned char* g8; unsigned char* m8;
    __device__ __forceinline__ void operator()(const f32x4 (&acc)[2][2][4][2], const Unit& u, int wr, int wc, int fr, int fq) const {
        const int row0 = u.pm * BM + wr * 64 + fr, col0 = u.pn * BM + wc * 32 + 8 * fq;
#pragma unroll
        for (int ai = 0; ai < 2; ++ai) {
            v2u g[4][2]; bf16x8 t[4][2];
#pragma unroll
            for (int m = 0; m < 4; ++m) { const size_t off = (size_t)(row0 + ai * HALF + m * 16) * D + col0;
#pragma unroll
                for (int bj = 0; bj < 2; ++bj) { g[m][bj] = *(const v2u*)(g8 + off + bj * HALF);
                    t[m][bj] = (bf16x8){0, 0, 0, 0, 0, 0, 0, 0}; if (MODE == 2) t[m][bj] = *(const bf16x8*)(ga + off + bj * HALF); } }
#pragma unroll
            for (int m = 0; m < 4; ++m) { const size_t off = (size_t)(row0 + ai * HALF + m * 16) * D + col0;
#pragma unroll
                for (int bj = 0; bj < 2; ++bj) {
                    f32x4 v0 = acc[ai][bj][m][0], v1 = acc[ai][bj][m][1];
                    const f32x2 q0 = __builtin_amdgcn_cvt_pk_f32_fp8((int)g[m][bj].x, false), q1 = __builtin_amdgcn_cvt_pk_f32_fp8((int)g[m][bj].x, true);
                    const f32x2 q2 = __builtin_amdgcn_cvt_pk_f32_fp8((int)g[m][bj].y, false), q3 = __builtin_amdgcn_cvt_pk_f32_fp8((int)g[m][bj].y, true);
                    const f32x4 ga0 = {q0.x, q0.y, q1.x, q1.y}, ga1 = {q2.x, q2.y, q3.x, q3.y};
#pragma unroll
                    for (int e = 0; e < 4; ++e) { v0[e] = sigmoidf_(ga0[e]) * v0[e]; v1[e] = sigmoidf_(ga1[e]) * v1[e];
                        if (MODE == 2) { v0[e] += bf2f(t[m][bj][e]); v1[e] += bf2f(t[m][bj][4 + e]); } }
                    if (MODE == 2) { v2u w8; w8.x = pk4f8(v0[0], v0[1], v0[2], v0[3]); w8.y = pk4f8(v1[0], v1[1], v1[2], v1[3]); *(v2u*)(m8 + off + bj * HALF) = w8; }
                    else *(v4u*)(ga + off + bj * HALF) = pack8(v0, v1); } }
            asm volatile("" ::: "memory");
        }
    }
};
struct EpiGateFused {
    static constexpr bool PERM = true; static constexpr bool SIGNAL = false; static constexpr bool PRE = false; static constexpr int MIDK = 4;
    const unsigned char* ga8; const unsigned char* gb8; unsigned char* m8;
    static __device__ __forceinline__ void dec8(v2u g, f32x4& lo, f32x4& hi) {
        const f32x2 q0 = __builtin_amdgcn_cvt_pk_f32_fp8((int)g.x, false), q1 = __builtin_amdgcn_cvt_pk_f32_fp8((int)g.x, true), q2 = __builtin_amdgcn_cvt_pk_f32_fp8((int)g.y, false), q3 = __builtin_amdgcn_cvt_pk_f32_fp8((int)g.y, true);
        lo = (f32x4){q0.x, q0.y, q1.x, q1.y}; hi = (f32x4){q2.x, q2.y, q3.x, q3.y}; }
    static __device__ __forceinline__ float en(float x) { return __builtin_amdgcn_exp2f(x); }
    __device__ __forceinline__ void mid(f32x4 (&acc)[2][2][4][2], const Unit& u, int wr, int wc, int fr, int fq) const {
        const int row0 = u.pm * BM + wr * 64 + fr, col0 = u.pn * BM + wc * 32 + 8 * fq;
        v2u a[2][2][2], b[2][2][2];
#define GF_LOAD(k_, buf_) { _Pragma("unroll") for (int mm = 0; mm < 2; ++mm) { const size_t off = (size_t)(row0 + ((k_) >> 1) * HALF + (2 * ((k_) & 1) + mm) * 16) * D + col0; \
            _Pragma("unroll") for (int bj = 0; bj < 2; ++bj) { a[buf_][mm][bj] = *(const v2u*)(ga8 + off + bj * HALF); b[buf_][mm][bj] = __builtin_nontemporal_load((const v2u*)(gb8 + off + bj * HALF)); } } }
        GF_LOAD(0, 0)
#pragma unroll
        for (int k = 0; k < 4; ++k) { const int ai = k >> 1, mp = k & 1, cb = k & 1;
            if (k == 0) GF_LOAD(1, 1) else if (k == 1) GF_LOAD(2, 0) else if (k == 2) GF_LOAD(3, 1)
            asm volatile("" ::: "memory");
#pragma unroll
            for (int mm = 0; mm < 2; ++mm) { const int m = 2 * mp + mm;
#pragma unroll
                for (int bj = 0; bj < 2; ++bj) { f32x4 a0, a1, b0, b1; dec8(a[cb][mm][bj], a0, a1); dec8(b[cb][mm][bj], b0, b1);
#pragma unroll
                    for (int e = 0; e < 4; ++e) { acc[ai][bj][m][0][e] *= (0.015625f + 0.015625f * en(a0[e])) * __builtin_amdgcn_rcpf(1.f + en(b0[e])); acc[ai][bj][m][1][e] *= (0.015625f + 0.015625f * en(a1[e])) * __builtin_amdgcn_rcpf(1.f + en(b1[e])); } } }
        }
#undef GF_LOAD
    }
    __device__ __forceinline__ void operator()(const f32x4 (&acc)[2][2][4][2], const Unit& u, int wr, int wc, int fr, int fq) const {
        const int row0 = u.pm * BM + wr * 64 + fr, col0 = u.pn * BM + wc * 32 + 8 * fq;
#pragma unroll
        for (int ai = 0; ai < 2; ++ai) {
            v2u a[4][2];
#pragma unroll
            for (int m = 0; m < 4; ++m) { const size_t off = (size_t)(row0 + ai * HALF + m * 16) * D + col0;
#pragma unroll
                for (int bj = 0; bj < 2; ++bj) a[m][bj] = __builtin_nontemporal_load((const v2u*)(ga8 + off + bj * HALF)); }
#pragma unroll
            for (int m = 0; m < 4; ++m) { const size_t off = (size_t)(row0 + ai * HALF + m * 16) * D + col0;
#pragma unroll
                for (int bj = 0; bj < 2; ++bj) { f32x4 a0, a1; dec8(a[m][bj], a0, a1); f32x4 v0, v1;
#pragma unroll
                    for (int e = 0; e < 4; ++e) { v0[e] = acc[ai][bj][m][0][e] * __builtin_amdgcn_rcpf(1.f + en(a0[e])); v1[e] = acc[ai][bj][m][1][e] * __builtin_amdgcn_rcpf(1.f + en(a1[e])); }
                    v2u w8; w8.x = pk4f8(v0[0], v0[1], v0[2], v0[3]); w8.y = pk4f8(v1[0], v1[1], v1[2], v1[3]); *(v2u*)(m8 + off + bj * HALF) = w8; } }
            asm volatile("" ::: "memory");
        }
    }
};
struct EpiRes {
    static constexpr bool PERM = false; static constexpr bool SIGNAL = false; static constexpr bool PRE = false; static constexpr int MIDK = 0;
    const float* xin; float* out; const float* gt;
    __device__ __forceinline__ void operator()(const f32x4 (&acc)[2][2][4][2], const Unit& u, int wr, int wc, int fr, int fq) const {
        const int col0 = u.pn * BM + wc * 32 + 4 * fq;
        const float* g = gt + ((u.pm * BM) / S) * 6 * D;
        f32x4 gv[2][2];
#pragma unroll
        for (int bj = 0; bj < 2; ++bj)
#pragma unroll
            for (int n = 0; n < 2; ++n) gv[bj][n] = *(const f32x4*)(g + col0 + bj * HALF + n * 16);
#pragma unroll
        for (int ai = 0; ai < 2; ++ai)
#pragma unroll
            for (int mp = 0; mp < 2; ++mp) {
                f32x4 xv[2][2][2];
#pragma unroll
                for (int mm = 0; mm < 2; ++mm) { const size_t off = (size_t)(u.pm * BM + ai * HALF + wr * 64 + (2 * mp + mm) * 16 + fr) * D + col0;
#pragma unroll
                    for (int bj = 0; bj < 2; ++bj)
#pragma unroll
                        for (int n = 0; n < 2; ++n) xv[mm][bj][n] = *(const f32x4*)(xin + off + bj * HALF + n * 16); }
#pragma unroll
                for (int mm = 0; mm < 2; ++mm) { const int m = 2 * mp + mm; const size_t off = (size_t)(u.pm * BM + ai * HALF + wr * 64 + m * 16 + fr) * D + col0;
#pragma unroll
                    for (int bj = 0; bj < 2; ++bj)
#pragma unroll
                        for (int n = 0; n < 2; ++n) *(f32x4*)(out + off + bj * HALF + n * 16) = xv[mm][bj][n] + gv[bj][n] * acc[ai][bj][m][n]; }
                asm volatile("" ::: "memory");
            }
    }
};
struct EpiRes16 {
    static constexpr bool PERM = true; static constexpr bool SIGNAL = false; static constexpr bool PRE = false; static constexpr int MIDK = 0;
    const float* xin32; bf16* x16; const float* gt;
    __device__ __forceinline__ void operator()(const f32x4 (&acc)[2][2][4][2], const Unit& u, int wr, int wc, int fr, int fq) const {
        const int row0 = u.pm * BM + wr * 64 + fr, col0 = u.pn * BM + wc * 32 + 8 * fq;
        const float* g = gt + ((u.pm * BM) / S) * 6 * D;
        f32x4 gv[2][2];
#pragma unroll
        for (int bj = 0; bj < 2; ++bj)
#pragma unroll
            for (int n = 0; n < 2; ++n) gv[bj][n] = *(const f32x4*)(g + col0 + bj * HALF + n * 4);
#pragma unroll
        for (int ai = 0; ai < 2; ++ai)
#pragma unroll
            for (int mp = 0; mp < 2; ++mp) {
                f32x4 xv[2][2][2];
#pragma unroll
                for (int mm = 0; mm < 2; ++mm) { const size_t off = (size_t)(row0 + ai * HALF + (2 * mp + mm) * 16) * D + col0;
#pragma unroll
                    for (int bj = 0; bj < 2; ++bj) {
                        if (xin32) { xv[mm][bj][0] = __builtin_nontemporal_load((const f32x4*)(xin32 + off + bj * HALF)); xv[mm][bj][1] = __builtin_nontemporal_load((const f32x4*)(xin32 + off + bj * HALF + 4)); }
                        else { const bf16x8 t = __builtin_nontemporal_load((const bf16x8*)(x16 + off + bj * HALF));
#pragma unroll
                            for (int e = 0; e < 4; ++e) { xv[mm][bj][0][e] = bf2f(t[e]); xv[mm][bj][1][e] = bf2f(t[4 + e]); } } } }
#pragma unroll
                for (int mm = 0; mm < 2; ++mm) { const int m = 2 * mp + mm; const size_t off = (size_t)(row0 + ai * HALF + m * 16) * D + col0;
#pragma unroll
                    for (int bj = 0; bj < 2; ++bj) *(v4u*)(x16 + off + bj * HALF) = pack8(xv[mm][bj][0] + gv[bj][0] * acc[ai][bj][m][0], xv[mm][bj][1] + gv[bj][1] * acc[ai][bj][m][1]); }
                asm volatile("" ::: "memory");
            }
    }
};
struct EpiAct {
    static constexpr bool PERM = true; static constexpr bool SIGNAL = true; static constexpr bool PRE = false; static constexpr int MIDK = 0;
    bf16* a2; const float* tokw; unsigned* flags;
    __device__ __forceinline__ void operator()(const f32x4 (&acc)[2][2][4][2], const Unit& u, int wr, int wc, int fr, int fq) const {
        const int col0 = u.pn * HALF + wc * 32 + 8 * fq;
        const __amdgpu_buffer_rsrc_t rsrc = __builtin_amdgcn_make_buffer_rsrc((void*)a2, 0, SLOTS_MAX * DE * 2, 0x00020000);
        float wv[2][4];
        if (u.list) { int tk[2][4];
#pragma unroll
            for (int ai = 0; ai < 2; ++ai)
#pragma unroll
                for (int m = 0; m < 4; ++m) { const int rl = ai * HALF + wr * 64 + m * 16 + fr; tk[ai][m] = rl < u.rows ? u.list[rl] : -1; }
#pragma unroll
            for (int ai = 0; ai < 2; ++ai)
#pragma unroll
                for (int m = 0; m < 4; ++m) wv[ai][m] = tk[ai][m] >= 0 ? tokw[tk[ai][m]] : 0.f;
        } else {
#pragma unroll
            for (int ai = 0; ai < 2; ++ai)
#pragma unroll
                for (int m = 0; m < 4; ++m) wv[ai][m] = 1.f; }
#pragma unroll
        for (int ai = 0; ai < 2; ++ai)
#pragma unroll
            for (int m = 0; m < 4; ++m) { const int rl = ai * HALF + wr * 64 + m * 16 + fr;
                const float w = wv[ai][m];
                f32x4 v0, v1;
#pragma unroll
                for (int e = 0; e < 4; ++e) { const float g0 = acc[ai][0][m][0][e], g1 = acc[ai][0][m][1][e];
                    v0[e] = g0 * __builtin_amdgcn_rcpf(1.f + __expf(-g0)) * acc[ai][1][m][0][e] * w; v1[e] = g1 * __builtin_amdgcn_rcpf(1.f + __expf(-g1)) * acc[ai][1][m][1][e] * w; }
                { v2u w8; w8.x = pk4f8(v0[0] * 8.f, v0[1] * 8.f, v0[2] * 8.f, v0[3] * 8.f); w8.y = pk4f8(v1[0] * 8.f, v1[1] * 8.f, v1[2] * 8.f, v1[3] * 8.f);
                  __builtin_amdgcn_raw_buffer_store_b64(w8, rsrc, (u.pm * BM + rl) * DE + col0, 0,   16); }
                asm volatile("" ::: "memory"); }
    }
    __device__ __forceinline__ void signal(const Unit& u, bool leader) const { if (leader) (void)xb_add(flags + u.pm, 1u); }
};

template <class Epi, class Sched, bool GATHER, bool F8 = false>
__device__ __forceinline__ void gemm_phase(LAS unsigned char* lds, const int tid_in, const Gemm g, const Sched& S, const Epi& E) {
    int tid = tid_in;
    if constexpr (Epi::PRE) {
        const int wid0 = __builtin_amdgcn_readfirstlane(tid >> 6); Unit u0;
        if (!S.next(0, u0, wid0)) return;
        E.pre(u0, wid0);
        asm volatile("" : "+v"(tid) :: "memory");
    }
    const int wid = __builtin_amdgcn_readfirstlane(tid >> 6), lane = tid & 63, wr = wid >> 2, wc = wid & 3, fr = lane & 15, fq = lane >> 4;
    const int K = g.K, nt = K / BK; const unsigned lda = g.lda;
    unsigned voffA[2], voffB[2]; int RA[2], CA2[2];
#pragma unroll
    for (int i = 0; i < 2; ++i) { int R, C; stage_rc(tid * 16 + i * 8192, R, C); const int Rb = Epi::PERM ? ((R & ~31) + perm32(R & 31)) : R;
        voffA[i] = (unsigned)R * lda + (unsigned)C * 2u; voffB[i] = (unsigned)(Rb * K + C) * 2u; RA[i] = R; CA2[i] = C * 2; }
    const size_t kstep = (size_t)(BK * 2);
    const size_t hstepA = (size_t)HALF * lda, hstepB = (size_t)HALF * K * 2, pstepA = (size_t)64 * lda, pstepB = (size_t)64 * K * 2;
    const unsigned ldsw = (unsigned)wid * 1024u;
    const int aoff = lds_byte(wr * 64 + fr, fq * 8), boff = lds_byte(wc * 32 + fr, fq * 8);
    unsigned offC[2], offN[2];
#define PG8_GOFF(dst, U) do { unsigned zz_ = 0u; asm volatile("" : "+v"(zz_)); const int t2_ = wid * 64 + (int)__builtin_amdgcn_mbcnt_hi(~0u, __builtin_amdgcn_mbcnt_lo(~0u, zz_)); \
        _Pragma("unroll") for (int i_ = 0; i_ < 2; ++i_) { int R_, C_; stage_rc(t2_ * 16 + i_ * 8192, R_, C_); unsigned pk_ = 0u; \
            _Pragma("unroll") for (int h_ = 0; h_ < 2; ++h_) { const int rl_ = h_ * HALF + R_; \
                int tok_; if ((U).list) tok_ = rl_ < (U).rows ? ((U).list[rl_] >> 1) : 0; else tok_ = (U).tok0 + rl_; pk_ |= (unsigned)tok_ << (16 * h_); } \
            dst[i_] = pk_; } } while (0)
#define PG8_SA(b, h) (((b) * 2 + (h)) * HTB)
#define PG8_SB(b, h) ((4 + (b) * 2 + (h)) * HTB)
#define PG8_GLDS(gp, bufoff, i_) __builtin_amdgcn_global_load_lds((const unsigned*)(gp), (LAS unsigned*)(lds + (bufoff) + ldsw + (i_) * 8192), 16, 0, 0)
#define PG8_OPQ(v_) ({ unsigned o__ = (v_); asm volatile("" : "+v"(o__)); o__; })
#define PG8_STAGE_B(bufoff, gbase) do { _Pragma("unroll") for (int _i = 0; _i < 2; ++_i) PG8_GLDS((const char*)(gbase) + (size_t)_i * pstepB + PG8_OPQ(voffB[0]), bufoff, _i); } while (0)
#define PG8_STAGE_A(bufoff, ub, NX, h, koff) do { if constexpr (GATHER) { _Pragma("unroll") for (int _i = 0; _i < 2; ++_i) { const unsigned o_ = PG8_OPQ(((((NX) ? offN[_i] : offC[_i]) >> (16 * (h))) & 0xffffu) * lda + (unsigned)CA2[0]); PG8_GLDS((ub) + (koff) + o_, bufoff, _i); } } \
        else { _Pragma("unroll") for (int _i = 0; _i < 2; ++_i) PG8_GLDS((ub) + (size_t)(h) * hstepA + (size_t)_i * pstepA + (koff) + PG8_OPQ(voffA[0]), bufoff, _i); } } while (0)
#define PG8_LDA(dst, b, h) do { _Pragma("unroll") for (int m = 0; m < 4; ++m) _Pragma("unroll") for (int k = 0; k < 2; ++k) dst[m][k] = *(const LAS sbf16x8*)(lds + PG8_SA(b, h) + aoff + m * 2048 + k * 1024); } while (0)
#define PG8_LDB(dst, b, h) do { _Pragma("unroll") for (int n = 0; n < 2; ++n) _Pragma("unroll") for (int k = 0; k < 2; ++k) dst[n][k] = *(const LAS sbf16x8*)(lds + PG8_SB(b, h) + boff + n * 2048 + k * 1024); } while (0)
#define PG8_CAT8(x_) __builtin_shufflevector(__builtin_bit_cast(v4i_, (x_)[0]), __builtin_bit_cast(v4i_, (x_)[1]), 0, 1, 2, 3, 4, 5, 6, 7)
#define PG8_MMA(ai, bj, At, Bt) do { __builtin_amdgcn_s_setprio(1); \
        if constexpr (F8) {   \
            _Pragma("unroll") for (int m = 0; m < 4; ++m) _Pragma("unroll") for (int n = 0; n < 2; ++n) \
                acc[ai][bj][m][n] = __builtin_amdgcn_mfma_scale_f32_16x16x128_f8f6f4(PG8_CAT8(Bt[n]), PG8_CAT8(At[m]), acc[ai][bj][m][n], 0, 0, 0, g.sw, 0, g.sx); } \
        else { _Pragma("unroll") for (int m = 0; m < 4; ++m) _Pragma("unroll") for (int n = 0; n < 2; ++n) _Pragma("unroll") for (int k = 0; k < 2; ++k) \
            acc[ai][bj][m][n] = __builtin_amdgcn_mfma_f32_16x16x32_bf16(Bt[n][k], At[m][k], acc[ai][bj][m][n], 0, 0, 0); } \
        __builtin_amdgcn_s_setprio(0); } while (0)
#define PG8_WAIT_V(n) asm volatile("s_waitcnt vmcnt(" #n ")" ::: "memory")
#define PG8_WAIT_L(n) asm volatile("s_waitcnt lgkmcnt(" #n ")" ::: "memory")
#define PG8_BAR __builtin_amdgcn_s_barrier()
#define PG8_SCHED __builtin_amdgcn_sched_barrier(0)
    Unit cur, nxt; int ui = 0;
    if (!S.next(0, cur, wid)) return;
    if constexpr (Sched::WAITS) PG8_BAR;
    f32x4 acc[2][2][4][2];
#define PG8_ZERO_ACC() do { float z_ = 0.f; asm volatile("" : "+v"(z_)); _Pragma("unroll") for (int a = 0; a < 2; ++a) _Pragma("unroll") for (int b = 0; b < 2; ++b) _Pragma("unroll") for (int m = 0; m < 4; ++m) \
        _Pragma("unroll") for (int n = 0; n < 2; ++n) acc[a][b][m][n] = (f32x4){z_, z_, z_, z_}; } while (0)
    sbf16x8 At[4][2], B0[2][2], B1[2][2];
    const char* cA = cur.a; const char* cB = cur.b;
    if constexpr (GATHER) { PG8_GOFF(offC, cur); PG8_WAIT_V(0); }
    PG8_STAGE_B(PG8_SB(0, 0), cB); PG8_STAGE_B(PG8_SB(0, 1), cB + hstepB); PG8_STAGE_A(PG8_SA(0, 0), cA, false, 0, 0); PG8_STAGE_A(PG8_SA(0, 1), cA, false, 1, 0);
    PG8_ZERO_ACC();
    if (wr == 1) PG8_BAR;
    PG8_WAIT_V(2); PG8_BAR;
    PG8_STAGE_B(PG8_SB(1, 0), cB + kstep); PG8_STAGE_A(PG8_SA(1, 0), cA, false, 0, kstep); PG8_STAGE_B(PG8_SB(1, 1), cB + hstepB + kstep);
    PG8_WAIT_V(6); PG8_BAR;
    for (;;) {
        const bool has_next = Sched::SINGLE ? false : S.next(ui + 1, nxt, wid);
        if constexpr (GATHER) { if (has_next) { PG8_GOFF(offN, nxt); PG8_WAIT_V(0); } else {
#pragma unroll
            for (int i_ = 0; i_ < 2; ++i_) offN[i_] = offC[i_]; } }
        const char* nA = has_next ? nxt.a : cA; const char* nB = has_next ? nxt.b : cB;
#define PG8_KITER(t) do { \
            const bool last = (t == nt - 2); \
            const size_t k1 = (size_t)(t + 1) * kstep; \
            const char* a2 = last ? nA : cA; const char* b2 = last ? nB : cB + (size_t)(t + 2) * kstep; \
            const size_t k2 = last ? 0 : (size_t)(t + 2) * kstep; \
            const char* b3 = b2 + kstep; \
 \
            PG8_LDB(B0, 0, 0); PG8_LDB(B1, 0, 1); PG8_SCHED; PG8_LDA(At, 0, 0); PG8_STAGE_A(PG8_SA(1, 1), cA, false, 1, k1); \
            PG8_WAIT_V(8); PG8_WAIT_L(0); PG8_BAR; PG8_MMA(0, 0, At, B0); PG8_MMA(0, 1, At, B1); PG8_BAR; PG8_SCHED; \
 \
            PG8_LDA(At, 0, 1); PG8_STAGE_B(PG8_SB(0, 0), b2); PG8_STAGE_B(PG8_SB(0, 1), b2 + hstepB); PG8_STAGE_A(PG8_SA(0, 0), a2, last, 0, k2); \
            PG8_WAIT_V(8); PG8_WAIT_L(0); PG8_BAR; PG8_MMA(1, 0, At, B0); PG8_MMA(1, 1, At, B1); PG8_BAR; PG8_SCHED; \
 \
            PG8_LDB(B0, 1, 0); PG8_LDB(B1, 1, 1); PG8_SCHED; PG8_LDA(At, 1, 0); PG8_STAGE_A(PG8_SA(0, 1), a2, last, 1, k2); \
            PG8_WAIT_V(8); PG8_WAIT_L(0); PG8_BAR; PG8_MMA(0, 0, At, B0); PG8_MMA(0, 1, At, B1); PG8_BAR; PG8_SCHED; \
 \
            PG8_LDA(At, 1, 1); PG8_STAGE_B(PG8_SB(1, 0), b3); PG8_STAGE_B(PG8_SB(1, 1), b3 + hstepB); PG8_STAGE_A(PG8_SA(1, 0), a2, last, 0, k2 + kstep); \
            PG8_WAIT_V(8); PG8_WAIT_L(0); PG8_BAR; PG8_MMA(1, 0, At, B0); PG8_MMA(1, 1, At, B1); PG8_BAR; PG8_SCHED; \
        } while (0)
        if constexpr (Epi::MIDK > 0) {
#pragma unroll 1
            for (int t = 0; t < Epi::MIDK; t += 2) PG8_KITER(t);
            { unsigned zm_ = 0u; asm volatile("" : "+v"(zm_)); const int lm_ = (int)__builtin_amdgcn_mbcnt_hi(~0u, __builtin_amdgcn_mbcnt_lo(~0u, zm_)); E.mid(acc, cur, wr, wc, lm_ & 15, lm_ >> 4); }
#pragma unroll 1
            for (int t = Epi::MIDK; t < nt; t += 2) PG8_KITER(t);
        } else {
#pragma unroll 1
            for (int t = 0; t < nt; t += 2) PG8_KITER(t);
        }
#undef PG8_KITER
        if (wr == 0) PG8_BAR;
        { unsigned z_ = 0u; asm volatile("" : "+v"(z_)); const int l2_ = (int)__builtin_amdgcn_mbcnt_hi(~0u, __builtin_amdgcn_mbcnt_lo(~0u, z_));
          E(acc, cur, wr, wc, l2_ & 15, l2_ >> 4);
          if constexpr (Epi::SIGNAL) { PG8_WAIT_V(0); PG8_BAR; E.signal(cur, wid == 0 && l2_ == 0); } }
        if (!has_next) break;
        cur = nxt; cA = nA; cB = nB; ++ui;
        if constexpr (GATHER) {
#pragma unroll
            for (int i_ = 0; i_ < 2; ++i_) offC[i_] = offN[i_]; }
        if constexpr (Epi::PRE) { PG8_BAR; E.pre(cur, wid); }
        PG8_ZERO_ACC();
        if (wr == 1) PG8_BAR;
    }
    PG8_WAIT_V(0);
    PG8_BAR;
#undef PG8_GOFF
#undef PG8_ZERO_ACC
#undef PG8_SA
#undef PG8_SB
#undef PG8_GLDS
#undef PG8_OPQ
#undef PG8_STAGE_A
#undef PG8_STAGE_B
#undef PG8_LDA
#undef PG8_LDB
#undef PG8_MMA
#undef PG8_CAT8
#undef PG8_WAIT_V
#undef PG8_WAIT_L
#undef PG8_BAR
#undef PG8_SCHED
}
}

template <class Epi>
__device__ __forceinline__ void run_dense(Frame& F, const bf16* A, int lda_elems, const bf16* Bt, int M, int N, int K, const Epi& E) {
    pg8::StaticOrder S; S.A = (const char*)A; S.Bt = (const char*)Bt; S.lda = (unsigned)lda_elems * 2u; S.K = K; S.nM = M / 256; S.nN = N / 256; S.nwg = S.nM * S.nN; S.G = F.G; S.c = F.bid;
    pg8::Gemm g{(unsigned)lda_elems * 2u, K};
    fresh_tid(F);
    pg8::gemm_phase<Epi, pg8::StaticOrder, false>(F.lds, F.tid, g, S, E);
}

template <class Epi>
__device__ __forceinline__ void run_dense8(Frame& F, const unsigned char* A, int lda_bytes, const unsigned char* Bt, int M, int N, int Kbytes, const Epi& E, int sx = 0x7f7f7f7f) {
    pg8::StaticOrder S; S.A = (const char*)A; S.Bt = (const char*)Bt; S.lda = (unsigned)lda_bytes; S.K = Kbytes / 2; S.nM = M / 256; S.nN = N / 256; S.nwg = S.nM * S.nN; S.G = F.G; S.c = F.bid;
    pg8::Gemm g{(unsigned)lda_bytes, Kbytes / 2, 0x7a7a7a7a, sx};
    fresh_tid(F);
    pg8::gemm_phase<Epi, pg8::StaticOrder, false, true>(F.lds, F.tid, g, S, E);
}

template <class Epi>
__device__ __forceinline__ void run_dense8_single(Frame& F, const unsigned char* A, int lda_bytes, const unsigned char* Bt, int M, int N, int Kbytes, const Epi& E, int sx = 0x7f7f7f7f, int sw = 0x7a7a7a7a) {
    pg8::StaticOrder1 S; S.A = (const char*)A; S.Bt = (const char*)Bt; S.lda = (unsigned)lda_bytes; S.K = Kbytes / 2; S.nM = M / 256; S.nN = N / 256; S.nwg = S.nM * S.nN; S.G = F.G; S.c = F.bid;
    pg8::Gemm g{(unsigned)lda_bytes, Kbytes / 2, sw, sx};
    for (int base = 0; base < S.nwg; base += F.G) { S.base = base; fresh_tid(F); pg8::gemm_phase<Epi, pg8::StaticOrder1, false, true>(F.lds, F.tid, g, S, E); }
}

constexpr int TB_OFF = 131072;
static_assert(pg8::KVE_END <= LDS_BYTES && TB_OFF + 2048 <= pg8::KVE_RSK, "LDS side tables");
constexpr int TE_OFF = TB_OFF + 1024;
__device__ __forceinline__ void compute_bases(Frame& F, int l) {
    fresh_tid(F);
    LAS unsigned* tb = (LAS unsigned*)(F.lds + TB_OFF); LAS unsigned* lc = tb + 32;
    if (F.tid == 0) { const unsigned* cnt = F.ctl + CW_CNT + CNT_LS * l; unsigned acc = 0;
        for (int e = 0; e < NE; ++e) { const unsigned c = cnt[CNT_ES * e]; lc[e] = c; tb[e] = acc; acc += (c + 255u) >> 8; }
        tb[16] = acc; tb[17] = acc + T / 256;
        if (F.bid == 0) { unsigned* base = F.ctl + CW_BASE + 32 * l; for (int e = 0; e < 18; ++e) base[e] = tb[e] * 256u; } }
    __syncthreads();
    if (F.tid < 256) { LAS unsigned* te = (LAS unsigned*)(F.lds + TE_OFF); unsigned e = 0;
        for (int j = 1; j <= NE; ++j) if ((unsigned)F.tid >= tb[j]) e = (unsigned)j;
        te[F.tid] = e | (((unsigned)F.tid - tb[e]) << 8); }
    __syncthreads();
}

struct Args { const GAS void* in[26]; GAS float* out; GAS unsigned char* ws; int lo, hi; };
constexpr int NPH = FAST_D ? 8 : 9;
constexpr int NSTEPS = 3 + 2 * NPH;

__global__ void __launch_bounds__(NTHREADS, 2) mk_fwd(Args args) {
    extern __shared__ __attribute__((aligned(16))) unsigned char lds_raw[];
    Frame F;
    F.lds = (LAS unsigned char*)lds_raw; F.MISC = (volatile LAS unsigned*)(F.lds + MISC_OFF);
    F.tid = threadIdx.x; F.lane = F.tid & 63; F.wave = __builtin_amdgcn_readfirstlane(F.tid >> 6); F.bid = blockIdx.x; F.G = gridDim.x;
    F.ws = args.ws; F.ctl = (unsigned*)(GAS unsigned*)(args.ws + WS_CTL); F.out = (float*)args.out;
    F.in = args.in; const int wave0 = F.wave;
    if (F.tid < 32) F.MISC[F.tid] = 0u;
    __syncthreads();
    XcdBarrier bar; bar.bar = F.ctl + CW_BAR; bar.x = 0; bar.st = nullptr;
    if (!MK_SPLIT) bar = xcd_barrier_post(F.ctl + CW_BAR, F.MISC + 8);

    for (int step_ = args.lo; step_ < args.hi; ++step_) {
        int step = step_; asm volatile("" : "+s"(step));
        { GAS unsigned char* w_ = args.ws; asm volatile("" : "+s"(w_)); F.ws = w_; F.ctl = (unsigned*)(GAS unsigned*)(w_ + WS_CTL);
          int b_ = blockIdx.x, g_ = gridDim.x, wv_ = wave0; GAS float* o_ = args.out; asm volatile("" : "+s"(b_), "+s"(g_), "+s"(wv_), "+s"(o_)); F.bid = b_; F.G = g_; F.wave = wv_; F.out = (float*)o_;
          F.tid = 0; F.lane = 0; }
#ifdef ONLY_PH
#define PHON(p) ((p) == ONLY_PH)
#else
#define PHON(p) true
#endif
        if (step == 0) { step_p0(F); if (FAST_ANY) convert_weights(F, 0); }
        else if (step == 1) step_p0_reduce(F);
        else if (step == NSTEPS - 1) { if (PHON(0)) step_a(F, 2); }
        else {
            const int l = (step - 2) / NPH, ph_ = (step - 2) % NPH, ph = (NPH == 8 && ph_ >= 3) ? ph_ + 1 : ph_, phx = ph == 2 ? 23 : ph;
            bf16* const XNp = WSP(bf16, WS_XN); const float* const MODp = WSP(float, WS_MOD);
            if (!PHON(ph)) {} else
            if (ph == 0) { if (FAST_ANY && l > 0) convert_weights(F, l); if (l == 0) for (int rep_ = 1; rep_ < REP_A0; ++rep_) step_a(F, 0); step_a(F, l); }
            else if (ph == 1) {
#if FAST_B
                for (int rep_ = 0; rep_ < REP_B; ++rep_) {
                    run_dense(F, XNp, D, WSP(bf16, WT_IN), T, 2048, D, pg8::EpiBf16{(bf16*)F.ws, 0, 1, G8P(F), 0});
                    run_dense8(F, WSP(unsigned char, WS_XN8), D, WSP(unsigned char, WT_IN) + 2048 * D * 2, T, 2048, D, pg8::EpiBf16{(bf16*)F.ws, 0, 1, G8P(F), 8}); }
#else
                EpiProj E{WSP(bf16, WS_CONV), WSP(bf16, WS_SMALL), WSP(bf16, WS_GA), GBP(F)};
                ngemm<8, false>(F, T, NIN, D, RowLin{XNp, D}, ((const float*)(const GAS float*)F.in[7]) + (size_t)l * D * NIN, nullptr, NIN, nullptr, E);
#endif
            } else if (phx == 23) { for (int rep_ = 0; rep_ < REP_C; ++rep_) step_c(F, l);
#if FAST_D
                for (int rep_ = 0; rep_ < REP_D; ++rep_) {
                run_dense(F, WSP(bf16, WS_SMALL), 512, WSP(bf16, WT_UQ), T, 1024, QL, pg8::EpiQ{WSP(unsigned char, WS_Q), WSP(bf16, WS_SMALL), WSP(f32x2, WS_ROPE), ((const float*)(const GAS float*)F.in[13]) + l * DQK, F.lds});
                run_dense(F, WSP(bf16, WS_SMALL) + 256, 512, WSP(bf16, WT_UKV), T, 1024, KVL, pg8::EpiKV{WSP(unsigned char, WS_K), WSP(unsigned char, WS_V), WSP(bf16, WS_SMALL), WSP(f32x2, WS_ROPE), ((const float*)(const GAS float*)F.in[14]) + l * DQK, F.lds}); }
#else
                ngemm<8, false>(F, T, 768, QL, RowLin{WSP(bf16, WS_SMALL), 512}, ((const float*)(const GAS float*)F.in[10]) + (size_t)l * QL * 768, nullptr, 768, ((const float*)(const GAS float*)F.in[9]) + l * QL, EpiStore{WSP(bf16, WS_QRAW), 768});
                ngemm<8, false>(F, T, 1024, KVL, RowLin{WSP(bf16, WS_SMALL) + 256, 512}, ((const float*)(const GAS float*)F.in[12]) + (size_t)l * KVL * 1024, nullptr, 1024, ((const float*)(const GAS float*)F.in[11]) + l * KVL, EpiStore{WSP(bf16, WS_KVRAW), 1024});
#endif
            } else if (ph == 3) {
#if !FAST_D
                for (int rep_ = 0; rep_ < REP_E; ++rep_) step_e(F, l);
#endif
#if FAST_G
#else
                ngemm<8, false>(F, T, D, CW, RowLin{WSP(bf16, WS_U), CW}, ((const float*)(const GAS float*)F.in[15]) + (size_t)l * CW * D, nullptr, D, nullptr, EpiGate1{WSP(bf16, WS_GA)});
#endif
            } else if (ph == 4) { for (int rep_ = 0; rep_ < REP_F; ++rep_) { if (FAST_ATTN && attn_static_ok(F, l)) step_f_fast(F); else step_f(F); }
            } else if (ph == 5) {
#if FAST_H
                run_dense8_single(F, WSP(unsigned char, WS_U), 1024, WSP(unsigned char, WT_CO), T, D, 1024, pg8::EpiGateFused{G8P(F), G8P(F) + (size_t)T * D, WSP(unsigned char, WS_GA)});
#else
                ngemm<8, false>(F, T, D, 512, RowLin{WSP(bf16, WS_O), 512}, ((const float*)(const GAS float*)F.in[16]) + (size_t)l * 512 * D, nullptr, D, nullptr, EpiGate2{WSP(bf16, WS_GA), GBP(F)});
#endif
            } else if (ph == 6) {
#if FAST_I
                run_dense8(F, WSP(unsigned char, WS_GA), D, WSP(unsigned char, WT_O), T, D, D, pg8::EpiRes16{l == 0 ? ((const float*)(const GAS float*)F.in[0]) : nullptr, WSP(bf16, WS_X16), MODp + (size_t)l * 2 * 6 * D + 2 * D});
#else
                ngemm<8, false>(F, T, D, D, RowLin{WSP(bf16, WS_GA), D}, ((const float*)(const GAS float*)F.in[17]) + (size_t)l * D * D, nullptr, D, nullptr,
                                EpiRes{l == 0 ? ((const float*)(const GAS float*)F.in[0]) : F.out, F.out, MODp + (size_t)l * 2 * 6 * D + 2 * D});
#endif
            } else if (ph == 7) { for (int rep_ = 1; rep_ < REP_J; ++rep_) step_j(F, l, true); if (USE_OLD_J) step_j_old(F, l); else step_j(F, l);
            } else {
                compute_bases(F, l);
                const LAS unsigned* tb = (const LAS unsigned*)(F.lds + TB_OFF); const LAS unsigned* cnt = tb + 32;
                unsigned* kf = F.ctl + CW_KF + 256 * l;
                pg8::MoeOrderX S; S.MT = (int)__builtin_amdgcn_readfirstlane(tb[17]); S.G = F.G; S.c = F.bid; S.tb = tb; S.cnt = cnt; S.te = (const LAS unsigned*)(F.lds + TE_OFF); S.LIST = WSP(int, WS_LIST); S.kN = 2; S.flags = kf; S.bar = F.ctl + CW_BAR;
                S.A = (const char*)XNp; S.Bt = (const char*)WSP(bf16, WT_GU); S.estride = (size_t)512 * D; S.lda = D; S.K = D / 2; S.nN = 2; S.gather = true; S.mode = 0;
                for (int i0 = 0; ; ++i0) { pg8::Unit tu_; if (!S.next(i0, tu_, 1)) break;
                    fresh_tid(F);
                    pg8::gemm_phase<pg8::EpiAct, pg8::MoeOrderX1, true, true>(F.lds, F.tid, pg8::Gemm{(unsigned)D, D / 2}, pg8::MoeOrderX1{S, i0}, pg8::EpiAct{WSP(bf16, WS_A2), WSP(float, WS_TOKW), kf}); }
                S.A = (const char*)WSP(bf16, WS_A2); S.Bt = (const char*)WSP(bf16, WT_DN); S.estride = (size_t)D * DE; S.lda = DE; S.K = DE / 2; S.nN = 4; S.gather = false; S.mode = 1;
                fresh_tid(F);
                pg8::gemm_phase<pg8::EpiY8, pg8::MoeOrderX, false, true>(F.lds, F.tid, pg8::Gemm{(unsigned)DE, DE / 2, 0x7a7a7a7a, 0x7c7c7c7c}, S, pg8::EpiY8{WSP(unsigned char, WS_Y)});
            }
        }
        if (step_ + 1 < args.hi) for (int rep_ = 0; rep_ < REP_BAR; ++rep_) xcd_barrier(bar);
    }
}

extern "C" void kernel_launch(void* const* d_in, const int* in_sizes, int n_in, void* d_out, int out_size, void* d_ws, size_t ws_size, hipStream_t stream) {
    static int grid = 0;
    if (grid == 0) {
        if (n_in != 26 || in_sizes[0] != T * D || out_size != T * D || ws_size < WS_END) {
            fprintf(stderr, "kernel_launch: unexpected shapes: n_in %d in0 %d out %d ws %zu (need >= %zu)\n", n_in, n_in > 0 ? in_sizes[0] : -1, out_size, ws_size, (size_t)WS_END); grid = -1; return; }
        int dev = 0, cus = 0;
        if (hipGetDevice(&dev) != hipSuccess || hipDeviceGetAttribute(&cus, hipDeviceAttributeMultiprocessorCount, dev) != hipSuccess) { grid = -1; return; }
        if (hipFuncSetAttribute((const void*)mk_fwd, hipFuncAttributeMaxDynamicSharedMemorySize, LDS_BYTES) != hipSuccess) { fprintf(stderr, "kernel_launch: hipFuncSetAttribute failed\n"); grid = -1; return; }
        int per_cu = 0;
        if (hipOccupancyMaxActiveBlocksPerMultiprocessor(&per_cu, (const void*)mk_fwd, NTHREADS, LDS_BYTES) != hipSuccess || per_cu < 1)
            fprintf(stderr, "kernel_launch: note: occupancy query reports %d blocks/CU\n", per_cu);
        (void)hipGetLastError();
        grid = cus;
    }
    if (grid < 0) return;
    if (hipMemsetAsync((char*)d_ws + WS_CTL, 0, CTL_ZERO_BYTES, stream) != hipSuccess) { fprintf(stderr, "kernel_launch: memset failed\n"); return; }
    Args a{};
    for (int i = 0; i < 26; ++i) a.in[i] = (const GAS void*)d_in[i];
    a.out = (GAS float*)d_out; a.ws = (GAS unsigned char*)d_ws;
#if MK_SPLIT
    for (int s = 0; s < NSTEPS; ++s) { a.lo = s; a.hi = s + 1; hipLaunchKernelGGL(mk_fwd, dim3(grid), dim3(NTHREADS), LDS_BYTES, stream, a); }
#else
    a.lo = 0; a.hi = NSTEPS;
    hipLaunchKernelGGL(mk_fwd, dim3(grid), dim3(NTHREADS), LDS_BYTES, stream, a);
#endif
    const hipError_t le = hipPeekAtLastError();
    if (le != hipSuccess) fprintf(stderr, "kernel_launch: launch failed: %s\n", hipGetErrorName(le));
}
```
